# Optimizing an MI355X kernel written in HIP

```python
import math
import jax, jax.numpy as jnp
from jax import lax
import numpy as np

D_MODEL = 2048
BATCH = 2
SEQ = 4096
DEPTH = 1

HEAD_DIM = 128
D_MIX = D_MODEL
RET_WIDTH = D_MIX // 2
FOX_WIDTH = D_MIX - RET_WIDTH
RET_HEADS = RET_WIDTH // HEAD_DIM
FOX_HEADS = FOX_WIDTH // HEAD_DIM
RET_CHUNK = 128
FOX_BLOCK = 128
ROPE_BASE = 10000.0
N_GROUPS = 4
EXPERTS_PER_GROUP = 8
N_EXPERTS = N_GROUPS * EXPERTS_PER_GROUP
TOP_K_FINE = 2
D_EXPERT = D_MODEL // 4
N_MOD = 6
EPS = 1e-6
IN_COLS = 4 * RET_WIDTH + 3 * FOX_WIDTH + FOX_HEADS

kernel_name = "hybrid_retention_fox_hmoe_layer"


def rms_norm(x, w):
    xf = x.astype(jnp.float32)
    y = xf * lax.rsqrt(jnp.mean(xf * xf, axis=-1, keepdims=True) + EPS)
    return y.astype(x.dtype) * w


def head_rms(x):
    xf = x.astype(jnp.float32)
    return (xf * lax.rsqrt(jnp.mean(xf * xf, axis=-1, keepdims=True) + EPS)).astype(x.dtype)


def head_layer_norm(x):
    xf = x.astype(jnp.float32)
    mu = jnp.mean(xf, axis=-1, keepdims=True)
    var = jnp.mean(jnp.square(xf - mu), axis=-1, keepdims=True)
    return ((xf - mu) * lax.rsqrt(var + EPS)).astype(x.dtype)


def split_heads(t, n_heads):
    b, s, _ = t.shape
    return t.reshape(b, s, n_heads, HEAD_DIM).transpose(0, 2, 1, 3)


def merge_heads(t):
    b, h, s, d = t.shape
    return t.transpose(0, 2, 1, 3).reshape(b, s, h * d)


def rope(x, cos, sin):
    x1, x2 = jnp.split(x, 2, axis=-1)
    return jnp.concatenate([x1 * cos - x2 * sin, x1 * sin + x2 * cos], axis=-1)


def retention_chunkwise(q, k, v):
    b, h, s, dh = q.shape
    c = RET_CHUNK
    n = s // c
    log_gamma = jnp.log1p(-jnp.exp2(-5.0 - jnp.arange(h, dtype=jnp.float32)))
    k = k * (dh ** -0.5)
    qc = q.reshape(b, h, n, c, dh)
    kc = k.reshape(b, h, n, c, dh)
    vc = v.reshape(b, h, n, c, dh)
    pos = jnp.arange(c, dtype=jnp.float32)
    diff = pos[:, None] - pos[None, :]
    decay = jnp.where(diff >= 0,
                      jnp.exp(log_gamma[:, None, None] * jnp.maximum(diff, 0.0)[None]),
                      0.0)
    zeta = jnp.exp(log_gamma[:, None] * (c - 1 - pos)[None])
    xi = jnp.exp(log_gamma[:, None] * (pos + 1)[None])
    chunk_decay = jnp.exp(log_gamma * c)
    scores = jnp.einsum('bhnid,bhnjd->bhnij', qc, kc) * decay[None, :, None]
    intra = jnp.einsum('bhnij,bhnjd->bhnid', scores, vc)
    kv = jnp.einsum('bhncd,bhnce->nbhde', kc * zeta[None, :, None, :, None], vc)

    def step(state, kv_n):
        return state * chunk_decay[None, :, None, None] + kv_n, state

    _, prev_states = lax.scan(step, jnp.zeros((b, h, dh, dh), kv.dtype), kv)
    cross = jnp.einsum('bhncd,nbhde->bhnce', qc, prev_states) * xi[None, :, None, :, None]
    return (intra + cross).reshape(b, h, s, dh)


def forgetting_attention(q, k, v, log_f):
    b, h, s, dh = q.shape
    nb = s // FOX_BLOCK
    cum = jnp.cumsum(log_f, axis=-1)
    qb = q.reshape(b, h, nb, FOX_BLOCK, dh).transpose(2, 0, 1, 3, 4)
    cb = cum.reshape(b, h, nb, FOX_BLOCK).transpose(2, 0, 1, 3)
    kpos = jnp.arange(s)
    scale = dh ** -0.5

    def block(args):
        i, q_i, c_i = args
        qpos = i * FOX_BLOCK + jnp.arange(FOX_BLOCK)
        logits = jnp.einsum('bhqd,bhkd->bhqk', q_i, k).astype(jnp.float32) * scale
        logits = logits + c_i[..., :, None] - cum[..., None, :]
        logits = jnp.where(kpos[None, :] <= qpos[:, None], logits, -jnp.inf)
        p = jax.nn.softmax(logits, axis=-1)
        return jnp.einsum('bhqk,bhkd->bhqd', p.astype(v.dtype), v)

    out = lax.map(block, (jnp.arange(nb), qb, cb))
    return out.transpose(1, 2, 0, 3, 4).reshape(b, h, s, dh)


def hybrid_mixer(h, w_in, fox_f_bias, ret_gn_w, fox_qn_w, fox_kn_w, fox_on_w, w_out, cos, sin):
    proj = h @ w_in
    r = RET_WIDTH
    f = FOX_WIDTH
    cuts = [r, 2 * r, 3 * r, 4 * r, 4 * r + f, 4 * r + 2 * f, 4 * r + 3 * f]
    rq, rk, rv, rg, fq, fk, fv, fgl = jnp.split(proj, cuts, axis=-1)
    rq = rope(split_heads(rq, RET_HEADS), cos, sin)
    rk = rope(split_heads(rk, RET_HEADS), cos, sin)
    rv = split_heads(rv, RET_HEADS)
    ret = merge_heads(head_layer_norm(retention_chunkwise(rq, rk, rv))) * ret_gn_w
    ret = jax.nn.silu(rg) * ret
    fq = head_rms(split_heads(fq, FOX_HEADS)) * fox_qn_w
    fk = head_rms(split_heads(fk, FOX_HEADS)) * fox_kn_w
    fv = split_heads(fv, FOX_HEADS)
    log_f = jax.nn.log_sigmoid(fgl.astype(jnp.float32) + fox_f_bias).transpose(0, 2, 1)
    fox = merge_heads(head_rms(forgetting_attention(fq, fk, fv, log_f))) * fox_on_w
    return jnp.concatenate([ret, fox], axis=-1) @ w_out


def hierarchical_moe(h, router_coarse_w, router_coarse_b, router_fine_w, router_fine_b, w1, w3, w2):
    b, s, d = h.shape
    t = h.reshape(b * s, d)
    coarse = (t @ router_coarse_w).astype(jnp.float32) + router_coarse_b
    g_prob, g_idx = lax.top_k(jax.nn.softmax(coarse, axis=-1), 1)
    fine = ((t @ router_fine_w).astype(jnp.float32) + router_fine_b).reshape(-1, N_GROUPS, EXPERTS_PER_GROUP)
    fine_sel = jnp.take_along_axis(fine, g_idx[:, :, None], axis=1)[:, 0]
    f_val, f_idx = lax.top_k(fine_sel, TOP_K_FINE)
    weights = g_prob * jax.nn.softmax(f_val, axis=-1)
    expert_id = g_idx * EXPERTS_PER_GROUP + f_idx
    combine = jnp.sum(jax.nn.one_hot(expert_id, N_EXPERTS, dtype=jnp.float32) * weights[..., None], axis=1)
    combine = combine.astype(t.dtype)

    def expert_step(acc, xs):
        w1_e, w3_e, w2_e, c_e = xs
        y = (jax.nn.silu(t @ w1_e) * (t @ w3_e)) @ w2_e
        return acc + c_e[:, None] * y, None

    acc, _ = lax.scan(expert_step, jnp.zeros_like(t), (w1, w3, w2, combine.T))
    return acc.reshape(b, s, d)


def setup_inputs(seed: int = 0) -> dict:
    key = jax.random.key(seed)
    ks = jax.random.split(key, 24)
    f32 = jnp.float32
    dm = D_MODEL
    nrm = lambda k, shape, sc: jax.random.normal(k, shape, f32) * sc
    gain = lambda k, shape: 1.0 + 0.02 * jax.random.normal(k, shape, f32)
    w_in_main = nrm(ks[2], (DEPTH, dm, IN_COLS - FOX_HEADS), dm ** -0.5)
    w_in_forget = nrm(ks[3], (DEPTH, dm, FOX_HEADS), 0.1 * dm ** -0.5)
    return {
        "x": jax.random.normal(ks[0], (BATCH, SEQ, dm), f32),
        "c": jax.random.normal(ks[1], (BATCH, dm), f32),
        "ada_w": nrm(ks[4], (DEPTH, dm, N_MOD * dm), 0.5 * dm ** -0.5),
        "ada_b": nrm(ks[5], (DEPTH, N_MOD * dm), 0.01),
        "norm_pre_mix": gain(ks[6], (DEPTH, dm)),
        "norm_post_mix": gain(ks[7], (DEPTH, dm)),
        "w_in": jnp.concatenate([w_in_main, w_in_forget], axis=-1),
        "fox_f_bias": 2.0 + 4.0 * jax.random.uniform(ks[8], (DEPTH, FOX_HEADS), f32),
        "ret_gn_w": gain(ks[9], (DEPTH, RET_WIDTH)),
        "fox_qn_w": gain(ks[10], (DEPTH, HEAD_DIM)),
        "fox_kn_w": gain(ks[11], (DEPTH, HEAD_DIM)),
        "fox_on_w": gain(ks[12], (DEPTH, FOX_WIDTH)),
        "w_out": nrm(ks[13], (DEPTH, D_MIX, dm), D_MIX ** -0.5),
        "norm_pre_ffn": gain(ks[14], (DEPTH, dm)),
        "norm_post_ffn": gain(ks[15], (DEPTH, dm)),
        "router_coarse_w": nrm(ks[16], (DEPTH, dm, N_GROUPS), dm ** -0.5),
        "router_coarse_b": nrm(ks[17], (DEPTH, N_GROUPS), 0.01),
        "router_fine_w": nrm(ks[18], (DEPTH, dm, N_EXPERTS), dm ** -0.5),
        "router_fine_b": nrm(ks[19], (DEPTH, N_EXPERTS), 0.01),
        "w1": nrm(ks[20], (DEPTH, N_EXPERTS, dm, D_EXPERT), dm ** -0.5),
        "w3": nrm(ks[21], (DEPTH, N_EXPERTS, dm, D_EXPERT), dm ** -0.5),
        "w2": nrm(ks[22], (DEPTH, N_EXPERTS, D_EXPERT, dm), D_EXPERT ** -0.5),
    }


def reference(x, c, ada_w, ada_b, norm_pre_mix, norm_post_mix, w_in, fox_f_bias, ret_gn_w,
              fox_qn_w, fox_kn_w, fox_on_w, w_out, norm_pre_ffn, norm_post_ffn,
              router_coarse_w, router_coarse_b, router_fine_w, router_fine_b, w1, w3, w2):
    s = x.shape[1]
    inv_freq = ROPE_BASE ** (-jnp.arange(0, HEAD_DIM, 2, dtype=jnp.float32) / HEAD_DIM)
    angle = jnp.arange(s, dtype=jnp.float32)[:, None] * inv_freq[None, :]
    cos = jnp.cos(angle).astype(x.dtype)
    sin = jnp.sin(angle).astype(x.dtype)
    c_act = jax.nn.silu(c)
    for l in range(DEPTH):
        mod = c_act @ ada_w[l] + ada_b[l]
        sh1, sc1, g1, sh2, sc2, g2 = [m[:, None, :] for m in jnp.split(mod, N_MOD, axis=-1)]
        h = rms_norm(x, norm_pre_mix[l]) * (1.0 + sc1) + sh1
        y = hybrid_mixer(h, w_in[l], fox_f_bias[l], ret_gn_w[l], fox_qn_w[l], fox_kn_w[l],
                         fox_on_w[l], w_out[l], cos, sin)
        x = x + g1 * rms_norm(y, norm_post_mix[l])
        h = rms_norm(x, norm_pre_ffn[l]) * (1.0 + sc2) + sh2
        y = hierarchical_moe(h, router_coarse_w[l], router_coarse_b[l], router_fine_w[l],
                             router_fine_b[l], w1[l], w3[l], w2[l])
        x = x + g2 * rms_norm(y, norm_post_ffn[l])
    return x
```

```cpp
#include <hip/hip_runtime.h>
#include <stdint.h>

constexpr int DM = 2048, NB = 2, SEQ = 4096, T = NB * SEQ;
constexpr int HD = 128, RW = 1024, FW = 1024, NH = 8;
constexpr int INC = 7176;
constexpr int NE = 32, DE = 512;
constexpr float EPS = 1e-6f;

__device__ __forceinline__ float silu_f(float v) { return v / (1.f + __expf(-v)); }
__device__ __forceinline__ float wave_sum(float v) {
#pragma unroll
    for (int o = 1; o < 64; o <<= 1) v += __shfl_xor(v, o);
    return v;
}
__device__ __forceinline__ float block_sum(float v, float* sm) {
    const int lane = threadIdx.x & 63, w = threadIdx.x >> 6, nw = blockDim.x >> 6;
    v = wave_sum(v);
    __syncthreads();
    if (lane == 0) sm[w] = v;
    __syncthreads();
    float s = 0.f;
    for (int i = 0; i < nw; ++i) s += sm[i];
    return s;
}
__device__ __forceinline__ float block_max(float v, float* sm) {
    const int lane = threadIdx.x & 63, w = threadIdx.x >> 6, nw = blockDim.x >> 6;
#pragma unroll
    for (int o = 1; o < 64; o <<= 1) v = fmaxf(v, __shfl_xor(v, o));
    __syncthreads();
    if (lane == 0) sm[w] = v;
    __syncthreads();
    float s = sm[0];
    for (int i = 1; i < nw; ++i) s = fmaxf(s, sm[i]);
    return s;
}

__global__ void k_mod(const float* __restrict__ c, const float* __restrict__ ada_w, const float* __restrict__ ada_b, float* __restrict__ mod) {
    __shared__ float ca[NB][DM];
    for (int i = threadIdx.x; i < NB * DM; i += blockDim.x) ca[i / DM][i % DM] = silu_f(c[i]);
    __syncthreads();
    const int j = blockIdx.x * blockDim.x + threadIdx.x;
    if (j >= 6 * DM) return;
    float a0 = 0.f, a1 = 0.f;
    for (int i = 0; i < DM; ++i) { const float w = ada_w[(size_t)i * (6 * DM) + j]; a0 = fmaf(ca[0][i], w, a0); a1 = fmaf(ca[1][i], w, a1); }
    mod[j] = a0 + ada_b[j]; mod[6 * DM + j] = a1 + ada_b[j];
}

__global__ void k_prenorm(const float* __restrict__ x, const float* __restrict__ w, const float* __restrict__ mod, int sh_off, int sc_off, float* __restrict__ h) {
    __shared__ float sm[32];
    const int row = blockIdx.x, b = row / SEQ;
    const float* xr = x + (size_t)row * DM;
    float s = 0.f;
    for (int i = threadIdx.x; i < DM; i += blockDim.x) { const float v = xr[i]; s += v * v; }
    s = block_sum(s, sm);
    const float rstd = rsqrtf(s / DM + EPS);
    const float* sh = mod + (size_t)b * 6 * DM + sh_off; const float* sc = mod + (size_t)b * 6 * DM + sc_off;
    for (int i = threadIdx.x; i < DM; i += blockDim.x) h[(size_t)row * DM + i] = xr[i] * rstd * w[i] * (1.f + sc[i]) + sh[i];
}

__global__ void __launch_bounds__(256) k_gemm(const float* __restrict__ A, int lda, const float* __restrict__ B, int ldb, size_t strideB,
                                              float* __restrict__ C, int ldc, int M, int N, int K,
                                              const int* __restrict__ seg_off, const int* __restrict__ seg_cnt, const int* __restrict__ arows) {
    __shared__ float As[16][68];
    __shared__ float Bs[16][68];
    const int z = blockIdx.z;
    int r0 = 0, cnt = M;
    if (seg_off) { r0 = seg_off[z]; cnt = seg_cnt[z]; }
    const int m0 = blockIdx.y * 64, n0 = blockIdx.x * 64;
    if (m0 >= cnt) return;
    const float* Bz = B + (size_t)z * strideB;
    const int tid = threadIdx.x, tx = tid & 15, ty = tid >> 4;
    float acc[4][4] = {};
    const int arow = tid >> 2, akq = (tid & 3) * 4;
    const bool a_ok = (m0 + arow) < cnt;
    size_t a_src = 0;
    if (a_ok) { const int r = r0 + m0 + arow; a_src = (size_t)(arows ? arows[r] : r) * lda; }
    const int bk = tid >> 4, bn = (tid & 15) * 4;
    const bool b_ok = (n0 + bn) < N;
    for (int k0 = 0; k0 < K; k0 += 16) {
        float4 av = make_float4(0.f, 0.f, 0.f, 0.f), bv = make_float4(0.f, 0.f, 0.f, 0.f);
        if (a_ok) av = *(const float4*)(A + a_src + k0 + akq);
        if (b_ok) bv = *(const float4*)(Bz + (size_t)(k0 + bk) * ldb + n0 + bn);
        __syncthreads();
        As[akq + 0][arow] = av.x; As[akq + 1][arow] = av.y; As[akq + 2][arow] = av.z; As[akq + 3][arow] = av.w;
        Bs[bk][bn + 0] = bv.x; Bs[bk][bn + 1] = bv.y; Bs[bk][bn + 2] = bv.z; Bs[bk][bn + 3] = bv.w;
        __syncthreads();
#pragma unroll
        for (int kk = 0; kk < 16; ++kk) {
            float a[4], b[4];
#pragma unroll
            for (int i = 0; i < 4; ++i) { a[i] = As[kk][ty * 4 + i]; b[i] = Bs[kk][tx * 4 + i]; }
#pragma unroll
            for (int i = 0; i < 4; ++i)
#pragma unroll
                for (int j = 0; j < 4; ++j) acc[i][j] = fmaf(a[i], b[j], acc[i][j]);
        }
    }
#pragma unroll
    for (int i = 0; i < 4; ++i) {
        const int m = m0 + ty * 4 + i;
        if (m >= cnt) continue;
#pragma unroll
        for (int j = 0; j < 4; ++j) { const int n = n0 + tx * 4 + j; if (n < N) C[(size_t)(r0 + m) * ldc + n] = acc[i][j]; }
    }
}

__global__ void k_post_inproj(const float* __restrict__ proj, const float* __restrict__ fox_f_bias, const float* __restrict__ qn_w, const float* __restrict__ kn_w,
                              float* __restrict__ RQ, float* __restrict__ RK, float* __restrict__ FQ, float* __restrict__ FK, float* __restrict__ logf) {
    __shared__ float sm[32];
    const int tok = blockIdx.x >> 3, hh = blockIdx.x & 7, d = threadIdx.x;
    const int b = tok / SEQ, s = tok % SEQ;
    const float* p = proj + (size_t)tok * INC;
    {
        const int i = d & 63;
        const float inv_freq = powf(10000.f, -(float)(2 * i) / 128.f);
        const float ang = (float)s * inv_freq;
        const float cs = cosf(ang), sn = sinf(ang);
        const float q1 = p[0 * 1024 + hh * 128 + i], q2 = p[0 * 1024 + hh * 128 + 64 + i];
        const float k1 = p[1 * 1024 + hh * 128 + i], k2 = p[1 * 1024 + hh * 128 + 64 + i];
        const float qo = (d < 64) ? (q1 * cs - q2 * sn) : (q1 * sn + q2 * cs);
        const float ko = (d < 64) ? (k1 * cs - k2 * sn) : (k1 * sn + k2 * cs);
        RQ[(size_t)tok * 1024 + hh * 128 + d] = qo;
        RK[(size_t)tok * 1024 + hh * 128 + d] = ko * 0.08838834764831845f;
    }
    {
        const float q = p[4096 + hh * 128 + d], k = p[5120 + hh * 128 + d];
        const float sq = block_sum(q * q, sm);
        const float sk = block_sum(k * k, sm);
        FQ[(size_t)tok * 1024 + hh * 128 + d] = q * rsqrtf(sq / 128.f + EPS) * qn_w[d];
        FK[(size_t)tok * 1024 + hh * 128 + d] = k * rsqrtf(sk / 128.f + EPS) * kn_w[d];
    }
    if (d == 0) {
        const float z = p[7168 + hh] + fox_f_bias[hh];
        const float ls = fminf(z, 0.f) - log1pf(expf(-fabsf(z)));
        logf[((size_t)b * NH + hh) * SEQ + s] = ls;
    }
}

__global__ void k_cumsum(const float* __restrict__ logf, float* __restrict__ cum) {
    const int bh = blockIdx.x * blockDim.x + threadIdx.x;
    if (bh >= NB * NH) return;
    float a = 0.f;
    for (int s = 0; s < SEQ; ++s) { a += logf[(size_t)bh * SEQ + s]; cum[(size_t)bh * SEQ + s] = a; }
}

__global__ void __launch_bounds__(128) k_attn(int mode, const float* __restrict__ Q, const float* __restrict__ Kt, const float* __restrict__ proj,
                                              const float* __restrict__ cum, const float* __restrict__ gn_w, const float* __restrict__ on_w, float* __restrict__ cat) {
    __shared__ float sc[SEQ];
    __shared__ float qs[HD];
    __shared__ float sm[32];
    const int q = blockIdx.x % SEQ, hh = (blockIdx.x / SEQ) % NH, b = blockIdx.x / (SEQ * NH);
    const int t = threadIdx.x;
    const size_t tokq = (size_t)b * SEQ + q;
    qs[t] = Q[tokq * 1024 + hh * 128 + t];
    __syncthreads();
    const int voff = (mode == 0) ? (2048 + hh * 128) : (6144 + hh * 128);
    const float lg = log1pf(-exp2f(-5.f - (float)hh));
    const float* cm = cum + ((size_t)b * NH + hh) * SEQ;
    const float cq = (mode == 1) ? cm[q] : 0.f;
    float lmax = -3.0e38f;
    for (int k = t; k <= q; k += 128) {
        const float* kr = Kt + ((size_t)b * SEQ + k) * 1024 + hh * 128;
        float a = 0.f;
#pragma unroll 8
        for (int d = 0; d < HD; d += 4) { const float4 kv = *(const float4*)(kr + d); a = fmaf(qs[d], kv.x, a); a = fmaf(qs[d + 1], kv.y, a); a = fmaf(qs[d + 2], kv.z, a); a = fmaf(qs[d + 3], kv.w, a); }
        float v;
        if (mode == 0) v = a * expf(lg * (float)(q - k));
        else { v = a * 0.08838834764831845f + cq - cm[k]; lmax = fmaxf(lmax, v); }
        sc[k] = v;
    }
    float denom = 1.f;
    if (mode == 1) {
        const float mx = block_max(lmax, sm);
        float ls = 0.f;
        for (int k = t; k <= q; k += 128) { const float e = expf(sc[k] - mx); sc[k] = e; ls += e; }
        denom = block_sum(ls, sm);
    }
    __syncthreads();
    float o = 0.f;
    for (int k = 0; k <= q; ++k) o = fmaf(sc[k], proj[((size_t)b * SEQ + k) * INC + voff + t], o);
    o /= denom;
    if (mode == 0) {
        const float mu = block_sum(o, sm) / 128.f;
        const float dv = o - mu;
        const float var = block_sum(dv * dv, sm) / 128.f;
        const float y = dv * rsqrtf(var + EPS) * gn_w[hh * 128 + t];
        const float g = proj[tokq * INC + 3072 + hh * 128 + t];
        cat[tokq * DM + hh * 128 + t] = silu_f(g) * y;
    } else {
        const float ms = block_sum(o * o, sm) / 128.f;
        cat[tokq * DM + 1024 + hh * 128 + t] = o * rsqrtf(ms + EPS) * on_w[hh * 128 + t];
    }
}

__global__ void k_resid_norm(const float* __restrict__ x, const float* __restrict__ y, const float* __restrict__ w, const float* __restrict__ mod, int g_off, float* __restrict__ out) {
    __shared__ float sm[32];
    const int row = blockIdx.x, b = row / SEQ;
    const float* yr = y + (size_t)row * DM;
    float s = 0.f;
    for (int i = threadIdx.x; i < DM; i += blockDim.x) { const float v = yr[i]; s += v * v; }
    s = block_sum(s, sm);
    const float rstd = rsqrtf(s / DM + EPS);
    const float* g = mod + (size_t)b * 6 * DM + g_off;
    for (int i = threadIdx.x; i < DM; i += blockDim.x) out[(size_t)row * DM + i] = x[(size_t)row * DM + i] + g[i] * (yr[i] * rstd * w[i]);
}

__global__ void __launch_bounds__(256) k_router(const float* __restrict__ h2, const float* __restrict__ rcw, const float* __restrict__ rcb, const float* __restrict__ rfw, const float* __restrict__ rfb,
                                                 int* __restrict__ cnt, int* __restrict__ slot_e, int* __restrict__ slot_pos, float* __restrict__ slot_w) {
    __shared__ float red[4][36];
    __shared__ float lg[36];
    const int tok = blockIdx.x, tid = threadIdx.x, lane = tid & 63, w = tid >> 6;
    float acc[36];
#pragma unroll
    for (int j = 0; j < 36; ++j) acc[j] = 0.f;
    for (int k = tid; k < DM; k += 256) {
        const float hv = h2[(size_t)tok * DM + k];
#pragma unroll
        for (int j = 0; j < 4; ++j) acc[j] = fmaf(hv, rcw[k * 4 + j], acc[j]);
#pragma unroll
        for (int j = 0; j < 32; ++j) acc[4 + j] = fmaf(hv, rfw[k * 32 + j], acc[4 + j]);
    }
#pragma unroll
    for (int j = 0; j < 36; ++j) { const float s = wave_sum(acc[j]); if (lane == 0) red[w][j] = s; }
    __syncthreads();
    if (tid < 36) lg[tid] = red[0][tid] + red[1][tid] + red[2][tid] + red[3][tid] + (tid < 4 ? rcb[tid] : rfb[tid - 4]);
    __syncthreads();
    if (tid == 0) {
        int g = 0; float mx = lg[0];
        for (int j = 1; j < 4; ++j) if (lg[j] > mx) { mx = lg[j]; g = j; }
        float den = 0.f;
        for (int j = 0; j < 4; ++j) den += expf(lg[j] - mx);
        const float gprob = 1.f / den;
        const float* f = lg + 4 + g * 8;
        int i0 = 0; float v0 = f[0];
        for (int j = 1; j < 8; ++j) if (f[j] > v0) { v0 = f[j]; i0 = j; }
        int i1 = -1; float v1 = -3.0e38f;
        for (int j = 0; j < 8; ++j) if (j != i0 && f[j] > v1) { v1 = f[j]; i1 = j; }
        const float e1 = expf(v1 - v0);
        const float w0 = gprob / (1.f + e1), w1 = gprob * e1 / (1.f + e1);
        const int ea = g * 8 + i0, eb = g * 8 + i1;
        slot_e[tok * 2 + 0] = ea; slot_pos[tok * 2 + 0] = atomicAdd(&cnt[ea], 1); slot_w[tok * 2 + 0] = w0;
        slot_e[tok * 2 + 1] = eb; slot_pos[tok * 2 + 1] = atomicAdd(&cnt[eb], 1); slot_w[tok * 2 + 1] = w1;
    }
}
__global__ void k_offsets(const int* __restrict__ cnt, int* __restrict__ off) {
    if (threadIdx.x == 0 && blockIdx.x == 0) { int a = 0; for (int e = 0; e < NE; ++e) { off[e] = a; a += cnt[e]; } }
}
__global__ void k_scatter(const int* __restrict__ slot_e, const int* __restrict__ slot_pos, const int* __restrict__ off, int* __restrict__ row_tok, int* __restrict__ slot_row) {
    const int i = blockIdx.x * blockDim.x + threadIdx.x;
    if (i >= 2 * T) return;
    const int r = off[slot_e[i]] + slot_pos[i];
    row_tok[r] = i >> 1; slot_row[i] = r;
}
__global__ void k_swiglu(const float* __restrict__ U, const float* __restrict__ V, float* __restrict__ G, size_t n) {
    const size_t i = (size_t)blockIdx.x * blockDim.x + threadIdx.x;
    if (i < n) G[i] = silu_f(U[i]) * V[i];
}
__global__ void k_final(const float* __restrict__ x1, const float* __restrict__ Y, const int* __restrict__ slot_row, const float* __restrict__ slot_w,
                        const float* __restrict__ w, const float* __restrict__ mod, int g_off, float* __restrict__ out) {
    __shared__ float sm[32];
    __shared__ float yv[DM];
    const int row = blockIdx.x, b = row / SEQ;
    const int r0 = slot_row[row * 2], r1 = slot_row[row * 2 + 1];
    const float w0 = slot_w[row * 2], w1 = slot_w[row * 2 + 1];
    float s = 0.f;
    for (int i = threadIdx.x; i < DM; i += blockDim.x) { const float v = w0 * Y[(size_t)r0 * DM + i] + w1 * Y[(size_t)r1 * DM + i]; yv[i] = v; s += v * v; }
    s = block_sum(s, sm);
    const float rstd = rsqrtf(s / DM + EPS);
    const float* g = mod + (size_t)b * 6 * DM + g_off;
    for (int i = threadIdx.x; i < DM; i += blockDim.x) out[(size_t)row * DM + i] = x1[(size_t)row * DM + i] + g[i] * (yv[i] * rstd * w[i]);
}

extern "C" void kernel_launch(void* const* d_in, const int* in_sizes, int n_in, void* d_out, int out_size, void* d_ws, size_t ws_size, hipStream_t stream) {
    const float* x = (const float*)d_in[0];
    const float* c = (const float*)d_in[1];
    const float* ada_w = (const float*)d_in[2];
    const float* ada_b = (const float*)d_in[3];
    const float* norm_pre_mix = (const float*)d_in[4];
    const float* norm_post_mix = (const float*)d_in[5];
    const float* w_in = (const float*)d_in[6];
    const float* fox_f_bias = (const float*)d_in[7];
    const float* ret_gn_w = (const float*)d_in[8];
    const float* fox_qn_w = (const float*)d_in[9];
    const float* fox_kn_w = (const float*)d_in[10];
    const float* fox_on_w = (const float*)d_in[11];
    const float* w_out = (const float*)d_in[12];
    const float* norm_pre_ffn = (const float*)d_in[13];
    const float* norm_post_ffn = (const float*)d_in[14];
    const float* rcw = (const float*)d_in[15];
    const float* rcb = (const float*)d_in[16];
    const float* rfw = (const float*)d_in[17];
    const float* rfb = (const float*)d_in[18];
    const float* w1 = (const float*)d_in[19];
    const float* w3 = (const float*)d_in[20];
    const float* w2 = (const float*)d_in[21];
    float* out = (float*)d_out;

    char* ws = (char*)d_ws;
    size_t off = 0;
    auto carve = [&](size_t bytes) { char* p = ws + off; off += (bytes + 255) & ~(size_t)255; return p; };
    int* ctl = (int*)carve(4096);
    float* mod = (float*)carve((size_t)NB * 6 * DM * 4);
    int* slot_e = (int*)carve((size_t)2 * T * 4);
    int* slot_pos = (int*)carve((size_t)2 * T * 4);
    float* slot_w = (float*)carve((size_t)2 * T * 4);
    int* slot_row = (int*)carve((size_t)2 * T * 4);
    int* row_tok = (int*)carve((size_t)2 * T * 4);
    float* logf = (float*)carve((size_t)NB * NH * SEQ * 4);
    float* cum = (float*)carve((size_t)NB * NH * SEQ * 4);
    float* proj = (float*)carve((size_t)T * INC * 4);
    float* U = proj;
    float* V = U + (size_t)2 * T * DE;
    float* G = V + (size_t)2 * T * DE;
    float* RQ = (float*)carve((size_t)T * 1024 * 4);
    float* RK = (float*)carve((size_t)T * 1024 * 4);
    float* FQ = (float*)carve((size_t)T * 1024 * 4);
    float* FK = (float*)carve((size_t)T * 1024 * 4);
    float* y = RQ;
    float* x1 = FQ;
    float* h = (float*)carve((size_t)T * DM * 4);
    float* cat = (float*)carve((size_t)T * DM * 4);
    float* Y = h;
    int* cnt = ctl; int* eoff = ctl + 64;

    hipMemsetAsync(ctl, 0, 4096, stream);
    k_mod<<<(6 * DM + 255) / 256, 256, 0, stream>>>(c, ada_w, ada_b, mod);
    k_prenorm<<<T, 256, 0, stream>>>(x, norm_pre_mix, mod, 0 * DM, 1 * DM, h);
    k_gemm<<<dim3((INC + 63) / 64, T / 64, 1), 256, 0, stream>>>(h, DM, w_in, INC, 0, proj, INC, T, INC, DM, nullptr, nullptr, nullptr);
    k_post_inproj<<<T * 8, 128, 0, stream>>>(proj, fox_f_bias, fox_qn_w, fox_kn_w, RQ, RK, FQ, FK, logf);
    k_cumsum<<<1, 64, 0, stream>>>(logf, cum);
    k_attn<<<NB * NH * SEQ, 128, 0, stream>>>(0, RQ, RK, proj, cum, ret_gn_w, fox_on_w, cat);
    k_attn<<<NB * NH * SEQ, 128, 0, stream>>>(1, FQ, FK, proj, cum, ret_gn_w, fox_on_w, cat);
    k_gemm<<<dim3(DM / 64, T / 64, 1), 256, 0, stream>>>(cat, DM, w_out, DM, 0, y, DM, T, DM, DM, nullptr, nullptr, nullptr);
    k_resid_norm<<<T, 256, 0, stream>>>(x, y, norm_post_mix, mod, 2 * DM, x1);
    k_prenorm<<<T, 256, 0, stream>>>(x1, norm_pre_ffn, mod, 3 * DM, 4 * DM, h);
    k_router<<<T, 256, 0, stream>>>(h, rcw, rcb, rfw, rfb, cnt, slot_e, slot_pos, slot_w);
    k_offsets<<<1, 64, 0, stream>>>(cnt, eoff);
    k_scatter<<<(2 * T + 255) / 256, 256, 0, stream>>>(slot_e, slot_pos, eoff, row_tok, slot_row);
    k_gemm<<<dim3(DE / 64, T / 64, NE), 256, 0, stream>>>(h, DM, w1, DE, (size_t)DM * DE, U, DE, 0, DE, DM, eoff, cnt, row_tok);
    k_gemm<<<dim3(DE / 64, T / 64, NE), 256, 0, stream>>>(h, DM, w3, DE, (size_t)DM * DE, V, DE, 0, DE, DM, eoff, cnt, row_tok);
    k_swiglu<<<(2 * T * DE + 255) / 256, 256, 0, stream>>>(U, V, G, (size_t)2 * T * DE);
    k_gemm<<<dim3(DM / 64, T / 64, NE), 256, 0, stream>>>(G, DE, w2, DM, (size_t)DE * DM, Y, DM, 0, DM, DE, eoff, cnt, nullptr);
    k_final<<<T, 256, 0, stream>>>(x1, Y, slot_row, slot_w, norm_post_ffn, mod, 5 * DM, out);
}
```

```cpp
#include <hip/hip_runtime.h>
#include <stdint.h>
#include <cstdio>

constexpr int DM = 2048, NB = 2, SEQ = 4096, T = NB * SEQ;
constexpr int HD = 128, NH = 8;
constexpr int INC = 7176, INCM = 7168;
constexpr int NE = 32, DE = 512;
constexpr float EPS = 1e-6f;
#define GAS __attribute__((address_space(1)))
#define LAS __attribute__((address_space(3)))
typedef unsigned short bf16;
typedef unsigned v4u __attribute__((ext_vector_type(4)));
typedef float f32x4 __attribute__((ext_vector_type(4)));
typedef short bf16x8 __attribute__((ext_vector_type(8)));
typedef GAS unsigned gu32;
typedef GAS unsigned long long gu64;
#define RLX_AGENT __ATOMIC_RELAXED, __HIP_MEMORY_SCOPE_AGENT
#define LDS_WAIT() asm volatile("s_waitcnt lgkmcnt(0)" ::: "memory")
#define VM_WAIT() asm volatile("s_waitcnt vmcnt(0)" ::: "memory")
__device__ __forceinline__ unsigned long long rt() { return __builtin_amdgcn_s_memrealtime(); }
__device__ __forceinline__ unsigned f2bf(float f) { unsigned u = __builtin_bit_cast(unsigned, f); return (u + 0x7fffu + ((u >> 16) & 1u)) >> 16; }
__device__ __forceinline__ unsigned pk2(float lo, float hi) { return f2bf(lo) | (f2bf(hi) << 16); }

#define XB_TMO      128
#define XB_XCNT(j)  (256  + 64 * (j))
#define XB_XSUB(j)  (1280 + 64 * (j))
#define XB_XGEN(j)  (2304 + 64 * (j))
#define XB_TOP      3328
#define XB_TOPGEN   3392
#define XCD_BAR_WORDS 3456
#define XB_SPIN_CAP (1u << 18)

__device__ __forceinline__ unsigned xb_ld(unsigned* p)              { return __hip_atomic_load(p, __ATOMIC_RELAXED, __HIP_MEMORY_SCOPE_AGENT); }
__device__ __forceinline__ unsigned xb_add(unsigned* p, unsigned v) { return __hip_atomic_fetch_add(p, v, __ATOMIC_RELAXED, __HIP_MEMORY_SCOPE_AGENT); }
__device__ __forceinline__ unsigned xb_xcc_id() { return (unsigned)__builtin_amdgcn_s_getreg((3 << 11) | 20) & 0xFu; }
#define XB_SPIN(cond, bar) do { unsigned _sp = 0; while (cond) { __builtin_amdgcn_s_sleep(1); \
    if ((++_sp & 255u) == 0u) { if (xb_ld(&(bar)[XB_TMO])) break; if (_sp > XB_SPIN_CAP) { atomicAdd(&(bar)[XB_TMO], 1u); break; } } } } while (0)

struct XcdBarrier {
    unsigned* bar; unsigned x;
    volatile LAS unsigned* st;
};

__device__ __forceinline__ XcdBarrier xcd_barrier_post(unsigned* bar, volatile LAS unsigned* st) {
    XcdBarrier b; b.bar = bar; b.x = xb_xcc_id(); b.st = st;
    if (threadIdx.x == 0) (void)xb_add(&bar[XB_XCNT(b.x)], 1u);
    return b;
}
__device__ __forceinline__ void xcd_barrier_complete(unsigned* bar, unsigned x, unsigned& nloc, unsigned& nx) {
    const unsigned G = gridDim.x * gridDim.y * gridDim.z;
    unsigned sum, cnt, mine, sp = 0u;
    for (;;) {
        sum = 0u; cnt = 0u; mine = 0u;
#pragma unroll
        for (unsigned j = 0; j < 16; ++j) { const unsigned c = xb_ld(&bar[XB_XCNT(j)]); sum += c; cnt += (c > 0u) ? 1u : 0u; mine = (j == x) ? c : mine; }
        if (sum == G) break;
        __builtin_amdgcn_s_sleep(1);
        if ((++sp & 255u) == 0u) { if (xb_ld(&bar[XB_TMO])) break; if (sp > XB_SPIN_CAP) { atomicAdd(&bar[XB_TMO], 1u); break; } }
    }
    nloc = mine > 0u ? mine : 1u; nx = cnt > 0u ? cnt : 1u;
}

__device__ __forceinline__ void xcd_barrier(const XcdBarrier& b) {
    asm volatile("s_waitcnt vmcnt(0)" ::: "memory");
    __syncthreads();
    if (threadIdx.x == 0) {
        unsigned* bar = b.bar;
        __builtin_amdgcn_s_waitcnt(0);
        unsigned nloc = b.st[0], nx = b.st[1];
        if (nloc == 0u) { xcd_barrier_complete(bar, b.x, nloc, nx); b.st[0] = nloc; b.st[1] = nx; }
        const unsigned old = xb_add(&bar[XB_XSUB(b.x)], 1u);
        const unsigned gen = old / nloc;
        if (old + 1u == (gen + 1u) * nloc) {
            __builtin_amdgcn_fence(__ATOMIC_RELEASE, "agent");
            asm volatile("s_waitcnt vmcnt(0)" ::: "memory");
            const unsigned og = xb_add(&bar[XB_TOP], 1u);
            const unsigned tg = og / nx;
            if (og + 1u == (tg + 1u) * nx) xb_add(&bar[XB_TOPGEN], 1u);
            else XB_SPIN(xb_ld(&bar[XB_TOPGEN]) == tg, bar);
            __builtin_amdgcn_fence(__ATOMIC_ACQUIRE, "agent");
            xb_add(&bar[XB_XGEN(b.x)], 1u);
            asm volatile("s_waitcnt vmcnt(0)" ::: "memory");
        } else {
            XB_SPIN(xb_ld(&bar[XB_XGEN(b.x)]) == gen, bar);
            __builtin_amdgcn_fence(__ATOMIC_ACQUIRE, "agent");
            asm volatile("s_waitcnt vmcnt(0)" ::: "memory");
        }
    }
    __syncthreads();
}
namespace pg8 {
#define PG8_LAS __attribute__((address_space(3)))
typedef unsigned short bf16_t;
typedef short bf16x8 __attribute__((ext_vector_type(8)));
typedef float f32x4 __attribute__((ext_vector_type(4)));
typedef unsigned u32x4 __attribute__((ext_vector_type(4)));
constexpr int BM = 256, BK = 64, HALF = 128, HTB = HALF * BK * 2  , STAGE_BYTES = 8 * HTB, NXCD = 8, WGM = 8;

__host__ __device__ __forceinline__ int lds_byte(int r, int c) { const int st = (r >> 4) * 2 + (c >> 5), rr = r & 15, cc = c & 31, ob = rr * 64 + cc * 2; return st * 1024 + (ob ^ (((ob >> 9) & 1) << 5)); }
__host__ __device__ __forceinline__ void stage_rc(int b, int& R, int& C) { const int st = b / 1024, sb = b % 1024, swz = sb ^ (((sb >> 9) & 1) << 5); R = (st >> 1) * 16 + swz / 64; C = (st & 1) * 32 + (swz % 64) / 2; }
__host__ __device__ __forceinline__ int perm32(int rho) { const int n = rho >> 4, i = rho & 15; return 8 * (i >> 2) + 4 * n + (i & 3); }

struct Unit { int pm, pn; };
struct Gemm { const bf16_t* A; const bf16_t* Bt; int M, N, K; };

struct StaticOrder {
    typedef Unit unit_t;
    int nM, nN, nwg, G, c;
    __host__ __device__ void init(int M, int N, int G_, int c_) { nM = M / BM; nN = N / BM; nwg = nM * nN; G = G_; c = c_; }
    __host__ __device__ bool next(int i, Unit& u) const {
        const long L = (long)i * G + c; if (L >= nwg) return false;
        int wgid = (int)L; { const int q = nwg / NXCD, r = nwg % NXCD, xcd = wgid % NXCD, off = wgid / NXCD; wgid = (xcd < r ? xcd * (q + 1) : r * (q + 1) + (xcd - r) * q) + off; }
        const int nig = WGM * nN, gid = wgid / nig, fm = gid * WGM, gsz = (nM - fm) < WGM ? (nM - fm) : WGM;
        u.pm = fm + ((wgid % nig) % gsz); u.pn = (wgid % nig) / gsz; return true;
    }
    __device__ __forceinline__ void a_ready(const Unit&) const {}
    __device__ __forceinline__ void done(const Unit&) const {}
};

__device__ __forceinline__ unsigned cvt_pk_bf16(float lo, float hi) { unsigned r; asm volatile("v_cvt_pk_bf16_f32 %0, %1, %2" : "=v"(r) : "v"(lo), "v"(hi)); return r; }
typedef float f32x2 __attribute__((ext_vector_type(2)));
__device__ __forceinline__ f32x2 gelu_pk(f32x2 v) {
    const f32x2 av = __builtin_elementwise_abs(v), d = av * 0.2316418882f + 1.0f;
    f32x2 t; t.x = __builtin_amdgcn_rcpf(d.x); t.y = __builtin_amdgcn_rcpf(d.y);
    f32x2 q = t * 0.5307027145f + (-0.7265760135f); q = q * t + 0.7107068705f; q = q * t + (-0.142248368f); q = q * t + 0.127414796f; q = q * t;
    const f32x2 s = (v * v) * (-0.72134752044f);
    f32x2 e; e.x = __builtin_amdgcn_exp2f(s.x); e.y = __builtin_amdgcn_exp2f(s.y);
    const f32x2 m = v * (q * e), r = v - m;
    f32x2 o; o.x = v.x < 0.f ? m.x : r.x; o.y = v.y < 0.f ? m.y : r.y; return o;
}

template <int ACT  > struct EpiBf16 {
    static constexpr bool PERM = true, AFTER_DRAIN = false; static_assert(ACT == 0 || ACT == 1, "EpiBf16: ACT is 0 (none) or 1 (gelu_pk)");
    bf16_t* O; int ldc; const float* bias; int split_cols; size_t split_stride; float scale0;
    __device__ __forceinline__ void operator()(const f32x4 (&acc)[2][2][4][2], const Unit& u, int wr, int wc, int fr, int fq) const {
        const int row0 = u.pm * BM + wr * 64 + fr; int colt = u.pn * BM; bf16_t* base = O;
        float sc = 1.f; if (split_cols) { const int t = colt / split_cols; base += (size_t)t * split_stride; colt -= t * split_cols; if (t == 0) sc = scale0; }
        const int col0 = colt + wc * 32 + 8 * fq, bcol0 = u.pn * BM + wc * 32 + 8 * fq;
        f32x4 bv[2][2];
#pragma unroll
        for (int bj = 0; bj < 2; ++bj)
#pragma unroll
            for (int n = 0; n < 2; ++n) bv[bj][n] = bias ? *(const f32x4*)(bias + bcol0 + bj * HALF + 4 * n) : (f32x4){0.f, 0.f, 0.f, 0.f};
#pragma unroll
        for (int ai = 0; ai < 2; ++ai)
#pragma unroll
            for (int m = 0; m < 4; ++m) { bf16_t* rowp = base + (size_t)(row0 + ai * HALF + m * 16) * ldc + col0;
#pragma unroll
                for (int bj = 0; bj < 2; ++bj) { f32x4 v0 = acc[ai][bj][m][0] + bv[bj][0], v1 = acc[ai][bj][m][1] + bv[bj][1];
                    if (ACT == 1) { f32x2 a = gelu_pk((f32x2){v0[0], v0[1]}), b = gelu_pk((f32x2){v0[2], v0[3]}), c = gelu_pk((f32x2){v1[0], v1[1]}), d = gelu_pk((f32x2){v1[2], v1[3]});
                        v0 = (f32x4){a.x, a.y, b.x, b.y}; v1 = (f32x4){c.x, c.y, d.x, d.y}; }
                    v0 = v0 * sc; v1 = v1 * sc; u32x4 w; w.x = cvt_pk_bf16(v0[0], v0[1]); w.y = cvt_pk_bf16(v0[2], v0[3]); w.z = cvt_pk_bf16(v1[0], v1[1]); w.w = cvt_pk_bf16(v1[2], v1[3]);
                    *(u32x4*)(rowp + bj * HALF) = w; } }
    }
};
struct IdentRows { template <class U> __device__ __forceinline__ unsigned row(const U& u, int r) const { return (unsigned)(u.pm * BM + r); } };
template <class Epi, class Sched, bool ALIGN_EPI = false, bool SP2 = false, class RowMap = IdentRows>
__device__ __forceinline__ void gemm_phase(PG8_LAS unsigned char* lds, const Gemm g, const Sched& S, const Epi& E, const RowMap RM = RowMap()) {
    typedef typename Sched::unit_t Unit;
    const int tid = threadIdx.x, wid = __builtin_amdgcn_readfirstlane(tid >> 6), lane = tid & 63, wr = wid >> 2, wc = wid & 3, fr = lane & 15, fq = lane >> 4;
    const int K = g.K, nt = K / BK;
    unsigned voffB[2]; int RA[2], CA[2];
#pragma unroll
    for (int i = 0; i < 2; ++i) { int R, C; stage_rc(tid * 16 + i * 8192, R, C); const int Rb = Epi::PERM ? ((R & ~31) + perm32(R & 31)) : R;
        RA[i] = R; CA[i] = C; voffB[i] = (unsigned)(Rb * K + C) * 2u; }
    unsigned ao[2][2], an[2][2];
#define PG8_AOFF(dst, U) do { _Pragma("unroll") for (int h_ = 0; h_ < 2; ++h_) _Pragma("unroll") for (int i_ = 0; i_ < 2; ++i_) { \
        dst[h_][i_] = RM.row((U), h_ * HALF + RA[i_]) * (unsigned)(K * 2) + (unsigned)(CA[i_] * 2); } } while (0)
    const size_t kstep = (size_t)(BK * 2);
    const size_t hstep = (size_t)HALF * K * 2;
    const size_t tstep = 2 * hstep;
    const unsigned ldsw = (unsigned)wid * 1024u;
    const int aoff = lds_byte(wr * 64 + fr, fq * 8), boff = lds_byte(wc * 32 + fr, fq * 8);
#define PG8_SA(b, h) (((b) * 2 + (h)) * HTB)
#define PG8_SB(b, h) ((4 + (b) * 2 + (h)) * HTB)
#define PG8_STAGE(bufoff, gbase, voff) do { _Pragma("unroll") for (int _i = 0; _i < 2; ++_i) \
        __builtin_amdgcn_global_load_lds((const unsigned*)((const char*)(gbase) + (voff)[_i]), (PG8_LAS unsigned*)(lds + (bufoff) + ldsw + _i * 8192), 16, 0, 0); } while (0)
#define PG8_STAGE_A(bufoff, kbase, off) do { _Pragma("unroll") for (int _i = 0; _i < 2; ++_i) \
        __builtin_amdgcn_global_load_lds((const unsigned*)((const char*)(kbase) + (off)[_i]), (PG8_LAS unsigned*)(lds + (bufoff) + ldsw + _i * 8192), 16, 0, 0); } while (0)
#define PG8_LDA(dst, b, h) do { _Pragma("unroll") for (int m = 0; m < 4; ++m) _Pragma("unroll") for (int k = 0; k < 2; ++k) dst[m][k] = *(const PG8_LAS bf16x8*)(lds + PG8_SA(b, h) + aoff + m * 2048 + k * 1024); } while (0)
#define PG8_LDB(dst, b, h) do { _Pragma("unroll") for (int n = 0; n < 2; ++n) _Pragma("unroll") for (int k = 0; k < 2; ++k) dst[n][k] = *(const PG8_LAS bf16x8*)(lds + PG8_SB(b, h) + boff + n * 2048 + k * 1024); } while (0)
#define PG8_MMA(ai, bj, At, Bt) do { __builtin_amdgcn_s_setprio(1); _Pragma("unroll") for (int m = 0; m < 4; ++m) _Pragma("unroll") for (int n = 0; n < 2; ++n) _Pragma("unroll") for (int k = 0; k < 2; ++k) \
        acc[ai][bj][m][n] = __builtin_amdgcn_mfma_f32_16x16x32_bf16(Bt[n][k], At[m][k], acc[ai][bj][m][n], 0, 0, 0); __builtin_amdgcn_s_setprio(0); } while (0)
#define PG8_WAIT_V(n) asm volatile("s_waitcnt vmcnt(" #n ")" ::: "memory")
#define PG8_WAIT_L(n) asm volatile("s_waitcnt lgkmcnt(" #n ")" ::: "memory")
#define PG8_BAR __builtin_amdgcn_s_barrier()
#define PG8_SCHED __builtin_amdgcn_sched_barrier(0)
    Unit cur, nxt; int ui = 0;
    if (!S.next(0, cur)) return;
    f32x4 acc[2][2][4][2];
#pragma unroll
    for (int a = 0; a < 2; ++a)
#pragma unroll
        for (int b = 0; b < 2; ++b)
#pragma unroll
            for (int m = 0; m < 4; ++m)
#pragma unroll
                for (int n = 0; n < 2; ++n) acc[a][b][m][n] = (f32x4){0.f, 0.f, 0.f, 0.f};
    bf16x8 At[4][2], B0[2][2], B1[2][2];
    const char* const Ab = (const char*)g.A; const char* cB = (const char*)g.Bt + (size_t)cur.pn * tstep;
    PG8_AOFF(ao, cur);
    S.a_ready(cur);
    if constexpr (SP2) {
        PG8_STAGE(PG8_SB(0, 0), cB, voffB); PG8_STAGE(PG8_SB(0, 1), cB + hstep, voffB); PG8_STAGE_A(PG8_SA(0, 0), Ab, ao[0]); PG8_STAGE_A(PG8_SA(0, 1), Ab, ao[1]);
        if (wr == 1) PG8_BAR;
        PG8_WAIT_V(2); PG8_BAR;
        PG8_STAGE(PG8_SB(1, 0), cB + kstep, voffB); PG8_STAGE_A(PG8_SA(1, 0), Ab + kstep, ao[0]); PG8_STAGE(PG8_SB(1, 1), cB + hstep + kstep, voffB);
        PG8_WAIT_V(6); PG8_BAR;
    } else {
        PG8_STAGE(PG8_SB(0, 0), cB, voffB); PG8_STAGE_A(PG8_SA(0, 0), Ab, ao[0]); PG8_STAGE(PG8_SB(0, 1), cB + hstep, voffB); PG8_STAGE_A(PG8_SA(0, 1), Ab, ao[1]);
        if (wr == 1) PG8_BAR;
        PG8_WAIT_V(4); PG8_BAR;
        PG8_STAGE(PG8_SB(1, 0), cB + kstep, voffB); PG8_STAGE_A(PG8_SA(1, 0), Ab + kstep, ao[0]); PG8_STAGE(PG8_SB(1, 1), cB + hstep + kstep, voffB);
        PG8_WAIT_V(6); PG8_BAR;
    }
    for (;;) {
        const bool has_next = S.next(ui + 1, nxt);
        const char* nB = has_next ? (const char*)g.Bt + (size_t)nxt.pn * tstep : cB;
        if (has_next) { PG8_AOFF(an, nxt); } else { _Pragma("unroll") for (int h_ = 0; h_ < 2; ++h_) _Pragma("unroll") for (int i_ = 0; i_ < 2; ++i_) an[h_][i_] = ao[h_][i_]; }
        for (int t = 0; t < nt; t += 2) {
            const bool last = (t == nt - 2);
            const char* a1 = Ab + (size_t)(t + 1) * kstep;
            const char* a2 = last ? Ab : Ab + (size_t)(t + 2) * kstep; const char* b2 = last ? nB : cB + (size_t)(t + 2) * kstep;
            const char* a3 = a2 + kstep; const char* b3 = b2 + kstep;
            unsigned as[2][2];
#pragma unroll
            for (int h_ = 0; h_ < 2; ++h_)
#pragma unroll
                for (int i_ = 0; i_ < 2; ++i_) as[h_][i_] = last ? an[h_][i_] : ao[h_][i_];
            if (last && has_next) S.a_ready(nxt);
            if constexpr (SP2) {
            PG8_LDB(B0, 0, 0); PG8_LDB(B1, 0, 1); PG8_SCHED; PG8_LDA(At, 0, 0); PG8_STAGE_A(PG8_SA(1, 1), a1, ao[1]);
            PG8_WAIT_V(8); PG8_WAIT_L(0); PG8_BAR; PG8_MMA(0, 0, At, B0); PG8_MMA(0, 1, At, B1); PG8_BAR; PG8_SCHED;
            PG8_LDA(At, 0, 1); PG8_STAGE(PG8_SB(0, 0), b2, voffB); PG8_STAGE(PG8_SB(0, 1), b2 + hstep, voffB); PG8_STAGE_A(PG8_SA(0, 0), a2, as[0]);
            PG8_WAIT_V(8); PG8_WAIT_L(0); PG8_BAR; PG8_MMA(1, 0, At, B0); PG8_MMA(1, 1, At, B1); PG8_BAR; PG8_SCHED;
            PG8_LDB(B0, 1, 0); PG8_LDB(B1, 1, 1); PG8_SCHED; PG8_LDA(At, 1, 0); PG8_STAGE_A(PG8_SA(0, 1), a2, as[1]);
            PG8_WAIT_V(8); PG8_WAIT_L(0); PG8_BAR; PG8_MMA(0, 0, At, B0); PG8_MMA(0, 1, At, B1); PG8_BAR; PG8_SCHED;
            PG8_LDA(At, 1, 1); PG8_STAGE(PG8_SB(1, 0), b3, voffB); PG8_STAGE(PG8_SB(1, 1), b3 + hstep, voffB); PG8_STAGE_A(PG8_SA(1, 0), a3, as[0]);
            PG8_WAIT_V(8); PG8_WAIT_L(0); PG8_BAR; PG8_MMA(1, 0, At, B0); PG8_MMA(1, 1, At, B1); PG8_BAR; PG8_SCHED;
            } else {
            PG8_LDB(B0, 0, 0); PG8_SCHED; PG8_LDA(At, 0, 0); PG8_STAGE_A(PG8_SA(1, 1), a1, ao[1]);
            PG8_WAIT_L(8); PG8_BAR; PG8_WAIT_L(0); PG8_MMA(0, 0, At, B0); PG8_BAR; PG8_SCHED;
            PG8_LDB(B1, 0, 1); PG8_STAGE(PG8_SB(0, 0), b2, voffB);
            PG8_BAR; PG8_WAIT_L(0); PG8_MMA(0, 1, At, B1); PG8_BAR;
            PG8_LDA(At, 0, 1); PG8_STAGE_A(PG8_SA(0, 0), a2, as[0]);
            PG8_BAR; PG8_WAIT_L(0); PG8_MMA(1, 0, At, B0); PG8_BAR; PG8_SCHED;
            PG8_STAGE(PG8_SB(0, 1), b2 + hstep, voffB);
            PG8_WAIT_V(6); PG8_BAR; PG8_MMA(1, 1, At, B1); PG8_BAR;
            PG8_LDB(B0, 1, 0); PG8_SCHED; PG8_LDA(At, 1, 0); PG8_STAGE_A(PG8_SA(0, 1), a2, as[1]);
            PG8_WAIT_L(8); PG8_BAR; PG8_WAIT_L(0); PG8_MMA(0, 0, At, B0); PG8_BAR; PG8_SCHED;
            PG8_LDB(B1, 1, 1); PG8_STAGE(PG8_SB(1, 0), b3, voffB);
            PG8_BAR; PG8_WAIT_L(0); PG8_MMA(0, 1, At, B1); PG8_BAR;
            PG8_LDA(At, 1, 1); PG8_STAGE_A(PG8_SA(1, 0), a3, as[0]);
            PG8_BAR; PG8_WAIT_L(0); PG8_MMA(1, 0, At, B0); PG8_BAR; PG8_SCHED;
            PG8_STAGE(PG8_SB(1, 1), b3 + hstep, voffB);
            PG8_WAIT_V(6); PG8_BAR; PG8_MMA(1, 1, At, B1); PG8_BAR;
            }
        }
        if constexpr (ALIGN_EPI) { if (wr == 0) PG8_BAR; }
        if constexpr (!Epi::AFTER_DRAIN) { E(acc, cur, wr, wc, fr, fq); S.done(cur); }
        if (!has_next) break;
#pragma unroll
        for (int a = 0; a < 2; ++a)
#pragma unroll
            for (int b = 0; b < 2; ++b)
#pragma unroll
                for (int m = 0; m < 4; ++m)
#pragma unroll
                    for (int n = 0; n < 2; ++n) acc[a][b][m][n] = (f32x4){0.f, 0.f, 0.f, 0.f};
        cur = nxt; cB = nB; ++ui;
#pragma unroll
        for (int h_ = 0; h_ < 2; ++h_)
#pragma unroll
            for (int i_ = 0; i_ < 2; ++i_) ao[h_][i_] = an[h_][i_];
        if constexpr (ALIGN_EPI) { if (wr == 1) PG8_BAR; }
    }
    PG8_WAIT_V(0);
    if constexpr (!ALIGN_EPI) { if (wr == 0) PG8_BAR; }
    PG8_BAR;
    if constexpr (Epi::AFTER_DRAIN) { E.fused(acc, cur, wr, wc, fr, fq, lds, wid, lane); S.done(cur); }
#undef PG8_SA
#undef PG8_SB
#undef PG8_STAGE
#undef PG8_STAGE_A
#undef PG8_AOFF
#undef PG8_LDA
#undef PG8_LDB
#undef PG8_MMA
#undef PG8_WAIT_V
#undef PG8_WAIT_L
#undef PG8_BAR
#undef PG8_SCHED
}
}
constexpr int NWAVES = 8;
constexpr int RING_OFF = 0, RING_BYTES = 131072;
constexpr int LDSCTL_OFF = 150 * 1024, MISC_OFF = LDSCTL_OFF + 320;
constexpr int LDS_BYTES = 160 * 1024;
constexpr size_t MiB = 1u << 20;
constexpr size_t WS_CTL = 0, CTL_ZERO_BYTES = 1 * MiB;
constexpr size_t WS_MOD = 1 * MiB;
constexpr size_t WS_RWP = WS_MOD + 128 * 1024;
constexpr size_t WS_CS = 2 * MiB;
constexpr size_t WS_LOGF = 4 * MiB;
constexpr size_t WS_CB = WS_LOGF + 256 * 1024;
constexpr size_t WS_Z = WS_CB + 256 * 1024;
constexpr size_t WS_WIN = 6 * MiB;
constexpr size_t WS_WOUT = 34 * MiB;
constexpr size_t WS_HB = 42 * MiB;
constexpr size_t WS_QKV = 74 * MiB;
constexpr size_t TSZ = (size_t)16 * 4096 * 128;
constexpr size_t WS_FAST_END = 186 * MiB;
constexpr size_t WS_YB = 74 * MiB;
constexpr size_t WS_GB = 74 * MiB;
constexpr size_t WS_YS = 110 * MiB;
constexpr size_t WS_W13 = 266 * MiB;
constexpr size_t WS_W2 = 394 * MiB;
constexpr size_t WS_LIST = 458 * MiB;
constexpr size_t WS_SLOT = 459 * MiB;
constexpr size_t WS_END = 460 * MiB;
constexpr int ECAP = 8192, CW_CNT = 32768;
constexpr int CW_BAR = 4096;

struct Frame {
    LAS unsigned char* lds; char* ldsg;
    volatile LAS unsigned* MISC;
    gu32* ctl;
    int tid, lane, wave, G, gw, NGW, cnt_off;
    const float* in[22]; float* out; unsigned char* ws;
};
struct Args { const float* in[22]; float* out; unsigned char* ws; int ph_lo, ph_hi, cnt_off, pad; };

template <int CTRL> __device__ __forceinline__ float dppa(float v) { const int t = __builtin_amdgcn_update_dpp(0, __float_as_int(v), CTRL, 0xf, 0xf, true); return v + __int_as_float(t); }
__device__ __forceinline__ float row16_sum(float v) { v = dppa<0xB1>(v); v = dppa<0x4E>(v); v = dppa<0x141>(v); v = dppa<0x140>(v); return v; }
__device__ __forceinline__ float half32_sum(float v) { v = row16_sum(v); return v + __shfl_xor(v, 16); }
__device__ __forceinline__ float wave_sum(float v) {
    v = row16_sum(v);
    const float s0 = __int_as_float(__builtin_amdgcn_readlane(__float_as_int(v), 0)), s1 = __int_as_float(__builtin_amdgcn_readlane(__float_as_int(v), 16));
    const float s2 = __int_as_float(__builtin_amdgcn_readlane(__float_as_int(v), 32)), s3 = __int_as_float(__builtin_amdgcn_readlane(__float_as_int(v), 48));
    return (s0 + s1) + (s2 + s3);
}
__device__ __forceinline__ float silu_f(float v) { return v / (1.f + __expf(-v)); }

__device__ __forceinline__ void p0_mod(Frame& F) {
    const float* c = F.in[1]; const float* ada_w = F.in[2]; const float* ada_b = F.in[3];
    float* mod = (float*)(F.ws + WS_MOD);
    LAS float* ca = (LAS float*)(F.lds);
    LAS float* red = ca + 2 * DM;
    for (int i = F.tid; i < 2 * DM; i += NWAVES * 64) ca[i] = silu_f(c[i]);
    __syncthreads();
    for (int cb = blockIdx.x; cb < 256; cb += F.G) {
        const int j0 = cb * 48;
        float a0 = 0.f, a1 = 0.f;
        if (F.lane < 48) {
#pragma unroll 8
            for (int k = F.wave; k < DM; k += NWAVES) { const float w = ada_w[(size_t)k * (6 * DM) + j0 + F.lane]; a0 = fmaf(ca[k], w, a0); a1 = fmaf(ca[DM + k], w, a1); }
            red[F.wave * 96 + F.lane] = a0; red[F.wave * 96 + 48 + F.lane] = a1;
        }
        __syncthreads();
        if (F.tid < 96) { float s = 0.f;
#pragma unroll
            for (int w = 0; w < NWAVES; ++w) s += red[w * 96 + F.tid];
            const int b = F.tid / 48, jj = F.tid % 48; mod[b * 6 * DM + j0 + jj] = s + ada_b[j0 + jj]; }
        __syncthreads();
    }
}
__device__ __forceinline__ void tr_tile(const float* __restrict__ src, int ldn, int k0, int n0, bf16* __restrict__ dst, int ldk, int drow0, LAS float* scr, int lane) {
#pragma unroll 4
    for (int i = 0; i < 16; ++i) { const int kk = 4 * i + (lane >> 4);
        const f32x4 v = *(const f32x4*)(src + (size_t)(k0 + kk) * ldn + n0 + 4 * (lane & 15));
        LAS float* p = scr + kk * 65 + 4 * (lane & 15); p[0] = v.x; p[1] = v.y; p[2] = v.z; p[3] = v.w; }
    LDS_WAIT(); asm volatile("" ::: "memory");
    const int c = lane & 7;
#pragma unroll
    for (int jj = 0; jj < 8; ++jj) { const int n = (lane >> 3) + 8 * jj; const LAS float* s = scr + (8 * c) * 65 + n;
        v4u o; o.x = pk2(s[0], s[65]); o.y = pk2(s[130], s[195]); o.z = pk2(s[260], s[325]); o.w = pk2(s[390], s[455]);
        *(v4u*)(dst + (size_t)(drow0 + n) * ldk + k0 + 8 * c) = o; }
    LDS_WAIT(); asm volatile("" ::: "memory");
}
constexpr int CW_CONVQ = 2112, CW_DONE = 2176;
constexpr int I_E = 256 * NE, CONV_PER_WAVE = 2, N_CONV_BI = 3 * I_E / (NWAVES * CONV_PER_WAVE);
struct ConvTile { const float* src; bf16* dst; int ldn, ldk; };
__device__ __forceinline__ ConvTile conv_decode(Frame& F, int r) {
    ConvTile t;
    if (r < 2 * I_E) { const int which = r / I_E, rr = r % I_E, e = rr >> 8, q = rr & 255, kt = q >> 3, nt = q & 7;
        t.src = (which == 0 ? F.in[19] : F.in[20]) + (size_t)e * DM * DE + (size_t)(64 * kt) * DE + 64 * nt; t.ldn = DE;
        t.dst = (bf16*)(F.ws + WS_W13) + (size_t)(e * 1024 + (nt >> 1) * 256 + which * 128 + (nt & 1) * 64) * DM + 64 * kt; t.ldk = DM; return t; }
    r -= 2 * I_E;
    { const int e = r >> 8, q = r & 255, kt = q >> 5, nt = q & 31;
      t.src = F.in[21] + (size_t)e * DE * DM + (size_t)(64 * kt) * DM + 64 * nt; t.ldn = DM;
      t.dst = (bf16*)(F.ws + WS_W2) + (size_t)(e * 2048 + 64 * nt) * DE + 64 * kt; t.ldk = DE; }
    return t;
}
__device__ __forceinline__ void conv_load(const ConvTile& t, f32x4 (&v)[16], int lane) {
#pragma unroll
    for (int i = 0; i < 16; ++i) v[i] = *(const f32x4*)(t.src + (size_t)(4 * i + (lane >> 4)) * t.ldn + 4 * (lane & 15));
}
__device__ __forceinline__ void conv_store(const ConvTile& t, const f32x4 (&v)[16], LAS float* scr, int lane) {
#pragma unroll
    for (int i = 0; i < 16; ++i) { LAS float* p = scr + (4 * i + (lane >> 4)) * 65 + 4 * (lane & 15); p[0] = v[i].x; p[1] = v[i].y; p[2] = v[i].z; p[3] = v[i].w; }
    LDS_WAIT(); asm volatile("" ::: "memory");
    const int c = lane & 7;
#pragma unroll
    for (int jj = 0; jj < 8; ++jj) { const int n = (lane >> 3) + 8 * jj; const LAS float* s = scr + (8 * c) * 65 + n;
        v4u o; o.x = pk2(s[0], s[65]); o.y = pk2(s[130], s[195]); o.z = pk2(s[260], s[325]); o.w = pk2(s[390], s[455]);
        *(v4u*)(t.dst + (size_t)n * t.ldk + 8 * c) = o; }
    LDS_WAIT(); asm volatile("" ::: "memory");
}
__device__ __forceinline__ void filler(Frame& F, int ph, bool drain) {
    __syncthreads();
    LAS float* scr = (LAS float*)(F.lds) + F.wave * (64 * 65);
    unsigned nxt = 0xffffffffu;
    if (F.tid == 0) { bool go = true;
        if (!drain) go = __hip_atomic_fetch_add(F.ctl + CW_DONE + 64 * ph, 1u, RLX_AGENT) < (unsigned)(3 * F.G / 4);
        if (go) nxt = __hip_atomic_fetch_add(F.ctl + CW_CONVQ, 1u, RLX_AGENT); }
    for (;;) {
        if (F.tid == 0) F.MISC[1] = nxt;
        __syncthreads();
        const unsigned it = F.MISC[1];
        __syncthreads();
        if (it >= (unsigned)N_CONV_BI) break;
        if (F.tid == 0) { const bool stop = !drain && __hip_atomic_load(F.ctl + CW_DONE + 64 * ph, RLX_AGENT) >= (unsigned)F.G;
            nxt = stop ? 0xffffffffu : __hip_atomic_fetch_add(F.ctl + CW_CONVQ, 1u, RLX_AGENT); }
        const int r0 = ((int)it * NWAVES + F.wave) * CONV_PER_WAVE;
        const ConvTile t0 = conv_decode(F, r0), t1 = conv_decode(F, r0 + 1);
        f32x4 va[16], vb[16];
        conv_load(t0, va, F.lane); conv_load(t1, vb, F.lane);
        conv_store(t0, va, scr, F.lane); conv_store(t1, vb, scr, F.lane);
    }
}
template <bool EXPERTS>
__device__ __forceinline__ void p0_prologue(Frame& F) {
    p0_mod(F);
    __syncthreads();
    LAS float* scr = (LAS float*)(F.lds) + F.wave * (64 * 65);
    bf16* WinT = (bf16*)(F.ws + WS_WIN); bf16* WoutT = (bf16*)(F.ws + WS_WOUT);
    constexpr int I_IN = 32 * 112, I_OUT = 32 * 32;
    constexpr int NIT = I_IN + I_OUT;
    for (int it = F.gw; it < NIT; it += F.NGW) {
        int r = it;
        if (r < I_IN) { tr_tile(F.in[6], INC, 64 * (r / 112), 64 * (r % 112), WinT, DM, 64 * (r % 112), scr, F.lane); continue; } r -= I_IN;
        if (r < I_OUT) { tr_tile(F.in[12], DM, 64 * (r / 32), 64 * (r % 32), WoutT, DM, 64 * (r % 32), scr, F.lane); continue; } r -= I_OUT;
    }
    { f32x4* rwp = (f32x4*)(F.ws + WS_RWP); const float* rcw = F.in[15]; const float* rfw = F.in[17];
      for (int idx = blockIdx.x * (NWAVES * 64) + F.tid; idx < 8 * 36 * 64; idx += F.G * NWAVES * 64) {
          const int l = idx & 63, o = (idx >> 6) % 36, j = idx / (36 * 64); f32x4 v;
#pragma unroll
          for (int i = 0; i < 4; ++i) { const int k = 256 * j + 4 * l + i; v[i] = o < 4 ? rcw[k * 4 + o] : rfw[k * 32 + (o - 4)]; }
          rwp[idx] = v; } }
    { float* cs = (float*)(F.ws + WS_CS);
      for (int idx = blockIdx.x * (NWAVES * 64) + F.tid; idx < SEQ * 64; idx += F.G * NWAVES * 64) {
          const int i = idx & 63, s = idx >> 6; const float inv_freq = powf(10000.f, -(float)(2 * i) / 128.f); const float ang = (float)s * inv_freq;
          cs[2 * idx] = cosf(ang); cs[2 * idx + 1] = sinf(ang); } }
}

__device__ __forceinline__ void p1_prenorm(Frame& F) {
    const float* x = F.in[0]; const float* wpre = F.in[4]; const float* w_in = F.in[6]; const float* fbias = F.in[7];
    const float* mod = (const float*)(F.ws + WS_MOD);
    bf16* Hb = (bf16*)(F.ws + WS_HB); float* logf = (float*)(F.ws + WS_LOGF); float* zb = (float*)(F.ws + WS_Z);
    LAS f32x4* wf = (LAS f32x4*)F.lds;
    for (int idx = F.tid; idx < 4096; idx += NWAVES * 64) { const int l = idx & 63, half = (idx >> 6) & 1, i = (idx >> 7) & 3, j = idx >> 9;
        wf[idx] = *(const f32x4*)(w_in + (size_t)(256 * j + 4 * l + i) * INC + INCM + 4 * half); }
    __syncthreads();
    for (int row = F.gw; row < T; row += F.NGW) {
        const int b = row >> 12, s = row & 4095;
        const f32x4* xr = (const f32x4*)(x + (size_t)row * DM) + F.lane;
        f32x4 v[8]; float ss = 0.f;
#pragma unroll
        for (int j = 0; j < 8; ++j) { v[j] = xr[64 * j]; ss += (v[j].x * v[j].x + v[j].y * v[j].y) + (v[j].z * v[j].z + v[j].w * v[j].w); }
        const float rstd = rsqrtf(wave_sum(ss) * (1.f / DM) + EPS);
        const f32x4* w4 = (const f32x4*)wpre + F.lane; const f32x4* sh4 = (const f32x4*)(mod + (size_t)b * 6 * DM) + F.lane; const f32x4* sc4 = (const f32x4*)(mod + (size_t)b * 6 * DM + DM) + F.lane;
        float acc[8];
#pragma unroll
        for (int o = 0; o < 8; ++o) acc[o] = 0.f;
        unsigned long long* o8 = (unsigned long long*)(Hb + (size_t)row * DM) + F.lane;
#pragma unroll
        for (int j = 0; j < 8; ++j) {
            const f32x4 h = v[j] * rstd * w4[64 * j] * (sc4[64 * j] + 1.0f) + sh4[64 * j];
            o8[64 * j] = (unsigned long long)pk2(h.x, h.y) | ((unsigned long long)pk2(h.z, h.w) << 32);
#pragma unroll
            for (int i = 0; i < 4; ++i) { const f32x4 wa = wf[((j * 4 + i) * 2 + 0) * 64 + F.lane], wb = wf[((j * 4 + i) * 2 + 1) * 64 + F.lane]; const float hv = h[i];
                acc[0] = fmaf(hv, wa.x, acc[0]); acc[1] = fmaf(hv, wa.y, acc[1]); acc[2] = fmaf(hv, wa.z, acc[2]); acc[3] = fmaf(hv, wa.w, acc[3]);
                acc[4] = fmaf(hv, wb.x, acc[4]); acc[5] = fmaf(hv, wb.y, acc[5]); acc[6] = fmaf(hv, wb.z, acc[6]); acc[7] = fmaf(hv, wb.w, acc[7]); }
            asm volatile("" ::: "memory");
        }
        float z = 0.f;
#pragma unroll
        for (int o = 0; o < 8; ++o) { const float t = wave_sum(acc[o]); z = (F.lane == o) ? t : z; }
        if (F.lane < 8) { const float zz = z + fbias[F.lane];
            logf[((size_t)b * NH + F.lane) * SEQ + s] = fminf(zz, 0.f) - log1pf(expf(-fabsf(zz)));
            zb[(size_t)row * 8 + F.lane] = z; }
    }
}

struct EpiHeads {
    static constexpr bool PERM = true, AFTER_DRAIN = false;
    bf16* base;
    __device__ __forceinline__ void operator()(const pg8::f32x4 (&acc)[2][2][4][2], const pg8::Unit& u, int wr, int wc, int fr, int fq) const {
        const int type = u.pn >> 2, head0 = (u.pn & 3) * 2; const int row0 = u.pm * 256 + wr * 64 + fr;
#pragma unroll
        for (int ai = 0; ai < 2; ++ai)
#pragma unroll
            for (int m = 0; m < 4; ++m) { const int r = row0 + ai * 128 + m * 16, b = r >> 12, s = r & 4095;
#pragma unroll
                for (int bj = 0; bj < 2; ++bj) { const pg8::f32x4 v0 = acc[ai][bj][m][0], v1 = acc[ai][bj][m][1];
                    pg8::u32x4 w; w.x = pg8::cvt_pk_bf16(v0[0], v0[1]); w.y = pg8::cvt_pk_bf16(v0[2], v0[3]); w.z = pg8::cvt_pk_bf16(v1[0], v1[1]); w.w = pg8::cvt_pk_bf16(v1[2], v1[3]);
                    *(pg8::u32x4*)(base + (size_t)type * TSZ + ((size_t)((b * 8 + head0 + bj) * SEQ + s)) * HD + wc * 32 + 8 * fq) = w; } }
    }
};

namespace fox {
__device__ __forceinline__ int fox_tid() { int t = threadIdx.x; asm volatile("" : "+v"(t)); return t; }
typedef unsigned short bf16;
constexpr int D = 128, OLD = 2048;
constexpr bool WSKIP = false; constexpr float THR = 8.f;
constexpr float SCALE = 0.08838834764831845f;
constexpr int NW = 8, QBLK = 32, KVBLK = 64, QB = NW * QBLK;
constexpr int SHM_V = KVBLK * D * 2, SHM_K = KVBLK * D * 2;
constexpr int LDS_BYTES = 2 * SHM_V + 2 * SHM_K + NW * 64 * 4 + 2 * 64 * 4;
typedef short bf16x8 __attribute__((ext_vector_type(8)));
typedef short s16x4 __attribute__((ext_vector_type(4)));
typedef float f32x16 __attribute__((ext_vector_type(16)));
typedef float f32x4 __attribute__((ext_vector_type(4)));
typedef unsigned u32x4 __attribute__((ext_vector_type(4)));
template <class A, class Bt> struct same_t { static constexpr bool v = false; };
template <class A> struct same_t<A, A> { static constexpr bool v = true; };

#define KSWZ(row, colB) ((row) * 256 + ((colB) ^ (((row) & 7) << 4)))
#define SBAR() __builtin_amdgcn_sched_barrier(0)
__device__ __forceinline__ int v_st(int k, int c) { const int kk = (k & ~0xC) | ((k & 4) << 1) | ((k & 8) >> 1); return ((kk >> 3) * 4 + (c >> 5)) * 512 + ((kk & 7) * 32 + (c & 31)) * 2; }
__device__ __forceinline__ int v_rd_base(int lane) { return ((lane & 3) << 3) | (((lane >> 2) & 3) << 6) | (((lane >> 4) & 1) << 5) | (((lane >> 5) & 1) << 8); }
constexpr int v_rd_off(int d0, int ks, int half) { return d0 * 512 + ks * 4096 + half * 2048; }
__device__ __forceinline__ int crow(int r, int hi) { return (r & 3) + 8 * (r >> 2) + 4 * hi; }
__device__ __forceinline__ unsigned cvtpk(float lo, float hi) {
    unsigned r; asm volatile("v_cvt_pk_bf16_f32 %0, %1, %2" : "=v"(r) : "v"(lo), "v"(hi)); return r;
}
__device__ __forceinline__ bf16x8 pack8(f32x4 a, f32x4 b) {
    u32x4 w = {cvtpk(a[0], a[1]), cvtpk(a[2], a[3]), cvtpk(b[0], b[1]), cvtpk(b[2], b[3])};
    return *reinterpret_cast<bf16x8*>(&w);
}
template <class T> __device__ __forceinline__ bf16x8 load8(const T* p) {
    if constexpr (same_t<T, float>::v) { return pack8(*(const f32x4*)p, *(const f32x4*)(p + 4)); }
    else { return *reinterpret_cast<const bf16x8*>(p); }
}
__device__ __forceinline__ void mask_tile(f32x16& p0, f32x16& p1, int dq, unsigned W) {
    const float NEG = -__builtin_inff();
#pragma unroll
    for (int r = 0; r < 16; ++r) {
        const int c = (r & 3) + 8 * (r >> 2);
        if ((unsigned)(dq - c) >= W) p0[r] = NEG;
        if ((unsigned)(dq - c - 32) >= W) p1[r] = NEG;
    }
}
__device__ __forceinline__ void partialSM(f32x16& p0, f32x16& p1, float& m_reg, float& mn, float& alpha) {
    float pmax = p0[0]; for (int r = 1; r < 16; ++r) pmax = fmaxf(pmax, p0[r]); for (int r = 0; r < 16; ++r) pmax = fmaxf(pmax, p1[r]);
    { auto rr = __builtin_amdgcn_permlane32_swap(__float_as_uint(pmax), __float_as_uint(pmax), false, false);
      pmax = fmaxf(__uint_as_float(rr[0]), __uint_as_float(rr[1])); }
    constexpr float C2 = 1.4426950408889634f * SCALE;
    if (__builtin_expect(__all((pmax - m_reg) * SCALE <= THR), 1)) { mn = m_reg; alpha = 1.f; }
    else { mn = fmaxf(m_reg, pmax); alpha = __builtin_amdgcn_exp2f((m_reg - mn) * C2); m_reg = mn; }
    const float mnL = -mn * C2;
    for (int r = 0; r < 16; ++r) p0[r] = fmaf(p0[r], C2, mnL); for (int r = 0; r < 16; ++r) p1[r] = fmaf(p1[r], C2, mnL);
    for (int r = 0; r < 16; ++r) p0[r] = __builtin_amdgcn_exp2f(p0[r]);
}
__device__ __forceinline__ void finishSM(f32x16& p0, f32x16& p1, float alpha, float& l_reg, bf16x8& pa0, bf16x8& pa1, bf16x8& pa2, bf16x8& pa3) {
    for (int r = 0; r < 16; ++r) p1[r] = __builtin_amdgcn_exp2f(p1[r]);
    float ps = 0; for (int r = 0; r < 16; ++r) ps += p0[r]; for (int r = 0; r < 16; ++r) ps += p1[r];
    { auto rr = __builtin_amdgcn_permlane32_swap(__float_as_uint(ps), __float_as_uint(ps), false, false);
      ps = __uint_as_float(rr[0]) + __uint_as_float(rr[1]); }
    l_reg = l_reg * alpha + ps;
#define PK4(P, B_, OUT) do { unsigned a0 = cvtpk(P[B_+0], P[B_+1]), a1 = cvtpk(P[B_+2], P[B_+3]);                          \
        unsigned b0 = cvtpk(P[B_+4], P[B_+5]), b1 = cvtpk(P[B_+6], P[B_+7]);                                             \
        auto r0 = __builtin_amdgcn_permlane32_swap(a0, b0, false, false); auto r1 = __builtin_amdgcn_permlane32_swap(a1, b1, false, false); \
        u32x4 w = {r0[0], r1[0], r0[1], r1[1]}; OUT = *reinterpret_cast<bf16x8*>(&w); } while (0)
    PK4(p0, 0, pa0); PK4(p0, 8, pa1); PK4(p1, 0, pa2); PK4(p1, 8, pa3);
#undef PK4
}
template <int KB, bool SK>
__device__ __forceinline__ void qkt(f32x16& p0, f32x16& p1, const char* K_lds, int r32, int hi, const bf16x8* qr, bool act) {
    if (SK && !act) { const float NEG = -__builtin_inff();
#pragma unroll
        for (int r = 0; r < 16; ++r) { p0[r] = NEG; p1[r] = NEG; } return; }
    { const float* bl = (const float*)(K_lds + 2 * SHM_K + NW * 64 * 4) + KB * 64 + 4 * hi;
#pragma unroll
      for (int g = 0; g < 4; ++g) { const f32x4 b0 = *(const f32x4*)(bl + 8 * g), b1 = *(const f32x4*)(bl + 32 + 8 * g);
          p0[4 * g] = b0[0]; p0[4 * g + 1] = b0[1]; p0[4 * g + 2] = b0[2]; p0[4 * g + 3] = b0[3]; p1[4 * g] = b1[0]; p1[4 * g + 1] = b1[1]; p1[4 * g + 2] = b1[2]; p1[4 * g + 3] = b1[3]; } }
    const char* kb[4];
#pragma unroll
    for (int dd = 0; dd < 4; ++dd) kb[dd] = K_lds + KB * SHM_K + KSWZ(r32, (dd * 16 + hi * 8) * 2);
#pragma unroll
    for (int d0 = 0; d0 < 8; ++d0) { const char* a = kb[d0 & 3] + (d0 >> 2) * 128;
        bf16x8 b0 = *reinterpret_cast<const bf16x8*>(a);
        bf16x8 b1 = *reinterpret_cast<const bf16x8*>(a + 32 * 256);
        p0 = __builtin_amdgcn_mfma_f32_32x32x16_bf16(b0, qr[d0], p0, 0, 0, 0);
        p1 = __builtin_amdgcn_mfma_f32_32x32x16_bf16(b1, qr[d0], p1, 0, 0, 0); }
}
template <int VB, bool SK>
__device__ __forceinline__ void pv_tile(f32x16* o, int vb0, bf16x8 pa0, bf16x8 pa1, bf16x8 pa2, bf16x8 pa3, bool act) {
    if (SK && !act) return;
#define TRRD(dst, off) asm volatile("ds_read_b64_tr_b16 %0, %1 offset:%2" : "=&v"(dst) : "v"(vb0), "i"(off) : "memory")
#define PV_D0(d0) do { s16x4 l0, l1, l2, l3, h0, h1, h2, h3; constexpr int b_ = VB * SHM_V + v_rd_off(d0, 0, 0);     \
        TRRD(l0, b_); TRRD(h0, b_ + 2048); TRRD(l1, b_ + 4096); TRRD(h1, b_ + 6144); TRRD(l2, b_ + 8192); TRRD(h2, b_ + 10240); TRRD(l3, b_ + 12288); TRRD(h3, b_ + 14336); \
        asm volatile("s_waitcnt lgkmcnt(0)" ::: "memory"); SBAR();                 \
        o[d0] = __builtin_amdgcn_mfma_f32_32x32x16_bf16(pa0, (bf16x8){l0[0], l0[1], l0[2], l0[3], h0[0], h0[1], h0[2], h0[3]}, o[d0], 0, 0, 0);   \
        o[d0] = __builtin_amdgcn_mfma_f32_32x32x16_bf16(pa1, (bf16x8){l1[0], l1[1], l1[2], l1[3], h1[0], h1[1], h1[2], h1[3]}, o[d0], 0, 0, 0);   \
        o[d0] = __builtin_amdgcn_mfma_f32_32x32x16_bf16(pa2, (bf16x8){l2[0], l2[1], l2[2], l2[3], h2[0], h2[1], h2[2], h2[3]}, o[d0], 0, 0, 0);   \
        o[d0] = __builtin_amdgcn_mfma_f32_32x32x16_bf16(pa3, (bf16x8){l3[0], l3[1], l3[2], l3[3], h3[0], h3[1], h3[2], h3[3]}, o[d0], 0, 0, 0); } while (0)
    PV_D0(0); PV_D0(1); PV_D0(2); PV_D0(3);
#undef PV_D0
#undef TRRD
}

template <class TIn, class TOut> struct BlockRef { const TIn* Q; const TIn* K; const TIn* V; TOut* O; const float* cb; const float* onw; int P0; };
template <class TIn> struct Seam {
    bf16x8 qr[8];
    bf16x8 st_v0, st_v1, st_k0, st_k1; float st_b; f32x4 sf0, sf1, sf2, sf3;
    f32x4 tq[16];
};
__device__ __forceinline__ int swa_jlo(int P0, int W) { const int lowk = P0 - W + 1; return lowk > 0 ? lowk / KVBLK : 0; }
#define ROW(p, k0, rr) ((p) + (size_t)((k0) + (rr)) * D + sc)
#define VMW() asm volatile("s_waitcnt vmcnt(0)" ::: "memory")
#define VMWN(n) asm volatile("s_waitcnt vmcnt(%0)" :: "i"(n) : "memory")
#define SLOAD_H(Kp, Vp, Bp, k0) do { S.st_v0 = load8<TIn>(ROW(Vp, k0, sr)); S.st_v1 = load8<TIn>(ROW(Vp, k0, 32 + sr));              \
                         S.st_k0 = load8<TIn>(ROW(Kp, k0, sr)); S.st_k1 = load8<TIn>(ROW(Kp, k0, 32 + sr)); S.st_b = (Bp)[(k0) + (tid & 63)]; } while (0)
#define SWRITE_HK(bf) do { *(bf16x8*)(K_lds + (bf) * SHM_K + kws) = S.st_k0; *(bf16x8*)(K_lds + (bf) * SHM_K + kws + 32 * 256) = S.st_k1; \
                           if (tid < 64) ((float*)(K_lds + 2 * SHM_K + NW * 64 * 4))[(bf) * 64 + tid] = S.st_b; } while (0)
#define SWRITE_HV(bf) do { *(bf16x8*)(V_lds + (bf) * SHM_V + vst0) = S.st_v0; *(bf16x8*)(V_lds + (bf) * SHM_V + vst1) = S.st_v1; } while (0)
#define SWRITE_H(bf) do { SWRITE_HV(bf); SWRITE_HK(bf); } while (0)
#define SLOAD_F(p, k0) do { S.sf0 = *(const f32x4*)ROW(p, k0, sr); S.sf1 = *(const f32x4*)(ROW(p, k0, sr) + 4);                \
                            S.sf2 = *(const f32x4*)ROW(p, k0, 32 + sr); S.sf3 = *(const f32x4*)(ROW(p, k0, 32 + sr) + 4); } while (0)
#define SWRITE_KF(bf) do { *(bf16x8*)(K_lds + (bf) * SHM_K + kws) = pack8(S.sf0, S.sf1); *(bf16x8*)(K_lds + (bf) * SHM_K + kws + 32 * 256) = pack8(S.sf2, S.sf3); } while (0)
#define SWRITE_VF(bf) do { *(bf16x8*)(V_lds + (bf) * SHM_V + vst0) = pack8(S.sf0, S.sf1); *(bf16x8*)(V_lds + (bf) * SHM_V + vst1) = pack8(S.sf2, S.sf3); } while (0)
template <class TIn, class TOut>
__device__ __forceinline__ void causal_swa_prime(const BlockRef<TIn, TOut>& cur, int W, char* lds, Seam<TIn>& S) {
    constexpr bool F32 = same_t<TIn, float>::v;
    const int tid = fox_tid(), wid = __builtin_amdgcn_readfirstlane(tid >> 6), lane = tid & 63, r32 = lane & 31, hi = lane >> 5;
    const int sr = tid >> 4, sc = (tid & 15) * 8, kws = KSWZ(sr, sc * 2); char* K_lds = lds + 2 * SHM_V;
    const int kb0 = swa_jlo(cur.P0, W) * KVBLK;
    for (int d0 = 0; d0 < 8; ++d0) S.qr[d0] = load8<TIn>(cur.Q + (size_t)(wid * QBLK + r32) * D + d0 * 16 + hi * 8);
    if constexpr (F32) { SLOAD_F((const float*)cur.K, kb0); VMW(); SWRITE_KF(0); SBAR(); SLOAD_F((const float*)cur.V, kb0); }
    else { SLOAD_H(cur.K, cur.V, cur.cb, kb0); VMW(); SWRITE_HK(0); }
    __syncthreads();
}
template <class TIn, class TOut>
__device__ __forceinline__ void causal_swa_block(const BlockRef<TIn, TOut>& cur, const BlockRef<TIn, TOut>& nxt, int skv, int W, char* lds, Seam<TIn>& S) {
    constexpr bool F32 = same_t<TIn, float>::v;
    const int tid = fox_tid(), wid = __builtin_amdgcn_readfirstlane(tid >> 6), lane = tid & 63, r32 = lane & 31, hi = lane >> 5;
    const int j_lo = swa_jlo(cur.P0, W);
    int j_hi = (cur.P0 + QB - 1) / KVBLK + 1; if (j_hi > skv / KVBLK) j_hi = skv / KVBLK;
    const int NT = j_hi - j_lo;
    const int kbn = swa_jlo(nxt.P0, W) * KVBLK;
    const int qlo = cur.P0 + wid * QBLK, qm = qlo + r32 - 4 * hi;
    char* V_lds = lds; char* K_lds = lds + 2 * SHM_V;
    float* ws = (float*)(lds + 2 * SHM_V + 2 * SHM_K) + wid * 64; float* li_l = ws, * al_l = ws + 32;
    float m_reg = -1e30f, l_reg = 0; f32x16 o[4] = {};
    const int sr = tid >> 4, sc = (tid & 15) * 8, vst0 = v_st(sr, sc), vst1 = v_st(32 + sr, sc), kws = KSWZ(sr, sc * 2);
    const int vb0 = (int)(uintptr_t)V_lds + v_rd_base(lane);
    const TIn* Kh = cur.K; const TIn* Vh = cur.V;
#define RESC(a) do { if (__any((a) < 1.f)) { if (hi == 0) al_l[r32] = (a); asm volatile("s_waitcnt lgkmcnt(0)" ::: "memory");              \
                     for (int d_ = 0; d_ < 4; ++d_) for (int r = 0; r < 16; ++r) o[d_][r] *= al_l[crow(r, hi)]; } } while (0)
#define KBASE(t) ((j_lo + (t)) * KVBLK)
#define ACT(t) (KBASE(t) <= qlo + QBLK - 1 && KBASE(t) + KVBLK - 1 >= qlo - W + 1)
#define MASKT(P0_, P1_, t) do { const int kb_ = KBASE(t); if ((!SK || ACT(t)) && (kb_ + KVBLK - 1 > qlo || kb_ <= qlo + QBLK - 1 - W)) mask_tile(P0_, P1_, qm - kb_, (unsigned)W); } while (0)
    constexpr int NQL = F32 ? 16 : 8;
    constexpr bool SK = WSKIP && !F32;
#define SEAM_K0() do { VMWN(NQL); if constexpr (F32) { SWRITE_KF(0); SBAR(); SLOAD_F((const float*)nxt.V, kbn); } else { SWRITE_HK(0); } SBAR(); } while (0)
    f32x16 pA0, pA1, pB0, pB1; float mnA, mnB, alA, alB; bf16x8 pa0, pa1, pa2, pa3;
    if constexpr (F32) { VMW(); SWRITE_VF(0); SBAR(); } else { SWRITE_HV(0); SBAR(); }
    if (NT > 1) { if constexpr (F32) SLOAD_F((const float*)Kh, KBASE(1)); else SLOAD_H(Kh, Vh, cur.cb, KBASE(1)); }
    SBAR(); qkt<0, SK>(pA0, pA1, K_lds, r32, hi, S.qr, ACT(0));
    if constexpr (F32) { if (NT > 1) { VMW(); SWRITE_KF(1); SBAR(); SLOAD_F((const float*)Vh, KBASE(1)); } }
    MASKT(pA0, pA1, 0); partialSM(pA0, pA1, m_reg, mnA, alA);
    if (NT > 1) { VMW(); if constexpr (F32) { SWRITE_VF(1); SBAR(); if (NT > 2) SLOAD_F((const float*)Kh, KBASE(2)); } else SWRITE_H(1); }
    __syncthreads();
#define HALF_STEP(PX0, PX1, mnX, alX, PY0, PY1, alY, t, KB, VB, SB) do {                                                      \
        SBAR(); qkt<KB, SK>(PX0, PX1, K_lds, r32, hi, S.qr, ACT(t));                                             \
        finishSM(PY0, PY1, alY, l_reg, pa0, pa1, pa2, pa3); SBAR();                                                           \
        if ((t) + 1 < NT) { if constexpr (F32) { VMW(); SWRITE_KF(SB); SBAR(); SLOAD_F((const float*)Vh, KBASE((t) + 1)); }  \
                            else { SLOAD_H(Kh, Vh, cur.cb, KBASE((t) + 1)); } SBAR(); }                                               \
        pv_tile<VB, SK>(o, vb0, pa0, pa1, pa2, pa3, ACT((t) - 1)); MASKT(PX0, PX1, (t)); partialSM(PX0, PX1, m_reg, mnX, alX);                                        \
        __syncthreads();                                                                                                      \
        if ((t) + 1 < NT) { VMW(); if constexpr (F32) { SWRITE_VF(SB); SBAR(); if ((t) + 2 < NT) SLOAD_F((const float*)Kh, KBASE((t) + 2)); } \
                            else { SWRITE_H(SB); } }                                                                          \
        RESC(alX); __syncthreads(); } while (0)
    for (int t = 1; t + 1 < NT; t += 2) {
        HALF_STEP(pB0, pB1, mnB, alB, pA0, pA1, alA, t, 1, 0, 0);
        HALF_STEP(pA0, pA1, mnA, alA, pB0, pB1, alB, t + 1, 0, 1, 1);
    }
    const bool even = (NT & 1) == 0;
    if (even) { SBAR(); qkt<1, SK>(pB0, pB1, K_lds, r32, hi, S.qr, ACT(NT - 1)); SBAR(); }
#define QROW(e) (nxt.Q + (size_t)(wid * QBLK + r32) * D + ((e) >> 1) * 16 + hi * 8 + ((e) & 1) * 4)
    if constexpr (F32) { SLOAD_F((const float*)nxt.K, kbn); SBAR();
#pragma unroll
        for (int e = 0; e < 8; ++e) S.tq[e] = *(const f32x4*)QROW(e); }
    else { SLOAD_H(nxt.K, nxt.V, nxt.cb, kbn); SBAR();
#pragma unroll
        for (int d0 = 0; d0 < 8; ++d0) S.qr[d0] = load8<TIn>(nxt.Q + (size_t)(wid * QBLK + r32) * D + d0 * 16 + hi * 8); }
    SBAR();
    finishSM(pA0, pA1, alA, l_reg, pa0, pa1, pa2, pa3); SBAR();
    if constexpr (F32) {
#pragma unroll
        for (int e = 8; e < 16; ++e) S.tq[e] = *(const f32x4*)QROW(e); SBAR(); }
#undef QROW
    pv_tile<0, SK>(o, vb0, pa0, pa1, pa2, pa3, ACT(even ? NT - 2 : NT - 1));
    if (even) { MASKT(pB0, pB1, NT - 1); partialSM(pB0, pB1, m_reg, mnB, alB); __syncthreads(); RESC(alB);
        finishSM(pB0, pB1, alB, l_reg, pa0, pa1, pa2, pa3); SBAR(); pv_tile<1, SK>(o, vb0, pa0, pa1, pa2, pa3, ACT(NT - 1)); }
    SBAR(); SEAM_K0();
    if (hi == 0) li_l[r32] = l_reg; asm volatile("s_waitcnt lgkmcnt(0)" ::: "memory");
    { float gw[4];
#pragma unroll
      for (int d0 = 0; d0 < 4; ++d0) gw[d0] = cur.onw[d0 * 32 + r32];
      TOut* Ow = cur.O + (size_t)(wid * QBLK) * OLD;
#pragma unroll
      for (int r = 0; r < 16; ++r) { const int orow = crow(r, hi); const float rl = __builtin_amdgcn_rcpf(li_l[orow]);
          float v[4]; float ss = 0.f;
#pragma unroll
          for (int d0 = 0; d0 < 4; ++d0) { v[d0] = o[d0][r] * rl; ss += v[d0] * v[d0]; }
          ss = half32_sum(ss);
          const float rs = rsqrtf(ss * (1.f / 128.f) + 1e-6f);
#pragma unroll
          for (int d0 = 0; d0 < 4; ++d0) { const float y = v[d0] * rs * gw[d0]; const float yn = __shfl_xor(y, 1);
              if ((r32 & 1) == 0) *(unsigned*)(Ow + (size_t)orow * OLD + d0 * 32 + r32) = cvtpk(y, yn); } } }
    if constexpr (F32) {
#pragma unroll
        for (int d0 = 0; d0 < 8; ++d0) S.qr[d0] = pack8(S.tq[2 * d0], S.tq[2 * d0 + 1]); }
    __syncthreads();
#undef RESC
#undef KBASE
#undef ACT
#undef MASKT
#undef SEAM_K0
#undef HALF_STEP
}
#undef ROW
#undef VMW
#undef VMWN
#undef SLOAD_H
#undef SWRITE_HK
#undef SWRITE_HV
#undef SWRITE_H
#undef SLOAD_F
#undef SWRITE_KF
#undef SWRITE_VF


#undef KSWZ
#undef SBAR
}
constexpr size_t WS_KV = 186 * MiB;
constexpr size_t WS_SP = 218 * MiB;
constexpr size_t WS_CAT = 234 * MiB;
constexpr size_t WS_P34_END = 266 * MiB;
constexpr int CW_RETQ = 2048;
typedef short v4i16_t __attribute__((ext_vector_type(4)));
typedef float f32x16 __attribute__((ext_vector_type(16)));
constexpr int TLD = 136;
constexpr int TILE_EL = 128 * TLD;

__device__ __forceinline__ bf16x8 frag_row(const LAS bf16* X, int r0, int k0, int lane) {
    return *(const LAS bf16x8*)(X + (r0 + (lane & 31)) * TLD + k0 + 8 * (lane >> 5));
}
__device__ __forceinline__ bf16x8 frag_tr(const LAS bf16* X, int k0, int c0, int lane) {
    const int g = lane >> 4, i = lane & 15, q = i >> 2, p = i & 3, h = g >> 1;
    const LAS bf16* a = X + (k0 + 8 * h + q) * TLD + c0 + 16 * (g & 1) + 4 * p;
    const v4i16_t lo = __builtin_amdgcn_ds_read_tr16_b64_v4i16((LAS v4i16_t*)a);
    const v4i16_t hi = __builtin_amdgcn_ds_read_tr16_b64_v4i16((LAS v4i16_t*)(a + 4 * TLD));
    return (bf16x8){lo[0], lo[1], lo[2], lo[3], hi[0], hi[1], hi[2], hi[3]};
}
__device__ __forceinline__ int crow16(int r, int hi) { return (r & 3) + 8 * (r >> 2) + 4 * hi; }
__device__ __forceinline__ float bf2f(unsigned short v) { return __uint_as_float((unsigned)v << 16); }
__device__ __forceinline__ float ret_lg2(int h) { return log1pf(-exp2f(-5.f - (float)h)) * 1.4426950408889634f; }

__device__ __forceinline__ void p3_item(Frame& F, int bh, int n) {
    const int h = bh & 7, tid = F.tid, lane = F.lane, w = F.wave;
    bf16* qkv = (bf16*)(F.ws + WS_QKV);
    const size_t rbase = ((size_t)bh * SEQ + (size_t)n * 128) * HD;
    bf16* RQ = qkv + 0 * TSZ + rbase; bf16* RK = qkv + 1 * TSZ + rbase; const bf16* RV = qkv + 2 * TSZ + rbase; bf16* RG = qkv + 3 * TSZ + rbase;
    bf16* FQ = qkv + 4 * TSZ + rbase; bf16* FK = qkv + 5 * TSZ + rbase;
    LAS bf16* Kz = (LAS bf16*)F.lds; LAS bf16* Vt = Kz + TILE_EL;
    const float lg2 = ret_lg2(h);
    { const int row = tid >> 2, c16 = (tid & 3) * 16, s = n * 128 + row;
      const float* cs = (const float*)(F.ws + WS_CS) + ((size_t)s * 64 + c16) * 2;
      float cv[16], sv[16];
#pragma unroll
      for (int i = 0; i < 16; i += 2) { const f32x4 t = *(const f32x4*)(cs + 2 * i); cv[i] = t[0]; sv[i] = t[1]; cv[i + 1] = t[2]; sv[i + 1] = t[3]; }
      const float zeta = exp2f(lg2 * (float)(127 - row));
#pragma unroll
      for (int which = 0; which < 2; ++which) {
          bf16* P = (which == 0 ? RQ : RK) + (size_t)row * HD + c16;
          const bf16x8 a0 = *(const bf16x8*)P, a1 = *(const bf16x8*)(P + 8), b0 = *(const bf16x8*)(P + 64), b1 = *(const bf16x8*)(P + 72);
          float o1[16], o2[16];
#pragma unroll
          for (int i = 0; i < 16; ++i) { const float x1 = bf2f((unsigned short)(i < 8 ? a0[i & 7] : a1[i & 7])), x2 = bf2f((unsigned short)(i < 8 ? b0[i & 7] : b1[i & 7]));
              o1[i] = x1 * cv[i] - x2 * sv[i]; o2[i] = x1 * sv[i] + x2 * cv[i]; }
          if (which == 1) {
#pragma unroll
              for (int i = 0; i < 16; ++i) { o1[i] *= 0.08838834764831845f; o2[i] *= 0.08838834764831845f; } }
          v4u w0, w1, w2, w3;
          w0.x = pk2(o1[0], o1[1]); w0.y = pk2(o1[2], o1[3]); w0.z = pk2(o1[4], o1[5]); w0.w = pk2(o1[6], o1[7]);
          w1.x = pk2(o1[8], o1[9]); w1.y = pk2(o1[10], o1[11]); w1.z = pk2(o1[12], o1[13]); w1.w = pk2(o1[14], o1[15]);
          w2.x = pk2(o2[0], o2[1]); w2.y = pk2(o2[2], o2[3]); w2.z = pk2(o2[4], o2[5]); w2.w = pk2(o2[6], o2[7]);
          w3.x = pk2(o2[8], o2[9]); w3.y = pk2(o2[10], o2[11]); w3.z = pk2(o2[12], o2[13]); w3.w = pk2(o2[14], o2[15]);
          *(v4u*)P = w0; *(v4u*)(P + 8) = w1; *(v4u*)(P + 64) = w2; *(v4u*)(P + 72) = w3;
          if (which == 1) {
              v4u z0, z1, z2, z3;
              z0.x = pk2(o1[0] * zeta, o1[1] * zeta); z0.y = pk2(o1[2] * zeta, o1[3] * zeta); z0.z = pk2(o1[4] * zeta, o1[5] * zeta); z0.w = pk2(o1[6] * zeta, o1[7] * zeta);
              z1.x = pk2(o1[8] * zeta, o1[9] * zeta); z1.y = pk2(o1[10] * zeta, o1[11] * zeta); z1.z = pk2(o1[12] * zeta, o1[13] * zeta); z1.w = pk2(o1[14] * zeta, o1[15] * zeta);
              z2.x = pk2(o2[0] * zeta, o2[1] * zeta); z2.y = pk2(o2[2] * zeta, o2[3] * zeta); z2.z = pk2(o2[4] * zeta, o2[5] * zeta); z2.w = pk2(o2[6] * zeta, o2[7] * zeta);
              z3.x = pk2(o2[8] * zeta, o2[9] * zeta); z3.y = pk2(o2[10] * zeta, o2[11] * zeta); z3.z = pk2(o2[12] * zeta, o2[13] * zeta); z3.w = pk2(o2[14] * zeta, o2[15] * zeta);
              LAS bf16* L = Kz + row * TLD + c16;
              *(LAS v4u*)L = z0; *(LAS v4u*)(L + 8) = z1; *(LAS v4u*)(L + 64) = z2; *(LAS v4u*)(L + 72) = z3; }
      } }
#pragma unroll
    for (int j = 0; j < 4; ++j) { const int c = tid + 512 * j, row = c >> 4, col8 = (c & 15) * 8;
        *(LAS v4u*)(Vt + row * TLD + col8) = *(const v4u*)(RV + (size_t)row * HD + col8);
        bf16x8 g = *(const bf16x8*)(RG + (size_t)row * HD + col8); float gv[8];
#pragma unroll
        for (int i = 0; i < 8; ++i) gv[i] = silu_f(bf2f((unsigned short)g[i]));
        v4u o; o.x = pk2(gv[0], gv[1]); o.y = pk2(gv[2], gv[3]); o.z = pk2(gv[4], gv[5]); o.w = pk2(gv[6], gv[7]);
        *(v4u*)(RG + (size_t)row * HD + col8) = o; }
    { const float* qn = F.in[9]; const float* kn = F.in[10];
      const float q0 = qn[2 * lane], q1 = qn[2 * lane + 1], k0 = kn[2 * lane], k1 = kn[2 * lane + 1];
#pragma unroll 4
      for (int rr = 0; rr < 16; ++rr) { const int row = w * 16 + rr;
          unsigned* pq = (unsigned*)(FQ + (size_t)row * HD) + lane; unsigned* pk = (unsigned*)(FK + (size_t)row * HD) + lane;
          const unsigned uq = *pq, uk = *pk;
          const float a0 = __uint_as_float(uq << 16), a1 = __uint_as_float(uq & 0xffff0000u), b0 = __uint_as_float(uk << 16), b1 = __uint_as_float(uk & 0xffff0000u);
          const float sq = wave_sum(a0 * a0 + a1 * a1), sk = wave_sum(b0 * b0 + b1 * b1);
          const float rq = rsqrtf(sq * (1.f / 128.f) + EPS), rk = rsqrtf(sk * (1.f / 128.f) + EPS);
          *pq = pk2(a0 * rq * q0, a1 * rq * q1); *pk = pk2(b0 * rk * k0, b1 * rk * k1); } }
    LDS_WAIT(); __syncthreads();
    { const int db = w >> 1, eb = 2 * (w & 1), hi = lane >> 5;
      f32x16 a0 = {}, a1 = {};
#pragma unroll
      for (int kk = 0; kk < 8; ++kk) { const bf16x8 a = frag_tr(Kz, 16 * kk, 32 * db, lane), b0 = frag_tr(Vt, 16 * kk, 32 * eb, lane), b1 = frag_tr(Vt, 16 * kk, 32 * eb + 32, lane);
          a0 = __builtin_amdgcn_mfma_f32_32x32x16_bf16(a, b0, a0, 0, 0, 0); a1 = __builtin_amdgcn_mfma_f32_32x32x16_bf16(a, b1, a1, 0, 0, 0); }
      float* KV = (float*)(F.ws + WS_KV) + ((size_t)bh * 32 + n) * 16384;
#pragma unroll
      for (int r = 0; r < 16; ++r) { const int d = 32 * db + crow16(r, hi); KV[d * 128 + 32 * eb + (lane & 31)] = a0[r]; KV[d * 128 + 32 * eb + 32 + (lane & 31)] = a1[r]; } }
    LDS_WAIT(); __syncthreads();
}
__device__ __forceinline__ void p3_cumsum(Frame& F, int bh) {
    const float* lf = (const float*)(F.ws + WS_LOGF) + (size_t)bh * SEQ + 64 * F.lane; float* cb = (float*)(F.ws + WS_CB) + (size_t)bh * SEQ + 64 * F.lane;
    float tot = 0.f;
#pragma unroll 8
    for (int i = 0; i < 64; ++i) tot += lf[i];
    float incl = tot;
#pragma unroll
    for (int o = 1; o < 64; o <<= 1) { const float t = __shfl_up(incl, o); if (F.lane >= o) incl += t; }
    float run = incl - tot;
#pragma unroll 8
    for (int i = 0; i < 64; ++i) { run += lf[i]; cb[i] = -run * 11.313708498984761f; }
}
__device__ __forceinline__ void p3_phase(Frame& F) {
    if (F.wave == 0) for (int bh = blockIdx.x; bh < 16; bh += F.G) p3_cumsum(F, bh);
    for (int it = blockIdx.x; it < 512; it += F.G) p3_item(F, it >> 5, it & 31);
}
__device__ __forceinline__ void p3b_scan(Frame& F) {
    const float* KV = (const float*)(F.ws + WS_KV); bf16* SP = (bf16*)(F.ws + WS_SP);
    for (int idx = blockIdx.x * (NWAVES * 64) + F.tid; idx < 16 * 16384; idx += F.G * NWAVES * 64) {
        const int bh = idx >> 14, de = idx & 16383; const float cd = exp2f(ret_lg2(bh & 7) * 128.f);
        float st = 0.f;
        for (int n = 0; n < 32; ++n) { const size_t o = ((size_t)bh * 32 + n) * 16384 + de; SP[o] = (bf16)f2bf(st); st = st * cd + KV[o]; }
    }
}
__device__ __forceinline__ void ret_item(Frame& F, int bh, int n) {
    const int h = bh & 7, b = bh >> 3, tid = F.tid, lane = F.lane, w = F.wave, hi = lane >> 5, c32 = lane & 31;
    const bf16* qkv = (const bf16*)(F.ws + WS_QKV);
    const size_t rbase = ((size_t)bh * SEQ + (size_t)n * 128) * HD;
    const bf16* RQ = qkv + 0 * TSZ + rbase; const bf16* RK = qkv + 1 * TSZ + rbase; const bf16* RV = qkv + 2 * TSZ + rbase; const bf16* RG = qkv + 3 * TSZ + rbase;
    const bf16* SPg = (const bf16*)(F.ws + WS_SP) + ((size_t)bh * 32 + n) * 16384;
    LAS bf16* Qs = (LAS bf16*)F.lds; LAS bf16* Ks = Qs + TILE_EL; LAS bf16* Vs = Ks + TILE_EL; LAS bf16* Ss = Vs + TILE_EL;
    LAS float* st = (LAS float*)(Ss + TILE_EL);
#pragma unroll
    for (int j = 0; j < 4; ++j) { const int c = tid + 512 * j, row = c >> 4, col8 = (c & 15) * 8; const size_t go = (size_t)row * HD + col8; const int lo = row * TLD + col8;
        *(LAS v4u*)(Qs + lo) = *(const v4u*)(RQ + go); *(LAS v4u*)(Ks + lo) = *(const v4u*)(RK + go);
        *(LAS v4u*)(Vs + lo) = *(const v4u*)(RV + go); *(LAS v4u*)(Ss + lo) = *(const v4u*)(SPg + go); }
    LDS_WAIT(); __syncthreads();
    const int qb = w >> 1, cb2 = 2 * (w & 1);
    const float lg2 = ret_lg2(h);
    f32x16 s0 = {}, s1 = {};
#pragma unroll
    for (int kk = 0; kk < 8; ++kk) { const bf16x8 a = frag_row(Qs, 32 * qb, 16 * kk, lane), b0 = frag_row(Ks, 32 * cb2, 16 * kk, lane), b1 = frag_row(Ks, 32 * cb2 + 32, 16 * kk, lane);
        s0 = __builtin_amdgcn_mfma_f32_32x32x16_bf16(a, b0, s0, 0, 0, 0); s1 = __builtin_amdgcn_mfma_f32_32x32x16_bf16(a, b1, s1, 0, 0, 0); }
    const int key0 = 32 * cb2 + c32, key1 = key0 + 32;
    const float f0 = exp2f(-lg2 * (float)(key0 + 1)), f1 = exp2f(-lg2 * (float)(key1 + 1));
    LDS_WAIT(); __syncthreads();
#pragma unroll
    for (int r = 0; r < 16; ++r) { const int q = 32 * qb + crow16(r, hi);
        Ks[q * TLD + key0] = (bf16)f2bf(key0 <= q ? s0[r] * f0 : 0.f); Ks[q * TLD + key1] = (bf16)f2bf(key1 <= q ? s1[r] * f1 : 0.f); }
    LDS_WAIT(); __syncthreads();
    f32x16 o0 = {}, o1 = {};
#pragma unroll
    for (int kk = 0; kk < 8; ++kk) { const bf16x8 a = frag_row(Ks, 32 * qb, 16 * kk, lane), b0 = frag_tr(Vs, 16 * kk, 32 * cb2, lane), b1 = frag_tr(Vs, 16 * kk, 32 * cb2 + 32, lane);
        o0 = __builtin_amdgcn_mfma_f32_32x32x16_bf16(a, b0, o0, 0, 0, 0); o1 = __builtin_amdgcn_mfma_f32_32x32x16_bf16(a, b1, o1, 0, 0, 0); }
#pragma unroll
    for (int kk = 0; kk < 8; ++kk) { const bf16x8 a = frag_row(Qs, 32 * qb, 16 * kk, lane), b0 = frag_tr(Ss, 16 * kk, 32 * cb2, lane), b1 = frag_tr(Ss, 16 * kk, 32 * cb2 + 32, lane);
        o0 = __builtin_amdgcn_mfma_f32_32x32x16_bf16(a, b0, o0, 0, 0, 0); o1 = __builtin_amdgcn_mfma_f32_32x32x16_bf16(a, b1, o1, 0, 0, 0); }
#pragma unroll
    for (int r = 0; r < 16; ++r) { const int q = 32 * qb + crow16(r, hi); const float xi = exp2f(lg2 * (float)(q + 1));
        o0[r] *= xi; o1[r] *= xi;
        float s = o0[r] + o1[r], ss = o0[r] * o0[r] + o1[r] * o1[r];
        s = half32_sum(s); ss = half32_sum(ss);
        if (c32 == 0) { st[q * 4 + (w & 1) * 2] = s; st[q * 4 + (w & 1) * 2 + 1] = ss; } }
    LDS_WAIT(); __syncthreads();
    { const float* gn = F.in[8] + h * 128; const float g0 = gn[key0], g1 = gn[key1];
      bf16* CAT = (bf16*)(F.ws + WS_CAT) + ((size_t)b * SEQ + (size_t)n * 128) * DM + h * 128;
#pragma unroll
      for (int r = 0; r < 16; ++r) { const int q = 32 * qb + crow16(r, hi);
          const float s = st[q * 4] + st[q * 4 + 2], ss = st[q * 4 + 1] + st[q * 4 + 3];
          const float mu = s * (1.f / 128.f), var = fmaxf(ss * (1.f / 128.f) - mu * mu, 0.f), rstd = rsqrtf(var + EPS);
          const float y0 = (o0[r] - mu) * rstd * g0 * bf2f(RG[(size_t)q * HD + key0]), y1 = (o1[r] - mu) * rstd * g1 * bf2f(RG[(size_t)q * HD + key1]);
          CAT[(size_t)q * DM + key0] = (bf16)f2bf(y0); CAT[(size_t)q * DM + key1] = (bf16)f2bf(y1); } }
    LDS_WAIT(); __syncthreads();
}
__device__ __forceinline__ void p4_phase(Frame& F) {
    const int bx = blockIdx.x; const int vcu = (F.G % 8 == 0) ? (bx % 8) * (F.G / 8) + bx / 8 : bx;
    const bf16* qkv = (const bf16*)(F.ws + WS_QKV);
    bf16* CAT = (bf16*)(F.ws + WS_CAT);
    for (int fb = vcu; fb < 256; fb += F.G) {
        const int bh = fb >> 4, qb = fb & 15, h = bh & 7, b = bh >> 3;
        fox::BlockRef<bf16, bf16> cur;
        cur.Q = qkv + 4 * TSZ + ((size_t)bh * SEQ + (size_t)qb * 256) * HD; cur.K = qkv + 5 * TSZ + (size_t)bh * SEQ * HD; cur.V = qkv + 6 * TSZ + (size_t)bh * SEQ * HD;
        cur.O = CAT + ((size_t)b * SEQ + (size_t)qb * 256) * DM + 1024 + h * 128; cur.cb = (const float*)(F.ws + WS_CB) + (size_t)bh * SEQ; cur.onw = F.in[11] + h * 128; cur.P0 = qb * 256;
        fox::Seam<bf16> S;
        fox::causal_swa_prime<bf16, bf16>(cur, SEQ, F.ldsg, S);
        fox::causal_swa_block<bf16, bf16>(cur, cur, SEQ, SEQ, F.ldsg, S);
        asm volatile("s_waitcnt vmcnt(0)" ::: "memory");
        __syncthreads();
    }
    for (;;) {
        if (F.tid == 0) F.MISC[0] = atomicAdd((unsigned*)(F.ws + WS_CTL) + CW_RETQ, 1u);
        __syncthreads();
        const unsigned item = F.MISC[0];
        __syncthreads();
        if (item >= 512u) break;
        ret_item(F, (int)(item >> 5), (int)(item & 31));
    }
}
constexpr int PADROWS = 24576;
constexpr int LTAB_OFF = LDSCTL_OFF + 1024;
struct EpiPlain {
    static constexpr bool PERM = true, AFTER_DRAIN = false;
    bf16* O; int ldc; int ntn;
    template <class U> __device__ __forceinline__ void operator()(const pg8::f32x4 (&acc)[2][2][4][2], const U& u, int wr, int wc, int fr, int fq) const {
        const int row0 = u.pm * 256 + wr * 64 + fr, col0 = (u.pn % ntn) * 256 + wc * 32 + 8 * fq;
#pragma unroll
        for (int ai = 0; ai < 2; ++ai)
#pragma unroll
            for (int m = 0; m < 4; ++m) { bf16* rowp = O + (size_t)(row0 + ai * 128 + m * 16) * ldc + col0;
#pragma unroll
                for (int bj = 0; bj < 2; ++bj) { const pg8::f32x4 v0 = acc[ai][bj][m][0], v1 = acc[ai][bj][m][1];
                    pg8::u32x4 w; w.x = pg8::cvt_pk_bf16(v0[0], v0[1]); w.y = pg8::cvt_pk_bf16(v0[2], v0[3]); w.z = pg8::cvt_pk_bf16(v1[0], v1[1]); w.w = pg8::cvt_pk_bf16(v1[2], v1[3]);
                    *(pg8::u32x4*)(rowp + bj * 128) = w; } }
    }
};
struct EpiSwiglu {
    static constexpr bool PERM = true, AFTER_DRAIN = false;
    bf16* O;
    template <class U> __device__ __forceinline__ void operator()(const pg8::f32x4 (&acc)[2][2][4][2], const U& u, int wr, int wc, int fr, int fq) const {
        const int row0 = u.pm * 256 + wr * 64 + fr, col0 = (u.pn & 3) * 128 + wc * 32 + 8 * fq;
#pragma unroll
        for (int ai = 0; ai < 2; ++ai)
#pragma unroll
            for (int m = 0; m < 4; ++m) { float g[8];
#pragma unroll
                for (int n = 0; n < 2; ++n)
#pragma unroll
                    for (int i = 0; i < 4; ++i) { const float a = acc[ai][0][m][n][i], b = acc[ai][1][m][n][i]; g[4 * n + i] = a * __builtin_amdgcn_rcpf(1.f + __expf(-a)) * b; }
                pg8::u32x4 w; w.x = pg8::cvt_pk_bf16(g[0], g[1]); w.y = pg8::cvt_pk_bf16(g[2], g[3]); w.z = pg8::cvt_pk_bf16(g[4], g[5]); w.w = pg8::cvt_pk_bf16(g[6], g[7]);
                *(pg8::u32x4*)(O + (size_t)(row0 + ai * 128 + m * 16) * DE + col0) = w; }
    }
};
struct GUnit { int pm, pn, e, lt; };
template <int NJ> struct GroupedOrder {
    typedef GUnit unit_t;
    const LAS int* ts; int G, c, total;
    __device__ __forceinline__ void init(const LAS int* ts_, int G_, int c_) { ts = ts_; G = G_; c = c_; total = ts_[32] * NJ; }
    __device__ __forceinline__ bool next(int i, GUnit& u) const {
        const int L = i * G + c; if (L >= total) return false;
        const int mt = L / NJ, j = L % NJ; int e = 0;
        while (ts[e + 1] <= mt) ++e;
        u.e = e; u.lt = mt - ts[e]; u.pm = mt; u.pn = e * NJ + j; return true;
    }
    __device__ __forceinline__ void a_ready(const GUnit&) const {}
    __device__ __forceinline__ void done(const GUnit&) const {}
};
struct GatherRows { const int* list; const LAS int* cntL;
    __device__ __forceinline__ unsigned row(const GUnit& u, int r) const { const int lr = u.lt * 256 + r; return lr < cntL[u.e] ? (unsigned)list[(size_t)u.e * ECAP + lr] : 0u; } };
__device__ __forceinline__ void moe_tables(Frame& F) {
    LAS int* cntL = (LAS int*)(F.lds + LTAB_OFF); LAS int* ts = cntL + 32;
    __syncthreads();
    if (F.tid < 32) cntL[F.tid] = (int)__hip_atomic_load(F.ctl + F.cnt_off + 64 * F.tid, RLX_AGENT);
    __syncthreads();
    if (F.tid == 0) { int a = 0; for (int e = 0; e < 32; ++e) { ts[e] = a; a += (cntL[e] + 255) >> 8; } ts[32] = a; }
    __syncthreads();
}
__device__ __forceinline__ f32x4 bf4(unsigned lo, unsigned hi) { return (f32x4){__uint_as_float(lo << 16), __uint_as_float(lo & 0xffff0000u), __uint_as_float(hi << 16), __uint_as_float(hi & 0xffff0000u)}; }
template <int VAR>
__device__ __forceinline__ void p6_phase(Frame& F) {
    const float* x = F.in[0]; const float* wpost = F.in[5]; const float* wpre = F.in[13]; const float* rcb = F.in[16]; const float* rfb = F.in[18];
    const float* mod = (const float*)(F.ws + WS_MOD); const bf16* Yb = (const bf16*)(F.ws + WS_YB); bf16* Hb = (bf16*)(F.ws + WS_HB);
    const f32x4* RWP = (const f32x4*)(F.ws + WS_RWP);
    int* list = (int*)(F.ws + WS_LIST); int* SE = (int*)(F.ws + WS_SLOT); int* SPOS = SE + 2 * T; float* SW = (float*)(SPOS + 2 * T);
    LAS f32x4* rw = (LAS f32x4*)F.lds;
    const int lane = F.lane;
    for (int pass = blockIdx.x; pass < T / 16; pass += F.G) {
        const int row0 = pass * 16 + 2 * F.wave;
        f32x4 h2[2][8];
#pragma unroll
        for (int rr = 0; rr < 2; ++rr) {
            const int row = row0 + rr, b = row >> 12;
            const f32x4* xr = (const f32x4*)(x + (size_t)row * DM) + lane; const uint2* yr = (const uint2*)(Yb + (size_t)row * DM) + lane;
            f32x4* outr = (f32x4*)(F.out + (size_t)row * DM) + lane; uint2* hr = (uint2*)(Hb + (size_t)row * DM) + lane;
            const f32x4* mb = (const f32x4*)(mod + (size_t)b * 6 * DM) + lane;
            f32x4 v[8]; float ss = 0.f;
#pragma unroll
            for (int j = 0; j < 8; ++j) { const uint2 u = yr[64 * j]; v[j] = bf4(u.x, u.y); ss += (v[j].x * v[j].x + v[j].y * v[j].y) + (v[j].z * v[j].z + v[j].w * v[j].w); }
            const float rstd_y = rsqrtf(wave_sum(ss) * (1.f / DM) + EPS);
            float s2 = 0.f;
#pragma unroll
            for (int j = 0; j < 8; ++j) { const f32x4 x1 = xr[64 * j] + mb[2 * 512 + 64 * j] * (v[j] * rstd_y * ((const f32x4*)wpost)[lane + 64 * j]);
                outr[64 * j] = x1; v[j] = x1; s2 += (x1.x * x1.x + x1.y * x1.y) + (x1.z * x1.z + x1.w * x1.w); }
            asm volatile("" ::: "memory");
            const float rstd = rsqrtf(wave_sum(s2) * (1.f / DM) + EPS);
#pragma unroll
            for (int j = 0; j < 8; ++j) { const f32x4 h = v[j] * rstd * ((const f32x4*)wpre)[lane + 64 * j] * (mb[4 * 512 + 64 * j] + 1.0f) + mb[3 * 512 + 64 * j];
                h2[rr][j] = h; uint2 o; o.x = pk2(h.x, h.y); o.y = pk2(h.z, h.w); hr[64 * j] = o; }
            asm volatile("" ::: "memory");
        }
        float acc[2][36];
#pragma unroll
        for (int o = 0; o < 36; ++o) { acc[0][o] = 0.f; acc[1][o] = 0.f; }
#define RW_STAGE(j_, buf_) do { for (int p_ = F.wave; p_ < 36; p_ += NWAVES) \
            __builtin_amdgcn_global_load_lds((const unsigned*)(RWP + (j_) * 36 * 64 + p_ * 64 + lane), (LAS unsigned*)(rw + (buf_) * 36 * 64 + p_ * 64), 16, 0, 0); } while (0)
        if (VAR != 2 && VAR != 3) { RW_STAGE(0, 0); }
#pragma unroll
        for (int j = 0; j < ((VAR == 2 || VAR == 3) ? 0 : 8); ++j) {
            asm volatile("s_waitcnt vmcnt(0)" ::: "memory"); __syncthreads();
            if (j + 1 < 8) RW_STAGE(j + 1, (j + 1) & 1);
            const LAS f32x4* rwj = rw + (j & 1) * 36 * 64;
#pragma unroll
            for (int o = 0; o < 36; ++o) { const f32x4 w4 = rwj[o * 64 + lane];
                acc[0][o] += (h2[0][j].x * w4.x + h2[0][j].y * w4.y) + (h2[0][j].z * w4.z + h2[0][j].w * w4.w);
                acc[1][o] += (h2[1][j].x * w4.x + h2[1][j].y * w4.y) + (h2[1][j].z * w4.z + h2[1][j].w * w4.w);
                asm volatile("" : "+v"(acc[0][o]), "+v"(acc[1][o])); }
        }
#pragma unroll
        for (int rr = 0; rr < 2; ++rr) {
            float lg[36];
#pragma unroll
            for (int o = 0; o < 36; ++o) lg[o] = (VAR == 3) ? (acc[rr][o] + h2[rr][o & 7].x) : wave_sum(acc[rr][o]);
            int g = 0; float mx = lg[0] + rcb[0]; float c4[4];
#pragma unroll
            for (int j = 0; j < 4; ++j) c4[j] = lg[j] + rcb[j];
#pragma unroll
            for (int j = 1; j < 4; ++j) if (c4[j] > mx) { mx = c4[j]; g = j; }
            float den = 0.f;
#pragma unroll
            for (int j = 0; j < 4; ++j) den += expf(c4[j] - mx);
            const float gprob = 1.f / den;
            float f[8];
#pragma unroll
            for (int i = 0; i < 8; ++i) f[i] = (g == 0 ? lg[4 + i] : g == 1 ? lg[12 + i] : g == 2 ? lg[20 + i] : lg[28 + i]) + rfb[g * 8 + i];
            int i0 = 0; float v0 = f[0];
#pragma unroll
            for (int i = 1; i < 8; ++i) if (f[i] > v0) { v0 = f[i]; i0 = i; }
            int i1 = -1; float v1 = -3.0e38f;
#pragma unroll
            for (int i = 0; i < 8; ++i) if (i != i0 && f[i] > v1) { v1 = f[i]; i1 = i; }
            const float e1 = expf(v1 - v0); const float w0 = gprob / (1.f + e1), w1 = gprob * e1 / (1.f + e1);
            if (VAR == 1 || VAR == 3) { if (lane == 0) SW[2 * (row0 + rr)] = w0 + w1 + (float)(g * 8 + i0 + i1); } else
            if (lane == 0) { const int row = row0 + rr, ea = g * 8 + i0, eb = g * 8 + i1;
                const int pa = (int)atomicAdd((unsigned*)(F.ws + WS_CTL) + F.cnt_off + 64 * ea, 1u), pb = (int)atomicAdd((unsigned*)(F.ws + WS_CTL) + F.cnt_off + 64 * eb, 1u);
                list[(size_t)ea * ECAP + pa] = row; list[(size_t)eb * ECAP + pb] = row;
                SE[2 * row] = ea; SPOS[2 * row] = pa; SW[2 * row] = w0; SE[2 * row + 1] = eb; SPOS[2 * row + 1] = pb; SW[2 * row + 1] = w1; }
        }
    }
}
__device__ __forceinline__ void p9_final(Frame& F) {
    moe_tables(F);
    const LAS int* ts = (const LAS int*)(F.lds + LTAB_OFF) + 32;
    const float* wpost = F.in[14]; const float* mod = (const float*)(F.ws + WS_MOD); const bf16* Ys = (const bf16*)(F.ws + WS_YS);
    const int* SE = (const int*)(F.ws + WS_SLOT); const int* SPOS = SE + 2 * T; const float* SW = (const float*)(SPOS + 2 * T);
    const int lane = F.lane;
    for (int row = F.gw; row < T; row += F.NGW) {
        const int b = row >> 12;
        const int r0 = ts[SE[2 * row]] * 256 + SPOS[2 * row], r1 = ts[SE[2 * row + 1]] * 256 + SPOS[2 * row + 1]; const float w0 = SW[2 * row], w1 = SW[2 * row + 1];
        const uint2* y0 = (const uint2*)(Ys + (size_t)r0 * DM) + lane; const uint2* y1 = (const uint2*)(Ys + (size_t)r1 * DM) + lane;
        f32x4* outr = (f32x4*)(F.out + (size_t)row * DM) + lane; const f32x4* g2 = (const f32x4*)(mod + (size_t)b * 6 * DM + 5 * DM) + lane;
        f32x4 v[8]; float ss = 0.f;
#pragma unroll
        for (int j = 0; j < 8; ++j) { const uint2 a = y0[64 * j], c = y1[64 * j]; v[j] = bf4(a.x, a.y) * w0 + bf4(c.x, c.y) * w1; ss += (v[j].x * v[j].x + v[j].y * v[j].y) + (v[j].z * v[j].z + v[j].w * v[j].w); }
        const float rstd = rsqrtf(wave_sum(ss) * (1.f / DM) + EPS);
#pragma unroll
        for (int j = 0; j < 8; ++j) outr[64 * j] = outr[64 * j] + g2[64 * j] * (v[j] * rstd * ((const f32x4*)wpost)[lane + 64 * j]);
    }
}
__global__ void __launch_bounds__(NWAVES * 64, 2) mega_fwd(Args args) {
    extern __shared__ __attribute__((aligned(16))) unsigned char lds[];
    Frame F;
    F.lds = (LAS unsigned char*)lds; F.ldsg = (char*)lds;
    F.MISC = (volatile LAS unsigned*)(F.lds + MISC_OFF);
    F.tid = threadIdx.x; F.lane = F.tid & 63; F.wave = __builtin_amdgcn_readfirstlane(F.tid >> 6);
    F.G = gridDim.x; F.gw = blockIdx.x * NWAVES + F.wave; F.NGW = F.G * NWAVES;
    F.cnt_off = args.cnt_off;
    F.ws = args.ws; F.out = args.out; F.ctl = (gu32*)(args.ws + WS_CTL);
#pragma unroll
    for (int i = 0; i < 22; ++i) F.in[i] = args.in[i];
    for (int u = F.tid; u < (LDS_BYTES - LDSCTL_OFF) / 4; u += NWAVES * 64) ((LAS unsigned*)(F.lds + LDSCTL_OFF))[u] = 0u;
    __syncthreads();
    XcdBarrier bar = xcd_barrier_post((unsigned*)(F.ctl + CW_BAR), F.MISC + 8);
    const int lo = args.ph_lo, hi = args.ph_hi;
#define IN(k) (lo <= (k) && (k) < hi)
#define BOTH(k) (IN(k) && IN((k) + 1))
#define GRID_BAR() xcd_barrier(bar)
    if (IN(0)) { p0_prologue<false>(F); if (BOTH(0)) GRID_BAR(); }
    if (IN(1)) { p1_prenorm(F); if (BOTH(1)) GRID_BAR(); }
    if (IN(2)) {
        pg8::Gemm g{(const bf16*)(F.ws + WS_HB), (const bf16*)(F.ws + WS_WIN), T, INCM, DM}; pg8::StaticOrder S; S.init(T, INCM, F.G, (int)blockIdx.x);
        EpiHeads E{(bf16*)(F.ws + WS_QKV)};
        pg8::gemm_phase<EpiHeads, pg8::StaticOrder, true, true>(F.lds + RING_OFF, g, S, E);
        filler(F, 2, false);
        if (BOTH(2)) GRID_BAR();
    }
    if (IN(3)) { p3_phase(F); if (BOTH(3)) GRID_BAR(); }
    if (IN(4)) { p3b_scan(F); if (BOTH(4)) GRID_BAR(); }
    if (IN(5)) { p4_phase(F); filler(F, 5, false); if (BOTH(5)) GRID_BAR(); }
    if (IN(6)) {
        pg8::Gemm g{(const bf16*)(F.ws + WS_CAT), (const bf16*)(F.ws + WS_WOUT), T, DM, DM}; pg8::StaticOrder S; S.init(T, DM, F.G, (int)blockIdx.x);
        EpiPlain E{(bf16*)(F.ws + WS_YB), DM, 8};
        pg8::gemm_phase<EpiPlain, pg8::StaticOrder, true, true>(F.lds + RING_OFF, g, S, E);
        if (BOTH(6)) GRID_BAR();
    }
    if (IN(7)) { p6_phase<0>(F); filler(F, 7, true); if (BOTH(7)) GRID_BAR(); }
#ifdef PROBE_VARIANTS
    if (lo == 11) p6_phase<1>(F);
    if (lo == 12) p6_phase<2>(F);
    if (lo == 13) p6_phase<3>(F);
#endif
    if (IN(8)) {
        moe_tables(F);
        pg8::Gemm g{(const bf16*)(F.ws + WS_HB), (const bf16*)(F.ws + WS_W13), PADROWS, NE * 1024, DM};
        GroupedOrder<4> S; S.init((const LAS int*)(F.lds + LTAB_OFF) + 32, F.G, (int)blockIdx.x);
        EpiSwiglu E{(bf16*)(F.ws + WS_GB)}; GatherRows R{(const int*)(F.ws + WS_LIST), (const LAS int*)(F.lds + LTAB_OFF)};
        pg8::gemm_phase<EpiSwiglu, GroupedOrder<4>, true, true, GatherRows>(F.lds + RING_OFF, g, S, E, R);
        if (BOTH(8)) GRID_BAR();
    }
    if (IN(9)) {
        moe_tables(F);
        pg8::Gemm g{(const bf16*)(F.ws + WS_GB), (const bf16*)(F.ws + WS_W2), PADROWS, NE * 2048, DE};
        GroupedOrder<8> S; S.init((const LAS int*)(F.lds + LTAB_OFF) + 32, F.G, (int)blockIdx.x);
        EpiPlain E{(bf16*)(F.ws + WS_YS), DM, 8};
        pg8::gemm_phase<EpiPlain, GroupedOrder<8>, true, true>(F.lds + RING_OFF, g, S, E);
        if (BOTH(9)) GRID_BAR();
    }
    if (IN(10)) { p9_final(F); }
#undef IN
#undef BOTH
}

__global__ void k_adapt_proj(const bf16* __restrict__ qkv, const float* __restrict__ zb, float* __restrict__ proj) {
    const size_t i = (size_t)blockIdx.x * blockDim.x + threadIdx.x;
    if (i >= (size_t)T * INC) return;
    const int tok = (int)(i / INC), c = (int)(i % INC);
    if (c >= INCM) { proj[i] = zb[(size_t)tok * 8 + (c - INCM)]; return; }
    const int type = c >> 10, hh = (c & 1023) >> 7, d = c & 127, b = tok >> 12, s = tok & 4095;
    const unsigned v = qkv[(size_t)type * TSZ + ((size_t)((b * 8 + hh) * SEQ + s)) * HD + d];
    proj[i] = __uint_as_float(v << 16);
}

__global__ void k_adapt_cat(const bf16* __restrict__ catb, float* __restrict__ cat) {
    const size_t i = (size_t)blockIdx.x * blockDim.x + threadIdx.x;
    if (i < (size_t)T * DM) cat[i] = __uint_as_float((unsigned)catb[i] << 16);
}
extern "C" void kernel_launch(void* const* d_in, const int* in_sizes, int n_in, void* d_out, int out_size, void* d_ws, size_t ws_size, hipStream_t stream) {
    static int grid = 0;
    if (grid == 0) {
        int dev = 0, cus = 0, per_cu = 0;
        (void)hipGetDevice(&dev); (void)hipDeviceGetAttribute(&cus, hipDeviceAttributeMultiprocessorCount, dev);
        (void)hipFuncSetAttribute((const void*)mega_fwd, hipFuncAttributeMaxDynamicSharedMemorySize, LDS_BYTES);
        (void)hipOccupancyMaxActiveBlocksPerMultiprocessor(&per_cu, (const void*)mega_fwd, NWAVES * 64, LDS_BYTES);
        (void)hipGetLastError();
        if (per_cu < 1) { fprintf(stderr, "kernel_launch: occupancy query says %d blocks/CU\n", per_cu); per_cu = 1; }
        grid = cus > 0 ? cus : 256;
        if (ws_size < WS_END) fprintf(stderr, "kernel_launch: workspace too small (%zu < %zu)\n", ws_size, (size_t)WS_END);
    }
    (void)hipMemsetAsync((char*)d_ws + WS_CTL, 0, CTL_ZERO_BYTES, stream);
    Args a{};
    for (int i = 0; i < 22; ++i) a.in[i] = (const float*)d_in[i];
    a.out = (float*)d_out; a.ws = (unsigned char*)d_ws; a.ph_lo = 0; a.ph_hi = 11; a.cnt_off = CW_CNT;
    hipLaunchKernelGGL(mega_fwd, dim3(grid), dim3(NWAVES * 64), LDS_BYTES, stream, a);
}
```

```cpp
#include <hip/hip_runtime.h>
#include <stdint.h>
#include <cstdio>

constexpr int DM = 2048, NB = 2, SEQ = 4096, T = NB * SEQ;
constexpr int HD = 128, NH = 8;
constexpr int INC = 7176, INCM = 7168;
constexpr int NE = 32, DE = 512;
constexpr float EPS = 1e-6f;
#define GAS __attribute__((address_space(1)))
#define LAS __attribute__((address_space(3)))
typedef unsigned short bf16;
typedef unsigned v4u __attribute__((ext_vector_type(4)));
typedef float f32x4 __attribute__((ext_vector_type(4)));
typedef short bf16x8 __attribute__((ext_vector_type(8)));
typedef GAS unsigned gu32;
typedef GAS unsigned long long gu64;
#define RLX_AGENT __ATOMIC_RELAXED, __HIP_MEMORY_SCOPE_AGENT
#define LDS_WAIT() asm volatile("s_waitcnt lgkmcnt(0)" ::: "memory")
#define VM_WAIT() asm volatile("s_waitcnt vmcnt(0)" ::: "memory")
__device__ __forceinline__ unsigned long long rt() { return __builtin_amdgcn_s_memrealtime(); }
__device__ __forceinline__ unsigned f2bf(float f) { unsigned u = __builtin_bit_cast(unsigned, f); return (u + 0x7fffu + ((u >> 16) & 1u)) >> 16; }
__device__ __forceinline__ unsigned pk2(float lo, float hi) { return f2bf(lo) | (f2bf(hi) << 16); }

#define XB_TMO      128
#define XB_XCNT(j)  (256  + 64 * (j))
#define XB_XSUB(j)  (1280 + 64 * (j))
#define XB_XGEN(j)  (2304 + 64 * (j))
#define XB_TOP      3328
#define XB_TOPGEN   3392
#define XCD_BAR_WORDS 3456
#define XB_SPIN_CAP (1u << 18)

__device__ __forceinline__ unsigned xb_ld(unsigned* p)              { return __hip_atomic_load(p, __ATOMIC_RELAXED, __HIP_MEMORY_SCOPE_AGENT); }
__device__ __forceinline__ unsigned xb_add(unsigned* p, unsigned v) { return __hip_atomic_fetch_add(p, v, __ATOMIC_RELAXED, __HIP_MEMORY_SCOPE_AGENT); }
__device__ __forceinline__ unsigned xb_xcc_id() { return (unsigned)__builtin_amdgcn_s_getreg((3 << 11) | 20) & 0xFu; }
#define XB_SPIN(cond, bar) do { unsigned _sp = 0; while (cond) { __builtin_amdgcn_s_sleep(1); \
    if ((++_sp & 255u) == 0u) { if (xb_ld(&(bar)[XB_TMO])) break; if (_sp > XB_SPIN_CAP) { atomicAdd(&(bar)[XB_TMO], 1u); break; } } } } while (0)

struct XcdBarrier {
    unsigned* bar; unsigned x;
    volatile LAS unsigned* st;
};

__device__ __forceinline__ XcdBarrier xcd_barrier_post(unsigned* bar, volatile LAS unsigned* st) {
    XcdBarrier b; b.bar = bar; b.x = xb_xcc_id(); b.st = st;
    if (threadIdx.x == 0) (void)xb_add(&bar[XB_XCNT(b.x)], 1u);
    return b;
}
__device__ __forceinline__ void xcd_barrier_complete(unsigned* bar, unsigned x, unsigned& nloc, unsigned& nx) {
    const unsigned G = gridDim.x * gridDim.y * gridDim.z;
    unsigned sum, cnt, mine, sp = 0u;
    for (;;) {
        sum = 0u; cnt = 0u; mine = 0u;
#pragma unroll
        for (unsigned j = 0; j < 16; ++j) { const unsigned c = xb_ld(&bar[XB_XCNT(j)]); sum += c; cnt += (c > 0u) ? 1u : 0u; mine = (j == x) ? c : mine; }
        if (sum == G) break;
        __builtin_amdgcn_s_sleep(1);
        if ((++sp & 255u) == 0u) { if (xb_ld(&bar[XB_TMO])) break; if (sp > XB_SPIN_CAP) { atomicAdd(&bar[XB_TMO], 1u); break; } }
    }
    nloc = mine > 0u ? mine : 1u; nx = cnt > 0u ? cnt : 1u;
}

__device__ __forceinline__ void xcd_barrier(const XcdBarrier& b) {
    asm volatile("s_waitcnt vmcnt(0)" ::: "memory");
    __syncthreads();
    if (threadIdx.x == 0) {
        unsigned* bar = b.bar;
        __builtin_amdgcn_s_waitcnt(0);
        unsigned nloc = b.st[0], nx = b.st[1];
        if (nloc == 0u) { xcd_barrier_complete(bar, b.x, nloc, nx); b.st[0] = nloc; b.st[1] = nx; }
        const unsigned old = xb_add(&bar[XB_XSUB(b.x)], 1u);
        const unsigned gen = old / nloc;
        if (old + 1u == (gen + 1u) * nloc) {
            __builtin_amdgcn_fence(__ATOMIC_RELEASE, "agent");
            asm volatile("s_waitcnt vmcnt(0)" ::: "memory");
            const unsigned og = xb_add(&bar[XB_TOP], 1u);
            const unsigned tg = og / nx;
            if (og + 1u == (tg + 1u) * nx) xb_add(&bar[XB_TOPGEN], 1u);
            else XB_SPIN(xb_ld(&bar[XB_TOPGEN]) == tg, bar);
            __builtin_amdgcn_fence(__ATOMIC_ACQUIRE, "agent");
            xb_add(&bar[XB_XGEN(b.x)], 1u);
            asm volatile("s_waitcnt vmcnt(0)" ::: "memory");
        } else {
            XB_SPIN(xb_ld(&bar[XB_XGEN(b.x)]) == gen, bar);
            __builtin_amdgcn_fence(__ATOMIC_ACQUIRE, "agent");
            asm volatile("s_waitcnt vmcnt(0)" ::: "memory");
        }
    }
    __syncthreads();
}
namespace pg8 {
#define PG8_LAS __attribute__((address_space(3)))
typedef unsigned short bf16_t;
typedef short bf16x8 __attribute__((ext_vector_type(8)));
typedef float f32x4 __attribute__((ext_vector_type(4)));
typedef unsigned u32x4 __attribute__((ext_vector_type(4)));
constexpr int BM = 256, BK = 64, HALF = 128, HTB = HALF * BK * 2  , STAGE_BYTES = 8 * HTB, NXCD = 8, WGM = 8;

__host__ __device__ __forceinline__ int lds_byte(int r, int c) { const int st = (r >> 4) * 2 + (c >> 5), rr = r & 15, cc = c & 31, ob = rr * 64 + cc * 2; return st * 1024 + (ob ^ (((ob >> 9) & 1) << 5)); }
__host__ __device__ __forceinline__ void stage_rc(int b, int& R, int& C) { const int st = b / 1024, sb = b % 1024, swz = sb ^ (((sb >> 9) & 1) << 5); R = (st >> 1) * 16 + swz / 64; C = (st & 1) * 32 + (swz % 64) / 2; }
__host__ __device__ __forceinline__ int perm32(int rho) { const int n = rho >> 4, i = rho & 15; return 8 * (i >> 2) + 4 * n + (i & 3); }

struct Unit { int pm, pn; };
struct Gemm { const bf16_t* A; const bf16_t* Bt; int M, N, K; };

struct StaticOrder {
    typedef Unit unit_t;
    int nM, nN, nwg, G, c;
    __host__ __device__ void init(int M, int N, int G_, int c_) { nM = M / BM; nN = N / BM; nwg = nM * nN; G = G_; c = c_; }
    __host__ __device__ bool next(int i, Unit& u) const {
        const long L = (long)i * G + c; if (L >= nwg) return false;
        int wgid = (int)L; { const int q = nwg / NXCD, r = nwg % NXCD, xcd = wgid % NXCD, off = wgid / NXCD; wgid = (xcd < r ? xcd * (q + 1) : r * (q + 1) + (xcd - r) * q) + off; }
        const int nig = WGM * nN, gid = wgid / nig, fm = gid * WGM, gsz = (nM - fm) < WGM ? (nM - fm) : WGM;
        u.pm = fm + ((wgid % nig) % gsz); u.pn = (wgid % nig) / gsz; return true;
    }
    __device__ __forceinline__ void a_ready(const Unit&) const {}
    __device__ __forceinline__ void done(const Unit&) const {}
};

__device__ __forceinline__ unsigned cvt_pk_bf16(float lo, float hi) { unsigned r; asm volatile("v_cvt_pk_bf16_f32 %0, %1, %2" : "=v"(r) : "v"(lo), "v"(hi)); return r; }
typedef float f32x2 __attribute__((ext_vector_type(2)));
__device__ __forceinline__ f32x2 gelu_pk(f32x2 v) {
    const f32x2 av = __builtin_elementwise_abs(v), d = av * 0.2316418882f + 1.0f;
    f32x2 t; t.x = __builtin_amdgcn_rcpf(d.x); t.y = __builtin_amdgcn_rcpf(d.y);
    f32x2 q = t * 0.5307027145f + (-0.7265760135f); q = q * t + 0.7107068705f; q = q * t + (-0.142248368f); q = q * t + 0.127414796f; q = q * t;
    const f32x2 s = (v * v) * (-0.72134752044f);
    f32x2 e; e.x = __builtin_amdgcn_exp2f(s.x); e.y = __builtin_amdgcn_exp2f(s.y);
    const f32x2 m = v * (q * e), r = v - m;
    f32x2 o; o.x = v.x < 0.f ? m.x : r.x; o.y = v.y < 0.f ? m.y : r.y; return o;
}

template <int ACT  > struct EpiBf16 {
    static constexpr bool PERM = true, AFTER_DRAIN = false; static_assert(ACT == 0 || ACT == 1, "EpiBf16: ACT is 0 (none) or 1 (gelu_pk)");
    bf16_t* O; int ldc; const float* bias; int split_cols; size_t split_stride; float scale0;
    __device__ __forceinline__ void operator()(const f32x4 (&acc)[2][2][4][2], const Unit& u, int wr, int wc, int fr, int fq) const {
        const int row0 = u.pm * BM + wr * 64 + fr; int colt = u.pn * BM; bf16_t* base = O;
        float sc = 1.f; if (split_cols) { const int t = colt / split_cols; base += (size_t)t * split_stride; colt -= t * split_cols; if (t == 0) sc = scale0; }
        const int col0 = colt + wc * 32 + 8 * fq, bcol0 = u.pn * BM + wc * 32 + 8 * fq;
        f32x4 bv[2][2];
#pragma unroll
        for (int bj = 0; bj < 2; ++bj)
#pragma unroll
            for (int n = 0; n < 2; ++n) bv[bj][n] = bias ? *(const f32x4*)(bias + bcol0 + bj * HALF + 4 * n) : (f32x4){0.f, 0.f, 0.f, 0.f};
#pragma unroll
        for (int ai = 0; ai < 2; ++ai)
#pragma unroll
            for (int m = 0; m < 4; ++m) { bf16_t* rowp = base + (size_t)(row0 + ai * HALF + m * 16) * ldc + col0;
#pragma unroll
                for (int bj = 0; bj < 2; ++bj) { f32x4 v0 = acc[ai][bj][m][0] + bv[bj][0], v1 = acc[ai][bj][m][1] + bv[bj][1];
                    if (ACT == 1) { f32x2 a = gelu_pk((f32x2){v0[0], v0[1]}), b = gelu_pk((f32x2){v0[2], v0[3]}), c = gelu_pk((f32x2){v1[0], v1[1]}), d = gelu_pk((f32x2){v1[2], v1[3]});
                        v0 = (f32x4){a.x, a.y, b.x, b.y}; v1 = (f32x4){c.x, c.y, d.x, d.y}; }
                    v0 = v0 * sc; v1 = v1 * sc; u32x4 w; w.x = cvt_pk_bf16(v0[0], v0[1]); w.y = cvt_pk_bf16(v0[2], v0[3]); w.z = cvt_pk_bf16(v1[0], v1[1]); w.w = cvt_pk_bf16(v1[2], v1[3]);
                    *(u32x4*)(rowp + bj * HALF) = w; } }
    }
};
struct IdentRows { template <class U> __device__ __forceinline__ unsigned row(const U& u, int r) const { return (unsigned)(u.pm * BM + r); } };
template <class Epi, class Sched, bool ALIGN_EPI = false, bool SP2 = false, class RowMap = IdentRows>
__device__ __forceinline__ void gemm_phase(PG8_LAS unsigned char* lds, const Gemm g, const Sched& S, const Epi& E, const RowMap RM = RowMap()) {
    typedef typename Sched::unit_t Unit;
    const int tid = threadIdx.x, wid = __builtin_amdgcn_readfirstlane(tid >> 6), lane = tid & 63, wr = wid >> 2, wc = wid & 3, fr = lane & 15, fq = lane >> 4;
    const int K = g.K, nt = K / BK;
    unsigned voffB[2]; int RA[2], CA[2];
#pragma unroll
    for (int i = 0; i < 2; ++i) { int R, C; stage_rc(tid * 16 + i * 8192, R, C); const int Rb = Epi::PERM ? ((R & ~31) + perm32(R & 31)) : R;
        RA[i] = R; CA[i] = C; voffB[i] = (unsigned)(Rb * K + C) * 2u; }
    unsigned ao[2][2], an[2][2];
#define PG8_AOFF(dst, U) do { _Pragma("unroll") for (int h_ = 0; h_ < 2; ++h_) _Pragma("unroll") for (int i_ = 0; i_ < 2; ++i_) { \
        dst[h_][i_] = RM.row((U), h_ * HALF + RA[i_]) * (unsigned)(K * 2) + (unsigned)(CA[i_] * 2); } } while (0)
    const size_t kstep = (size_t)(BK * 2);
    const size_t hstep = (size_t)HALF * K * 2;
    const size_t tstep = 2 * hstep;
    const unsigned ldsw = (unsigned)wid * 1024u;
    const int aoff = lds_byte(wr * 64 + fr, fq * 8), boff = lds_byte(wc * 32 + fr, fq * 8);
#define PG8_SA(b, h) (((b) * 2 + (h)) * HTB)
#define PG8_SB(b, h) ((4 + (b) * 2 + (h)) * HTB)
#define PG8_STAGE(bufoff, gbase, voff) do { _Pragma("unroll") for (int _i = 0; _i < 2; ++_i) \
        __builtin_amdgcn_global_load_lds((const unsigned*)((const char*)(gbase) + (voff)[_i]), (PG8_LAS unsigned*)(lds + (bufoff) + ldsw + _i * 8192), 16, 0, 0); } while (0)
#define PG8_STAGE_A(bufoff, kbase, off) do { _Pragma("unroll") for (int _i = 0; _i < 2; ++_i) \
        __builtin_amdgcn_global_load_lds((const unsigned*)((const char*)(kbase) + (off)[_i]), (PG8_LAS unsigned*)(lds + (bufoff) + ldsw + _i * 8192), 16, 0, 0); } while (0)
#define PG8_LDA(dst, b, h) do { _Pragma("unroll") for (int m = 0; m < 4; ++m) _Pragma("unroll") for (int k = 0; k < 2; ++k) dst[m][k] = *(const PG8_LAS bf16x8*)(lds + PG8_SA(b, h) + aoff + m * 2048 + k * 1024); } while (0)
#define PG8_LDB(dst, b, h) do { _Pragma("unroll") for (int n = 0; n < 2; ++n) _Pragma("unroll") for (int k = 0; k < 2; ++k) dst[n][k] = *(const PG8_LAS bf16x8*)(lds + PG8_SB(b, h) + boff + n * 2048 + k * 1024); } while (0)
#define PG8_MMA(ai, bj, At, Bt) do { __builtin_amdgcn_s_setprio(1); _Pragma("unroll") for (int m = 0; m < 4; ++m) _Pragma("unroll") for (int n = 0; n < 2; ++n) _Pragma("unroll") for (int k = 0; k < 2; ++k) \
        acc[ai][bj][m][n] = __builtin_amdgcn_mfma_f32_16x16x32_bf16(Bt[n][k], At[m][k], acc[ai][bj][m][n], 0, 0, 0); __builtin_amdgcn_s_setprio(0); } while (0)
#define PG8_WAIT_V(n) asm volatile("s_waitcnt vmcnt(" #n ")" ::: "memory")
#define PG8_WAIT_L(n) asm volatile("s_waitcnt lgkmcnt(" #n ")" ::: "memory")
#define PG8_BAR __builtin_amdgcn_s_barrier()
#define PG8_SCHED __builtin_amdgcn_sched_barrier(0)
    Unit cur, nxt; int ui = 0;
    if (!S.next(0, cur)) return;
    f32x4 acc[2][2][4][2];
#pragma unroll
    for (int a = 0; a < 2; ++a)
#pragma unroll
        for (int b = 0; b < 2; ++b)
#pragma unroll
            for (int m = 0; m < 4; ++m)
#pragma unroll
                for (int n = 0; n < 2; ++n) acc[a][b][m][n] = (f32x4){0.f, 0.f, 0.f, 0.f};
    bf16x8 At[4][2], B0[2][2], B1[2][2];
    const char* const Ab = (const char*)g.A; const char* cB = (const char*)g.Bt + (size_t)cur.pn * tstep;
    PG8_AOFF(ao, cur);
    S.a_ready(cur);
    if constexpr (SP2) {
        PG8_STAGE(PG8_SB(0, 0), cB, voffB); PG8_STAGE(PG8_SB(0, 1), cB + hstep, voffB); PG8_STAGE_A(PG8_SA(0, 0), Ab, ao[0]); PG8_STAGE_A(PG8_SA(0, 1), Ab, ao[1]);
        if (wr == 1) PG8_BAR;
        PG8_WAIT_V(2); PG8_BAR;
        PG8_STAGE(PG8_SB(1, 0), cB + kstep, voffB); PG8_STAGE_A(PG8_SA(1, 0), Ab + kstep, ao[0]); PG8_STAGE(PG8_SB(1, 1), cB + hstep + kstep, voffB);
        PG8_WAIT_V(6); PG8_BAR;
    } else {
        PG8_STAGE(PG8_SB(0, 0), cB, voffB); PG8_STAGE_A(PG8_SA(0, 0), Ab, ao[0]); PG8_STAGE(PG8_SB(0, 1), cB + hstep, voffB); PG8_STAGE_A(PG8_SA(0, 1), Ab, ao[1]);
        if (wr == 1) PG8_BAR;
        PG8_WAIT_V(4); PG8_BAR;
        PG8_STAGE(PG8_SB(1, 0), cB + kstep, voffB); PG8_STAGE_A(PG8_SA(1, 0), Ab + kstep, ao[0]); PG8_STAGE(PG8_SB(1, 1), cB + hstep + kstep, voffB);
        PG8_WAIT_V(6); PG8_BAR;
    }
    for (;;) {
        const bool has_next = S.next(ui + 1, nxt);
        const char* nB = has_next ? (const char*)g.Bt + (size_t)nxt.pn * tstep : cB;
        if (has_next) { PG8_AOFF(an, nxt); } else { _Pragma("unroll") for (int h_ = 0; h_ < 2; ++h_) _Pragma("unroll") for (int i_ = 0; i_ < 2; ++i_) an[h_][i_] = ao[h_][i_]; }
        for (int t = 0; t < nt; t += 2) {
            const bool last = (t == nt - 2);
            const char* a1 = Ab + (size_t)(t + 1) * kstep;
            const char* a2 = last ? Ab : Ab + (size_t)(t + 2) * kstep; const char* b2 = last ? nB : cB + (size_t)(t + 2) * kstep;
            const char* a3 = a2 + kstep; const char* b3 = b2 + kstep;
            unsigned as[2][2];
#pragma unroll
            for (int h_ = 0; h_ < 2; ++h_)
#pragma unroll
                for (int i_ = 0; i_ < 2; ++i_) as[h_][i_] = last ? an[h_][i_] : ao[h_][i_];
            if (last && has_next) S.a_ready(nxt);
            if constexpr (SP2) {
            PG8_LDB(B0, 0, 0); PG8_LDB(B1, 0, 1); PG8_SCHED; PG8_LDA(At, 0, 0); PG8_STAGE_A(PG8_SA(1, 1), a1, ao[1]);
            PG8_WAIT_V(8); PG8_WAIT_L(0); PG8_BAR; PG8_MMA(0, 0, At, B0); PG8_MMA(0, 1, At, B1); PG8_BAR; PG8_SCHED;
            PG8_LDA(At, 0, 1); PG8_STAGE(PG8_SB(0, 0), b2, voffB); PG8_STAGE(PG8_SB(0, 1), b2 + hstep, voffB); PG8_STAGE_A(PG8_SA(0, 0), a2, as[0]);
            PG8_WAIT_V(8); PG8_WAIT_L(0); PG8_BAR; PG8_MMA(1, 0, At, B0); PG8_MMA(1, 1, At, B1); PG8_BAR; PG8_SCHED;
            PG8_LDB(B0, 1, 0); PG8_LDB(B1, 1, 1); PG8_SCHED; PG8_LDA(At, 1, 0); PG8_STAGE_A(PG8_SA(0, 1), a2, as[1]);
            PG8_WAIT_V(8); PG8_WAIT_L(0); PG8_BAR; PG8_MMA(0, 0, At, B0); PG8_MMA(0, 1, At, B1); PG8_BAR; PG8_SCHED;
            PG8_LDA(At, 1, 1); PG8_STAGE(PG8_SB(1, 0), b3, voffB); PG8_STAGE(PG8_SB(1, 1), b3 + hstep, voffB); PG8_STAGE_A(PG8_SA(1, 0), a3, as[0]);
            PG8_WAIT_V(8); PG8_WAIT_L(0); PG8_BAR; PG8_MMA(1, 0, At, B0); PG8_MMA(1, 1, At, B1); PG8_BAR; PG8_SCHED;
            } else {
            PG8_LDB(B0, 0, 0); PG8_SCHED; PG8_LDA(At, 0, 0); PG8_STAGE_A(PG8_SA(1, 1), a1, ao[1]);
            PG8_WAIT_L(8); PG8_BAR; PG8_WAIT_L(0); PG8_MMA(0, 0, At, B0); PG8_BAR; PG8_SCHED;
            PG8_LDB(B1, 0, 1); PG8_STAGE(PG8_SB(0, 0), b2, voffB);
            PG8_BAR; PG8_WAIT_L(0); PG8_MMA(0, 1, At, B1); PG8_BAR;
            PG8_LDA(At, 0, 1); PG8_STAGE_A(PG8_SA(0, 0), a2, as[0]);
            PG8_BAR; PG8_WAIT_L(0); PG8_MMA(1, 0, At, B0); PG8_BAR; PG8_SCHED;
            PG8_STAGE(PG8_SB(0, 1), b2 + hstep, voffB);
            PG8_WAIT_V(6); PG8_BAR; PG8_MMA(1, 1, At, B1); PG8_BAR;
            PG8_LDB(B0, 1, 0); PG8_SCHED; PG8_LDA(At, 1, 0); PG8_STAGE_A(PG8_SA(0, 1), a2, as[1]);
            PG8_WAIT_L(8); PG8_BAR; PG8_WAIT_L(0); PG8_MMA(0, 0, At, B0); PG8_BAR; PG8_SCHED;
            PG8_LDB(B1, 1, 1); PG8_STAGE(PG8_SB(1, 0), b3, voffB);
            PG8_BAR; PG8_WAIT_L(0); PG8_MMA(0, 1, At, B1); PG8_BAR;
            PG8_LDA(At, 1, 1); PG8_STAGE_A(PG8_SA(1, 0), a3, as[0]);
            PG8_BAR; PG8_WAIT_L(0); PG8_MMA(1, 0, At, B0); PG8_BAR; PG8_SCHED;
            PG8_STAGE(PG8_SB(1, 1), b3 + hstep, voffB);
            PG8_WAIT_V(6); PG8_BAR; PG8_MMA(1, 1, At, B1); PG8_BAR;
            }
        }
        if constexpr (ALIGN_EPI) { if (wr == 0) PG8_BAR; }
        if constexpr (!Epi::AFTER_DRAIN) { E(acc, cur, wr, wc, fr, fq); S.done(cur); }
        if (!has_next) break;
#pragma unroll
        for (int a = 0; a < 2; ++a)
#pragma unroll
            for (int b = 0; b < 2; ++b)
#pragma unroll
                for (int m = 0; m < 4; ++m)
#pragma unroll
                    for (int n = 0; n < 2; ++n) acc[a][b][m][n] = (f32x4){0.f, 0.f, 0.f, 0.f};
        cur = nxt; cB = nB; ++ui;
#pragma unroll
        for (int h_ = 0; h_ < 2; ++h_)
#pragma unroll
            for (int i_ = 0; i_ < 2; ++i_) ao[h_][i_] = an[h_][i_];
        if constexpr (ALIGN_EPI) { if (wr == 1) PG8_BAR; }
    }
    PG8_WAIT_V(0);
    if constexpr (!ALIGN_EPI) { if (wr == 0) PG8_BAR; }
    PG8_BAR;
    if constexpr (Epi::AFTER_DRAIN) { E.fused(acc, cur, wr, wc, fr, fq, lds, wid, lane); S.done(cur); }
#undef PG8_SA
#undef PG8_SB
#undef PG8_STAGE
#undef PG8_STAGE_A
#undef PG8_AOFF
#undef PG8_LDA
#undef PG8_LDB
#undef PG8_MMA
#undef PG8_WAIT_V
#undef PG8_WAIT_L
#undef PG8_BAR
#undef PG8_SCHED
}
}
constexpr int NWAVES = 8;
constexpr int RING_OFF = 0, RING_BYTES = 131072;
constexpr int LDSCTL_OFF = 150 * 1024, MISC_OFF = LDSCTL_OFF + 320;
constexpr int LDS_BYTES = 160 * 1024;
constexpr size_t MiB = 1u << 20;
constexpr size_t WS_CTL = 0, CTL_ZERO_BYTES = 1 * MiB;
constexpr size_t WS_MOD = 1 * MiB;
constexpr size_t WS_RWP = WS_MOD + 128 * 1024;
constexpr size_t WS_CS = 2 * MiB;
constexpr size_t WS_LOGF = 4 * MiB;
constexpr size_t WS_CB = WS_LOGF + 256 * 1024;
constexpr size_t WS_Z = WS_CB + 256 * 1024;
constexpr size_t WS_WIN = 6 * MiB;
constexpr size_t WS_WOUT = 34 * MiB;
constexpr size_t WS_HB = 42 * MiB;
constexpr size_t WS_QKV = 74 * MiB;
constexpr size_t TSZ = (size_t)16 * 4096 * 128;
constexpr size_t WS_FAST_END = 186 * MiB;
constexpr size_t WS_YB = 74 * MiB;
constexpr size_t WS_GB = 74 * MiB;
constexpr size_t WS_YS = 110 * MiB;
constexpr size_t WS_W13 = 266 * MiB;
constexpr size_t WS_W2 = 394 * MiB;
constexpr size_t WS_LIST = 458 * MiB;
constexpr size_t WS_SLOT = 459 * MiB;
constexpr size_t WS_END = 460 * MiB;
constexpr int ECAP = 8192, CW_CNT = 32768;
constexpr int CW_BAR = 4096;

struct Frame {
    LAS unsigned char* lds; char* ldsg;
    volatile LAS unsigned* MISC;
    gu32* ctl;
    int tid, lane, wave, G, gw, NGW, cnt_off;
    const float* in[22]; float* out; unsigned char* ws;
};
struct Args { const float* in[22]; float* out; unsigned char* ws; int ph_lo, ph_hi, cnt_off, pad; };

template <int CTRL> __device__ __forceinline__ float dppa(float v) { const int t = __builtin_amdgcn_update_dpp(0, __float_as_int(v), CTRL, 0xf, 0xf, true); return v + __int_as_float(t); }
__device__ __forceinline__ float row16_sum(float v) { v = dppa<0xB1>(v); v = dppa<0x4E>(v); v = dppa<0x141>(v); v = dppa<0x140>(v); return v; }
__device__ __forceinline__ float half32_sum(float v) { v = row16_sum(v); return v + __shfl_xor(v, 16); }
__device__ __forceinline__ float wave_sum(float v) {
    v = row16_sum(v);
    const float s0 = __int_as_float(__builtin_amdgcn_readlane(__float_as_int(v), 0)), s1 = __int_as_float(__builtin_amdgcn_readlane(__float_as_int(v), 16));
    const float s2 = __int_as_float(__builtin_amdgcn_readlane(__float_as_int(v), 32)), s3 = __int_as_float(__builtin_amdgcn_readlane(__float_as_int(v), 48));
    return (s0 + s1) + (s2 + s3);
}
__device__ __forceinline__ float silu_f(float v) { return v / (1.f + __expf(-v)); }

__device__ __forceinline__ void p0_mod(Frame& F) {
    const float* c = F.in[1]; const float* ada_w = F.in[2]; const float* ada_b = F.in[3];
    float* mod = (float*)(F.ws + WS_MOD);
    LAS float* ca = (LAS float*)(F.lds);
    LAS float* red = ca + 2 * DM;
    for (int i = F.tid; i < 2 * DM; i += NWAVES * 64) ca[i] = silu_f(c[i]);
    __syncthreads();
    for (int cb = blockIdx.x; cb < 256; cb += F.G) {
        const int j0 = cb * 48;
        float a0 = 0.f, a1 = 0.f;
        if (F.lane < 48) {
#pragma unroll 8
            for (int k = F.wave; k < DM; k += NWAVES) { const float w = ada_w[(size_t)k * (6 * DM) + j0 + F.lane]; a0 = fmaf(ca[k], w, a0); a1 = fmaf(ca[DM + k], w, a1); }
            red[F.wave * 96 + F.lane] = a0; red[F.wave * 96 + 48 + F.lane] = a1;
        }
        __syncthreads();
        if (F.tid < 96) { float s = 0.f;
#pragma unroll
            for (int w = 0; w < NWAVES; ++w) s += red[w * 96 + F.tid];
            const int b = F.tid / 48, jj = F.tid % 48; mod[b * 6 * DM + j0 + jj] = s + ada_b[j0 + jj]; }
        __syncthreads();
    }
}
__device__ __forceinline__ void tr_tile(const float* __restrict__ src, int ldn, int k0, int n0, bf16* __restrict__ dst, int ldk, int drow0, LAS float* scr, int lane) {
#pragma unroll 4
    for (int i = 0; i < 16; ++i) { const int kk = 4 * i + (lane >> 4);
        const f32x4 v = *(const f32x4*)(src + (size_t)(k0 + kk) * ldn + n0 + 4 * (lane & 15));
        LAS float* p = scr + kk * 65 + 4 * (lane & 15); p[0] = v.x; p[1] = v.y; p[2] = v.z; p[3] = v.w; }
    LDS_WAIT(); asm volatile("" ::: "memory");
    const int c = lane & 7;
#pragma unroll
    for (int jj = 0; jj < 8; ++jj) { const int n = (lane >> 3) + 8 * jj; const LAS float* s = scr + (8 * c) * 65 + n;
        v4u o; o.x = pk2(s[0], s[65]); o.y = pk2(s[130], s[195]); o.z = pk2(s[260], s[325]); o.w = pk2(s[390], s[455]);
        *(v4u*)(dst + (size_t)(drow0 + n) * ldk + k0 + 8 * c) = o; }
    LDS_WAIT(); asm volatile("" ::: "memory");
}
constexpr int CW_CONVQ = 2112, CW_DONE = 2176;
constexpr int I_E = 256 * NE, CONV_PER_WAVE = 2, N_CONV_BI = 3 * I_E / (NWAVES * CONV_PER_WAVE);
struct ConvTile { const float* src; bf16* dst; int ldn, ldk; };
__device__ __forceinline__ ConvTile conv_decode(Frame& F, int r) {
    ConvTile t;
    if (r < 2 * I_E) { const int which = r / I_E, rr = r % I_E, e = rr >> 8, q = rr & 255, kt = q >> 3, nt = q & 7;
        t.src = (which == 0 ? F.in[19] : F.in[20]) + (size_t)e * DM * DE + (size_t)(64 * kt) * DE + 64 * nt; t.ldn = DE;
        t.dst = (bf16*)(F.ws + WS_W13) + (size_t)(e * 1024 + (nt >> 1) * 256 + which * 128 + (nt & 1) * 64) * DM + 64 * kt; t.ldk = DM; return t; }
    r -= 2 * I_E;
    { const int e = r >> 8, q = r & 255, kt = q >> 5, nt = q & 31;
      t.src = F.in[21] + (size_t)e * DE * DM + (size_t)(64 * kt) * DM + 64 * nt; t.ldn = DM;
      t.dst = (bf16*)(F.ws + WS_W2) + (size_t)(e * 2048 + 64 * nt) * DE + 64 * kt; t.ldk = DE; }
    return t;
}
__device__ __forceinline__ void conv_load(const ConvTile& t, f32x4 (&v)[16], int lane) {
#pragma unroll
    for (int i = 0; i < 16; ++i) v[i] = *(const f32x4*)(t.src + (size_t)(4 * i + (lane >> 4)) * t.ldn + 4 * (lane & 15));
}
__device__ __forceinline__ void conv_store(const ConvTile& t, const f32x4 (&v)[16], LAS float* scr, int lane) {
#pragma unroll
    for (int i = 0; i < 16; ++i) { LAS float* p = scr + (4 * i + (lane >> 4)) * 65 + 4 * (lane & 15); p[0] = v[i].x; p[1] = v[i].y; p[2] = v[i].z; p[3] = v[i].w; }
    LDS_WAIT(); asm volatile("" ::: "memory");
    const int c = lane & 7;
#pragma unroll
    for (int jj = 0; jj < 8; ++jj) { const int n = (lane >> 3) + 8 * jj; const LAS float* s = scr + (8 * c) * 65 + n;
        v4u o; o.x = pk2(s[0], s[65]); o.y = pk2(s[130], s[195]); o.z = pk2(s[260], s[325]); o.w = pk2(s[390], s[455]);
        *(v4u*)(t.dst + (size_t)n * t.ldk + 8 * c) = o; }
    LDS_WAIT(); asm volatile("" ::: "memory");
}
__device__ __forceinline__ void filler(Frame& F, int ph, int mode, unsigned nfin, unsigned early) {
    __syncthreads();
    LAS float* scr = (LAS float*)(F.lds) + F.wave * (64 * 65);
    unsigned nxt = 0xffffffffu;
    if (F.tid == 0) { bool go = true;
        if (mode == 0) go = __hip_atomic_fetch_add(F.ctl + CW_DONE + 64 * ph, 1u, RLX_AGENT) < early;
        if (mode == 1) go = __hip_atomic_load(F.ctl + CW_DONE + 64 * ph, RLX_AGENT) < nfin;
        if (go) nxt = __hip_atomic_fetch_add(F.ctl + CW_CONVQ, 1u, RLX_AGENT); }
    for (;;) {
        if (F.tid == 0) F.MISC[1] = nxt;
        __syncthreads();
        const unsigned it = F.MISC[1];
        __syncthreads();
        if (it >= (unsigned)N_CONV_BI) break;
        if (F.tid == 0) { const bool stop = mode != 2 && __hip_atomic_load(F.ctl + CW_DONE + 64 * ph, RLX_AGENT) >= nfin;
            nxt = stop ? 0xffffffffu : __hip_atomic_fetch_add(F.ctl + CW_CONVQ, 1u, RLX_AGENT); }
        const int r0 = ((int)it * NWAVES + F.wave) * CONV_PER_WAVE;
        const ConvTile t0 = conv_decode(F, r0), t1 = conv_decode(F, r0 + 1);
        f32x4 va[16], vb[16];
        conv_load(t0, va, F.lane); conv_load(t1, vb, F.lane);
        conv_store(t0, va, scr, F.lane); conv_store(t1, vb, scr, F.lane);
    }
}
template <bool EXPERTS>
__device__ __forceinline__ void p0_prologue(Frame& F) {
    p0_mod(F);
    __syncthreads();
    LAS float* scr = (LAS float*)(F.lds) + F.wave * (64 * 65);
    bf16* WinT = (bf16*)(F.ws + WS_WIN); bf16* WoutT = (bf16*)(F.ws + WS_WOUT);
    constexpr int I_IN = 32 * 112, I_OUT = 32 * 32;
    constexpr int NIT = I_IN + I_OUT;
    for (int it = F.gw; it < NIT; it += F.NGW) {
        int r = it;
        if (r < I_IN) { tr_tile(F.in[6], INC, 64 * (r / 112), 64 * (r % 112), WinT, DM, 64 * (r % 112), scr, F.lane); continue; } r -= I_IN;
        if (r < I_OUT) { tr_tile(F.in[12], DM, 64 * (r / 32), 64 * (r % 32), WoutT, DM, 64 * (r % 32), scr, F.lane); continue; } r -= I_OUT;
    }
    { f32x4* rwp = (f32x4*)(F.ws + WS_RWP); const float* rcw = F.in[15]; const float* rfw = F.in[17];
      for (int idx = blockIdx.x * (NWAVES * 64) + F.tid; idx < 8 * 36 * 64; idx += F.G * NWAVES * 64) {
          const int l = idx & 63, o = (idx >> 6) % 36, j = idx / (36 * 64); f32x4 v;
#pragma unroll
          for (int i = 0; i < 4; ++i) { const int k = 256 * j + 4 * l + i; v[i] = o < 4 ? rcw[k * 4 + o] : rfw[k * 32 + (o - 4)]; }
          rwp[idx] = v; } }
    { float* cs = (float*)(F.ws + WS_CS);
      for (int idx = blockIdx.x * (NWAVES * 64) + F.tid; idx < SEQ * 64; idx += F.G * NWAVES * 64) {
          const int i = idx & 63, s = idx >> 6; const float inv_freq = powf(10000.f, -(float)(2 * i) / 128.f); const float ang = (float)s * inv_freq;
          cs[2 * idx] = cosf(ang); cs[2 * idx + 1] = sinf(ang); } }
}

__device__ __forceinline__ void p1_prenorm(Frame& F) {
    const float* x = F.in[0]; const float* wpre = F.in[4]; const float* w_in = F.in[6]; const float* fbias = F.in[7];
    const float* mod = (const float*)(F.ws + WS_MOD);
    bf16* Hb = (bf16*)(F.ws + WS_HB); float* logf = (float*)(F.ws + WS_LOGF); float* zb = (float*)(F.ws + WS_Z);
    LAS f32x4* wf = (LAS f32x4*)F.lds;
    for (int idx = F.tid; idx < 4096; idx += NWAVES * 64) { const int l = idx & 63, half = (idx >> 6) & 1, i = (idx >> 7) & 3, j = idx >> 9;
        wf[idx] = *(const f32x4*)(w_in + (size_t)(256 * j + 4 * l + i) * INC + INCM + 4 * half); }
    __syncthreads();
    for (int row = F.gw; row < T; row += F.NGW) {
        const int b = row >> 12, s = row & 4095;
        const f32x4* xr = (const f32x4*)(x + (size_t)row * DM) + F.lane;
        f32x4 v[8]; float ss = 0.f;
#pragma unroll
        for (int j = 0; j < 8; ++j) { v[j] = xr[64 * j]; ss += (v[j].x * v[j].x + v[j].y * v[j].y) + (v[j].z * v[j].z + v[j].w * v[j].w); }
        const float rstd = rsqrtf(wave_sum(ss) * (1.f / DM) + EPS);
        const f32x4* w4 = (const f32x4*)wpre + F.lane; const f32x4* sh4 = (const f32x4*)(mod + (size_t)b * 6 * DM) + F.lane; const f32x4* sc4 = (const f32x4*)(mod + (size_t)b * 6 * DM + DM) + F.lane;
        float acc[8];
#pragma unroll
        for (int o = 0; o < 8; ++o) acc[o] = 0.f;
        unsigned long long* o8 = (unsigned long long*)(Hb + (size_t)row * DM) + F.lane;
#pragma unroll
        for (int j = 0; j < 8; ++j) {
            const f32x4 h = v[j] * rstd * w4[64 * j] * (sc4[64 * j] + 1.0f) + sh4[64 * j];
            o8[64 * j] = (unsigned long long)pk2(h.x, h.y) | ((unsigned long long)pk2(h.z, h.w) << 32);
#pragma unroll
            for (int i = 0; i < 4; ++i) { const f32x4 wa = wf[((j * 4 + i) * 2 + 0) * 64 + F.lane], wb = wf[((j * 4 + i) * 2 + 1) * 64 + F.lane]; const float hv = h[i];
                acc[0] = fmaf(hv, wa.x, acc[0]); acc[1] = fmaf(hv, wa.y, acc[1]); acc[2] = fmaf(hv, wa.z, acc[2]); acc[3] = fmaf(hv, wa.w, acc[3]);
                acc[4] = fmaf(hv, wb.x, acc[4]); acc[5] = fmaf(hv, wb.y, acc[5]); acc[6] = fmaf(hv, wb.z, acc[6]); acc[7] = fmaf(hv, wb.w, acc[7]); }
            asm volatile("" ::: "memory");
        }
        float z = 0.f;
#pragma unroll
        for (int o = 0; o < 8; ++o) { const float t = wave_sum(acc[o]); z = (F.lane == o) ? t : z; }
        if (F.lane < 8) { const float zz = z + fbias[F.lane];
            logf[((size_t)b * NH + F.lane) * SEQ + s] = fminf(zz, 0.f) - log1pf(expf(-fabsf(zz)));
            zb[(size_t)row * 8 + F.lane] = z; }
    }
}

struct EpiHeads {
    static constexpr bool PERM = true, AFTER_DRAIN = false;
    bf16* base;
    __device__ __forceinline__ void operator()(const pg8::f32x4 (&acc)[2][2][4][2], const pg8::Unit& u, int wr, int wc, int fr, int fq) const {
        const int type = u.pn >> 2, head0 = (u.pn & 3) * 2; const int row0 = u.pm * 256 + wr * 64 + fr;
#pragma unroll
        for (int ai = 0; ai < 2; ++ai)
#pragma unroll
            for (int m = 0; m < 4; ++m) { const int r = row0 + ai * 128 + m * 16, b = r >> 12, s = r & 4095;
#pragma unroll
                for (int bj = 0; bj < 2; ++bj) { const pg8::f32x4 v0 = acc[ai][bj][m][0], v1 = acc[ai][bj][m][1];
                    pg8::u32x4 w; w.x = pg8::cvt_pk_bf16(v0[0], v0[1]); w.y = pg8::cvt_pk_bf16(v0[2], v0[3]); w.z = pg8::cvt_pk_bf16(v1[0], v1[1]); w.w = pg8::cvt_pk_bf16(v1[2], v1[3]);
                    *(pg8::u32x4*)(base + (size_t)type * TSZ + ((size_t)((b * 8 + head0 + bj) * SEQ + s)) * HD + wc * 32 + 8 * fq) = w; } }
    }
};

namespace fox {
__device__ __forceinline__ int fox_tid() { int t = threadIdx.x; asm volatile("" : "+v"(t)); return t; }
typedef unsigned short bf16;
constexpr int D = 128, OLD = 2048;
constexpr bool WSKIP = false; constexpr float THR = 8.f;
constexpr float SCALE = 0.08838834764831845f;
constexpr int NW = 8, QBLK = 32, KVBLK = 64, QB = NW * QBLK;
constexpr int SHM_V = KVBLK * D * 2, SHM_K = KVBLK * D * 2;
constexpr int LDS_BYTES = 2 * SHM_V + 2 * SHM_K + NW * 64 * 4 + 2 * 64 * 4;
typedef short bf16x8 __attribute__((ext_vector_type(8)));
typedef short s16x4 __attribute__((ext_vector_type(4)));
typedef float f32x16 __attribute__((ext_vector_type(16)));
typedef float f32x4 __attribute__((ext_vector_type(4)));
typedef unsigned u32x4 __attribute__((ext_vector_type(4)));
template <class A, class Bt> struct same_t { static constexpr bool v = false; };
template <class A> struct same_t<A, A> { static constexpr bool v = true; };

#define KSWZ(row, colB) ((row) * 256 + ((colB) ^ (((row) & 7) << 4)))
#define SBAR() __builtin_amdgcn_sched_barrier(0)
__device__ __forceinline__ int v_st(int k, int c) { const int kk = (k & ~0xC) | ((k & 4) << 1) | ((k & 8) >> 1); return ((kk >> 3) * 4 + (c >> 5)) * 512 + ((kk & 7) * 32 + (c & 31)) * 2; }
__device__ __forceinline__ int v_rd_base(int lane) { return ((lane & 3) << 3) | (((lane >> 2) & 3) << 6) | (((lane >> 4) & 1) << 5) | (((lane >> 5) & 1) << 8); }
constexpr int v_rd_off(int d0, int ks, int half) { return d0 * 512 + ks * 4096 + half * 2048; }
__device__ __forceinline__ int crow(int r, int hi) { return (r & 3) + 8 * (r >> 2) + 4 * hi; }
__device__ __forceinline__ unsigned cvtpk(float lo, float hi) {
    unsigned r; asm volatile("v_cvt_pk_bf16_f32 %0, %1, %2" : "=v"(r) : "v"(lo), "v"(hi)); return r;
}
__device__ __forceinline__ bf16x8 pack8(f32x4 a, f32x4 b) {
    u32x4 w = {cvtpk(a[0], a[1]), cvtpk(a[2], a[3]), cvtpk(b[0], b[1]), cvtpk(b[2], b[3])};
    return *reinterpret_cast<bf16x8*>(&w);
}
template <class T> __device__ __forceinline__ bf16x8 load8(const T* p) {
    if constexpr (same_t<T, float>::v) { return pack8(*(const f32x4*)p, *(const f32x4*)(p + 4)); }
    else { return *reinterpret_cast<const bf16x8*>(p); }
}
__device__ __forceinline__ void mask_tile(f32x16& p0, f32x16& p1, int dq, unsigned W) {
    const float NEG = -__builtin_inff();
#pragma unroll
    for (int r = 0; r < 16; ++r) {
        const int c = (r & 3) + 8 * (r >> 2);
        if ((unsigned)(dq - c) >= W) p0[r] = NEG;
        if ((unsigned)(dq - c - 32) >= W) p1[r] = NEG;
    }
}
__device__ __forceinline__ void partialSM(f32x16& p0, f32x16& p1, float& m_reg, float& mn, float& alpha) {
    float pmax = p0[0]; for (int r = 1; r < 16; ++r) pmax = fmaxf(pmax, p0[r]); for (int r = 0; r < 16; ++r) pmax = fmaxf(pmax, p1[r]);
    { auto rr = __builtin_amdgcn_permlane32_swap(__float_as_uint(pmax), __float_as_uint(pmax), false, false);
      pmax = fmaxf(__uint_as_float(rr[0]), __uint_as_float(rr[1])); }
    constexpr float C2 = 1.4426950408889634f * SCALE;
    if (__builtin_expect(__all((pmax - m_reg) * SCALE <= THR), 1)) { mn = m_reg; alpha = 1.f; }
    else { mn = fmaxf(m_reg, pmax); alpha = __builtin_amdgcn_exp2f((m_reg - mn) * C2); m_reg = mn; }
    const float mnL = -mn * C2;
    for (int r = 0; r < 16; ++r) p0[r] = fmaf(p0[r], C2, mnL); for (int r = 0; r < 16; ++r) p1[r] = fmaf(p1[r], C2, mnL);
    for (int r = 0; r < 16; ++r) p0[r] = __builtin_amdgcn_exp2f(p0[r]);
}
__device__ __forceinline__ void finishSM(f32x16& p0, f32x16& p1, float alpha, float& l_reg, bf16x8& pa0, bf16x8& pa1, bf16x8& pa2, bf16x8& pa3) {
    for (int r = 0; r < 16; ++r) p1[r] = __builtin_amdgcn_exp2f(p1[r]);
    float ps = 0; for (int r = 0; r < 16; ++r) ps += p0[r]; for (int r = 0; r < 16; ++r) ps += p1[r];
    { auto rr = __builtin_amdgcn_permlane32_swap(__float_as_uint(ps), __float_as_uint(ps), false, false);
      ps = __uint_as_float(rr[0]) + __uint_as_float(rr[1]); }
    l_reg = l_reg * alpha + ps;
#define PK4(P, B_, OUT) do { unsigned a0 = cvtpk(P[B_+0], P[B_+1]), a1 = cvtpk(P[B_+2], P[B_+3]);                          \
        unsigned b0 = cvtpk(P[B_+4], P[B_+5]), b1 = cvtpk(P[B_+6], P[B_+7]);                                             \
        auto r0 = __builtin_amdgcn_permlane32_swap(a0, b0, false, false); auto r1 = __builtin_amdgcn_permlane32_swap(a1, b1, false, false); \
        u32x4 w = {r0[0], r1[0], r0[1], r1[1]}; OUT = *reinterpret_cast<bf16x8*>(&w); } while (0)
    PK4(p0, 0, pa0); PK4(p0, 8, pa1); PK4(p1, 0, pa2); PK4(p1, 8, pa3);
#undef PK4
}
template <int KB, bool SK>
__device__ __forceinline__ void qkt(f32x16& p0, f32x16& p1, const char* K_lds, int r32, int hi, const bf16x8* qr, bool act) {
    if (SK && !act) { const float NEG = -__builtin_inff();
#pragma unroll
        for (int r = 0; r < 16; ++r) { p0[r] = NEG; p1[r] = NEG; } return; }
    { const float* bl = (const float*)(K_lds + 2 * SHM_K + NW * 64 * 4) + KB * 64 + 4 * hi;
#pragma unroll
      for (int g = 0; g < 4; ++g) { const f32x4 b0 = *(const f32x4*)(bl + 8 * g), b1 = *(const f32x4*)(bl + 32 + 8 * g);
          p0[4 * g] = b0[0]; p0[4 * g + 1] = b0[1]; p0[4 * g + 2] = b0[2]; p0[4 * g + 3] = b0[3]; p1[4 * g] = b1[0]; p1[4 * g + 1] = b1[1]; p1[4 * g + 2] = b1[2]; p1[4 * g + 3] = b1[3]; } }
    const char* kb[4];
#pragma unroll
    for (int dd = 0; dd < 4; ++dd) kb[dd] = K_lds + KB * SHM_K + KSWZ(r32, (dd * 16 + hi * 8) * 2);
#pragma unroll
    for (int d0 = 0; d0 < 8; ++d0) { const char* a = kb[d0 & 3] + (d0 >> 2) * 128;
        bf16x8 b0 = *reinterpret_cast<const bf16x8*>(a);
        bf16x8 b1 = *reinterpret_cast<const bf16x8*>(a + 32 * 256);
        p0 = __builtin_amdgcn_mfma_f32_32x32x16_bf16(b0, qr[d0], p0, 0, 0, 0);
        p1 = __builtin_amdgcn_mfma_f32_32x32x16_bf16(b1, qr[d0], p1, 0, 0, 0); }
}
template <int VB, bool SK>
__device__ __forceinline__ void pv_tile(f32x16* o, int vb0, bf16x8 pa0, bf16x8 pa1, bf16x8 pa2, bf16x8 pa3, bool act) {
    if (SK && !act) return;
#define TRRD(dst, off) asm volatile("ds_read_b64_tr_b16 %0, %1 offset:%2" : "=&v"(dst) : "v"(vb0), "i"(off) : "memory")
#define PV_D0(d0) do { s16x4 l0, l1, l2, l3, h0, h1, h2, h3; constexpr int b_ = VB * SHM_V + v_rd_off(d0, 0, 0);     \
        TRRD(l0, b_); TRRD(h0, b_ + 2048); TRRD(l1, b_ + 4096); TRRD(h1, b_ + 6144); TRRD(l2, b_ + 8192); TRRD(h2, b_ + 10240); TRRD(l3, b_ + 12288); TRRD(h3, b_ + 14336); \
        asm volatile("s_waitcnt lgkmcnt(0)" ::: "memory"); SBAR();                 \
        o[d0] = __builtin_amdgcn_mfma_f32_32x32x16_bf16(pa0, (bf16x8){l0[0], l0[1], l0[2], l0[3], h0[0], h0[1], h0[2], h0[3]}, o[d0], 0, 0, 0);   \
        o[d0] = __builtin_amdgcn_mfma_f32_32x32x16_bf16(pa1, (bf16x8){l1[0], l1[1], l1[2], l1[3], h1[0], h1[1], h1[2], h1[3]}, o[d0], 0, 0, 0);   \
        o[d0] = __builtin_amdgcn_mfma_f32_32x32x16_bf16(pa2, (bf16x8){l2[0], l2[1], l2[2], l2[3], h2[0], h2[1], h2[2], h2[3]}, o[d0], 0, 0, 0);   \
        o[d0] = __builtin_amdgcn_mfma_f32_32x32x16_bf16(pa3, (bf16x8){l3[0], l3[1], l3[2], l3[3], h3[0], h3[1], h3[2], h3[3]}, o[d0], 0, 0, 0); } while (0)
    PV_D0(0); PV_D0(1); PV_D0(2); PV_D0(3);
#undef PV_D0
#undef TRRD
}

template <class TIn, class TOut> struct BlockRef { const TIn* Q; const TIn* K; const TIn* V; TOut* O; const float* cb; const float* onw; int P0; };
template <class TIn> struct Seam {
    bf16x8 qr[8];
    bf16x8 st_v0, st_v1, st_k0, st_k1; float st_b; f32x4 sf0, sf1, sf2, sf3;
    f32x4 tq[16];
};
__device__ __forceinline__ int swa_jlo(int P0, int W) { const int lowk = P0 - W + 1; return lowk > 0 ? lowk / KVBLK : 0; }
#define ROW(p, k0, rr) ((p) + (size_t)((k0) + (rr)) * D + sc)
#define VMW() asm volatile("s_waitcnt vmcnt(0)" ::: "memory")
#define VMWN(n) asm volatile("s_waitcnt vmcnt(%0)" :: "i"(n) : "memory")
#define SLOAD_H(Kp, Vp, Bp, k0) do { S.st_v0 = load8<TIn>(ROW(Vp, k0, sr)); S.st_v1 = load8<TIn>(ROW(Vp, k0, 32 + sr));              \
                         S.st_k0 = load8<TIn>(ROW(Kp, k0, sr)); S.st_k1 = load8<TIn>(ROW(Kp, k0, 32 + sr)); S.st_b = (Bp)[(k0) + (tid & 63)]; } while (0)
#define SWRITE_HK(bf) do { *(bf16x8*)(K_lds + (bf) * SHM_K + kws) = S.st_k0; *(bf16x8*)(K_lds + (bf) * SHM_K + kws + 32 * 256) = S.st_k1; \
                           if (tid < 64) ((float*)(K_lds + 2 * SHM_K + NW * 64 * 4))[(bf) * 64 + tid] = S.st_b; } while (0)
#define SWRITE_HV(bf) do { *(bf16x8*)(V_lds + (bf) * SHM_V + vst0) = S.st_v0; *(bf16x8*)(V_lds + (bf) * SHM_V + vst1) = S.st_v1; } while (0)
#define SWRITE_H(bf) do { SWRITE_HV(bf); SWRITE_HK(bf); } while (0)
#define SLOAD_F(p, k0) do { S.sf0 = *(const f32x4*)ROW(p, k0, sr); S.sf1 = *(const f32x4*)(ROW(p, k0, sr) + 4);                \
                            S.sf2 = *(const f32x4*)ROW(p, k0, 32 + sr); S.sf3 = *(const f32x4*)(ROW(p, k0, 32 + sr) + 4); } while (0)
#define SWRITE_KF(bf) do { *(bf16x8*)(K_lds + (bf) * SHM_K + kws) = pack8(S.sf0, S.sf1); *(bf16x8*)(K_lds + (bf) * SHM_K + kws + 32 * 256) = pack8(S.sf2, S.sf3); } while (0)
#define SWRITE_VF(bf) do { *(bf16x8*)(V_lds + (bf) * SHM_V + vst0) = pack8(S.sf0, S.sf1); *(bf16x8*)(V_lds + (bf) * SHM_V + vst1) = pack8(S.sf2, S.sf3); } while (0)
template <class TIn, class TOut>
__device__ __forceinline__ void causal_swa_prime(const BlockRef<TIn, TOut>& cur, int W, char* lds, Seam<TIn>& S) {
    constexpr bool F32 = same_t<TIn, float>::v;
    const int tid = fox_tid(), wid = __builtin_amdgcn_readfirstlane(tid >> 6), lane = tid & 63, r32 = lane & 31, hi = lane >> 5;
    const int sr = tid >> 4, sc = (tid & 15) * 8, kws = KSWZ(sr, sc * 2); char* K_lds = lds + 2 * SHM_V;
    const int kb0 = swa_jlo(cur.P0, W) * KVBLK;
    for (int d0 = 0; d0 < 8; ++d0) S.qr[d0] = load8<TIn>(cur.Q + (size_t)(wid * QBLK + r32) * D + d0 * 16 + hi * 8);
    if constexpr (F32) { SLOAD_F((const float*)cur.K, kb0); VMW(); SWRITE_KF(0); SBAR(); SLOAD_F((const float*)cur.V, kb0); }
    else { SLOAD_H(cur.K, cur.V, cur.cb, kb0); VMW(); SWRITE_HK(0); }
    __syncthreads();
}
template <class TIn, class TOut>
__device__ __forceinline__ void causal_swa_block(const BlockRef<TIn, TOut>& cur, const BlockRef<TIn, TOut>& nxt, int skv, int W, char* lds, Seam<TIn>& S) {
    constexpr bool F32 = same_t<TIn, float>::v;
    const int tid = fox_tid(), wid = __builtin_amdgcn_readfirstlane(tid >> 6), lane = tid & 63, r32 = lane & 31, hi = lane >> 5;
    const int j_lo = swa_jlo(cur.P0, W);
    int j_hi = (cur.P0 + QB - 1) / KVBLK + 1; if (j_hi > skv / KVBLK) j_hi = skv / KVBLK;
    const int NT = j_hi - j_lo;
    const int kbn = swa_jlo(nxt.P0, W) * KVBLK;
    const int qlo = cur.P0 + wid * QBLK, qm = qlo + r32 - 4 * hi;
    char* V_lds = lds; char* K_lds = lds + 2 * SHM_V;
    float* ws = (float*)(lds + 2 * SHM_V + 2 * SHM_K) + wid * 64; float* li_l = ws, * al_l = ws + 32;
    float m_reg = -1e30f, l_reg = 0; f32x16 o[4] = {};
    const int sr = tid >> 4, sc = (tid & 15) * 8, vst0 = v_st(sr, sc), vst1 = v_st(32 + sr, sc), kws = KSWZ(sr, sc * 2);
    const int vb0 = (int)(uintptr_t)V_lds + v_rd_base(lane);
    const TIn* Kh = cur.K; const TIn* Vh = cur.V;
#define RESC(a) do { if (__any((a) < 1.f)) { if (hi == 0) al_l[r32] = (a); asm volatile("s_waitcnt lgkmcnt(0)" ::: "memory");              \
                     for (int d_ = 0; d_ < 4; ++d_) for (int r = 0; r < 16; ++r) o[d_][r] *= al_l[crow(r, hi)]; } } while (0)
#define KBASE(t) ((j_lo + (t)) * KVBLK)
#define ACT(t) (KBASE(t) <= qlo + QBLK - 1 && KBASE(t) + KVBLK - 1 >= qlo - W + 1)
#define MASKT(P0_, P1_, t) do { const int kb_ = KBASE(t); if ((!SK || ACT(t)) && (kb_ + KVBLK - 1 > qlo || kb_ <= qlo + QBLK - 1 - W)) mask_tile(P0_, P1_, qm - kb_, (unsigned)W); } while (0)
    constexpr int NQL = F32 ? 16 : 8;
    constexpr bool SK = WSKIP && !F32;
#define SEAM_K0() do { VMWN(NQL); if constexpr (F32) { SWRITE_KF(0); SBAR(); SLOAD_F((const float*)nxt.V, kbn); } else { SWRITE_HK(0); } SBAR(); } while (0)
    f32x16 pA0, pA1, pB0, pB1; float mnA, mnB, alA, alB; bf16x8 pa0, pa1, pa2, pa3;
    if constexpr (F32) { VMW(); SWRITE_VF(0); SBAR(); } else { SWRITE_HV(0); SBAR(); }
    if (NT > 1) { if constexpr (F32) SLOAD_F((const float*)Kh, KBASE(1)); else SLOAD_H(Kh, Vh, cur.cb, KBASE(1)); }
    SBAR(); qkt<0, SK>(pA0, pA1, K_lds, r32, hi, S.qr, ACT(0));
    if constexpr (F32) { if (NT > 1) { VMW(); SWRITE_KF(1); SBAR(); SLOAD_F((const float*)Vh, KBASE(1)); } }
    MASKT(pA0, pA1, 0); partialSM(pA0, pA1, m_reg, mnA, alA);
    if (NT > 1) { VMW(); if constexpr (F32) { SWRITE_VF(1); SBAR(); if (NT > 2) SLOAD_F((const float*)Kh, KBASE(2)); } else SWRITE_H(1); }
    __syncthreads();
#define HALF_STEP(PX0, PX1, mnX, alX, PY0, PY1, alY, t, KB, VB, SB) do {                                                      \
        SBAR(); qkt<KB, SK>(PX0, PX1, K_lds, r32, hi, S.qr, ACT(t));                                             \
        finishSM(PY0, PY1, alY, l_reg, pa0, pa1, pa2, pa3); SBAR();                                                           \
        if ((t) + 1 < NT) { if constexpr (F32) { VMW(); SWRITE_KF(SB); SBAR(); SLOAD_F((const float*)Vh, KBASE((t) + 1)); }  \
                            else { SLOAD_H(Kh, Vh, cur.cb, KBASE((t) + 1)); } SBAR(); }                                               \
        pv_tile<VB, SK>(o, vb0, pa0, pa1, pa2, pa3, ACT((t) - 1)); MASKT(PX0, PX1, (t)); partialSM(PX0, PX1, m_reg, mnX, alX);                                        \
        __syncthreads();                                                                                                      \
        if ((t) + 1 < NT) { VMW(); if constexpr (F32) { SWRITE_VF(SB); SBAR(); if ((t) + 2 < NT) SLOAD_F((const float*)Kh, KBASE((t) + 2)); } \
                            else { SWRITE_H(SB); } }                                                                          \
        RESC(alX); __syncthreads(); } while (0)
    for (int t = 1; t + 1 < NT; t += 2) {
        HALF_STEP(pB0, pB1, mnB, alB, pA0, pA1, alA, t, 1, 0, 0);
        HALF_STEP(pA0, pA1, mnA, alA, pB0, pB1, alB, t + 1, 0, 1, 1);
    }
    const bool even = (NT & 1) == 0;
    if (even) { SBAR(); qkt<1, SK>(pB0, pB1, K_lds, r32, hi, S.qr, ACT(NT - 1)); SBAR(); }
#define QROW(e) (nxt.Q + (size_t)(wid * QBLK + r32) * D + ((e) >> 1) * 16 + hi * 8 + ((e) & 1) * 4)
    if constexpr (F32) { SLOAD_F((const float*)nxt.K, kbn); SBAR();
#pragma unroll
        for (int e = 0; e < 8; ++e) S.tq[e] = *(const f32x4*)QROW(e); }
    else { SLOAD_H(nxt.K, nxt.V, nxt.cb, kbn); SBAR();
#pragma unroll
        for (int d0 = 0; d0 < 8; ++d0) S.qr[d0] = load8<TIn>(nxt.Q + (size_t)(wid * QBLK + r32) * D + d0 * 16 + hi * 8); }
    SBAR();
    finishSM(pA0, pA1, alA, l_reg, pa0, pa1, pa2, pa3); SBAR();
    if constexpr (F32) {
#pragma unroll
        for (int e = 8; e < 16; ++e) S.tq[e] = *(const f32x4*)QROW(e); SBAR(); }
#undef QROW
    pv_tile<0, SK>(o, vb0, pa0, pa1, pa2, pa3, ACT(even ? NT - 2 : NT - 1));
    if (even) { MASKT(pB0, pB1, NT - 1); partialSM(pB0, pB1, m_reg, mnB, alB); __syncthreads(); RESC(alB);
        finishSM(pB0, pB1, alB, l_reg, pa0, pa1, pa2, pa3); SBAR(); pv_tile<1, SK>(o, vb0, pa0, pa1, pa2, pa3, ACT(NT - 1)); }
    SBAR(); SEAM_K0();
    if (hi == 0) li_l[r32] = l_reg; asm volatile("s_waitcnt lgkmcnt(0)" ::: "memory");
    { float gw[4];
#pragma unroll
      for (int d0 = 0; d0 < 4; ++d0) gw[d0] = cur.onw[d0 * 32 + r32];
      TOut* Ow = cur.O + (size_t)(wid * QBLK) * OLD;
#pragma unroll
      for (int r = 0; r < 16; ++r) { const int orow = crow(r, hi); const float rl = __builtin_amdgcn_rcpf(li_l[orow]);
          float v[4]; float ss = 0.f;
#pragma unroll
          for (int d0 = 0; d0 < 4; ++d0) { v[d0] = o[d0][r] * rl; ss += v[d0] * v[d0]; }
          ss = half32_sum(ss);
          const float rs = rsqrtf(ss * (1.f / 128.f) + 1e-6f);
#pragma unroll
          for (int d0 = 0; d0 < 4; ++d0) { const float y = v[d0] * rs * gw[d0]; const float yn = __shfl_xor(y, 1);
              if ((r32 & 1) == 0) *(unsigned*)(Ow + (size_t)orow * OLD + d0 * 32 + r32) = cvtpk(y, yn); } } }
    if constexpr (F32) {
#pragma unroll
        for (int d0 = 0; d0 < 8; ++d0) S.qr[d0] = pack8(S.tq[2 * d0], S.tq[2 * d0 + 1]); }
    __syncthreads();
#undef RESC
#undef KBASE
#undef ACT
#undef MASKT
#undef SEAM_K0
#undef HALF_STEP
}
#undef ROW
#undef VMW
#undef VMWN
#undef SLOAD_H
#undef SWRITE_HK
#undef SWRITE_HV
#undef SWRITE_H
#undef SLOAD_F
#undef SWRITE_KF
#undef SWRITE_VF


#undef KSWZ
#undef SBAR
}
constexpr size_t WS_KV = 186 * MiB;
constexpr size_t WS_SP = 218 * MiB;
constexpr size_t WS_CAT = 234 * MiB;
constexpr size_t WS_P34_END = 266 * MiB;
constexpr int CW_RETQ = 2048;
typedef short v4i16_t __attribute__((ext_vector_type(4)));
typedef float f32x16 __attribute__((ext_vector_type(16)));
constexpr int TLD = 136;
constexpr int TILE_EL = 128 * TLD;

__device__ __forceinline__ bf16x8 frag_row(const LAS bf16* X, int r0, int k0, int lane) {
    return *(const LAS bf16x8*)(X + (r0 + (lane & 31)) * TLD + k0 + 8 * (lane >> 5));
}
__device__ __forceinline__ bf16x8 frag_tr(const LAS bf16* X, int k0, int c0, int lane) {
    const int g = lane >> 4, i = lane & 15, q = i >> 2, p = i & 3, h = g >> 1;
    const LAS bf16* a = X + (k0 + 8 * h + q) * TLD + c0 + 16 * (g & 1) + 4 * p;
    const v4i16_t lo = __builtin_amdgcn_ds_read_tr16_b64_v4i16((LAS v4i16_t*)a);
    const v4i16_t hi = __builtin_amdgcn_ds_read_tr16_b64_v4i16((LAS v4i16_t*)(a + 4 * TLD));
    return (bf16x8){lo[0], lo[1], lo[2], lo[3], hi[0], hi[1], hi[2], hi[3]};
}
__device__ __forceinline__ int crow16(int r, int hi) { return (r & 3) + 8 * (r >> 2) + 4 * hi; }
__device__ __forceinline__ float bf2f(unsigned short v) { return __uint_as_float((unsigned)v << 16); }
__device__ __forceinline__ float ret_lg2(int h) { return log1pf(-exp2f(-5.f - (float)h)) * 1.4426950408889634f; }

__device__ __forceinline__ void p3_item(Frame& F, int bh, int n) {
    const int h = bh & 7, tid = F.tid, lane = F.lane, w = F.wave;
    bf16* qkv = (bf16*)(F.ws + WS_QKV);
    const size_t rbase = ((size_t)bh * SEQ + (size_t)n * 128) * HD;
    bf16* RQ = qkv + 0 * TSZ + rbase; bf16* RK = qkv + 1 * TSZ + rbase; const bf16* RV = qkv + 2 * TSZ + rbase; bf16* RG = qkv + 3 * TSZ + rbase;
    bf16* FQ = qkv + 4 * TSZ + rbase; bf16* FK = qkv + 5 * TSZ + rbase;
    LAS bf16* Kz = (LAS bf16*)F.lds; LAS bf16* Vt = Kz + TILE_EL;
    const float lg2 = ret_lg2(h);
    { const int row = tid >> 2, c16 = (tid & 3) * 16, s = n * 128 + row;
      const float* cs = (const float*)(F.ws + WS_CS) + ((size_t)s * 64 + c16) * 2;
      float cv[16], sv[16];
#pragma unroll
      for (int i = 0; i < 16; i += 2) { const f32x4 t = *(const f32x4*)(cs + 2 * i); cv[i] = t[0]; sv[i] = t[1]; cv[i + 1] = t[2]; sv[i + 1] = t[3]; }
      const float zeta = exp2f(lg2 * (float)(127 - row));
#pragma unroll
      for (int which = 0; which < 2; ++which) {
          bf16* P = (which == 0 ? RQ : RK) + (size_t)row * HD + c16;
          const bf16x8 a0 = *(const bf16x8*)P, a1 = *(const bf16x8*)(P + 8), b0 = *(const bf16x8*)(P + 64), b1 = *(const bf16x8*)(P + 72);
          float o1[16], o2[16];
#pragma unroll
          for (int i = 0; i < 16; ++i) { const float x1 = bf2f((unsigned short)(i < 8 ? a0[i & 7] : a1[i & 7])), x2 = bf2f((unsigned short)(i < 8 ? b0[i & 7] : b1[i & 7]));
              o1[i] = x1 * cv[i] - x2 * sv[i]; o2[i] = x1 * sv[i] + x2 * cv[i]; }
          if (which == 1) {
#pragma unroll
              for (int i = 0; i < 16; ++i) { o1[i] *= 0.08838834764831845f; o2[i] *= 0.08838834764831845f; } }
          v4u w0, w1, w2, w3;
          w0.x = pk2(o1[0], o1[1]); w0.y = pk2(o1[2], o1[3]); w0.z = pk2(o1[4], o1[5]); w0.w = pk2(o1[6], o1[7]);
          w1.x = pk2(o1[8], o1[9]); w1.y = pk2(o1[10], o1[11]); w1.z = pk2(o1[12], o1[13]); w1.w = pk2(o1[14], o1[15]);
          w2.x = pk2(o2[0], o2[1]); w2.y = pk2(o2[2], o2[3]); w2.z = pk2(o2[4], o2[5]); w2.w = pk2(o2[6], o2[7]);
          w3.x = pk2(o2[8], o2[9]); w3.y = pk2(o2[10], o2[11]); w3.z = pk2(o2[12], o2[13]); w3.w = pk2(o2[14], o2[15]);
          *(v4u*)P = w0; *(v4u*)(P + 8) = w1; *(v4u*)(P + 64) = w2; *(v4u*)(P + 72) = w3;
          if (which == 1) {
              v4u z0, z1, z2, z3;
              z0.x = pk2(o1[0] * zeta, o1[1] * zeta); z0.y = pk2(o1[2] * zeta, o1[3] * zeta); z0.z = pk2(o1[4] * zeta, o1[5] * zeta); z0.w = pk2(o1[6] * zeta, o1[7] * zeta);
              z1.x = pk2(o1[8] * zeta, o1[9] * zeta); z1.y = pk2(o1[10] * zeta, o1[11] * zeta); z1.z = pk2(o1[12] * zeta, o1[13] * zeta); z1.w = pk2(o1[14] * zeta, o1[15] * zeta);
              z2.x = pk2(o2[0] * zeta, o2[1] * zeta); z2.y = pk2(o2[2] * zeta, o2[3] * zeta); z2.z = pk2(o2[4] * zeta, o2[5] * zeta); z2.w = pk2(o2[6] * zeta, o2[7] * zeta);
              z3.x = pk2(o2[8] * zeta, o2[9] * zeta); z3.y = pk2(o2[10] * zeta, o2[11] * zeta); z3.z = pk2(o2[12] * zeta, o2[13] * zeta); z3.w = pk2(o2[14] * zeta, o2[15] * zeta);
              LAS bf16* L = Kz + row * TLD + c16;
              *(LAS v4u*)L = z0; *(LAS v4u*)(L + 8) = z1; *(LAS v4u*)(L + 64) = z2; *(LAS v4u*)(L + 72) = z3; }
      } }
#pragma unroll
    for (int j = 0; j < 4; ++j) { const int c = tid + 512 * j, row = c >> 4, col8 = (c & 15) * 8;
        *(LAS v4u*)(Vt + row * TLD + col8) = *(const v4u*)(RV + (size_t)row * HD + col8);
        bf16x8 g = *(const bf16x8*)(RG + (size_t)row * HD + col8); float gv[8];
#pragma unroll
        for (int i = 0; i < 8; ++i) gv[i] = silu_f(bf2f((unsigned short)g[i]));
        v4u o; o.x = pk2(gv[0], gv[1]); o.y = pk2(gv[2], gv[3]); o.z = pk2(gv[4], gv[5]); o.w = pk2(gv[6], gv[7]);
        *(v4u*)(RG + (size_t)row * HD + col8) = o; }
    { const float* qn = F.in[9]; const float* kn = F.in[10];
      const float q0 = qn[2 * lane], q1 = qn[2 * lane + 1], k0 = kn[2 * lane], k1 = kn[2 * lane + 1];
#pragma unroll 4
      for (int rr = 0; rr < 16; ++rr) { const int row = w * 16 + rr;
          unsigned* pq = (unsigned*)(FQ + (size_t)row * HD) + lane; unsigned* pk = (unsigned*)(FK + (size_t)row * HD) + lane;
          const unsigned uq = *pq, uk = *pk;
          const float a0 = __uint_as_float(uq << 16), a1 = __uint_as_float(uq & 0xffff0000u), b0 = __uint_as_float(uk << 16), b1 = __uint_as_float(uk & 0xffff0000u);
          const float sq = wave_sum(a0 * a0 + a1 * a1), sk = wave_sum(b0 * b0 + b1 * b1);
          const float rq = rsqrtf(sq * (1.f / 128.f) + EPS), rk = rsqrtf(sk * (1.f / 128.f) + EPS);
          *pq = pk2(a0 * rq * q0, a1 * rq * q1); *pk = pk2(b0 * rk * k0, b1 * rk * k1); } }
    LDS_WAIT(); __syncthreads();
    { const int db = w >> 1, eb = 2 * (w & 1), hi = lane >> 5;
      f32x16 a0 = {}, a1 = {};
#pragma unroll
      for (int kk = 0; kk < 8; ++kk) { const bf16x8 a = frag_tr(Kz, 16 * kk, 32 * db, lane), b0 = frag_tr(Vt, 16 * kk, 32 * eb, lane), b1 = frag_tr(Vt, 16 * kk, 32 * eb + 32, lane);
          a0 = __builtin_amdgcn_mfma_f32_32x32x16_bf16(a, b0, a0, 0, 0, 0); a1 = __builtin_amdgcn_mfma_f32_32x32x16_bf16(a, b1, a1, 0, 0, 0); }
      float* KV = (float*)(F.ws + WS_KV) + ((size_t)bh * 32 + n) * 16384;
#pragma unroll
      for (int r = 0; r < 16; ++r) { const int d = 32 * db + crow16(r, hi); KV[d * 128 + 32 * eb + (lane & 31)] = a0[r]; KV[d * 128 + 32 * eb + 32 + (lane & 31)] = a1[r]; } }
    LDS_WAIT(); __syncthreads();
}
__device__ __forceinline__ void p3_cumsum(Frame& F, int bh) {
    const float* lf = (const float*)(F.ws + WS_LOGF) + (size_t)bh * SEQ + 64 * F.lane; float* cb = (float*)(F.ws + WS_CB) + (size_t)bh * SEQ + 64 * F.lane;
    float tot = 0.f;
#pragma unroll 8
    for (int i = 0; i < 64; ++i) tot += lf[i];
    float incl = tot;
#pragma unroll
    for (int o = 1; o < 64; o <<= 1) { const float t = __shfl_up(incl, o); if (F.lane >= o) incl += t; }
    float run = incl - tot;
#pragma unroll 8
    for (int i = 0; i < 64; ++i) { run += lf[i]; cb[i] = -run * 11.313708498984761f; }
}
__device__ __forceinline__ void p3_phase(Frame& F) {
    if (F.wave == 0) for (int bh = blockIdx.x; bh < 16; bh += F.G) p3_cumsum(F, bh);
    for (int it = blockIdx.x; it < 512; it += F.G) p3_item(F, it >> 5, it & 31);
}
__device__ __forceinline__ void p3b_scan(Frame& F) {
    const float* KV = (const float*)(F.ws + WS_KV); bf16* SP = (bf16*)(F.ws + WS_SP);
    for (int idx = blockIdx.x * (NWAVES * 64) + F.tid; idx < 16 * 16384; idx += F.G * NWAVES * 64) {
        const int bh = idx >> 14, de = idx & 16383; const float cd = exp2f(ret_lg2(bh & 7) * 128.f);
        float st = 0.f;
        for (int n = 0; n < 32; ++n) { const size_t o = ((size_t)bh * 32 + n) * 16384 + de; SP[o] = (bf16)f2bf(st); st = st * cd + KV[o]; }
    }
}
__device__ __forceinline__ void ret_item(Frame& F, int bh, int n) {
    const int h = bh & 7, b = bh >> 3, tid = F.tid, lane = F.lane, w = F.wave, hi = lane >> 5, c32 = lane & 31;
    const bf16* qkv = (const bf16*)(F.ws + WS_QKV);
    const size_t rbase = ((size_t)bh * SEQ + (size_t)n * 128) * HD;
    const bf16* RQ = qkv + 0 * TSZ + rbase; const bf16* RK = qkv + 1 * TSZ + rbase; const bf16* RV = qkv + 2 * TSZ + rbase; const bf16* RG = qkv + 3 * TSZ + rbase;
    const bf16* SPg = (const bf16*)(F.ws + WS_SP) + ((size_t)bh * 32 + n) * 16384;
    LAS bf16* Qs = (LAS bf16*)F.lds; LAS bf16* Ks = Qs + TILE_EL; LAS bf16* Vs = Ks + TILE_EL; LAS bf16* Ss = Vs + TILE_EL;
    LAS float* st = (LAS float*)(Ss + TILE_EL);
#pragma unroll
    for (int j = 0; j < 4; ++j) { const int c = tid + 512 * j, row = c >> 4, col8 = (c & 15) * 8; const size_t go = (size_t)row * HD + col8; const int lo = row * TLD + col8;
        *(LAS v4u*)(Qs + lo) = *(const v4u*)(RQ + go); *(LAS v4u*)(Ks + lo) = *(const v4u*)(RK + go);
        *(LAS v4u*)(Vs + lo) = *(const v4u*)(RV + go); *(LAS v4u*)(Ss + lo) = *(const v4u*)(SPg + go); }
    LDS_WAIT(); __syncthreads();
    const int qb = w >> 1, cb2 = 2 * (w & 1);
    const float lg2 = ret_lg2(h);
    f32x16 s0 = {}, s1 = {};
#pragma unroll
    for (int kk = 0; kk < 8; ++kk) { const bf16x8 a = frag_row(Qs, 32 * qb, 16 * kk, lane), b0 = frag_row(Ks, 32 * cb2, 16 * kk, lane), b1 = frag_row(Ks, 32 * cb2 + 32, 16 * kk, lane);
        s0 = __builtin_amdgcn_mfma_f32_32x32x16_bf16(a, b0, s0, 0, 0, 0); s1 = __builtin_amdgcn_mfma_f32_32x32x16_bf16(a, b1, s1, 0, 0, 0); }
    const int key0 = 32 * cb2 + c32, key1 = key0 + 32;
    const float f0 = exp2f(-lg2 * (float)(key0 + 1)), f1 = exp2f(-lg2 * (float)(key1 + 1));
    LDS_WAIT(); __syncthreads();
#pragma unroll
    for (int r = 0; r < 16; ++r) { const int q = 32 * qb + crow16(r, hi);
        Ks[q * TLD + key0] = (bf16)f2bf(key0 <= q ? s0[r] * f0 : 0.f); Ks[q * TLD + key1] = (bf16)f2bf(key1 <= q ? s1[r] * f1 : 0.f); }
    LDS_WAIT(); __syncthreads();
    f32x16 o0 = {}, o1 = {};
#pragma unroll
    for (int kk = 0; kk < 8; ++kk) { const bf16x8 a = frag_row(Ks, 32 * qb, 16 * kk, lane), b0 = frag_tr(Vs, 16 * kk, 32 * cb2, lane), b1 = frag_tr(Vs, 16 * kk, 32 * cb2 + 32, lane);
        o0 = __builtin_amdgcn_mfma_f32_32x32x16_bf16(a, b0, o0, 0, 0, 0); o1 = __builtin_amdgcn_mfma_f32_32x32x16_bf16(a, b1, o1, 0, 0, 0); }
#pragma unroll
    for (int kk = 0; kk < 8; ++kk) { const bf16x8 a = frag_row(Qs, 32 * qb, 16 * kk, lane), b0 = frag_tr(Ss, 16 * kk, 32 * cb2, lane), b1 = frag_tr(Ss, 16 * kk, 32 * cb2 + 32, lane);
        o0 = __builtin_amdgcn_mfma_f32_32x32x16_bf16(a, b0, o0, 0, 0, 0); o1 = __builtin_amdgcn_mfma_f32_32x32x16_bf16(a, b1, o1, 0, 0, 0); }
#pragma unroll
    for (int r = 0; r < 16; ++r) { const int q = 32 * qb + crow16(r, hi); const float xi = exp2f(lg2 * (float)(q + 1));
        o0[r] *= xi; o1[r] *= xi;
        float s = o0[r] + o1[r], ss = o0[r] * o0[r] + o1[r] * o1[r];
        s = half32_sum(s); ss = half32_sum(ss);
        if (c32 == 0) { st[q * 4 + (w & 1) * 2] = s; st[q * 4 + (w & 1) * 2 + 1] = ss; } }
    LDS_WAIT(); __syncthreads();
    { const float* gn = F.in[8] + h * 128; const float g0 = gn[key0], g1 = gn[key1];
      bf16* CAT = (bf16*)(F.ws + WS_CAT) + ((size_t)b * SEQ + (size_t)n * 128) * DM + h * 128;
#pragma unroll
      for (int r = 0; r < 16; ++r) { const int q = 32 * qb + crow16(r, hi);
          const float s = st[q * 4] + st[q * 4 + 2], ss = st[q * 4 + 1] + st[q * 4 + 3];
          const float mu = s * (1.f / 128.f), var = fmaxf(ss * (1.f / 128.f) - mu * mu, 0.f), rstd = rsqrtf(var + EPS);
          const float y0 = (o0[r] - mu) * rstd * g0 * bf2f(RG[(size_t)q * HD + key0]), y1 = (o1[r] - mu) * rstd * g1 * bf2f(RG[(size_t)q * HD + key1]);
          CAT[(size_t)q * DM + key0] = (bf16)f2bf(y0); CAT[(size_t)q * DM + key1] = (bf16)f2bf(y1); } }
    LDS_WAIT(); __syncthreads();
}
__device__ __forceinline__ void p4_phase(Frame& F) {
    const int bx = blockIdx.x; const int vcu = (F.G % 8 == 0) ? (bx % 8) * (F.G / 8) + bx / 8 : bx;
    const bf16* qkv = (const bf16*)(F.ws + WS_QKV);
    bf16* CAT = (bf16*)(F.ws + WS_CAT);
    for (int fb = vcu; fb < 256; fb += F.G) {
        const int bh = fb >> 4, qb = fb & 15, h = bh & 7, b = bh >> 3;
        fox::BlockRef<bf16, bf16> cur;
        cur.Q = qkv + 4 * TSZ + ((size_t)bh * SEQ + (size_t)qb * 256) * HD; cur.K = qkv + 5 * TSZ + (size_t)bh * SEQ * HD; cur.V = qkv + 6 * TSZ + (size_t)bh * SEQ * HD;
        cur.O = CAT + ((size_t)b * SEQ + (size_t)qb * 256) * DM + 1024 + h * 128; cur.cb = (const float*)(F.ws + WS_CB) + (size_t)bh * SEQ; cur.onw = F.in[11] + h * 128; cur.P0 = qb * 256;
        fox::Seam<bf16> S;
        fox::causal_swa_prime<bf16, bf16>(cur, SEQ, F.ldsg, S);
        fox::causal_swa_block<bf16, bf16>(cur, cur, SEQ, SEQ, F.ldsg, S);
        asm volatile("s_waitcnt vmcnt(0)" ::: "memory");
        __syncthreads();
    }
    for (;;) {
        if (F.tid == 0) F.MISC[0] = atomicAdd((unsigned*)(F.ws + WS_CTL) + CW_RETQ, 1u);
        __syncthreads();
        const unsigned item = F.MISC[0];
        __syncthreads();
        if (item >= 512u) break;
        ret_item(F, (int)(item >> 5), (int)(item & 31));
    }
}
constexpr int PADROWS = 24576;
constexpr int LTAB_OFF = LDSCTL_OFF + 1024;
struct EpiPlain {
    static constexpr bool PERM = true, AFTER_DRAIN = false;
    bf16* O; int ldc; int ntn;
    template <class U> __device__ __forceinline__ void operator()(const pg8::f32x4 (&acc)[2][2][4][2], const U& u, int wr, int wc, int fr, int fq) const {
        const int row0 = u.pm * 256 + wr * 64 + fr, col0 = (u.pn % ntn) * 256 + wc * 32 + 8 * fq;
#pragma unroll
        for (int ai = 0; ai < 2; ++ai)
#pragma unroll
            for (int m = 0; m < 4; ++m) { bf16* rowp = O + (size_t)(row0 + ai * 128 + m * 16) * ldc + col0;
#pragma unroll
                for (int bj = 0; bj < 2; ++bj) { const pg8::f32x4 v0 = acc[ai][bj][m][0], v1 = acc[ai][bj][m][1];
                    pg8::u32x4 w; w.x = pg8::cvt_pk_bf16(v0[0], v0[1]); w.y = pg8::cvt_pk_bf16(v0[2], v0[3]); w.z = pg8::cvt_pk_bf16(v1[0], v1[1]); w.w = pg8::cvt_pk_bf16(v1[2], v1[3]);
                    *(pg8::u32x4*)(rowp + bj * 128) = w; } }
    }
};
struct EpiSwiglu {
    static constexpr bool PERM = true, AFTER_DRAIN = false;
    bf16* O;
    template <class U> __device__ __forceinline__ void operator()(const pg8::f32x4 (&acc)[2][2][4][2], const U& u, int wr, int wc, int fr, int fq) const {
        const int row0 = u.pm * 256 + wr * 64 + fr, col0 = (u.pn & 3) * 128 + wc * 32 + 8 * fq;
#pragma unroll
        for (int ai = 0; ai < 2; ++ai)
#pragma unroll
            for (int m = 0; m < 4; ++m) { float g[8];
#pragma unroll
                for (int n = 0; n < 2; ++n)
#pragma unroll
                    for (int i = 0; i < 4; ++i) { const float a = acc[ai][0][m][n][i], b = acc[ai][1][m][n][i]; g[4 * n + i] = a * __builtin_amdgcn_rcpf(1.f + __expf(-a)) * b; }
                pg8::u32x4 w; w.x = pg8::cvt_pk_bf16(g[0], g[1]); w.y = pg8::cvt_pk_bf16(g[2], g[3]); w.z = pg8::cvt_pk_bf16(g[4], g[5]); w.w = pg8::cvt_pk_bf16(g[6], g[7]);
                *(pg8::u32x4*)(O + (size_t)(row0 + ai * 128 + m * 16) * DE + col0) = w; }
    }
};
struct GUnit { int pm, pn, e, lt; };
template <int NJ> struct GroupedOrder {
    typedef GUnit unit_t;
    const LAS int* ts; int G, c, total;
    __device__ __forceinline__ void init(const LAS int* ts_, int G_, int c_) { ts = ts_; G = G_; c = c_; total = ts_[32] * NJ; }
    __device__ __forceinline__ bool next(int i, GUnit& u) const {
        const int L = i * G + c; if (L >= total) return false;
        const int mt = L / NJ, j = L % NJ; int e = 0;
        while (ts[e + 1] <= mt) ++e;
        u.e = e; u.lt = mt - ts[e]; u.pm = mt; u.pn = e * NJ + j; return true;
    }
    __device__ __forceinline__ void a_ready(const GUnit&) const {}
    __device__ __forceinline__ void done(const GUnit&) const {}
};
struct GatherRows { const int* list; const LAS int* cntL;
    __device__ __forceinline__ unsigned row(const GUnit& u, int r) const { const int lr = u.lt * 256 + r; return lr < cntL[u.e] ? (unsigned)list[(size_t)u.e * ECAP + lr] : 0u; } };
__device__ __forceinline__ void moe_tables(Frame& F) {
    LAS int* cntL = (LAS int*)(F.lds + LTAB_OFF); LAS int* ts = cntL + 32;
    __syncthreads();
    if (F.tid < 32) cntL[F.tid] = (int)__hip_atomic_load(F.ctl + F.cnt_off + 64 * F.tid, RLX_AGENT);
    __syncthreads();
    if (F.tid == 0) { int a = 0; for (int e = 0; e < 32; ++e) { ts[e] = a; a += (cntL[e] + 255) >> 8; } ts[32] = a; }
    __syncthreads();
}
__device__ __forceinline__ f32x4 bf4(unsigned lo, unsigned hi) { return (f32x4){__uint_as_float(lo << 16), __uint_as_float(lo & 0xffff0000u), __uint_as_float(hi << 16), __uint_as_float(hi & 0xffff0000u)}; }
template <int VAR>
__device__ __forceinline__ void p6_phase(Frame& F) {
    const float* x = F.in[0]; const float* wpost = F.in[5]; const float* wpre = F.in[13]; const float* rcb = F.in[16]; const float* rfb = F.in[18];
    const float* mod = (const float*)(F.ws + WS_MOD); const bf16* Yb = (const bf16*)(F.ws + WS_YB); bf16* Hb = (bf16*)(F.ws + WS_HB);
    const f32x4* RWP = (const f32x4*)(F.ws + WS_RWP);
    int* list = (int*)(F.ws + WS_LIST); int* SE = (int*)(F.ws + WS_SLOT); int* SPOS = SE + 2 * T; float* SW = (float*)(SPOS + 2 * T);
    LAS f32x4* rw = (LAS f32x4*)F.lds;
    const int lane = F.lane;
    for (int pass = blockIdx.x; pass < T / 16; pass += F.G) {
        const int row0 = pass * 16 + 2 * F.wave;
        f32x4 h2[2][8];
#pragma unroll
        for (int rr = 0; rr < 2; ++rr) {
            const int row = row0 + rr, b = row >> 12;
            const f32x4* xr = (const f32x4*)(x + (size_t)row * DM) + lane; const uint2* yr = (const uint2*)(Yb + (size_t)row * DM) + lane;
            f32x4* outr = (f32x4*)(F.out + (size_t)row * DM) + lane; uint2* hr = (uint2*)(Hb + (size_t)row * DM) + lane;
            const f32x4* mb = (const f32x4*)(mod + (size_t)b * 6 * DM) + lane;
            f32x4 v[8]; float ss = 0.f;
#pragma unroll
            for (int j = 0; j < 8; ++j) { const uint2 u = yr[64 * j]; v[j] = bf4(u.x, u.y); ss += (v[j].x * v[j].x + v[j].y * v[j].y) + (v[j].z * v[j].z + v[j].w * v[j].w); }
            const float rstd_y = rsqrtf(wave_sum(ss) * (1.f / DM) + EPS);
            float s2 = 0.f;
#pragma unroll
            for (int j = 0; j < 8; ++j) { const f32x4 x1 = xr[64 * j] + mb[2 * 512 + 64 * j] * (v[j] * rstd_y * ((const f32x4*)wpost)[lane + 64 * j]);
                outr[64 * j] = x1; v[j] = x1; s2 += (x1.x * x1.x + x1.y * x1.y) + (x1.z * x1.z + x1.w * x1.w); }
            asm volatile("" ::: "memory");
            const float rstd = rsqrtf(wave_sum(s2) * (1.f / DM) + EPS);
#pragma unroll
            for (int j = 0; j < 8; ++j) { const f32x4 h = v[j] * rstd * ((const f32x4*)wpre)[lane + 64 * j] * (mb[4 * 512 + 64 * j] + 1.0f) + mb[3 * 512 + 64 * j];
                h2[rr][j] = h; uint2 o; o.x = pk2(h.x, h.y); o.y = pk2(h.z, h.w); hr[64 * j] = o; }
            asm volatile("" ::: "memory");
        }
        float acc[2][36];
#pragma unroll
        for (int o = 0; o < 36; ++o) { acc[0][o] = 0.f; acc[1][o] = 0.f; }
#define RW_STAGE(j_, buf_) do { for (int p_ = F.wave; p_ < 36; p_ += NWAVES) \
            __builtin_amdgcn_global_load_lds((const unsigned*)(RWP + (j_) * 36 * 64 + p_ * 64 + lane), (LAS unsigned*)(rw + (buf_) * 36 * 64 + p_ * 64), 16, 0, 0); } while (0)
        if (VAR != 2 && VAR != 3) { RW_STAGE(0, 0); }
#pragma unroll
        for (int j = 0; j < ((VAR == 2 || VAR == 3) ? 0 : 8); ++j) {
            asm volatile("s_waitcnt vmcnt(0)" ::: "memory"); __syncthreads();
            if (j + 1 < 8) RW_STAGE(j + 1, (j + 1) & 1);
            const LAS f32x4* rwj = rw + (j & 1) * 36 * 64;
#pragma unroll
            for (int o = 0; o < 36; ++o) { const f32x4 w4 = rwj[o * 64 + lane];
                acc[0][o] += (h2[0][j].x * w4.x + h2[0][j].y * w4.y) + (h2[0][j].z * w4.z + h2[0][j].w * w4.w);
                acc[1][o] += (h2[1][j].x * w4.x + h2[1][j].y * w4.y) + (h2[1][j].z * w4.z + h2[1][j].w * w4.w);
                asm volatile("" : "+v"(acc[0][o]), "+v"(acc[1][o])); }
        }
#pragma unroll
        for (int rr = 0; rr < 2; ++rr) {
            float lg[36];
#pragma unroll
            for (int o = 0; o < 36; ++o) lg[o] = (VAR == 3) ? (acc[rr][o] + h2[rr][o & 7].x) : wave_sum(acc[rr][o]);
            int g = 0; float mx = lg[0] + rcb[0]; float c4[4];
#pragma unroll
            for (int j = 0; j < 4; ++j) c4[j] = lg[j] + rcb[j];
#pragma unroll
            for (int j = 1; j < 4; ++j) if (c4[j] > mx) { mx = c4[j]; g = j; }
            float den = 0.f;
#pragma unroll
            for (int j = 0; j < 4; ++j) den += expf(c4[j] - mx);
            const float gprob = 1.f / den;
            float f[8];
#pragma unroll
            for (int i = 0; i < 8; ++i) f[i] = (g == 0 ? lg[4 + i] : g == 1 ? lg[12 + i] : g == 2 ? lg[20 + i] : lg[28 + i]) + rfb[g * 8 + i];
            int i0 = 0; float v0 = f[0];
#pragma unroll
            for (int i = 1; i < 8; ++i) if (f[i] > v0) { v0 = f[i]; i0 = i; }
            int i1 = -1; float v1 = -3.0e38f;
#pragma unroll
            for (int i = 0; i < 8; ++i) if (i != i0 && f[i] > v1) { v1 = f[i]; i1 = i; }
            const float e1 = expf(v1 - v0); const float w0 = gprob / (1.f + e1), w1 = gprob * e1 / (1.f + e1);
            if (VAR == 1 || VAR == 3) { if (lane == 0) SW[2 * (row0 + rr)] = w0 + w1 + (float)(g * 8 + i0 + i1); } else
            if (lane == 0) { const int row = row0 + rr, ea = g * 8 + i0, eb = g * 8 + i1;
                const int pa = (int)atomicAdd((unsigned*)(F.ws + WS_CTL) + F.cnt_off + 64 * ea, 1u), pb = (int)atomicAdd((unsigned*)(F.ws + WS_CTL) + F.cnt_off + 64 * eb, 1u);
                list[(size_t)ea * ECAP + pa] = row; list[(size_t)eb * ECAP + pb] = row;
                SE[2 * row] = ea; SPOS[2 * row] = pa; SW[2 * row] = w0; SE[2 * row + 1] = eb; SPOS[2 * row + 1] = pb; SW[2 * row + 1] = w1; }
        }
    }
}
__device__ __forceinline__ void p9_final(Frame& F) {
    moe_tables(F);
    const LAS int* ts = (const LAS int*)(F.lds + LTAB_OFF) + 32;
    const float* wpost = F.in[14]; const float* mod = (const float*)(F.ws + WS_MOD); const bf16* Ys = (const bf16*)(F.ws + WS_YS);
    const int* SE = (const int*)(F.ws + WS_SLOT); const int* SPOS = SE + 2 * T; const float* SW = (const float*)(SPOS + 2 * T);
    const int lane = F.lane;
    for (int row = F.gw; row < T; row += F.NGW) {
        const int b = row >> 12;
        const int r0 = ts[SE[2 * row]] * 256 + SPOS[2 * row], r1 = ts[SE[2 * row + 1]] * 256 + SPOS[2 * row + 1]; const float w0 = SW[2 * row], w1 = SW[2 * row + 1];
        const uint2* y0 = (const uint2*)(Ys + (size_t)r0 * DM) + lane; const uint2* y1 = (const uint2*)(Ys + (size_t)r1 * DM) + lane;
        f32x4* outr = (f32x4*)(F.out + (size_t)row * DM) + lane; const f32x4* g2 = (const f32x4*)(mod + (size_t)b * 6 * DM + 5 * DM) + lane;
        f32x4 v[8]; float ss = 0.f;
#pragma unroll
        for (int j = 0; j < 8; ++j) { const uint2 a = y0[64 * j], c = y1[64 * j]; v[j] = bf4(a.x, a.y) * w0 + bf4(c.x, c.y) * w1; ss += (v[j].x * v[j].x + v[j].y * v[j].y) + (v[j].z * v[j].z + v[j].w * v[j].w); }
        const float rstd = rsqrtf(wave_sum(ss) * (1.f / DM) + EPS);
#pragma unroll
        for (int j = 0; j < 8; ++j) outr[64 * j] = outr[64 * j] + g2[64 * j] * (v[j] * rstd * ((const f32x4*)wpost)[lane + 64 * j]);
    }
}
__global__ void __launch_bounds__(NWAVES * 64, 2) mega_fwd(Args args) {
    extern __shared__ __attribute__((aligned(16))) unsigned char lds[];
    Frame F;
    F.lds = (LAS unsigned char*)lds; F.ldsg = (char*)lds;
    F.MISC = (volatile LAS unsigned*)(F.lds + MISC_OFF);
    F.tid = threadIdx.x; F.lane = F.tid & 63; F.wave = __builtin_amdgcn_readfirstlane(F.tid >> 6);
    F.G = gridDim.x; F.gw = blockIdx.x * NWAVES + F.wave; F.NGW = F.G * NWAVES;
    F.cnt_off = args.cnt_off;
    F.ws = args.ws; F.out = args.out; F.ctl = (gu32*)(args.ws + WS_CTL);
#pragma unroll
    for (int i = 0; i < 22; ++i) F.in[i] = args.in[i];
    for (int u = F.tid; u < (LDS_BYTES - LDSCTL_OFF) / 4; u += NWAVES * 64) ((LAS unsigned*)(F.lds + LDSCTL_OFF))[u] = 0u;
    __syncthreads();
    XcdBarrier bar = xcd_barrier_post((unsigned*)(F.ctl + CW_BAR), F.MISC + 8);
    const int lo = args.ph_lo, hi = args.ph_hi;
#define IN(k) (lo <= (k) && (k) < hi)
#define BOTH(k) (IN(k) && IN((k) + 1))
#define GRID_BAR() xcd_barrier(bar)
    if (IN(0)) { p0_prologue<false>(F); if (BOTH(0)) GRID_BAR(); }
    if (IN(1)) { p1_prenorm(F); if (BOTH(1)) GRID_BAR(); }
    if (IN(2)) {
        const int NG2 = (F.G == 256) ? 224 : F.G;
        if ((int)blockIdx.x < NG2) {
            pg8::Gemm g{(const bf16*)(F.ws + WS_HB), (const bf16*)(F.ws + WS_WIN), T, INCM, DM}; pg8::StaticOrder S; S.init(T, INCM, NG2, (int)blockIdx.x);
            EpiHeads E{(bf16*)(F.ws + WS_QKV)};
            pg8::gemm_phase<EpiHeads, pg8::StaticOrder, true, true>(F.lds + RING_OFF, g, S, E);
            if (F.tid == 0) __hip_atomic_fetch_add(F.ctl + CW_DONE + 64 * 2, 1u, RLX_AGENT);
        } else filler(F, 2, 1, (unsigned)NG2, 0u);
        if (BOTH(2)) GRID_BAR();
    }
    if (IN(3)) { p3_phase(F); if (BOTH(3)) GRID_BAR(); }
    if (IN(4)) { p3b_scan(F); if (BOTH(4)) GRID_BAR(); }
    if (IN(5)) { p4_phase(F); filler(F, 5, 0, (unsigned)F.G, (unsigned)(F.G - F.G / 8)); if (BOTH(5)) GRID_BAR(); }
    if (IN(6)) {
        pg8::Gemm g{(const bf16*)(F.ws + WS_CAT), (const bf16*)(F.ws + WS_WOUT), T, DM, DM}; pg8::StaticOrder S; S.init(T, DM, F.G, (int)blockIdx.x);
        EpiPlain E{(bf16*)(F.ws + WS_YB), DM, 8};
        pg8::gemm_phase<EpiPlain, pg8::StaticOrder, true, true>(F.lds + RING_OFF, g, S, E);
        if (BOTH(6)) GRID_BAR();
    }
    if (IN(7)) { p6_phase<0>(F); filler(F, 7, 2, 0u, 0u); if (BOTH(7)) GRID_BAR(); }
#ifdef PROBE_VARIANTS
    if (lo == 11) p6_phase<1>(F);
    if (lo == 12) p6_phase<2>(F);
    if (lo == 13) p6_phase<3>(F);
#endif
    if (IN(8)) {
        moe_tables(F);
        pg8::Gemm g{(const bf16*)(F.ws + WS_HB), (const bf16*)(F.ws + WS_W13), PADROWS, NE * 1024, DM};
        GroupedOrder<4> S; S.init((const LAS int*)(F.lds + LTAB_OFF) + 32, F.G, (int)blockIdx.x);
        EpiSwiglu E{(bf16*)(F.ws + WS_GB)}; GatherRows R{(const int*)(F.ws + WS_LIST), (const LAS int*)(F.lds + LTAB_OFF)};
        pg8::gemm_phase<EpiSwiglu, GroupedOrder<4>, true, true, GatherRows>(F.lds + RING_OFF, g, S, E, R);
        if (BOTH(8)) GRID_BAR();
    }
    if (IN(9)) {
        moe_tables(F);
        pg8::Gemm g{(const bf16*)(F.ws + WS_GB), (const bf16*)(F.ws + WS_W2), PADROWS, NE * 2048, DE};
        GroupedOrder<8> S; S.init((const LAS int*)(F.lds + LTAB_OFF) + 32, F.G, (int)blockIdx.x);
        EpiPlain E{(bf16*)(F.ws + WS_YS), DM, 8};
        pg8::gemm_phase<EpiPlain, GroupedOrder<8>, true, true>(F.lds + RING_OFF, g, S, E);
        if (BOTH(9)) GRID_BAR();
    }
    if (IN(10)) { p9_final(F); }
#undef IN
#undef BOTH
}

__global__ void k_adapt_proj(const bf16* __restrict__ qkv, const float* __restrict__ zb, float* __restrict__ proj) {
    const size_t i = (size_t)blockIdx.x * blockDim.x + threadIdx.x;
    if (i >= (size_t)T * INC) return;
    const int tok = (int)(i / INC), c = (int)(i % INC);
    if (c >= INCM) { proj[i] = zb[(size_t)tok * 8 + (c - INCM)]; return; }
    const int type = c >> 10, hh = (c & 1023) >> 7, d = c & 127, b = tok >> 12, s = tok & 4095;
    const unsigned v = qkv[(size_t)type * TSZ + ((size_t)((b * 8 + hh) * SEQ + s)) * HD + d];
    proj[i] = __uint_as_float(v << 16);
}

__global__ void k_adapt_cat(const bf16* __restrict__ catb, float* __restrict__ cat) {
    const size_t i = (size_t)blockIdx.x * blockDim.x + threadIdx.x;
    if (i < (size_t)T * DM) cat[i] = __uint_as_float((unsigned)catb[i] << 16);
}
extern "C" void kernel_launch(void* const* d_in, const int* in_sizes, int n_in, void* d_out, int out_size, void* d_ws, size_t ws_size, hipStream_t stream) {
    static int grid = 0;
    if (grid == 0) {
        int dev = 0, cus = 0, per_cu = 0;
        (void)hipGetDevice(&dev); (void)hipDeviceGetAttribute(&cus, hipDeviceAttributeMultiprocessorCount, dev);
        (void)hipFuncSetAttribute((const void*)mega_fwd, hipFuncAttributeMaxDynamicSharedMemorySize, LDS_BYTES);
        (void)hipOccupancyMaxActiveBlocksPerMultiprocessor(&per_cu, (const void*)mega_fwd, NWAVES * 64, LDS_BYTES);
        (void)hipGetLastError();
        if (per_cu < 1) { fprintf(stderr, "kernel_launch: occupancy query says %d blocks/CU\n", per_cu); per_cu = 1; }
        grid = cus > 0 ? cus : 256;
        if (ws_size < WS_END) fprintf(stderr, "kernel_launch: workspace too small (%zu < %zu)\n", ws_size, (size_t)WS_END);
    }
    (void)hipMemsetAsync((char*)d_ws + WS_CTL, 0, CTL_ZERO_BYTES, stream);
    Args a{};
    for (int i = 0; i < 22; ++i) a.in[i] = (const float*)d_in[i];
    a.out = (float*)d_out; a.ws = (unsigned char*)d_ws; a.ph_lo = 0; a.ph_hi = 11; a.cnt_off = CW_CNT;
    hipLaunchKernelGGL(mega_fwd, dim3(grid), dim3(NWAVES * 64), LDS_BYTES, stream, a);
}
```

```cpp
#include <hip/hip_runtime.h>
#include <stdint.h>
#include <cstdio>

constexpr int DM = 2048, NB = 2, SEQ = 4096, T = NB * SEQ;
constexpr int HD = 128, NH = 8;
constexpr int INC = 7176, INCM = 7168;
constexpr int NE = 32, DE = 512;
constexpr float EPS = 1e-6f;
#define GAS __attribute__((address_space(1)))
#define LAS __attribute__((address_space(3)))
typedef unsigned short bf16;
typedef unsigned v4u __attribute__((ext_vector_type(4)));
typedef float f32x4 __attribute__((ext_vector_type(4)));
typedef short bf16x8 __attribute__((ext_vector_type(8)));
typedef GAS unsigned gu32;
typedef GAS unsigned long long gu64;
#define RLX_AGENT __ATOMIC_RELAXED, __HIP_MEMORY_SCOPE_AGENT
#define LDS_WAIT() asm volatile("s_waitcnt lgkmcnt(0)" ::: "memory")
#define VM_WAIT() asm volatile("s_waitcnt vmcnt(0)" ::: "memory")
__device__ __forceinline__ unsigned long long rt() { return __builtin_amdgcn_s_memrealtime(); }
__device__ __forceinline__ unsigned f2bf(float f) { unsigned u = __builtin_bit_cast(unsigned, f); return (u + 0x7fffu + ((u >> 16) & 1u)) >> 16; }
__device__ __forceinline__ unsigned pk2(float lo, float hi) { return f2bf(lo) | (f2bf(hi) << 16); }

#define XB_TMO      128
#define XB_XCNT(j)  (256  + 64 * (j))
#define XB_XSUB(j)  (1280 + 64 * (j))
#define XB_XGEN(j)  (2304 + 64 * (j))
#define XB_TOP      3328
#define XB_TOPGEN   3392
#define XCD_BAR_WORDS 3456
#define XB_SPIN_CAP (1u << 18)

__device__ __forceinline__ unsigned xb_ld(unsigned* p)              { return __hip_atomic_load(p, __ATOMIC_RELAXED, __HIP_MEMORY_SCOPE_AGENT); }
__device__ __forceinline__ unsigned xb_add(unsigned* p, unsigned v) { return __hip_atomic_fetch_add(p, v, __ATOMIC_RELAXED, __HIP_MEMORY_SCOPE_AGENT); }
__device__ __forceinline__ unsigned xb_xcc_id() { return (unsigned)__builtin_amdgcn_s_getreg((3 << 11) | 20) & 0xFu; }
#define XB_SPIN(cond, bar) do { unsigned _sp = 0; while (cond) { __builtin_amdgcn_s_sleep(1); \
    if ((++_sp & 255u) == 0u) { if (xb_ld(&(bar)[XB_TMO])) break; if (_sp > XB_SPIN_CAP) { atomicAdd(&(bar)[XB_TMO], 1u); break; } } } } while (0)

struct XcdBarrier {
    unsigned* bar; unsigned x;
    volatile LAS unsigned* st;
};

__device__ __forceinline__ XcdBarrier xcd_barrier_post(unsigned* bar, volatile LAS unsigned* st) {
    XcdBarrier b; b.bar = bar; b.x = xb_xcc_id(); b.st = st;
    if (threadIdx.x == 0) (void)xb_add(&bar[XB_XCNT(b.x)], 1u);
    return b;
}
__device__ __forceinline__ void xcd_barrier_complete(unsigned* bar, unsigned x, unsigned& nloc, unsigned& nx) {
    const unsigned G = gridDim.x * gridDim.y * gridDim.z;
    unsigned sum, cnt, mine, sp = 0u;
    for (;;) {
        sum = 0u; cnt = 0u; mine = 0u;
#pragma unroll
        for (unsigned j = 0; j < 16; ++j) { const unsigned c = xb_ld(&bar[XB_XCNT(j)]); sum += c; cnt += (c > 0u) ? 1u : 0u; mine = (j == x) ? c : mine; }
        if (sum == G) break;
        __builtin_amdgcn_s_sleep(1);
        if ((++sp & 255u) == 0u) { if (xb_ld(&bar[XB_TMO])) break; if (sp > XB_SPIN_CAP) { atomicAdd(&bar[XB_TMO], 1u); break; } }
    }
    nloc = mine > 0u ? mine : 1u; nx = cnt > 0u ? cnt : 1u;
}

__device__ __forceinline__ void xcd_barrier(const XcdBarrier& b) {
    asm volatile("s_waitcnt vmcnt(0)" ::: "memory");
    __syncthreads();
    if (threadIdx.x == 0) {
        unsigned* bar = b.bar;
        __builtin_amdgcn_s_waitcnt(0);
        unsigned nloc = b.st[0], nx = b.st[1];
        if (nloc == 0u) { xcd_barrier_complete(bar, b.x, nloc, nx); b.st[0] = nloc; b.st[1] = nx; }
        const unsigned old = xb_add(&bar[XB_XSUB(b.x)], 1u);
        const unsigned gen = old / nloc;
        if (old + 1u == (gen + 1u) * nloc) {
            __builtin_amdgcn_fence(__ATOMIC_RELEASE, "agent");
            asm volatile("s_waitcnt vmcnt(0)" ::: "memory");
            const unsigned og = xb_add(&bar[XB_TOP], 1u);
            const unsigned tg = og / nx;
            if (og + 1u == (tg + 1u) * nx) xb_add(&bar[XB_TOPGEN], 1u);
            else XB_SPIN(xb_ld(&bar[XB_TOPGEN]) == tg, bar);
            __builtin_amdgcn_fence(__ATOMIC_ACQUIRE, "agent");
            xb_add(&bar[XB_XGEN(b.x)], 1u);
            asm volatile("s_waitcnt vmcnt(0)" ::: "memory");
        } else {
            XB_SPIN(xb_ld(&bar[XB_XGEN(b.x)]) == gen, bar);
            __builtin_amdgcn_fence(__ATOMIC_ACQUIRE, "agent");
            asm volatile("s_waitcnt vmcnt(0)" ::: "memory");
        }
    }
    __syncthreads();
}
namespace pg8 {
#define PG8_LAS __attribute__((address_space(3)))
typedef unsigned short bf16_t;
typedef short bf16x8 __attribute__((ext_vector_type(8)));
typedef float f32x4 __attribute__((ext_vector_type(4)));
typedef unsigned u32x4 __attribute__((ext_vector_type(4)));
constexpr int BM = 256, BK = 64, HALF = 128, HTB = HALF * BK * 2  , STAGE_BYTES = 8 * HTB, NXCD = 8, WGM = 8;

__host__ __device__ __forceinline__ int lds_byte(int r, int c) { const int st = (r >> 4) * 2 + (c >> 5), rr = r & 15, cc = c & 31, ob = rr * 64 + cc * 2; return st * 1024 + (ob ^ (((ob >> 9) & 1) << 5)); }
__host__ __device__ __forceinline__ void stage_rc(int b, int& R, int& C) { const int st = b / 1024, sb = b % 1024, swz = sb ^ (((sb >> 9) & 1) << 5); R = (st >> 1) * 16 + swz / 64; C = (st & 1) * 32 + (swz % 64) / 2; }
__host__ __device__ __forceinline__ int perm32(int rho) { const int n = rho >> 4, i = rho & 15; return 8 * (i >> 2) + 4 * n + (i & 3); }

struct Unit { int pm, pn; };
struct Gemm { const bf16_t* A; const bf16_t* Bt; int M, N, K; };

struct StaticOrder {
    typedef Unit unit_t;
    int nM, nN, nwg, G, c;
    __host__ __device__ void init(int M, int N, int G_, int c_) { nM = M / BM; nN = N / BM; nwg = nM * nN; G = G_; c = c_; }
    __host__ __device__ bool next(int i, Unit& u) const {
        const long L = (long)i * G + c; if (L >= nwg) return false;
        int wgid = (int)L; { const int q = nwg / NXCD, r = nwg % NXCD, xcd = wgid % NXCD, off = wgid / NXCD; wgid = (xcd < r ? xcd * (q + 1) : r * (q + 1) + (xcd - r) * q) + off; }
        const int nig = WGM * nN, gid = wgid / nig, fm = gid * WGM, gsz = (nM - fm) < WGM ? (nM - fm) : WGM;
        u.pm = fm + ((wgid % nig) % gsz); u.pn = (wgid % nig) / gsz; return true;
    }
    __device__ __forceinline__ void a_ready(const Unit&) const {}
    __device__ __forceinline__ void done(const Unit&) const {}
};

__device__ __forceinline__ unsigned cvt_pk_bf16(float lo, float hi) { unsigned r; asm volatile("v_cvt_pk_bf16_f32 %0, %1, %2" : "=v"(r) : "v"(lo), "v"(hi)); return r; }
typedef float f32x2 __attribute__((ext_vector_type(2)));
__device__ __forceinline__ f32x2 gelu_pk(f32x2 v) {
    const f32x2 av = __builtin_elementwise_abs(v), d = av * 0.2316418882f + 1.0f;
    f32x2 t; t.x = __builtin_amdgcn_rcpf(d.x); t.y = __builtin_amdgcn_rcpf(d.y);
    f32x2 q = t * 0.5307027145f + (-0.7265760135f); q = q * t + 0.7107068705f; q = q * t + (-0.142248368f); q = q * t + 0.127414796f; q = q * t;
    const f32x2 s = (v * v) * (-0.72134752044f);
    f32x2 e; e.x = __builtin_amdgcn_exp2f(s.x); e.y = __builtin_amdgcn_exp2f(s.y);
    const f32x2 m = v * (q * e), r = v - m;
    f32x2 o; o.x = v.x < 0.f ? m.x : r.x; o.y = v.y < 0.f ? m.y : r.y; return o;
}

template <int ACT  > struct EpiBf16 {
    static constexpr bool PERM = true, AFTER_DRAIN = false; static_assert(ACT == 0 || ACT == 1, "EpiBf16: ACT is 0 (none) or 1 (gelu_pk)");
    bf16_t* O; int ldc; const float* bias; int split_cols; size_t split_stride; float scale0;
    __device__ __forceinline__ void operator()(const f32x4 (&acc)[2][2][4][2], const Unit& u, int wr, int wc, int fr, int fq) const {
        const int row0 = u.pm * BM + wr * 64 + fr; int colt = u.pn * BM; bf16_t* base = O;
        float sc = 1.f; if (split_cols) { const int t = colt / split_cols; base += (size_t)t * split_stride; colt -= t * split_cols; if (t == 0) sc = scale0; }
        const int col0 = colt + wc * 32 + 8 * fq, bcol0 = u.pn * BM + wc * 32 + 8 * fq;
        f32x4 bv[2][2];
#pragma unroll
        for (int bj = 0; bj < 2; ++bj)
#pragma unroll
            for (int n = 0; n < 2; ++n) bv[bj][n] = bias ? *(const f32x4*)(bias + bcol0 + bj * HALF + 4 * n) : (f32x4){0.f, 0.f, 0.f, 0.f};
#pragma unroll
        for (int ai = 0; ai < 2; ++ai)
#pragma unroll
            for (int m = 0; m < 4; ++m) { bf16_t* rowp = base + (size_t)(row0 + ai * HALF + m * 16) * ldc + col0;
#pragma unroll
                for (int bj = 0; bj < 2; ++bj) { f32x4 v0 = acc[ai][bj][m][0] + bv[bj][0], v1 = acc[ai][bj][m][1] + bv[bj][1];
                    if (ACT == 1) { f32x2 a = gelu_pk((f32x2){v0[0], v0[1]}), b = gelu_pk((f32x2){v0[2], v0[3]}), c = gelu_pk((f32x2){v1[0], v1[1]}), d = gelu_pk((f32x2){v1[2], v1[3]});
                        v0 = (f32x4){a.x, a.y, b.x, b.y}; v1 = (f32x4){c.x, c.y, d.x, d.y}; }
                    v0 = v0 * sc; v1 = v1 * sc; u32x4 w; w.x = cvt_pk_bf16(v0[0], v0[1]); w.y = cvt_pk_bf16(v0[2], v0[3]); w.z = cvt_pk_bf16(v1[0], v1[1]); w.w = cvt_pk_bf16(v1[2], v1[3]);
                    *(u32x4*)(rowp + bj * HALF) = w; } }
    }
};
struct IdentRows { template <class U> __device__ __forceinline__ unsigned row(const U& u, int r) const { return (unsigned)(u.pm * BM + r); } };
template <class Epi, class Sched, bool ALIGN_EPI = false, bool SP2 = false, class RowMap = IdentRows>
__device__ __forceinline__ void gemm_phase(PG8_LAS unsigned char* lds, const Gemm g, const Sched& S, const Epi& E, const RowMap RM = RowMap()) {
    typedef typename Sched::unit_t Unit;
    const int tid = threadIdx.x, wid = __builtin_amdgcn_readfirstlane(tid >> 6), lane = tid & 63, wr = wid >> 2, wc = wid & 3, fr = lane & 15, fq = lane >> 4;
    const int K = g.K, nt = K / BK;
    unsigned voffB[2]; int RA[2], CA[2];
#pragma unroll
    for (int i = 0; i < 2; ++i) { int R, C; stage_rc(tid * 16 + i * 8192, R, C); const int Rb = Epi::PERM ? ((R & ~31) + perm32(R & 31)) : R;
        RA[i] = R; CA[i] = C; voffB[i] = (unsigned)(Rb * K + C) * 2u; }
    unsigned ao[2][2], an[2][2];
#define PG8_AOFF(dst, U) do { _Pragma("unroll") for (int h_ = 0; h_ < 2; ++h_) _Pragma("unroll") for (int i_ = 0; i_ < 2; ++i_) { \
        dst[h_][i_] = RM.row((U), h_ * HALF + RA[i_]) * (unsigned)(K * 2) + (unsigned)(CA[i_] * 2); } } while (0)
    const size_t kstep = (size_t)(BK * 2);
    const size_t hstep = (size_t)HALF * K * 2;
    const size_t tstep = 2 * hstep;
    const unsigned ldsw = (unsigned)wid * 1024u;
    const int aoff = lds_byte(wr * 64 + fr, fq * 8), boff = lds_byte(wc * 32 + fr, fq * 8);
#define PG8_SA(b, h) (((b) * 2 + (h)) * HTB)
#define PG8_SB(b, h) ((4 + (b) * 2 + (h)) * HTB)
#define PG8_STAGE(bufoff, gbase, voff) do { _Pragma("unroll") for (int _i = 0; _i < 2; ++_i) \
        __builtin_amdgcn_global_load_lds((const unsigned*)((const char*)(gbase) + (voff)[_i]), (PG8_LAS unsigned*)(lds + (bufoff) + ldsw + _i * 8192), 16, 0, 0); } while (0)
#define PG8_STAGE_A(bufoff, kbase, off) do { _Pragma("unroll") for (int _i = 0; _i < 2; ++_i) \
        __builtin_amdgcn_global_load_lds((const unsigned*)((const char*)(kbase) + (off)[_i]), (PG8_LAS unsigned*)(lds + (bufoff) + ldsw + _i * 8192), 16, 0, 0); } while (0)
#define PG8_LDA(dst, b, h) do { _Pragma("unroll") for (int m = 0; m < 4; ++m) _Pragma("unroll") for (int k = 0; k < 2; ++k) dst[m][k] = *(const PG8_LAS bf16x8*)(lds + PG8_SA(b, h) + aoff + m * 2048 + k * 1024); } while (0)
#define PG8_LDB(dst, b, h) do { _Pragma("unroll") for (int n = 0; n < 2; ++n) _Pragma("unroll") for (int k = 0; k < 2; ++k) dst[n][k] = *(const PG8_LAS bf16x8*)(lds + PG8_SB(b, h) + boff + n * 2048 + k * 1024); } while (0)
#define PG8_MMA(ai, bj, At, Bt) do { __builtin_amdgcn_s_setprio(1); _Pragma("unroll") for (int m = 0; m < 4; ++m) _Pragma("unroll") for (int n = 0; n < 2; ++n) _Pragma("unroll") for (int k = 0; k < 2; ++k) \
        acc[ai][bj][m][n] = __builtin_amdgcn_mfma_f32_16x16x32_bf16(Bt[n][k], At[m][k], acc[ai][bj][m][n], 0, 0, 0); __builtin_amdgcn_s_setprio(0); } while (0)
#define PG8_WAIT_V(n) asm volatile("s_waitcnt vmcnt(" #n ")" ::: "memory")
#define PG8_WAIT_L(n) asm volatile("s_waitcnt lgkmcnt(" #n ")" ::: "memory")
#define PG8_BAR __builtin_amdgcn_s_barrier()
#define PG8_SCHED __builtin_amdgcn_sched_barrier(0)
    Unit cur, nxt; int ui = 0;
    if (!S.next(0, cur)) return;
    f32x4 acc[2][2][4][2];
#pragma unroll
    for (int a = 0; a < 2; ++a)
#pragma unroll
        for (int b = 0; b < 2; ++b)
#pragma unroll
            for (int m = 0; m < 4; ++m)
#pragma unroll
                for (int n = 0; n < 2; ++n) acc[a][b][m][n] = (f32x4){0.f, 0.f, 0.f, 0.f};
    bf16x8 At[4][2], B0[2][2], B1[2][2];
    const char* const Ab = (const char*)g.A; const char* cB = (const char*)g.Bt + (size_t)cur.pn * tstep;
    PG8_AOFF(ao, cur);
    S.a_ready(cur);
    if constexpr (SP2) {
        PG8_STAGE(PG8_SB(0, 0), cB, voffB); PG8_STAGE(PG8_SB(0, 1), cB + hstep, voffB); PG8_STAGE_A(PG8_SA(0, 0), Ab, ao[0]); PG8_STAGE_A(PG8_SA(0, 1), Ab, ao[1]);
        if (wr == 1) PG8_BAR;
        PG8_WAIT_V(2); PG8_BAR;
        PG8_STAGE(PG8_SB(1, 0), cB + kstep, voffB); PG8_STAGE_A(PG8_SA(1, 0), Ab + kstep, ao[0]); PG8_STAGE(PG8_SB(1, 1), cB + hstep + kstep, voffB);
        PG8_WAIT_V(6); PG8_BAR;
    } else {
        PG8_STAGE(PG8_SB(0, 0), cB, voffB); PG8_STAGE_A(PG8_SA(0, 0), Ab, ao[0]); PG8_STAGE(PG8_SB(0, 1), cB + hstep, voffB); PG8_STAGE_A(PG8_SA(0, 1), Ab, ao[1]);
        if (wr == 1) PG8_BAR;
        PG8_WAIT_V(4); PG8_BAR;
        PG8_STAGE(PG8_SB(1, 0), cB + kstep, voffB); PG8_STAGE_A(PG8_SA(1, 0), Ab + kstep, ao[0]); PG8_STAGE(PG8_SB(1, 1), cB + hstep + kstep, voffB);
        PG8_WAIT_V(6); PG8_BAR;
    }
    for (;;) {
        const bool has_next = S.next(ui + 1, nxt);
        const char* nB = has_next ? (const char*)g.Bt + (size_t)nxt.pn * tstep : cB;
        if (has_next) { PG8_AOFF(an, nxt); } else { _Pragma("unroll") for (int h_ = 0; h_ < 2; ++h_) _Pragma("unroll") for (int i_ = 0; i_ < 2; ++i_) an[h_][i_] = ao[h_][i_]; }
        for (int t = 0; t < nt; t += 2) {
            const bool last = (t == nt - 2);
            const char* a1 = Ab + (size_t)(t + 1) * kstep;
            const char* a2 = last ? Ab : Ab + (size_t)(t + 2) * kstep; const char* b2 = last ? nB : cB + (size_t)(t + 2) * kstep;
            const char* a3 = a2 + kstep; const char* b3 = b2 + kstep;
            unsigned as[2][2];
#pragma unroll
            for (int h_ = 0; h_ < 2; ++h_)
#pragma unroll
                for (int i_ = 0; i_ < 2; ++i_) as[h_][i_] = last ? an[h_][i_] : ao[h_][i_];
            if (last && has_next) S.a_ready(nxt);
            if constexpr (SP2) {
            PG8_LDB(B0, 0, 0); PG8_LDB(B1, 0, 1); PG8_SCHED; PG8_LDA(At, 0, 0); PG8_STAGE_A(PG8_SA(1, 1), a1, ao[1]);
            PG8_WAIT_V(8); PG8_WAIT_L(0); PG8_BAR; PG8_MMA(0, 0, At, B0); PG8_MMA(0, 1, At, B1); PG8_BAR; PG8_SCHED;
            PG8_LDA(At, 0, 1); PG8_STAGE(PG8_SB(0, 0), b2, voffB); PG8_STAGE(PG8_SB(0, 1), b2 + hstep, voffB); PG8_STAGE_A(PG8_SA(0, 0), a2, as[0]);
            PG8_WAIT_V(8); PG8_WAIT_L(0); PG8_BAR; PG8_MMA(1, 0, At, B0); PG8_MMA(1, 1, At, B1); PG8_BAR; PG8_SCHED;
            PG8_LDB(B0, 1, 0); PG8_LDB(B1, 1, 1); PG8_SCHED; PG8_LDA(At, 1, 0); PG8_STAGE_A(PG8_SA(0, 1), a2, as[1]);
            PG8_WAIT_V(8); PG8_WAIT_L(0); PG8_BAR; PG8_MMA(0, 0, At, B0); PG8_MMA(0, 1, At, B1); PG8_BAR; PG8_SCHED;
            PG8_LDA(At, 1, 1); PG8_STAGE(PG8_SB(1, 0), b3, voffB); PG8_STAGE(PG8_SB(1, 1), b3 + hstep, voffB); PG8_STAGE_A(PG8_SA(1, 0), a3, as[0]);
            PG8_WAIT_V(8); PG8_WAIT_L(0); PG8_BAR; PG8_MMA(1, 0, At, B0); PG8_MMA(1, 1, At, B1); PG8_BAR; PG8_SCHED;
            } else {
            PG8_LDB(B0, 0, 0); PG8_SCHED; PG8_LDA(At, 0, 0); PG8_STAGE_A(PG8_SA(1, 1), a1, ao[1]);
            PG8_WAIT_L(8); PG8_BAR; PG8_WAIT_L(0); PG8_MMA(0, 0, At, B0); PG8_BAR; PG8_SCHED;
            PG8_LDB(B1, 0, 1); PG8_STAGE(PG8_SB(0, 0), b2, voffB);
            PG8_BAR; PG8_WAIT_L(0); PG8_MMA(0, 1, At, B1); PG8_BAR;
            PG8_LDA(At, 0, 1); PG8_STAGE_A(PG8_SA(0, 0), a2, as[0]);
            PG8_BAR; PG8_WAIT_L(0); PG8_MMA(1, 0, At, B0); PG8_BAR; PG8_SCHED;
            PG8_STAGE(PG8_SB(0, 1), b2 + hstep, voffB);
            PG8_WAIT_V(6); PG8_BAR; PG8_MMA(1, 1, At, B1); PG8_BAR;
            PG8_LDB(B0, 1, 0); PG8_SCHED; PG8_LDA(At, 1, 0); PG8_STAGE_A(PG8_SA(0, 1), a2, as[1]);
            PG8_WAIT_L(8); PG8_BAR; PG8_WAIT_L(0); PG8_MMA(0, 0, At, B0); PG8_BAR; PG8_SCHED;
            PG8_LDB(B1, 1, 1); PG8_STAGE(PG8_SB(1, 0), b3, voffB);
            PG8_BAR; PG8_WAIT_L(0); PG8_MMA(0, 1, At, B1); PG8_BAR;
            PG8_LDA(At, 1, 1); PG8_STAGE_A(PG8_SA(1, 0), a3, as[0]);
            PG8_BAR; PG8_WAIT_L(0); PG8_MMA(1, 0, At, B0); PG8_BAR; PG8_SCHED;
            PG8_STAGE(PG8_SB(1, 1), b3 + hstep, voffB);
            PG8_WAIT_V(6); PG8_BAR; PG8_MMA(1, 1, At, B1); PG8_BAR;
            }
        }
        if constexpr (ALIGN_EPI) { if (wr == 0) PG8_BAR; }
        if constexpr (!Epi::AFTER_DRAIN) { E(acc, cur, wr, wc, fr, fq); S.done(cur); }
        if (!has_next) break;
#pragma unroll
        for (int a = 0; a < 2; ++a)
#pragma unroll
            for (int b = 0; b < 2; ++b)
#pragma unroll
                for (int m = 0; m < 4; ++m)
#pragma unroll
                    for (int n = 0; n < 2; ++n) acc[a][b][m][n] = (f32x4){0.f, 0.f, 0.f, 0.f};
        cur = nxt; cB = nB; ++ui;
#pragma unroll
        for (int h_ = 0; h_ < 2; ++h_)
#pragma unroll
            for (int i_ = 0; i_ < 2; ++i_) ao[h_][i_] = an[h_][i_];
        if constexpr (ALIGN_EPI) { if (wr == 1) PG8_BAR; }
    }
    PG8_WAIT_V(0);
    if constexpr (!ALIGN_EPI) { if (wr == 0) PG8_BAR; }
    PG8_BAR;
    if constexpr (Epi::AFTER_DRAIN) { E.fused(acc, cur, wr, wc, fr, fq, lds, wid, lane); S.done(cur); }
#undef PG8_SA
#undef PG8_SB
#undef PG8_STAGE
#undef PG8_STAGE_A
#undef PG8_AOFF
#undef PG8_LDA
#undef PG8_LDB
#undef PG8_MMA
#undef PG8_WAIT_V
#undef PG8_WAIT_L
#undef PG8_BAR
#undef PG8_SCHED
}
}
constexpr int NWAVES = 8;
constexpr int RING_OFF = 0, RING_BYTES = 131072;
constexpr int LDSCTL_OFF = 150 * 1024, MISC_OFF = LDSCTL_OFF + 320;
constexpr int LDS_BYTES = 160 * 1024;
constexpr size_t MiB = 1u << 20;
constexpr size_t WS_CTL = 0, CTL_ZERO_BYTES = 1 * MiB;
constexpr size_t WS_MOD = 1 * MiB;
constexpr size_t WS_RWP = WS_MOD + 128 * 1024;
constexpr size_t WS_CS = 2 * MiB;
constexpr size_t WS_LOGF = 4 * MiB;
constexpr size_t WS_CB = WS_LOGF + 256 * 1024;
constexpr size_t WS_Z = WS_CB + 256 * 1024;
constexpr size_t WS_WIN = 6 * MiB;
constexpr size_t WS_WOUT = 34 * MiB;
constexpr size_t WS_HB = 42 * MiB;
constexpr size_t WS_QKV = 74 * MiB;
constexpr size_t TSZ = (size_t)16 * 4096 * 128;
constexpr size_t WS_FAST_END = 186 * MiB;
constexpr size_t WS_YB = 74 * MiB;
constexpr size_t WS_GB = 74 * MiB;
constexpr size_t WS_YS = 110 * MiB;
constexpr size_t WS_W13 = 266 * MiB;
constexpr size_t WS_W2 = 394 * MiB;
constexpr size_t WS_LIST = 458 * MiB;
constexpr size_t WS_SLOT = 459 * MiB;
constexpr size_t WS_END = 460 * MiB;
constexpr int ECAP = 8192, CW_CNT = 32768;
constexpr int CW_BAR = 4096;

struct Frame {
    LAS unsigned char* lds; char* ldsg;
    volatile LAS unsigned* MISC;
    gu32* ctl;
    int tid, lane, wave, G, gw, NGW, cnt_off;
    const float* in[22]; float* out; unsigned char* ws;
};
struct Args { const float* in[22]; float* out; unsigned char* ws; int ph_lo, ph_hi, cnt_off, pad; };

template <int CTRL> __device__ __forceinline__ float dppa(float v) { const int t = __builtin_amdgcn_update_dpp(0, __float_as_int(v), CTRL, 0xf, 0xf, true); return v + __int_as_float(t); }
__device__ __forceinline__ float row16_sum(float v) { v = dppa<0xB1>(v); v = dppa<0x4E>(v); v = dppa<0x141>(v); v = dppa<0x140>(v); return v; }
__device__ __forceinline__ float half32_sum(float v) { v = row16_sum(v); return v + __shfl_xor(v, 16); }
__device__ __forceinline__ float wave_sum(float v) {
    v = row16_sum(v);
    const float s0 = __int_as_float(__builtin_amdgcn_readlane(__float_as_int(v), 0)), s1 = __int_as_float(__builtin_amdgcn_readlane(__float_as_int(v), 16));
    const float s2 = __int_as_float(__builtin_amdgcn_readlane(__float_as_int(v), 32)), s3 = __int_as_float(__builtin_amdgcn_readlane(__float_as_int(v), 48));
    return (s0 + s1) + (s2 + s3);
}
__device__ __forceinline__ float silu_f(float v) { return v / (1.f + __expf(-v)); }

__device__ __forceinline__ void p0_mod(Frame& F) {
    const float* c = F.in[1]; const float* ada_w = F.in[2]; const float* ada_b = F.in[3];
    float* mod = (float*)(F.ws + WS_MOD);
    LAS float* ca = (LAS float*)(F.lds);
    LAS float* red = ca + 2 * DM;
    for (int i = F.tid; i < 2 * DM; i += NWAVES * 64) ca[i] = silu_f(c[i]);
    __syncthreads();
    for (int cb = blockIdx.x; cb < 256; cb += F.G) {
        const int j0 = cb * 48;
        float a0 = 0.f, a1 = 0.f;
        if (F.lane < 48) {
#pragma unroll 8
            for (int k = F.wave; k < DM; k += NWAVES) { const float w = ada_w[(size_t)k * (6 * DM) + j0 + F.lane]; a0 = fmaf(ca[k], w, a0); a1 = fmaf(ca[DM + k], w, a1); }
            red[F.wave * 96 + F.lane] = a0; red[F.wave * 96 + 48 + F.lane] = a1;
        }
        __syncthreads();
        if (F.tid < 96) { float s = 0.f;
#pragma unroll
            for (int w = 0; w < NWAVES; ++w) s += red[w * 96 + F.tid];
            const int b = F.tid / 48, jj = F.tid % 48; mod[b * 6 * DM + j0 + jj] = s + ada_b[j0 + jj]; }
        __syncthreads();
    }
}
__device__ __forceinline__ void tr_tile(const float* __restrict__ src, int ldn, int k0, int n0, bf16* __restrict__ dst, int ldk, int drow0, LAS float* scr, int lane) {
#pragma unroll 4
    for (int i = 0; i < 16; ++i) { const int kk = 4 * i + (lane >> 4);
        const f32x4 v = *(const f32x4*)(src + (size_t)(k0 + kk) * ldn + n0 + 4 * (lane & 15));
        LAS float* p = scr + kk * 65 + 4 * (lane & 15); p[0] = v.x; p[1] = v.y; p[2] = v.z; p[3] = v.w; }
    LDS_WAIT(); asm volatile("" ::: "memory");
    const int c = lane & 7;
#pragma unroll
    for (int jj = 0; jj < 8; ++jj) { const int n = (lane >> 3) + 8 * jj; const LAS float* s = scr + (8 * c) * 65 + n;
        v4u o; o.x = pk2(s[0], s[65]); o.y = pk2(s[130], s[195]); o.z = pk2(s[260], s[325]); o.w = pk2(s[390], s[455]);
        *(v4u*)(dst + (size_t)(drow0 + n) * ldk + k0 + 8 * c) = o; }
    LDS_WAIT(); asm volatile("" ::: "memory");
}
constexpr int CW_CONVQ = 2112, CW_DONE = 2176;
constexpr int I_E = 256 * NE, CONV_PER_WAVE = 2, N_CONV_BI = 3 * I_E / (NWAVES * CONV_PER_WAVE);
struct ConvTile { const float* src; bf16* dst; int ldn, ldk; };
__device__ __forceinline__ ConvTile conv_decode(Frame& F, int r) {
    ConvTile t;
    if (r < 2 * I_E) { const int which = r / I_E, rr = r % I_E, e = rr >> 8, q = rr & 255, kt = q >> 3, nt = q & 7;
        t.src = (which == 0 ? F.in[19] : F.in[20]) + (size_t)e * DM * DE + (size_t)(64 * kt) * DE + 64 * nt; t.ldn = DE;
        t.dst = (bf16*)(F.ws + WS_W13) + (size_t)(e * 1024 + (nt >> 1) * 256 + which * 128 + (nt & 1) * 64) * DM + 64 * kt; t.ldk = DM; return t; }
    r -= 2 * I_E;
    { const int e = r >> 8, q = r & 255, kt = q >> 5, nt = q & 31;
      t.src = F.in[21] + (size_t)e * DE * DM + (size_t)(64 * kt) * DM + 64 * nt; t.ldn = DM;
      t.dst = (bf16*)(F.ws + WS_W2) + (size_t)(e * 2048 + 64 * nt) * DE + 64 * kt; t.ldk = DE; }
    return t;
}
__device__ __forceinline__ void conv_load(const ConvTile& t, f32x4 (&v)[16], int lane) {
#pragma unroll
    for (int i = 0; i < 16; ++i) v[i] = *(const f32x4*)(t.src + (size_t)(4 * i + (lane >> 4)) * t.ldn + 4 * (lane & 15));
}
__device__ __forceinline__ void conv_store(const ConvTile& t, const f32x4 (&v)[16], LAS float* scr, int lane) {
#pragma unroll
    for (int i = 0; i < 16; ++i) { LAS float* p = scr + (4 * i + (lane >> 4)) * 65 + 4 * (lane & 15); p[0] = v[i].x; p[1] = v[i].y; p[2] = v[i].z; p[3] = v[i].w; }
    LDS_WAIT(); asm volatile("" ::: "memory");
    const int c = lane & 7;
#pragma unroll
    for (int jj = 0; jj < 8; ++jj) { const int n = (lane >> 3) + 8 * jj; const LAS float* s = scr + (8 * c) * 65 + n;
        v4u o; o.x = pk2(s[0], s[65]); o.y = pk2(s[130], s[195]); o.z = pk2(s[260], s[325]); o.w = pk2(s[390], s[455]);
        *(v4u*)(t.dst + (size_t)n * t.ldk + 8 * c) = o; }
    LDS_WAIT(); asm volatile("" ::: "memory");
}
__device__ __forceinline__ void filler(Frame& F, int ph, int mode, unsigned nfin, unsigned early) {
    __syncthreads();
    LAS float* scr = (LAS float*)(F.lds) + F.wave * (64 * 65);
    unsigned nxt = 0xffffffffu;
    if (F.tid == 0) { bool go = true;
        if (mode == 0) go = __hip_atomic_fetch_add(F.ctl + CW_DONE + 64 * ph, 1u, RLX_AGENT) < early;
        if (mode == 1) go = __hip_atomic_load(F.ctl + CW_DONE + 64 * ph, RLX_AGENT) < nfin;
        if (go) nxt = __hip_atomic_fetch_add(F.ctl + CW_CONVQ, 1u, RLX_AGENT); }
    for (;;) {
        if (F.tid == 0) F.MISC[1] = nxt;
        __syncthreads();
        const unsigned it = F.MISC[1];
        __syncthreads();
        if (it >= (unsigned)N_CONV_BI) break;
        if (F.tid == 0) { const bool stop = mode != 2 && __hip_atomic_load(F.ctl + CW_DONE + 64 * ph, RLX_AGENT) >= nfin;
            nxt = stop ? 0xffffffffu : __hip_atomic_fetch_add(F.ctl + CW_CONVQ, 1u, RLX_AGENT); }
        const int r0 = ((int)it * NWAVES + F.wave) * CONV_PER_WAVE;
        const ConvTile t0 = conv_decode(F, r0), t1 = conv_decode(F, r0 + 1);
        f32x4 va[16], vb[16];
        conv_load(t0, va, F.lane); conv_load(t1, vb, F.lane);
        conv_store(t0, va, scr, F.lane); conv_store(t1, vb, scr, F.lane);
    }
}
template <bool EXPERTS>
__device__ __forceinline__ void p0_prologue(Frame& F) {
    p0_mod(F);
    __syncthreads();
    LAS float* scr = (LAS float*)(F.lds) + F.wave * (64 * 65);
    bf16* WinT = (bf16*)(F.ws + WS_WIN); bf16* WoutT = (bf16*)(F.ws + WS_WOUT);
    constexpr int I_IN = 32 * 112, I_OUT = 32 * 32;
    constexpr int NIT = I_IN + I_OUT;
    for (int it = F.gw; it < NIT; it += F.NGW) {
        int r = it;
        if (r < I_IN) { tr_tile(F.in[6], INC, 64 * (r / 112), 64 * (r % 112), WinT, DM, 64 * (r % 112), scr, F.lane); continue; } r -= I_IN;
        if (r < I_OUT) { tr_tile(F.in[12], DM, 64 * (r / 32), 64 * (r % 32), WoutT, DM, 64 * (r % 32), scr, F.lane); continue; } r -= I_OUT;
    }
    { bf16* rh = (bf16*)(F.ws + WS_RWP); bf16* rl = rh + 48 * DM; const float* rcw = F.in[15]; const float* rfw = F.in[17];
      for (int idx = blockIdx.x * (NWAVES * 64) + F.tid; idx < 48 * DM; idx += F.G * NWAVES * 64) {
          const int o = idx >> 11, k = idx & 2047; const float v = o < 4 ? rcw[k * 4 + o] : (o < 36 ? rfw[k * 32 + (o - 4)] : 0.f);
          const unsigned h = f2bf(v); const float hf = __uint_as_float(h << 16);
          rh[idx] = (bf16)h; rl[idx] = (bf16)f2bf(v - hf); } }
    { float* cs = (float*)(F.ws + WS_CS);
      for (int idx = blockIdx.x * (NWAVES * 64) + F.tid; idx < SEQ * 64; idx += F.G * NWAVES * 64) {
          const int i = idx & 63, s = idx >> 6; const float inv_freq = powf(10000.f, -(float)(2 * i) / 128.f); const float ang = (float)s * inv_freq;
          cs[2 * idx] = cosf(ang); cs[2 * idx + 1] = sinf(ang); } }
}

__device__ __forceinline__ void p1_prenorm(Frame& F) {
    const float* x = F.in[0]; const float* wpre = F.in[4]; const float* w_in = F.in[6]; const float* fbias = F.in[7];
    const float* mod = (const float*)(F.ws + WS_MOD);
    bf16* Hb = (bf16*)(F.ws + WS_HB); float* logf = (float*)(F.ws + WS_LOGF); float* zb = (float*)(F.ws + WS_Z);
    LAS f32x4* wf = (LAS f32x4*)F.lds;
    for (int idx = F.tid; idx < 4096; idx += NWAVES * 64) { const int l = idx & 63, half = (idx >> 6) & 1, i = (idx >> 7) & 3, j = idx >> 9;
        wf[idx] = *(const f32x4*)(w_in + (size_t)(256 * j + 4 * l + i) * INC + INCM + 4 * half); }
    __syncthreads();
    for (int row = F.gw; row < T; row += F.NGW) {
        const int b = row >> 12, s = row & 4095;
        const f32x4* xr = (const f32x4*)(x + (size_t)row * DM) + F.lane;
        f32x4 v[8]; float ss = 0.f;
#pragma unroll
        for (int j = 0; j < 8; ++j) { v[j] = xr[64 * j]; ss += (v[j].x * v[j].x + v[j].y * v[j].y) + (v[j].z * v[j].z + v[j].w * v[j].w); }
        const float rstd = rsqrtf(wave_sum(ss) * (1.f / DM) + EPS);
        const f32x4* w4 = (const f32x4*)wpre + F.lane; const f32x4* sh4 = (const f32x4*)(mod + (size_t)b * 6 * DM) + F.lane; const f32x4* sc4 = (const f32x4*)(mod + (size_t)b * 6 * DM + DM) + F.lane;
        float acc[8];
#pragma unroll
        for (int o = 0; o < 8; ++o) acc[o] = 0.f;
        unsigned long long* o8 = (unsigned long long*)(Hb + (size_t)row * DM) + F.lane;
#pragma unroll
        for (int j = 0; j < 8; ++j) {
            const f32x4 h = v[j] * rstd * w4[64 * j] * (sc4[64 * j] + 1.0f) + sh4[64 * j];
            o8[64 * j] = (unsigned long long)pk2(h.x, h.y) | ((unsigned long long)pk2(h.z, h.w) << 32);
#pragma unroll
            for (int i = 0; i < 4; ++i) { const f32x4 wa = wf[((j * 4 + i) * 2 + 0) * 64 + F.lane], wb = wf[((j * 4 + i) * 2 + 1) * 64 + F.lane]; const float hv = h[i];
                acc[0] = fmaf(hv, wa.x, acc[0]); acc[1] = fmaf(hv, wa.y, acc[1]); acc[2] = fmaf(hv, wa.z, acc[2]); acc[3] = fmaf(hv, wa.w, acc[3]);
                acc[4] = fmaf(hv, wb.x, acc[4]); acc[5] = fmaf(hv, wb.y, acc[5]); acc[6] = fmaf(hv, wb.z, acc[6]); acc[7] = fmaf(hv, wb.w, acc[7]); }
            asm volatile("" ::: "memory");
        }
        float z = 0.f;
#pragma unroll
        for (int o = 0; o < 8; ++o) { const float t = wave_sum(acc[o]); z = (F.lane == o) ? t : z; }
        if (F.lane < 8) { const float zz = z + fbias[F.lane];
            logf[((size_t)b * NH + F.lane) * SEQ + s] = fminf(zz, 0.f) - log1pf(expf(-fabsf(zz)));
            zb[(size_t)row * 8 + F.lane] = z; }
    }
}

struct EpiHeads {
    static constexpr bool PERM = true, AFTER_DRAIN = false;
    bf16* base;
    __device__ __forceinline__ void operator()(const pg8::f32x4 (&acc)[2][2][4][2], const pg8::Unit& u, int wr, int wc, int fr, int fq) const {
        const int type = u.pn >> 2, head0 = (u.pn & 3) * 2; const int row0 = u.pm * 256 + wr * 64 + fr;
#pragma unroll
        for (int ai = 0; ai < 2; ++ai)
#pragma unroll
            for (int m = 0; m < 4; ++m) { const int r = row0 + ai * 128 + m * 16, b = r >> 12, s = r & 4095;
#pragma unroll
                for (int bj = 0; bj < 2; ++bj) { const pg8::f32x4 v0 = acc[ai][bj][m][0], v1 = acc[ai][bj][m][1];
                    pg8::u32x4 w; w.x = pg8::cvt_pk_bf16(v0[0], v0[1]); w.y = pg8::cvt_pk_bf16(v0[2], v0[3]); w.z = pg8::cvt_pk_bf16(v1[0], v1[1]); w.w = pg8::cvt_pk_bf16(v1[2], v1[3]);
                    *(pg8::u32x4*)(base + (size_t)type * TSZ + ((size_t)((b * 8 + head0 + bj) * SEQ + s)) * HD + wc * 32 + 8 * fq) = w; } }
    }
};

namespace fox {
__device__ __forceinline__ int fox_tid() { int t = threadIdx.x; asm volatile("" : "+v"(t)); return t; }
typedef unsigned short bf16;
constexpr int D = 128, OLD = 2048;
constexpr bool WSKIP = false; constexpr float THR = 8.f;
constexpr float SCALE = 0.08838834764831845f;
constexpr int NW = 8, QBLK = 32, KVBLK = 64, QB = NW * QBLK;
constexpr int SHM_V = KVBLK * D * 2, SHM_K = KVBLK * D * 2;
constexpr int LDS_BYTES = 2 * SHM_V + 2 * SHM_K + NW * 64 * 4 + 2 * 64 * 4;
typedef short bf16x8 __attribute__((ext_vector_type(8)));
typedef short s16x4 __attribute__((ext_vector_type(4)));
typedef float f32x16 __attribute__((ext_vector_type(16)));
typedef float f32x4 __attribute__((ext_vector_type(4)));
typedef unsigned u32x4 __attribute__((ext_vector_type(4)));
template <class A, class Bt> struct same_t { static constexpr bool v = false; };
template <class A> struct same_t<A, A> { static constexpr bool v = true; };

#define KSWZ(row, colB) ((row) * 256 + ((colB) ^ (((row) & 7) << 4)))
#define SBAR() __builtin_amdgcn_sched_barrier(0)
__device__ __forceinline__ int v_st(int k, int c) { const int kk = (k & ~0xC) | ((k & 4) << 1) | ((k & 8) >> 1); return ((kk >> 3) * 4 + (c >> 5)) * 512 + ((kk & 7) * 32 + (c & 31)) * 2; }
__device__ __forceinline__ int v_rd_base(int lane) { return ((lane & 3) << 3) | (((lane >> 2) & 3) << 6) | (((lane >> 4) & 1) << 5) | (((lane >> 5) & 1) << 8); }
constexpr int v_rd_off(int d0, int ks, int half) { return d0 * 512 + ks * 4096 + half * 2048; }
__device__ __forceinline__ int crow(int r, int hi) { return (r & 3) + 8 * (r >> 2) + 4 * hi; }
__device__ __forceinline__ unsigned cvtpk(float lo, float hi) {
    unsigned r; asm volatile("v_cvt_pk_bf16_f32 %0, %1, %2" : "=v"(r) : "v"(lo), "v"(hi)); return r;
}
__device__ __forceinline__ bf16x8 pack8(f32x4 a, f32x4 b) {
    u32x4 w = {cvtpk(a[0], a[1]), cvtpk(a[2], a[3]), cvtpk(b[0], b[1]), cvtpk(b[2], b[3])};
    return *reinterpret_cast<bf16x8*>(&w);
}
template <class T> __device__ __forceinline__ bf16x8 load8(const T* p) {
    if constexpr (same_t<T, float>::v) { return pack8(*(const f32x4*)p, *(const f32x4*)(p + 4)); }
    else { return *reinterpret_cast<const bf16x8*>(p); }
}
__device__ __forceinline__ void mask_tile(f32x16& p0, f32x16& p1, int dq, unsigned W) {
    const float NEG = -__builtin_inff();
#pragma unroll
    for (int r = 0; r < 16; ++r) {
        const int c = (r & 3) + 8 * (r >> 2);
        if ((unsigned)(dq - c) >= W) p0[r] = NEG;
        if ((unsigned)(dq - c - 32) >= W) p1[r] = NEG;
    }
}
__device__ __forceinline__ void partialSM(f32x16& p0, f32x16& p1, float& m_reg, float& mn, float& alpha) {
    float pmax = p0[0]; for (int r = 1; r < 16; ++r) pmax = fmaxf(pmax, p0[r]); for (int r = 0; r < 16; ++r) pmax = fmaxf(pmax, p1[r]);
    { auto rr = __builtin_amdgcn_permlane32_swap(__float_as_uint(pmax), __float_as_uint(pmax), false, false);
      pmax = fmaxf(__uint_as_float(rr[0]), __uint_as_float(rr[1])); }
    constexpr float C2 = 1.4426950408889634f * SCALE;
    if (__builtin_expect(__all((pmax - m_reg) * SCALE <= THR), 1)) { mn = m_reg; alpha = 1.f; }
    else { mn = fmaxf(m_reg, pmax); alpha = __builtin_amdgcn_exp2f((m_reg - mn) * C2); m_reg = mn; }
    const float mnL = -mn * C2;
    for (int r = 0; r < 16; ++r) p0[r] = fmaf(p0[r], C2, mnL); for (int r = 0; r < 16; ++r) p1[r] = fmaf(p1[r], C2, mnL);
    for (int r = 0; r < 16; ++r) p0[r] = __builtin_amdgcn_exp2f(p0[r]);
}
__device__ __forceinline__ void finishSM(f32x16& p0, f32x16& p1, float alpha, float& l_reg, bf16x8& pa0, bf16x8& pa1, bf16x8& pa2, bf16x8& pa3) {
    for (int r = 0; r < 16; ++r) p1[r] = __builtin_amdgcn_exp2f(p1[r]);
    float ps = 0; for (int r = 0; r < 16; ++r) ps += p0[r]; for (int r = 0; r < 16; ++r) ps += p1[r];
    { auto rr = __builtin_amdgcn_permlane32_swap(__float_as_uint(ps), __float_as_uint(ps), false, false);
      ps = __uint_as_float(rr[0]) + __uint_as_float(rr[1]); }
    l_reg = l_reg * alpha + ps;
#define PK4(P, B_, OUT) do { unsigned a0 = cvtpk(P[B_+0], P[B_+1]), a1 = cvtpk(P[B_+2], P[B_+3]);                          \
        unsigned b0 = cvtpk(P[B_+4], P[B_+5]), b1 = cvtpk(P[B_+6], P[B_+7]);                                             \
        auto r0 = __builtin_amdgcn_permlane32_swap(a0, b0, false, false); auto r1 = __builtin_amdgcn_permlane32_swap(a1, b1, false, false); \
        u32x4 w = {r0[0], r1[0], r0[1], r1[1]}; OUT = *reinterpret_cast<bf16x8*>(&w); } while (0)
    PK4(p0, 0, pa0); PK4(p0, 8, pa1); PK4(p1, 0, pa2); PK4(p1, 8, pa3);
#undef PK4
}
template <int KB, bool SK>
__device__ __forceinline__ void qkt(f32x16& p0, f32x16& p1, const char* K_lds, int r32, int hi, const bf16x8* qr, bool act) {
    if (SK && !act) { const float NEG = -__builtin_inff();
#pragma unroll
        for (int r = 0; r < 16; ++r) { p0[r] = NEG; p1[r] = NEG; } return; }
    { const float* bl = (const float*)(K_lds + 2 * SHM_K + NW * 64 * 4) + KB * 64 + 4 * hi;
#pragma unroll
      for (int g = 0; g < 4; ++g) { const f32x4 b0 = *(const f32x4*)(bl + 8 * g), b1 = *(const f32x4*)(bl + 32 + 8 * g);
          p0[4 * g] = b0[0]; p0[4 * g + 1] = b0[1]; p0[4 * g + 2] = b0[2]; p0[4 * g + 3] = b0[3]; p1[4 * g] = b1[0]; p1[4 * g + 1] = b1[1]; p1[4 * g + 2] = b1[2]; p1[4 * g + 3] = b1[3]; } }
    const char* kb[4];
#pragma unroll
    for (int dd = 0; dd < 4; ++dd) kb[dd] = K_lds + KB * SHM_K + KSWZ(r32, (dd * 16 + hi * 8) * 2);
#pragma unroll
    for (int d0 = 0; d0 < 8; ++d0) { const char* a = kb[d0 & 3] + (d0 >> 2) * 128;
        bf16x8 b0 = *reinterpret_cast<const bf16x8*>(a);
        bf16x8 b1 = *reinterpret_cast<const bf16x8*>(a + 32 * 256);
        p0 = __builtin_amdgcn_mfma_f32_32x32x16_bf16(b0, qr[d0], p0, 0, 0, 0);
        p1 = __builtin_amdgcn_mfma_f32_32x32x16_bf16(b1, qr[d0], p1, 0, 0, 0); }
}
template <int VB, bool SK>
__device__ __forceinline__ void pv_tile(f32x16* o, int vb0, bf16x8 pa0, bf16x8 pa1, bf16x8 pa2, bf16x8 pa3, bool act) {
    if (SK && !act) return;
#define TRRD(dst, off) asm volatile("ds_read_b64_tr_b16 %0, %1 offset:%2" : "=&v"(dst) : "v"(vb0), "i"(off) : "memory")
#define PV_D0(d0) do { s16x4 l0, l1, l2, l3, h0, h1, h2, h3; constexpr int b_ = VB * SHM_V + v_rd_off(d0, 0, 0);     \
        TRRD(l0, b_); TRRD(h0, b_ + 2048); TRRD(l1, b_ + 4096); TRRD(h1, b_ + 6144); TRRD(l2, b_ + 8192); TRRD(h2, b_ + 10240); TRRD(l3, b_ + 12288); TRRD(h3, b_ + 14336); \
        asm volatile("s_waitcnt lgkmcnt(0)" ::: "memory"); SBAR();                 \
        o[d0] = __builtin_amdgcn_mfma_f32_32x32x16_bf16(pa0, (bf16x8){l0[0], l0[1], l0[2], l0[3], h0[0], h0[1], h0[2], h0[3]}, o[d0], 0, 0, 0);   \
        o[d0] = __builtin_amdgcn_mfma_f32_32x32x16_bf16(pa1, (bf16x8){l1[0], l1[1], l1[2], l1[3], h1[0], h1[1], h1[2], h1[3]}, o[d0], 0, 0, 0);   \
        o[d0] = __builtin_amdgcn_mfma_f32_32x32x16_bf16(pa2, (bf16x8){l2[0], l2[1], l2[2], l2[3], h2[0], h2[1], h2[2], h2[3]}, o[d0], 0, 0, 0);   \
        o[d0] = __builtin_amdgcn_mfma_f32_32x32x16_bf16(pa3, (bf16x8){l3[0], l3[1], l3[2], l3[3], h3[0], h3[1], h3[2], h3[3]}, o[d0], 0, 0, 0); } while (0)
    PV_D0(0); PV_D0(1); PV_D0(2); PV_D0(3);
#undef PV_D0
#undef TRRD
}

template <class TIn, class TOut> struct BlockRef { const TIn* Q; const TIn* K; const TIn* V; TOut* O; const float* cb; const float* onw; int P0; };
template <class TIn> struct Seam {
    bf16x8 qr[8];
    bf16x8 st_v0, st_v1, st_k0, st_k1; float st_b; f32x4 sf0, sf1, sf2, sf3;
    f32x4 tq[16];
};
__device__ __forceinline__ int swa_jlo(int P0, int W) { const int lowk = P0 - W + 1; return lowk > 0 ? lowk / KVBLK : 0; }
#define ROW(p, k0, rr) ((p) + (size_t)((k0) + (rr)) * D + sc)
#define VMW() asm volatile("s_waitcnt vmcnt(0)" ::: "memory")
#define VMWN(n) asm volatile("s_waitcnt vmcnt(%0)" :: "i"(n) : "memory")
#define SLOAD_H(Kp, Vp, Bp, k0) do { S.st_v0 = load8<TIn>(ROW(Vp, k0, sr)); S.st_v1 = load8<TIn>(ROW(Vp, k0, 32 + sr));              \
                         S.st_k0 = load8<TIn>(ROW(Kp, k0, sr)); S.st_k1 = load8<TIn>(ROW(Kp, k0, 32 + sr)); S.st_b = (Bp)[(k0) + (tid & 63)]; } while (0)
#define SWRITE_HK(bf) do { *(bf16x8*)(K_lds + (bf) * SHM_K + kws) = S.st_k0; *(bf16x8*)(K_lds + (bf) * SHM_K + kws + 32 * 256) = S.st_k1; \
                           if (tid < 64) ((float*)(K_lds + 2 * SHM_K + NW * 64 * 4))[(bf) * 64 + tid] = S.st_b; } while (0)
#define SWRITE_HV(bf) do { *(bf16x8*)(V_lds + (bf) * SHM_V + vst0) = S.st_v0; *(bf16x8*)(V_lds + (bf) * SHM_V + vst1) = S.st_v1; } while (0)
#define SWRITE_H(bf) do { SWRITE_HV(bf); SWRITE_HK(bf); } while (0)
#define SLOAD_F(p, k0) do { S.sf0 = *(const f32x4*)ROW(p, k0, sr); S.sf1 = *(const f32x4*)(ROW(p, k0, sr) + 4);                \
                            S.sf2 = *(const f32x4*)ROW(p, k0, 32 + sr); S.sf3 = *(const f32x4*)(ROW(p, k0, 32 + sr) + 4); } while (0)
#define SWRITE_KF(bf) do { *(bf16x8*)(K_lds + (bf) * SHM_K + kws) = pack8(S.sf0, S.sf1); *(bf16x8*)(K_lds + (bf) * SHM_K + kws + 32 * 256) = pack8(S.sf2, S.sf3); } while (0)
#define SWRITE_VF(bf) do { *(bf16x8*)(V_lds + (bf) * SHM_V + vst0) = pack8(S.sf0, S.sf1); *(bf16x8*)(V_lds + (bf) * SHM_V + vst1) = pack8(S.sf2, S.sf3); } while (0)
template <class TIn, class TOut>
__device__ __forceinline__ void causal_swa_prime(const BlockRef<TIn, TOut>& cur, int W, char* lds, Seam<TIn>& S) {
    constexpr bool F32 = same_t<TIn, float>::v;
    const int tid = fox_tid(), wid = __builtin_amdgcn_readfirstlane(tid >> 6), lane = tid & 63, r32 = lane & 31, hi = lane >> 5;
    const int sr = tid >> 4, sc = (tid & 15) * 8, kws = KSWZ(sr, sc * 2); char* K_lds = lds + 2 * SHM_V;
    const int kb0 = swa_jlo(cur.P0, W) * KVBLK;
    for (int d0 = 0; d0 < 8; ++d0) S.qr[d0] = load8<TIn>(cur.Q + (size_t)(wid * QBLK + r32) * D + d0 * 16 + hi * 8);
    if constexpr (F32) { SLOAD_F((const float*)cur.K, kb0); VMW(); SWRITE_KF(0); SBAR(); SLOAD_F((const float*)cur.V, kb0); }
    else { SLOAD_H(cur.K, cur.V, cur.cb, kb0); VMW(); SWRITE_HK(0); }
    __syncthreads();
}
template <class TIn, class TOut>
__device__ __forceinline__ void causal_swa_block(const BlockRef<TIn, TOut>& cur, const BlockRef<TIn, TOut>& nxt, int skv, int W, char* lds, Seam<TIn>& S) {
    constexpr bool F32 = same_t<TIn, float>::v;
    const int tid = fox_tid(), wid = __builtin_amdgcn_readfirstlane(tid >> 6), lane = tid & 63, r32 = lane & 31, hi = lane >> 5;
    const int j_lo = swa_jlo(cur.P0, W);
    int j_hi = (cur.P0 + QB - 1) / KVBLK + 1; if (j_hi > skv / KVBLK) j_hi = skv / KVBLK;
    const int NT = j_hi - j_lo;
    const int kbn = swa_jlo(nxt.P0, W) * KVBLK;
    const int qlo = cur.P0 + wid * QBLK, qm = qlo + r32 - 4 * hi;
    char* V_lds = lds; char* K_lds = lds + 2 * SHM_V;
    float* ws = (float*)(lds + 2 * SHM_V + 2 * SHM_K) + wid * 64; float* li_l = ws, * al_l = ws + 32;
    float m_reg = -1e30f, l_reg = 0; f32x16 o[4] = {};
    const int sr = tid >> 4, sc = (tid & 15) * 8, vst0 = v_st(sr, sc), vst1 = v_st(32 + sr, sc), kws = KSWZ(sr, sc * 2);
    const int vb0 = (int)(uintptr_t)V_lds + v_rd_base(lane);
    const TIn* Kh = cur.K; const TIn* Vh = cur.V;
#define RESC(a) do { if (__any((a) < 1.f)) { if (hi == 0) al_l[r32] = (a); asm volatile("s_waitcnt lgkmcnt(0)" ::: "memory");              \
                     for (int d_ = 0; d_ < 4; ++d_) for (int r = 0; r < 16; ++r) o[d_][r] *= al_l[crow(r, hi)]; } } while (0)
#define KBASE(t) ((j_lo + (t)) * KVBLK)
#define ACT(t) (KBASE(t) <= qlo + QBLK - 1 && KBASE(t) + KVBLK - 1 >= qlo - W + 1)
#define MASKT(P0_, P1_, t) do { const int kb_ = KBASE(t); if ((!SK || ACT(t)) && (kb_ + KVBLK - 1 > qlo || kb_ <= qlo + QBLK - 1 - W)) mask_tile(P0_, P1_, qm - kb_, (unsigned)W); } while (0)
    constexpr int NQL = F32 ? 16 : 8;
    constexpr bool SK = WSKIP && !F32;
#define SEAM_K0() do { VMWN(NQL); if constexpr (F32) { SWRITE_KF(0); SBAR(); SLOAD_F((const float*)nxt.V, kbn); } else { SWRITE_HK(0); } SBAR(); } while (0)
    f32x16 pA0, pA1, pB0, pB1; float mnA, mnB, alA, alB; bf16x8 pa0, pa1, pa2, pa3;
    if constexpr (F32) { VMW(); SWRITE_VF(0); SBAR(); } else { SWRITE_HV(0); SBAR(); }
    if (NT > 1) { if constexpr (F32) SLOAD_F((const float*)Kh, KBASE(1)); else SLOAD_H(Kh, Vh, cur.cb, KBASE(1)); }
    SBAR(); qkt<0, SK>(pA0, pA1, K_lds, r32, hi, S.qr, ACT(0));
    if constexpr (F32) { if (NT > 1) { VMW(); SWRITE_KF(1); SBAR(); SLOAD_F((const float*)Vh, KBASE(1)); } }
    MASKT(pA0, pA1, 0); partialSM(pA0, pA1, m_reg, mnA, alA);
    if (NT > 1) { VMW(); if constexpr (F32) { SWRITE_VF(1); SBAR(); if (NT > 2) SLOAD_F((const float*)Kh, KBASE(2)); } else SWRITE_H(1); }
    __syncthreads();
#define HALF_STEP(PX0, PX1, mnX, alX, PY0, PY1, alY, t, KB, VB, SB) do {                                                      \
        SBAR(); qkt<KB, SK>(PX0, PX1, K_lds, r32, hi, S.qr, ACT(t));                                             \
        finishSM(PY0, PY1, alY, l_reg, pa0, pa1, pa2, pa3); SBAR();                                                           \
        if ((t) + 1 < NT) { if constexpr (F32) { VMW(); SWRITE_KF(SB); SBAR(); SLOAD_F((const float*)Vh, KBASE((t) + 1)); }  \
                            else { SLOAD_H(Kh, Vh, cur.cb, KBASE((t) + 1)); } SBAR(); }                                               \
        pv_tile<VB, SK>(o, vb0, pa0, pa1, pa2, pa3, ACT((t) - 1)); MASKT(PX0, PX1, (t)); partialSM(PX0, PX1, m_reg, mnX, alX);                                        \
        __syncthreads();                                                                                                      \
        if ((t) + 1 < NT) { VMW(); if constexpr (F32) { SWRITE_VF(SB); SBAR(); if ((t) + 2 < NT) SLOAD_F((const float*)Kh, KBASE((t) + 2)); } \
                            else { SWRITE_H(SB); } }                                                                          \
        RESC(alX); __syncthreads(); } while (0)
    for (int t = 1; t + 1 < NT; t += 2) {
        HALF_STEP(pB0, pB1, mnB, alB, pA0, pA1, alA, t, 1, 0, 0);
        HALF_STEP(pA0, pA1, mnA, alA, pB0, pB1, alB, t + 1, 0, 1, 1);
    }
    const bool even = (NT & 1) == 0;
    if (even) { SBAR(); qkt<1, SK>(pB0, pB1, K_lds, r32, hi, S.qr, ACT(NT - 1)); SBAR(); }
#define QROW(e) (nxt.Q + (size_t)(wid * QBLK + r32) * D + ((e) >> 1) * 16 + hi * 8 + ((e) & 1) * 4)
    if constexpr (F32) { SLOAD_F((const float*)nxt.K, kbn); SBAR();
#pragma unroll
        for (int e = 0; e < 8; ++e) S.tq[e] = *(const f32x4*)QROW(e); }
    else { SLOAD_H(nxt.K, nxt.V, nxt.cb, kbn); SBAR();
#pragma unroll
        for (int d0 = 0; d0 < 8; ++d0) S.qr[d0] = load8<TIn>(nxt.Q + (size_t)(wid * QBLK + r32) * D + d0 * 16 + hi * 8); }
    SBAR();
    finishSM(pA0, pA1, alA, l_reg, pa0, pa1, pa2, pa3); SBAR();
    if constexpr (F32) {
#pragma unroll
        for (int e = 8; e < 16; ++e) S.tq[e] = *(const f32x4*)QROW(e); SBAR(); }
#undef QROW
    pv_tile<0, SK>(o, vb0, pa0, pa1, pa2, pa3, ACT(even ? NT - 2 : NT - 1));
    if (even) { MASKT(pB0, pB1, NT - 1); partialSM(pB0, pB1, m_reg, mnB, alB); __syncthreads(); RESC(alB);
        finishSM(pB0, pB1, alB, l_reg, pa0, pa1, pa2, pa3); SBAR(); pv_tile<1, SK>(o, vb0, pa0, pa1, pa2, pa3, ACT(NT - 1)); }
    SBAR(); SEAM_K0();
    if (hi == 0) li_l[r32] = l_reg; asm volatile("s_waitcnt lgkmcnt(0)" ::: "memory");
    { float gw[4];
#pragma unroll
      for (int d0 = 0; d0 < 4; ++d0) gw[d0] = cur.onw[d0 * 32 + r32];
      TOut* Ow = cur.O + (size_t)(wid * QBLK) * OLD;
#pragma unroll
      for (int r = 0; r < 16; ++r) { const int orow = crow(r, hi); const float rl = __builtin_amdgcn_rcpf(li_l[orow]);
          float v[4]; float ss = 0.f;
#pragma unroll
          for (int d0 = 0; d0 < 4; ++d0) { v[d0] = o[d0][r] * rl; ss += v[d0] * v[d0]; }
          ss = half32_sum(ss);
          const float rs = rsqrtf(ss * (1.f / 128.f) + 1e-6f);
#pragma unroll
          for (int d0 = 0; d0 < 4; ++d0) { const float y = v[d0] * rs * gw[d0]; const float yn = __shfl_xor(y, 1);
              if ((r32 & 1) == 0) *(unsigned*)(Ow + (size_t)orow * OLD + d0 * 32 + r32) = cvtpk(y, yn); } } }
    if constexpr (F32) {
#pragma unroll
        for (int d0 = 0; d0 < 8; ++d0) S.qr[d0] = pack8(S.tq[2 * d0], S.tq[2 * d0 + 1]); }
    __syncthreads();
#undef RESC
#undef KBASE
#undef ACT
#undef MASKT
#undef SEAM_K0
#undef HALF_STEP
}
#undef ROW
#undef VMW
#undef VMWN
#undef SLOAD_H
#undef SWRITE_HK
#undef SWRITE_HV
#undef SWRITE_H
#undef SLOAD_F
#undef SWRITE_KF
#undef SWRITE_VF


#undef KSWZ
#undef SBAR
}
constexpr size_t WS_KV = 186 * MiB;
constexpr size_t WS_SP = 218 * MiB;
constexpr size_t WS_CAT = 234 * MiB;
constexpr size_t WS_P34_END = 266 * MiB;
constexpr int CW_RETQ = 2048;
typedef short v4i16_t __attribute__((ext_vector_type(4)));
typedef float f32x16 __attribute__((ext_vector_type(16)));
constexpr int TLD = 136;
constexpr int TILE_EL = 128 * TLD;

__device__ __forceinline__ bf16x8 frag_row(const LAS bf16* X, int r0, int k0, int lane) {
    return *(const LAS bf16x8*)(X + (r0 + (lane & 31)) * TLD + k0 + 8 * (lane >> 5));
}
__device__ __forceinline__ bf16x8 frag_tr(const LAS bf16* X, int k0, int c0, int lane) {
    const int g = lane >> 4, i = lane & 15, q = i >> 2, p = i & 3, h = g >> 1;
    const LAS bf16* a = X + (k0 + 8 * h + q) * TLD + c0 + 16 * (g & 1) + 4 * p;
    const v4i16_t lo = __builtin_amdgcn_ds_read_tr16_b64_v4i16((LAS v4i16_t*)a);
    const v4i16_t hi = __builtin_amdgcn_ds_read_tr16_b64_v4i16((LAS v4i16_t*)(a + 4 * TLD));
    return (bf16x8){lo[0], lo[1], lo[2], lo[3], hi[0], hi[1], hi[2], hi[3]};
}
__device__ __forceinline__ int crow16(int r, int hi) { return (r & 3) + 8 * (r >> 2) + 4 * hi; }
__device__ __forceinline__ float bf2f(unsigned short v) { return __uint_as_float((unsigned)v << 16); }
__device__ __forceinline__ float ret_lg2(int h) { return log1pf(-exp2f(-5.f - (float)h)) * 1.4426950408889634f; }

__device__ __forceinline__ void p3_item(Frame& F, int bh, int n) {
    const int h = bh & 7, tid = F.tid, lane = F.lane, w = F.wave;
    bf16* qkv = (bf16*)(F.ws + WS_QKV);
    const size_t rbase = ((size_t)bh * SEQ + (size_t)n * 128) * HD;
    bf16* RQ = qkv + 0 * TSZ + rbase; bf16* RK = qkv + 1 * TSZ + rbase; const bf16* RV = qkv + 2 * TSZ + rbase; bf16* RG = qkv + 3 * TSZ + rbase;
    bf16* FQ = qkv + 4 * TSZ + rbase; bf16* FK = qkv + 5 * TSZ + rbase;
    LAS bf16* Kz = (LAS bf16*)F.lds; LAS bf16* Vt = Kz + TILE_EL;
    const float lg2 = ret_lg2(h);
    { const int row = tid >> 2, c16 = (tid & 3) * 16, s = n * 128 + row;
      const float* cs = (const float*)(F.ws + WS_CS) + ((size_t)s * 64 + c16) * 2;
      float cv[16], sv[16];
#pragma unroll
      for (int i = 0; i < 16; i += 2) { const f32x4 t = *(const f32x4*)(cs + 2 * i); cv[i] = t[0]; sv[i] = t[1]; cv[i + 1] = t[2]; sv[i + 1] = t[3]; }
      const float zeta = exp2f(lg2 * (float)(127 - row));
#pragma unroll
      for (int which = 0; which < 2; ++which) {
          bf16* P = (which == 0 ? RQ : RK) + (size_t)row * HD + c16;
          const bf16x8 a0 = *(const bf16x8*)P, a1 = *(const bf16x8*)(P + 8), b0 = *(const bf16x8*)(P + 64), b1 = *(const bf16x8*)(P + 72);
          float o1[16], o2[16];
#pragma unroll
          for (int i = 0; i < 16; ++i) { const float x1 = bf2f((unsigned short)(i < 8 ? a0[i & 7] : a1[i & 7])), x2 = bf2f((unsigned short)(i < 8 ? b0[i & 7] : b1[i & 7]));
              o1[i] = x1 * cv[i] - x2 * sv[i]; o2[i] = x1 * sv[i] + x2 * cv[i]; }
          if (which == 1) {
#pragma unroll
              for (int i = 0; i < 16; ++i) { o1[i] *= 0.08838834764831845f; o2[i] *= 0.08838834764831845f; } }
          v4u w0, w1, w2, w3;
          w0.x = pk2(o1[0], o1[1]); w0.y = pk2(o1[2], o1[3]); w0.z = pk2(o1[4], o1[5]); w0.w = pk2(o1[6], o1[7]);
          w1.x = pk2(o1[8], o1[9]); w1.y = pk2(o1[10], o1[11]); w1.z = pk2(o1[12], o1[13]); w1.w = pk2(o1[14], o1[15]);
          w2.x = pk2(o2[0], o2[1]); w2.y = pk2(o2[2], o2[3]); w2.z = pk2(o2[4], o2[5]); w2.w = pk2(o2[6], o2[7]);
          w3.x = pk2(o2[8], o2[9]); w3.y = pk2(o2[10], o2[11]); w3.z = pk2(o2[12], o2[13]); w3.w = pk2(o2[14], o2[15]);
          *(v4u*)P = w0; *(v4u*)(P + 8) = w1; *(v4u*)(P + 64) = w2; *(v4u*)(P + 72) = w3;
          if (which == 1) {
              v4u z0, z1, z2, z3;
              z0.x = pk2(o1[0] * zeta, o1[1] * zeta); z0.y = pk2(o1[2] * zeta, o1[3] * zeta); z0.z = pk2(o1[4] * zeta, o1[5] * zeta); z0.w = pk2(o1[6] * zeta, o1[7] * zeta);
              z1.x = pk2(o1[8] * zeta, o1[9] * zeta); z1.y = pk2(o1[10] * zeta, o1[11] * zeta); z1.z = pk2(o1[12] * zeta, o1[13] * zeta); z1.w = pk2(o1[14] * zeta, o1[15] * zeta);
              z2.x = pk2(o2[0] * zeta, o2[1] * zeta); z2.y = pk2(o2[2] * zeta, o2[3] * zeta); z2.z = pk2(o2[4] * zeta, o2[5] * zeta); z2.w = pk2(o2[6] * zeta, o2[7] * zeta);
              z3.x = pk2(o2[8] * zeta, o2[9] * zeta); z3.y = pk2(o2[10] * zeta, o2[11] * zeta); z3.z = pk2(o2[12] * zeta, o2[13] * zeta); z3.w = pk2(o2[14] * zeta, o2[15] * zeta);
              LAS bf16* L = Kz + row * TLD + c16;
              *(LAS v4u*)L = z0; *(LAS v4u*)(L + 8) = z1; *(LAS v4u*)(L + 64) = z2; *(LAS v4u*)(L + 72) = z3; }
      } }
#pragma unroll
    for (int j = 0; j < 4; ++j) { const int c = tid + 512 * j, row = c >> 4, col8 = (c & 15) * 8;
        *(LAS v4u*)(Vt + row * TLD + col8) = *(const v4u*)(RV + (size_t)row * HD + col8);
        bf16x8 g = *(const bf16x8*)(RG + (size_t)row * HD + col8); float gv[8];
#pragma unroll
        for (int i = 0; i < 8; ++i) gv[i] = silu_f(bf2f((unsigned short)g[i]));
        v4u o; o.x = pk2(gv[0], gv[1]); o.y = pk2(gv[2], gv[3]); o.z = pk2(gv[4], gv[5]); o.w = pk2(gv[6], gv[7]);
        *(v4u*)(RG + (size_t)row * HD + col8) = o; }
    { const float* qn = F.in[9]; const float* kn = F.in[10];
      const float q0 = qn[2 * lane], q1 = qn[2 * lane + 1], k0 = kn[2 * lane], k1 = kn[2 * lane + 1];
#pragma unroll 4
      for (int rr = 0; rr < 16; ++rr) { const int row = w * 16 + rr;
          unsigned* pq = (unsigned*)(FQ + (size_t)row * HD) + lane; unsigned* pk = (unsigned*)(FK + (size_t)row * HD) + lane;
          const unsigned uq = *pq, uk = *pk;
          const float a0 = __uint_as_float(uq << 16), a1 = __uint_as_float(uq & 0xffff0000u), b0 = __uint_as_float(uk << 16), b1 = __uint_as_float(uk & 0xffff0000u);
          const float sq = wave_sum(a0 * a0 + a1 * a1), sk = wave_sum(b0 * b0 + b1 * b1);
          const float rq = rsqrtf(sq * (1.f / 128.f) + EPS), rk = rsqrtf(sk * (1.f / 128.f) + EPS);
          *pq = pk2(a0 * rq * q0, a1 * rq * q1); *pk = pk2(b0 * rk * k0, b1 * rk * k1); } }
    LDS_WAIT(); __syncthreads();
    { const int db = w >> 1, eb = 2 * (w & 1), hi = lane >> 5;
      f32x16 a0 = {}, a1 = {};
#pragma unroll
      for (int kk = 0; kk < 8; ++kk) { const bf16x8 a = frag_tr(Kz, 16 * kk, 32 * db, lane), b0 = frag_tr(Vt, 16 * kk, 32 * eb, lane), b1 = frag_tr(Vt, 16 * kk, 32 * eb + 32, lane);
          a0 = __builtin_amdgcn_mfma_f32_32x32x16_bf16(a, b0, a0, 0, 0, 0); a1 = __builtin_amdgcn_mfma_f32_32x32x16_bf16(a, b1, a1, 0, 0, 0); }
      float* KV = (float*)(F.ws + WS_KV) + ((size_t)bh * 32 + n) * 16384;
#pragma unroll
      for (int r = 0; r < 16; ++r) { const int d = 32 * db + crow16(r, hi); KV[d * 128 + 32 * eb + (lane & 31)] = a0[r]; KV[d * 128 + 32 * eb + 32 + (lane & 31)] = a1[r]; } }
    LDS_WAIT(); __syncthreads();
}
__device__ __forceinline__ void p3_cumsum(Frame& F, int bh) {
    const float* lf = (const float*)(F.ws + WS_LOGF) + (size_t)bh * SEQ + 64 * F.lane; float* cb = (float*)(F.ws + WS_CB) + (size_t)bh * SEQ + 64 * F.lane;
    float tot = 0.f;
#pragma unroll 8
    for (int i = 0; i < 64; ++i) tot += lf[i];
    float incl = tot;
#pragma unroll
    for (int o = 1; o < 64; o <<= 1) { const float t = __shfl_up(incl, o); if (F.lane >= o) incl += t; }
    float run = incl - tot;
#pragma unroll 8
    for (int i = 0; i < 64; ++i) { run += lf[i]; cb[i] = -run * 11.313708498984761f; }
}
__device__ __forceinline__ void p3_phase(Frame& F) {
    if (F.wave == 0) for (int bh = blockIdx.x; bh < 16; bh += F.G) p3_cumsum(F, bh);
    for (int it = blockIdx.x; it < 512; it += F.G) p3_item(F, it >> 5, it & 31);
}
__device__ __forceinline__ void p3b_scan(Frame& F) {
    const float* KV = (const float*)(F.ws + WS_KV); bf16* SP = (bf16*)(F.ws + WS_SP);
    for (int idx = blockIdx.x * (NWAVES * 64) + F.tid; idx < 16 * 16384; idx += F.G * NWAVES * 64) {
        const int bh = idx >> 14, de = idx & 16383; const float cd = exp2f(ret_lg2(bh & 7) * 128.f);
        float st = 0.f;
        for (int n = 0; n < 32; ++n) { const size_t o = ((size_t)bh * 32 + n) * 16384 + de; SP[o] = (bf16)f2bf(st); st = st * cd + KV[o]; }
    }
}
__device__ __forceinline__ void ret_item(Frame& F, int bh, int n) {
    const int h = bh & 7, b = bh >> 3, tid = F.tid, lane = F.lane, w = F.wave, hi = lane >> 5, c32 = lane & 31;
    const bf16* qkv = (const bf16*)(F.ws + WS_QKV);
    const size_t rbase = ((size_t)bh * SEQ + (size_t)n * 128) * HD;
    const bf16* RQ = qkv + 0 * TSZ + rbase; const bf16* RK = qkv + 1 * TSZ + rbase; const bf16* RV = qkv + 2 * TSZ + rbase; const bf16* RG = qkv + 3 * TSZ + rbase;
    const bf16* SPg = (const bf16*)(F.ws + WS_SP) + ((size_t)bh * 32 + n) * 16384;
    LAS bf16* Qs = (LAS bf16*)F.lds; LAS bf16* Ks = Qs + TILE_EL; LAS bf16* Vs = Ks + TILE_EL; LAS bf16* Ss = Vs + TILE_EL;
    LAS float* st = (LAS float*)(Ss + TILE_EL);
#pragma unroll
    for (int j = 0; j < 4; ++j) { const int c = tid + 512 * j, row = c >> 4, col8 = (c & 15) * 8; const size_t go = (size_t)row * HD + col8; const int lo = row * TLD + col8;
        *(LAS v4u*)(Qs + lo) = *(const v4u*)(RQ + go); *(LAS v4u*)(Ks + lo) = *(const v4u*)(RK + go);
        *(LAS v4u*)(Vs + lo) = *(const v4u*)(RV + go); *(LAS v4u*)(Ss + lo) = *(const v4u*)(SPg + go); }
    LDS_WAIT(); __syncthreads();
    const int qb = w >> 1, cb2 = 2 * (w & 1);
    const float lg2 = ret_lg2(h);
    f32x16 s0 = {}, s1 = {};
#pragma unroll
    for (int kk = 0; kk < 8; ++kk) { const bf16x8 a = frag_row(Qs, 32 * qb, 16 * kk, lane), b0 = frag_row(Ks, 32 * cb2, 16 * kk, lane), b1 = frag_row(Ks, 32 * cb2 + 32, 16 * kk, lane);
        s0 = __builtin_amdgcn_mfma_f32_32x32x16_bf16(a, b0, s0, 0, 0, 0); s1 = __builtin_amdgcn_mfma_f32_32x32x16_bf16(a, b1, s1, 0, 0, 0); }
    const int key0 = 32 * cb2 + c32, key1 = key0 + 32;
    const float f0 = exp2f(-lg2 * (float)(key0 + 1)), f1 = exp2f(-lg2 * (float)(key1 + 1));
    LDS_WAIT(); __syncthreads();
#pragma unroll
    for (int r = 0; r < 16; ++r) { const int q = 32 * qb + crow16(r, hi);
        Ks[q * TLD + key0] = (bf16)f2bf(key0 <= q ? s0[r] * f0 : 0.f); Ks[q * TLD + key1] = (bf16)f2bf(key1 <= q ? s1[r] * f1 : 0.f); }
    LDS_WAIT(); __syncthreads();
    f32x16 o0 = {}, o1 = {};
#pragma unroll
    for (int kk = 0; kk < 8; ++kk) { const bf16x8 a = frag_row(Ks, 32 * qb, 16 * kk, lane), b0 = frag_tr(Vs, 16 * kk, 32 * cb2, lane), b1 = frag_tr(Vs, 16 * kk, 32 * cb2 + 32, lane);
        o0 = __builtin_amdgcn_mfma_f32_32x32x16_bf16(a, b0, o0, 0, 0, 0); o1 = __builtin_amdgcn_mfma_f32_32x32x16_bf16(a, b1, o1, 0, 0, 0); }
#pragma unroll
    for (int kk = 0; kk < 8; ++kk) { const bf16x8 a = frag_row(Qs, 32 * qb, 16 * kk, lane), b0 = frag_tr(Ss, 16 * kk, 32 * cb2, lane), b1 = frag_tr(Ss, 16 * kk, 32 * cb2 + 32, lane);
        o0 = __builtin_amdgcn_mfma_f32_32x32x16_bf16(a, b0, o0, 0, 0, 0); o1 = __builtin_amdgcn_mfma_f32_32x32x16_bf16(a, b1, o1, 0, 0, 0); }
#pragma unroll
    for (int r = 0; r < 16; ++r) { const int q = 32 * qb + crow16(r, hi); const float xi = exp2f(lg2 * (float)(q + 1));
        o0[r] *= xi; o1[r] *= xi;
        float s = o0[r] + o1[r], ss = o0[r] * o0[r] + o1[r] * o1[r];
        s = half32_sum(s); ss = half32_sum(ss);
        if (c32 == 0) { st[q * 4 + (w & 1) * 2] = s; st[q * 4 + (w & 1) * 2 + 1] = ss; } }
    LDS_WAIT(); __syncthreads();
    { const float* gn = F.in[8] + h * 128; const float g0 = gn[key0], g1 = gn[key1];
      bf16* CAT = (bf16*)(F.ws + WS_CAT) + ((size_t)b * SEQ + (size_t)n * 128) * DM + h * 128;
#pragma unroll
      for (int r = 0; r < 16; ++r) { const int q = 32 * qb + crow16(r, hi);
          const float s = st[q * 4] + st[q * 4 + 2], ss = st[q * 4 + 1] + st[q * 4 + 3];
          const float mu = s * (1.f / 128.f), var = fmaxf(ss * (1.f / 128.f) - mu * mu, 0.f), rstd = rsqrtf(var + EPS);
          const float y0 = (o0[r] - mu) * rstd * g0 * bf2f(RG[(size_t)q * HD + key0]), y1 = (o1[r] - mu) * rstd * g1 * bf2f(RG[(size_t)q * HD + key1]);
          CAT[(size_t)q * DM + key0] = (bf16)f2bf(y0); CAT[(size_t)q * DM + key1] = (bf16)f2bf(y1); } }
    LDS_WAIT(); __syncthreads();
}
__device__ __forceinline__ void p4_phase(Frame& F) {
    const int bx = blockIdx.x; const int vcu = (F.G % 8 == 0) ? (bx % 8) * (F.G / 8) + bx / 8 : bx;
    const bf16* qkv = (const bf16*)(F.ws + WS_QKV);
    bf16* CAT = (bf16*)(F.ws + WS_CAT);
    for (int fb = vcu; fb < 256; fb += F.G) {
        const int bh = fb >> 4, qb = fb & 15, h = bh & 7, b = bh >> 3;
        fox::BlockRef<bf16, bf16> cur;
        cur.Q = qkv + 4 * TSZ + ((size_t)bh * SEQ + (size_t)qb * 256) * HD; cur.K = qkv + 5 * TSZ + (size_t)bh * SEQ * HD; cur.V = qkv + 6 * TSZ + (size_t)bh * SEQ * HD;
        cur.O = CAT + ((size_t)b * SEQ + (size_t)qb * 256) * DM + 1024 + h * 128; cur.cb = (const float*)(F.ws + WS_CB) + (size_t)bh * SEQ; cur.onw = F.in[11] + h * 128; cur.P0 = qb * 256;
        fox::Seam<bf16> S;
        fox::causal_swa_prime<bf16, bf16>(cur, SEQ, F.ldsg, S);
        fox::causal_swa_block<bf16, bf16>(cur, cur, SEQ, SEQ, F.ldsg, S);
        asm volatile("s_waitcnt vmcnt(0)" ::: "memory");
        __syncthreads();
    }
    for (;;) {
        if (F.tid == 0) F.MISC[0] = atomicAdd((unsigned*)(F.ws + WS_CTL) + CW_RETQ, 1u);
        __syncthreads();
        const unsigned item = F.MISC[0];
        __syncthreads();
        if (item >= 512u) break;
        ret_item(F, (int)(item >> 5), (int)(item & 31));
    }
}
constexpr int PADROWS = 24576;
constexpr int LTAB_OFF = LDSCTL_OFF + 1024;
struct EpiPlain {
    static constexpr bool PERM = true, AFTER_DRAIN = false;
    bf16* O; int ldc; int ntn;
    template <class U> __device__ __forceinline__ void operator()(const pg8::f32x4 (&acc)[2][2][4][2], const U& u, int wr, int wc, int fr, int fq) const {
        const int row0 = u.pm * 256 + wr * 64 + fr, col0 = (u.pn % ntn) * 256 + wc * 32 + 8 * fq;
#pragma unroll
        for (int ai = 0; ai < 2; ++ai)
#pragma unroll
            for (int m = 0; m < 4; ++m) { bf16* rowp = O + (size_t)(row0 + ai * 128 + m * 16) * ldc + col0;
#pragma unroll
                for (int bj = 0; bj < 2; ++bj) { const pg8::f32x4 v0 = acc[ai][bj][m][0], v1 = acc[ai][bj][m][1];
                    pg8::u32x4 w; w.x = pg8::cvt_pk_bf16(v0[0], v0[1]); w.y = pg8::cvt_pk_bf16(v0[2], v0[3]); w.z = pg8::cvt_pk_bf16(v1[0], v1[1]); w.w = pg8::cvt_pk_bf16(v1[2], v1[3]);
                    *(pg8::u32x4*)(rowp + bj * 128) = w; } }
    }
};
struct EpiSwiglu {
    static constexpr bool PERM = true, AFTER_DRAIN = false;
    bf16* O;
    template <class U> __device__ __forceinline__ void operator()(const pg8::f32x4 (&acc)[2][2][4][2], const U& u, int wr, int wc, int fr, int fq) const {
        const int row0 = u.pm * 256 + wr * 64 + fr, col0 = (u.pn & 3) * 128 + wc * 32 + 8 * fq;
#pragma unroll
        for (int ai = 0; ai < 2; ++ai)
#pragma unroll
            for (int m = 0; m < 4; ++m) { float g[8];
#pragma unroll
                for (int n = 0; n < 2; ++n)
#pragma unroll
                    for (int i = 0; i < 4; ++i) { const float a = acc[ai][0][m][n][i], b = acc[ai][1][m][n][i]; g[4 * n + i] = a * __builtin_amdgcn_rcpf(1.f + __expf(-a)) * b; }
                pg8::u32x4 w; w.x = pg8::cvt_pk_bf16(g[0], g[1]); w.y = pg8::cvt_pk_bf16(g[2], g[3]); w.z = pg8::cvt_pk_bf16(g[4], g[5]); w.w = pg8::cvt_pk_bf16(g[6], g[7]);
                *(pg8::u32x4*)(O + (size_t)(row0 + ai * 128 + m * 16) * DE + col0) = w; }
    }
};
struct GUnit { int pm, pn, e, lt; };
template <int NJ> struct GroupedOrder {
    typedef GUnit unit_t;
    const LAS int* ts; int G, c, total;
    __device__ __forceinline__ void init(const LAS int* ts_, int G_, int c_) { ts = ts_; G = G_; c = c_; total = ts_[32] * NJ; }
    __device__ __forceinline__ bool next(int i, GUnit& u) const {
        const int L = i * G + c; if (L >= total) return false;
        const int mt = L / NJ, j = L % NJ; int e = 0;
        while (ts[e + 1] <= mt) ++e;
        u.e = e; u.lt = mt - ts[e]; u.pm = mt; u.pn = e * NJ + j; return true;
    }
    __device__ __forceinline__ void a_ready(const GUnit&) const {}
    __device__ __forceinline__ void done(const GUnit&) const {}
};
struct GatherRows { const int* list; const LAS int* cntL;
    __device__ __forceinline__ unsigned row(const GUnit& u, int r) const { const int lr = u.lt * 256 + r; return lr < cntL[u.e] ? (unsigned)list[(size_t)u.e * ECAP + lr] : 0u; } };
__device__ __forceinline__ void moe_tables(Frame& F) {
    LAS int* cntL = (LAS int*)(F.lds + LTAB_OFF); LAS int* ts = cntL + 32;
    __syncthreads();
    if (F.tid < 32) cntL[F.tid] = (int)__hip_atomic_load(F.ctl + F.cnt_off + 64 * F.tid, RLX_AGENT);
    __syncthreads();
    if (F.tid == 0) { int a = 0; for (int e = 0; e < 32; ++e) { ts[e] = a; a += (cntL[e] + 255) >> 8; } ts[32] = a; }
    __syncthreads();
}
__device__ __forceinline__ f32x4 bf4(unsigned lo, unsigned hi) { return (f32x4){__uint_as_float(lo << 16), __uint_as_float(lo & 0xffff0000u), __uint_as_float(hi << 16), __uint_as_float(hi & 0xffff0000u)}; }
constexpr int P6_PAR = 0, P6_AH = 40960, P6_AHLD = 1028, P6_RED = P6_AH + 16 * P6_AHLD * 4, P6_LG = P6_RED + 8 * 768 * 4, P6_END = P6_LG + 16 * 48 * 4;
static_assert(P6_END <= LDSCTL_OFF, "p6 LDS map");
typedef float f32x4v __attribute__((ext_vector_type(4)));
__device__ __forceinline__ void split8(const f32x4 a, const f32x4 b, bf16x8& hi, bf16x8& lo) {
    float v[8] = {a.x, a.y, a.z, a.w, b.x, b.y, b.z, b.w}; unsigned h[8], l[8];
#pragma unroll
    for (int i = 0; i < 8; ++i) { h[i] = f2bf(v[i]); l[i] = f2bf(v[i] - __uint_as_float(h[i] << 16)); }
    hi = (bf16x8){(short)h[0], (short)h[1], (short)h[2], (short)h[3], (short)h[4], (short)h[5], (short)h[6], (short)h[7]};
    lo = (bf16x8){(short)l[0], (short)l[1], (short)l[2], (short)l[3], (short)l[4], (short)l[5], (short)l[6], (short)l[7]};
}
__device__ __forceinline__ void p6_phase(Frame& F) {
    const float* x = F.in[0]; const float* wpost = F.in[5]; const float* wpre = F.in[13]; const float* rcb = F.in[16]; const float* rfb = F.in[18];
    const float* mod = (const float*)(F.ws + WS_MOD); const bf16* Yb = (const bf16*)(F.ws + WS_YB); bf16* Hb = (bf16*)(F.ws + WS_HB);
    const bf16* RWH = (const bf16*)(F.ws + WS_RWP); const bf16* RWL = RWH + 48 * DM;
    int* list = (int*)(F.ws + WS_LIST); int* SE = (int*)(F.ws + WS_SLOT); int* SPOS = SE + 2 * T; float* SW = (float*)(SPOS + 2 * T);
    LAS f32x4* PAR = (LAS f32x4*)(F.lds + P6_PAR);
    LAS float* AH = (LAS float*)(F.lds + P6_AH); LAS float* RED = (LAS float*)(F.lds + P6_RED); LAS float* LG = (LAS float*)(F.lds + P6_LG);
    const int lane = F.lane, w = F.wave;
    for (int pass = blockIdx.x; pass < T / 16; pass += F.G) {
        const int row0 = pass * 16 + 2 * w, b = (pass * 16) >> 12;
        f32x4 xv[2][8];
        __syncthreads();
        { const f32x4* mb = (const f32x4*)(mod + (size_t)b * 6 * DM);
          for (int c = F.tid; c < 512; c += NWAVES * 64) { PAR[c] = mb[2 * 512 + c]; PAR[512 + c] = ((const f32x4*)wpost)[c]; PAR[1024 + c] = ((const f32x4*)wpre)[c]; PAR[1536 + c] = mb[4 * 512 + c] + 1.0f; PAR[2048 + c] = mb[3 * 512 + c]; } }
        LDS_WAIT(); __syncthreads();
#pragma unroll
        for (int rr = 0; rr < 2; ++rr) {
            f32x4* outr = (f32x4*)(F.out + (size_t)(row0 + rr) * DM) + lane; uint2* hr = (uint2*)(Hb + (size_t)(row0 + rr) * DM) + lane;
            uint2 yu[8];
            { const f32x4* xr = (const f32x4*)(x + (size_t)(row0 + rr) * DM) + lane; const uint2* yr = (const uint2*)(Yb + (size_t)(row0 + rr) * DM) + lane;
#pragma unroll
              for (int j = 0; j < 8; ++j) { xv[rr][j] = xr[64 * j]; yu[j] = yr[64 * j]; } }
            f32x4 yv[8]; float ss = 0.f;
#pragma unroll
            for (int j = 0; j < 8; ++j) { yv[j] = bf4(yu[j].x, yu[j].y); ss += (yv[j].x * yv[j].x + yv[j].y * yv[j].y) + (yv[j].z * yv[j].z + yv[j].w * yv[j].w); }
            const float rstd_y = rsqrtf(wave_sum(ss) * (1.f / DM) + EPS);
            float s2 = 0.f;
            asm volatile("" ::: "memory");
#pragma unroll
            for (int j = 0; j < 8; ++j) { const f32x4 x1 = xv[rr][j] + PAR[lane + 64 * j] * (yv[j] * rstd_y * PAR[512 + lane + 64 * j]);
                outr[64 * j] = x1; xv[rr][j] = x1; s2 += (x1.x * x1.x + x1.y * x1.y) + (x1.z * x1.z + x1.w * x1.w); }
            const float rstd = rsqrtf(wave_sum(s2) * (1.f / DM) + EPS);
            asm volatile("" ::: "memory");
#pragma unroll
            for (int j = 0; j < 8; ++j) { const f32x4 h = xv[rr][j] * rstd * PAR[1024 + lane + 64 * j] * PAR[1536 + lane + 64 * j] + PAR[2048 + lane + 64 * j];
                xv[rr][j] = h; uint2 o; o.x = pk2(h.x, h.y); o.y = pk2(h.z, h.w); hr[64 * j] = o; }
            asm volatile("" ::: "memory");
        }
        pg8::f32x4 acc[3] = {{0.f, 0.f, 0.f, 0.f}, {0.f, 0.f, 0.f, 0.f}, {0.f, 0.f, 0.f, 0.f}};
#pragma unroll
        for (int half = 0; half < 2; ++half) {
            __syncthreads();
#pragma unroll
            for (int rr = 0; rr < 2; ++rr)
#pragma unroll
                for (int j = 0; j < 4; ++j) *(LAS f32x4*)(AH + (2 * w + rr) * P6_AHLD + 256 * j + 4 * lane) = xv[rr][4 * half + j];
            LDS_WAIT(); __syncthreads();
#pragma unroll
            for (int ks = 0; ks < 4; ++ks) {
                const int kh = 128 * w + 32 * ks + 8 * (lane >> 4); const LAS float* ap = AH + (lane & 15) * P6_AHLD + kh;
                const f32x4 a0 = *(const LAS f32x4*)ap, a1 = *(const LAS f32x4*)(ap + 4); bf16x8 ahi, alo; split8(a0, a1, ahi, alo);
#pragma unroll
                for (int nt = 0; nt < 3; ++nt) { const size_t bo = (size_t)(nt * 16 + (lane & 15)) * DM + 1024 * half + kh;
                    const bf16x8 bh = *(const bf16x8*)(RWH + bo), bl = *(const bf16x8*)(RWL + bo);
                    acc[nt] = __builtin_amdgcn_mfma_f32_16x16x32_bf16(ahi, bh, acc[nt], 0, 0, 0);
                    acc[nt] = __builtin_amdgcn_mfma_f32_16x16x32_bf16(alo, bh, acc[nt], 0, 0, 0);
                    acc[nt] = __builtin_amdgcn_mfma_f32_16x16x32_bf16(ahi, bl, acc[nt], 0, 0, 0); }
                if (ks & 1) asm volatile("" ::: "memory");
            }
        }
#pragma unroll
        for (int nt = 0; nt < 3; ++nt)
#pragma unroll
            for (int r = 0; r < 4; ++r) RED[w * 768 + (nt * 4 + r) * 64 + lane] = acc[nt][r];
        LDS_WAIT(); __syncthreads();
        for (int idx = F.tid; idx < 768; idx += NWAVES * 64) { float s = 0.f;
#pragma unroll
            for (int ww = 0; ww < NWAVES; ++ww) s += RED[ww * 768 + idx];
            const int nt = idx >> 8, r = (idx >> 6) & 3, l = idx & 63; LG[(4 * (l >> 4) + r) * 48 + nt * 16 + (l & 15)] = s; }
        LDS_WAIT(); __syncthreads();
        if (w == 0) {
            const int r = lane & 15; float lg[36];
#pragma unroll
            for (int o = 0; o < 36; ++o) lg[o] = LG[r * 48 + o] + (o < 4 ? rcb[o] : rfb[o - 4]);
            int g = 0; float mx = lg[0];
#pragma unroll
            for (int j = 1; j < 4; ++j) if (lg[j] > mx) { mx = lg[j]; g = j; }
            float den = 0.f;
#pragma unroll
            for (int j = 0; j < 4; ++j) den += expf(lg[j] - mx);
            const float gprob = 1.f / den;
            float f[8];
#pragma unroll
            for (int i = 0; i < 8; ++i) f[i] = g == 0 ? lg[4 + i] : g == 1 ? lg[12 + i] : g == 2 ? lg[20 + i] : lg[28 + i];
            int i0 = 0; float v0 = f[0];
#pragma unroll
            for (int i = 1; i < 8; ++i) if (f[i] > v0) { v0 = f[i]; i0 = i; }
            int i1 = -1; float v1 = -3.0e38f;
#pragma unroll
            for (int i = 0; i < 8; ++i) if (i != i0 && f[i] > v1) { v1 = f[i]; i1 = i; }
            const float e1 = expf(v1 - v0); const float w0 = gprob / (1.f + e1), w1 = gprob * e1 / (1.f + e1);
            if (lane < 32) { const int slot = lane >> 4, row = pass * 16 + r, e = g * 8 + (slot ? i1 : i0);
                const int pos = (int)atomicAdd((unsigned*)(F.ws + WS_CTL) + F.cnt_off + 64 * e, 1u);
                list[(size_t)e * ECAP + pos] = row; SE[2 * row + slot] = e; SPOS[2 * row + slot] = pos; SW[2 * row + slot] = slot ? w1 : w0; }
        }
    }
}
__device__ __forceinline__ void p9_final(Frame& F) {
    moe_tables(F);
    const LAS int* ts = (const LAS int*)(F.lds + LTAB_OFF) + 32;
    const float* wpost = F.in[14]; const float* mod = (const float*)(F.ws + WS_MOD); const bf16* Ys = (const bf16*)(F.ws + WS_YS);
    const int* SE = (const int*)(F.ws + WS_SLOT); const int* SPOS = SE + 2 * T; const float* SW = (const float*)(SPOS + 2 * T);
    const int lane = F.lane;
    for (int row = F.gw; row < T; row += F.NGW) {
        const int b = row >> 12;
        const int r0 = ts[SE[2 * row]] * 256 + SPOS[2 * row], r1 = ts[SE[2 * row + 1]] * 256 + SPOS[2 * row + 1]; const float w0 = SW[2 * row], w1 = SW[2 * row + 1];
        const uint2* y0 = (const uint2*)(Ys + (size_t)r0 * DM) + lane; const uint2* y1 = (const uint2*)(Ys + (size_t)r1 * DM) + lane;
        f32x4* outr = (f32x4*)(F.out + (size_t)row * DM) + lane; const f32x4* g2 = (const f32x4*)(mod + (size_t)b * 6 * DM + 5 * DM) + lane;
        f32x4 v[8]; float ss = 0.f;
#pragma unroll
        for (int j = 0; j < 8; ++j) { const uint2 a = y0[64 * j], c = y1[64 * j]; v[j] = bf4(a.x, a.y) * w0 + bf4(c.x, c.y) * w1; ss += (v[j].x * v[j].x + v[j].y * v[j].y) + (v[j].z * v[j].z + v[j].w * v[j].w); }
        const float rstd = rsqrtf(wave_sum(ss) * (1.f / DM) + EPS);
#pragma unroll
        for (int j = 0; j < 8; ++j) outr[64 * j] = outr[64 * j] + g2[64 * j] * (v[j] * rstd * ((const f32x4*)wpost)[lane + 64 * j]);
    }
}
__global__ void __launch_bounds__(NWAVES * 64, 2) mega_fwd(Args args) {
    extern __shared__ __attribute__((aligned(16))) unsigned char lds[];
    Frame F;
    F.lds = (LAS unsigned char*)lds; F.ldsg = (char*)lds;
    F.MISC = (volatile LAS unsigned*)(F.lds + MISC_OFF);
    F.tid = threadIdx.x; F.lane = F.tid & 63; F.wave = __builtin_amdgcn_readfirstlane(F.tid >> 6);
    F.G = gridDim.x; F.gw = blockIdx.x * NWAVES + F.wave; F.NGW = F.G * NWAVES;
    F.cnt_off = args.cnt_off;
    F.ws = args.ws; F.out = args.out; F.ctl = (gu32*)(args.ws + WS_CTL);
#pragma unroll
    for (int i = 0; i < 22; ++i) F.in[i] = args.in[i];
    for (int u = F.tid; u < (LDS_BYTES - LDSCTL_OFF) / 4; u += NWAVES * 64) ((LAS unsigned*)(F.lds + LDSCTL_OFF))[u] = 0u;
    __syncthreads();
    XcdBarrier bar = xcd_barrier_post((unsigned*)(F.ctl + CW_BAR), F.MISC + 8);
    const int lo = args.ph_lo, hi = args.ph_hi;
#define IN(k) (lo <= (k) && (k) < hi)
#define BOTH(k) (IN(k) && IN((k) + 1))
#define GRID_BAR() xcd_barrier(bar)
#define REFRESH() do { int t_ = threadIdx.x; asm volatile("" : "+v"(t_)); F.tid = t_; F.lane = t_ & 63; F.wave = __builtin_amdgcn_readfirstlane(t_ >> 6); F.gw = blockIdx.x * NWAVES + F.wave; } while (0)
    if (IN(0)) { REFRESH(); p0_prologue<false>(F); if (BOTH(0)) GRID_BAR(); }
    if (IN(1)) { REFRESH(); p1_prenorm(F); if (BOTH(1)) GRID_BAR(); }
    if (IN(2)) { REFRESH();
        const int NG2 = (F.G == 256) ? 224 : F.G;
        if ((int)blockIdx.x < NG2) {
            pg8::Gemm g{(const bf16*)(F.ws + WS_HB), (const bf16*)(F.ws + WS_WIN), T, INCM, DM}; pg8::StaticOrder S; S.init(T, INCM, NG2, (int)blockIdx.x);
            EpiHeads E{(bf16*)(F.ws + WS_QKV)};
            pg8::gemm_phase<EpiHeads, pg8::StaticOrder, true, true>(F.lds + RING_OFF, g, S, E);
            if (F.tid == 0) __hip_atomic_fetch_add(F.ctl + CW_DONE + 64 * 2, 1u, RLX_AGENT);
        } else filler(F, 2, 1, (unsigned)NG2, 0u);
        if (BOTH(2)) GRID_BAR();
    }
    if (IN(3)) { REFRESH(); p3_phase(F); if (BOTH(3)) GRID_BAR(); }
    if (IN(4)) { REFRESH(); p3b_scan(F); if (BOTH(4)) GRID_BAR(); }
    if (IN(5)) { REFRESH(); p4_phase(F); filler(F, 5, 0, (unsigned)F.G, (unsigned)(F.G - F.G / 8)); if (BOTH(5)) GRID_BAR(); }
    if (IN(6)) { REFRESH();
        pg8::Gemm g{(const bf16*)(F.ws + WS_CAT), (const bf16*)(F.ws + WS_WOUT), T, DM, DM}; pg8::StaticOrder S; S.init(T, DM, F.G, (int)blockIdx.x);
        EpiPlain E{(bf16*)(F.ws + WS_YB), DM, 8};
        pg8::gemm_phase<EpiPlain, pg8::StaticOrder, true, true>(F.lds + RING_OFF, g, S, E);
        if (BOTH(6)) GRID_BAR();
    }
    if (IN(7)) { REFRESH(); p6_phase(F); filler(F, 7, 2, 0u, 0u); if (BOTH(7)) GRID_BAR(); }
    if (IN(8)) { REFRESH();
        moe_tables(F);
        pg8::Gemm g{(const bf16*)(F.ws + WS_HB), (const bf16*)(F.ws + WS_W13), PADROWS, NE * 1024, DM};
        GroupedOrder<4> S; S.init((const LAS int*)(F.lds + LTAB_OFF) + 32, F.G, (int)blockIdx.x);
        EpiSwiglu E{(bf16*)(F.ws + WS_GB)}; GatherRows R{(const int*)(F.ws + WS_LIST), (const LAS int*)(F.lds + LTAB_OFF)};
        pg8::gemm_phase<EpiSwiglu, GroupedOrder<4>, true, true, GatherRows>(F.lds + RING_OFF, g, S, E, R);
        if (BOTH(8)) GRID_BAR();
    }
    if (IN(9)) { REFRESH();
        moe_tables(F);
        pg8::Gemm g{(const bf16*)(F.ws + WS_GB), (const bf16*)(F.ws + WS_W2), PADROWS, NE * 2048, DE};
        GroupedOrder<8> S; S.init((const LAS int*)(F.lds + LTAB_OFF) + 32, F.G, (int)blockIdx.x);
        EpiPlain E{(bf16*)(F.ws + WS_YS), DM, 8};
        pg8::gemm_phase<EpiPlain, GroupedOrder<8>, true, true>(F.lds + RING_OFF, g, S, E);
        if (BOTH(9)) GRID_BAR();
    }
    if (IN(10)) { REFRESH(); p9_final(F); }
#undef IN
#undef BOTH
}

__global__ void k_adapt_proj(const bf16* __restrict__ qkv, const float* __restrict__ zb, float* __restrict__ proj) {
    const size_t i = (size_t)blockIdx.x * blockDim.x + threadIdx.x;
    if (i >= (size_t)T * INC) return;
    const int tok = (int)(i / INC), c = (int)(i % INC);
    if (c >= INCM) { proj[i] = zb[(size_t)tok * 8 + (c - INCM)]; return; }
    const int type = c >> 10, hh = (c & 1023) >> 7, d = c & 127, b = tok >> 12, s = tok & 4095;
    const unsigned v = qkv[(size_t)type * TSZ + ((size_t)((b * 8 + hh) * SEQ + s)) * HD + d];
    proj[i] = __uint_as_float(v << 16);
}

__global__ void k_adapt_cat(const bf16* __restrict__ catb, float* __restrict__ cat) {
    const size_t i = (size_t)blockIdx.x * blockDim.x + threadIdx.x;
    if (i < (size_t)T * DM) cat[i] = __uint_as_float((unsigned)catb[i] << 16);
}
extern "C" void kernel_launch(void* const* d_in, const int* in_sizes, int n_in, void* d_out, int out_size, void* d_ws, size_t ws_size, hipStream_t stream) {
    static int grid = 0;
    if (grid == 0) {
        int dev = 0, cus = 0, per_cu = 0;
        (void)hipGetDevice(&dev); (void)hipDeviceGetAttribute(&cus, hipDeviceAttributeMultiprocessorCount, dev);
        (void)hipFuncSetAttribute((const void*)mega_fwd, hipFuncAttributeMaxDynamicSharedMemorySize, LDS_BYTES);
        (void)hipOccupancyMaxActiveBlocksPerMultiprocessor(&per_cu, (const void*)mega_fwd, NWAVES * 64, LDS_BYTES);
        (void)hipGetLastError();
        if (per_cu < 1) { fprintf(stderr, "kernel_launch: occupancy query says %d blocks/CU\n", per_cu); per_cu = 1; }
        grid = cus > 0 ? cus : 256;
        if (ws_size < WS_END) fprintf(stderr, "kernel_launch: workspace too small (%zu < %zu)\n", ws_size, (size_t)WS_END);
    }
    (void)hipMemsetAsync((char*)d_ws + WS_CTL, 0, CTL_ZERO_BYTES, stream);
    Args a{};
    for (int i = 0; i < 22; ++i) a.in[i] = (const float*)d_in[i];
    a.out = (float*)d_out; a.ws = (unsigned char*)d_ws; a.ph_lo = 0; a.ph_hi = 11; a.cnt_off = CW_CNT;
    hipLaunchKernelGGL(mega_fwd, dim3(grid), dim3(NWAVES * 64), LDS_BYTES, stream, a);
}
```

```cpp
#include <hip/hip_runtime.h>
#include <stdint.h>
#include <cstdio>

constexpr int DM = 2048, NB = 2, SEQ = 4096, T = NB * SEQ;
constexpr int HD = 128, NH = 8;
constexpr int INC = 7176, INCM = 7168;
constexpr int NE = 32, DE = 512;
constexpr float EPS = 1e-6f;
#define GAS __attribute__((address_space(1)))
#define LAS __attribute__((address_space(3)))
typedef unsigned short bf16;
typedef unsigned v4u __attribute__((ext_vector_type(4)));
typedef float f32x4 __attribute__((ext_vector_type(4)));
typedef short bf16x8 __attribute__((ext_vector_type(8)));
typedef GAS unsigned gu32;
typedef GAS unsigned long long gu64;
#define RLX_AGENT __ATOMIC_RELAXED, __HIP_MEMORY_SCOPE_AGENT
#define LDS_WAIT() asm volatile("s_waitcnt lgkmcnt(0)" ::: "memory")
#define VM_WAIT() asm volatile("s_waitcnt vmcnt(0)" ::: "memory")
__device__ __forceinline__ unsigned long long rt() { return __builtin_amdgcn_s_memrealtime(); }
__device__ __forceinline__ unsigned f2bf(float f) { unsigned u = __builtin_bit_cast(unsigned, f); return (u + 0x7fffu + ((u >> 16) & 1u)) >> 16; }
__device__ __forceinline__ unsigned pk2(float lo, float hi) { return f2bf(lo) | (f2bf(hi) << 16); }

#define XB_TMO      128
#define XB_XCNT(j)  (256  + 64 * (j))
#define XB_XSUB(j)  (1280 + 64 * (j))
#define XB_XGEN(j)  (2304 + 64 * (j))
#define XB_TOP      3328
#define XB_TOPGEN   3392
#define XCD_BAR_WORDS 3456
#define XB_SPIN_CAP (1u << 18)

__device__ __forceinline__ unsigned xb_ld(unsigned* p)              { return __hip_atomic_load(p, __ATOMIC_RELAXED, __HIP_MEMORY_SCOPE_AGENT); }
__device__ __forceinline__ unsigned xb_add(unsigned* p, unsigned v) { return __hip_atomic_fetch_add(p, v, __ATOMIC_RELAXED, __HIP_MEMORY_SCOPE_AGENT); }
__device__ __forceinline__ unsigned xb_xcc_id() { return (unsigned)__builtin_amdgcn_s_getreg((3 << 11) | 20) & 0xFu; }
#define XB_SPIN(cond, bar) do { unsigned _sp = 0; while (cond) { __builtin_amdgcn_s_sleep(1); \
    if ((++_sp & 255u) == 0u) { if (xb_ld(&(bar)[XB_TMO])) break; if (_sp > XB_SPIN_CAP) { atomicAdd(&(bar)[XB_TMO], 1u); break; } } } } while (0)

struct XcdBarrier {
    unsigned* bar; unsigned x;
    volatile LAS unsigned* st;
};

__device__ __forceinline__ XcdBarrier xcd_barrier_post(unsigned* bar, volatile LAS unsigned* st) {
    XcdBarrier b; b.bar = bar; b.x = xb_xcc_id(); b.st = st;
    if (threadIdx.x == 0) (void)xb_add(&bar[XB_XCNT(b.x)], 1u);
    return b;
}
__device__ __forceinline__ void xcd_barrier_complete(unsigned* bar, unsigned x, unsigned& nloc, unsigned& nx) {
    const unsigned G = gridDim.x * gridDim.y * gridDim.z;
    unsigned sum, cnt, mine, sp = 0u;
    for (;;) {
        sum = 0u; cnt = 0u; mine = 0u;
#pragma unroll
        for (unsigned j = 0; j < 16; ++j) { const unsigned c = xb_ld(&bar[XB_XCNT(j)]); sum += c; cnt += (c > 0u) ? 1u : 0u; mine = (j == x) ? c : mine; }
        if (sum == G) break;
        __builtin_amdgcn_s_sleep(1);
        if ((++sp & 255u) == 0u) { if (xb_ld(&bar[XB_TMO])) break; if (sp > XB_SPIN_CAP) { atomicAdd(&bar[XB_TMO], 1u); break; } }
    }
    nloc = mine > 0u ? mine : 1u; nx = cnt > 0u ? cnt : 1u;
}

__device__ __forceinline__ void xcd_barrier(const XcdBarrier& b) {
    asm volatile("s_waitcnt vmcnt(0)" ::: "memory");
    __syncthreads();
    if (threadIdx.x == 0) {
        unsigned* bar = b.bar;
        __builtin_amdgcn_s_waitcnt(0);
        unsigned nloc = b.st[0], nx = b.st[1];
        if (nloc == 0u) { xcd_barrier_complete(bar, b.x, nloc, nx); b.st[0] = nloc; b.st[1] = nx; }
        const unsigned old = xb_add(&bar[XB_XSUB(b.x)], 1u);
        const unsigned gen = old / nloc;
        if (old + 1u == (gen + 1u) * nloc) {
            __builtin_amdgcn_fence(__ATOMIC_RELEASE, "agent");
            asm volatile("s_waitcnt vmcnt(0)" ::: "memory");
            const unsigned og = xb_add(&bar[XB_TOP], 1u);
            const unsigned tg = og / nx;
            if (og + 1u == (tg + 1u) * nx) xb_add(&bar[XB_TOPGEN], 1u);
            else XB_SPIN(xb_ld(&bar[XB_TOPGEN]) == tg, bar);
            __builtin_amdgcn_fence(__ATOMIC_ACQUIRE, "agent");
            xb_add(&bar[XB_XGEN(b.x)], 1u);
            asm volatile("s_waitcnt vmcnt(0)" ::: "memory");
        } else {
            XB_SPIN(xb_ld(&bar[XB_XGEN(b.x)]) == gen, bar);
            __builtin_amdgcn_fence(__ATOMIC_ACQUIRE, "agent");
            asm volatile("s_waitcnt vmcnt(0)" ::: "memory");
        }
    }
    __syncthreads();
}
namespace pg8 {
#define PG8_LAS __attribute__((address_space(3)))
typedef unsigned short bf16_t;
typedef short bf16x8 __attribute__((ext_vector_type(8)));
typedef float f32x4 __attribute__((ext_vector_type(4)));
typedef unsigned u32x4 __attribute__((ext_vector_type(4)));
constexpr int BM = 256, BK = 64, HALF = 128, HTB = HALF * BK * 2  , STAGE_BYTES = 8 * HTB, NXCD = 8, WGM = 8;

__host__ __device__ __forceinline__ int lds_byte(int r, int c) { const int st = (r >> 4) * 2 + (c >> 5), rr = r & 15, cc = c & 31, ob = rr * 64 + cc * 2; return st * 1024 + (ob ^ (((ob >> 9) & 1) << 5)); }
__host__ __device__ __forceinline__ void stage_rc(int b, int& R, int& C) { const int st = b / 1024, sb = b % 1024, swz = sb ^ (((sb >> 9) & 1) << 5); R = (st >> 1) * 16 + swz / 64; C = (st & 1) * 32 + (swz % 64) / 2; }
__host__ __device__ __forceinline__ int perm32(int rho) { const int n = rho >> 4, i = rho & 15; return 8 * (i >> 2) + 4 * n + (i & 3); }

struct Unit { int pm, pn; };
struct Gemm { const bf16_t* A; const bf16_t* Bt; int M, N, K; };

struct StaticOrder {
    typedef Unit unit_t;
    int nM, nN, nwg, G, c;
    __host__ __device__ void init(int M, int N, int G_, int c_) { nM = M / BM; nN = N / BM; nwg = nM * nN; G = G_; c = c_; }
    __host__ __device__ bool next(int i, Unit& u) const {
        const long L = (long)i * G + c; if (L >= nwg) return false;
        int wgid = (int)L; { const int q = nwg / NXCD, r = nwg % NXCD, xcd = wgid % NXCD, off = wgid / NXCD; wgid = (xcd < r ? xcd * (q + 1) : r * (q + 1) + (xcd - r) * q) + off; }
        const int nig = WGM * nN, gid = wgid / nig, fm = gid * WGM, gsz = (nM - fm) < WGM ? (nM - fm) : WGM;
        u.pm = fm + ((wgid % nig) % gsz); u.pn = (wgid % nig) / gsz; return true;
    }
    __device__ __forceinline__ void a_ready(const Unit&) const {}
    __device__ __forceinline__ void done(const Unit&) const {}
};

__device__ __forceinline__ unsigned cvt_pk_bf16(float lo, float hi) { unsigned r; asm volatile("v_cvt_pk_bf16_f32 %0, %1, %2" : "=v"(r) : "v"(lo), "v"(hi)); return r; }
typedef float f32x2 __attribute__((ext_vector_type(2)));
__device__ __forceinline__ f32x2 gelu_pk(f32x2 v) {
    const f32x2 av = __builtin_elementwise_abs(v), d = av * 0.2316418882f + 1.0f;
    f32x2 t; t.x = __builtin_amdgcn_rcpf(d.x); t.y = __builtin_amdgcn_rcpf(d.y);
    f32x2 q = t * 0.5307027145f + (-0.7265760135f); q = q * t + 0.7107068705f; q = q * t + (-0.142248368f); q = q * t + 0.127414796f; q = q * t;
    const f32x2 s = (v * v) * (-0.72134752044f);
    f32x2 e; e.x = __builtin_amdgcn_exp2f(s.x); e.y = __builtin_amdgcn_exp2f(s.y);
    const f32x2 m = v * (q * e), r = v - m;
    f32x2 o; o.x = v.x < 0.f ? m.x : r.x; o.y = v.y < 0.f ? m.y : r.y; return o;
}

template <int ACT  > struct EpiBf16 {
    static constexpr bool PERM = true, AFTER_DRAIN = false; static_assert(ACT == 0 || ACT == 1, "EpiBf16: ACT is 0 (none) or 1 (gelu_pk)");
    bf16_t* O; int ldc; const float* bias; int split_cols; size_t split_stride; float scale0;
    __device__ __forceinline__ void operator()(const f32x4 (&acc)[2][2][4][2], const Unit& u, int wr, int wc, int fr, int fq) const {
        const int row0 = u.pm * BM + wr * 64 + fr; int colt = u.pn * BM; bf16_t* base = O;
        float sc = 1.f; if (split_cols) { const int t = colt / split_cols; base += (size_t)t * split_stride; colt -= t * split_cols; if (t == 0) sc = scale0; }
        const int col0 = colt + wc * 32 + 8 * fq, bcol0 = u.pn * BM + wc * 32 + 8 * fq;
        f32x4 bv[2][2];
#pragma unroll
        for (int bj = 0; bj < 2; ++bj)
#pragma unroll
            for (int n = 0; n < 2; ++n) bv[bj][n] = bias ? *(const f32x4*)(bias + bcol0 + bj * HALF + 4 * n) : (f32x4){0.f, 0.f, 0.f, 0.f};
#pragma unroll
        for (int ai = 0; ai < 2; ++ai)
#pragma unroll
            for (int m = 0; m < 4; ++m) { bf16_t* rowp = base + (size_t)(row0 + ai * HALF + m * 16) * ldc + col0;
#pragma unroll
                for (int bj = 0; bj < 2; ++bj) { f32x4 v0 = acc[ai][bj][m][0] + bv[bj][0], v1 = acc[ai][bj][m][1] + bv[bj][1];
                    if (ACT == 1) { f32x2 a = gelu_pk((f32x2){v0[0], v0[1]}), b = gelu_pk((f32x2){v0[2], v0[3]}), c = gelu_pk((f32x2){v1[0], v1[1]}), d = gelu_pk((f32x2){v1[2], v1[3]});
                        v0 = (f32x4){a.x, a.y, b.x, b.y}; v1 = (f32x4){c.x, c.y, d.x, d.y}; }
                    v0 = v0 * sc; v1 = v1 * sc; u32x4 w; w.x = cvt_pk_bf16(v0[0], v0[1]); w.y = cvt_pk_bf16(v0[2], v0[3]); w.z = cvt_pk_bf16(v1[0], v1[1]); w.w = cvt_pk_bf16(v1[2], v1[3]);
                    *(u32x4*)(rowp + bj * HALF) = w; } }
    }
};
struct IdentRows { template <class U> __device__ __forceinline__ unsigned row(const U& u, int r) const { return (unsigned)(u.pm * BM + r); } };
template <class Epi, class Sched, bool ALIGN_EPI = false, bool SP2 = false, class RowMap = IdentRows>
__device__ __forceinline__ void gemm_phase(PG8_LAS unsigned char* lds, const Gemm g, const Sched& S, const Epi& E, const RowMap RM = RowMap()) {
    typedef typename Sched::unit_t Unit;
    const int tid = threadIdx.x, wid = __builtin_amdgcn_readfirstlane(tid >> 6), lane = tid & 63, wr = wid >> 2, wc = wid & 3, fr = lane & 15, fq = lane >> 4;
    const int K = g.K, nt = K / BK;
    unsigned voffB[2]; int RA[2], CA[2];
#pragma unroll
    for (int i = 0; i < 2; ++i) { int R, C; stage_rc(tid * 16 + i * 8192, R, C); const int Rb = Epi::PERM ? ((R & ~31) + perm32(R & 31)) : R;
        RA[i] = R; CA[i] = C; voffB[i] = (unsigned)(Rb * K + C) * 2u; }
    unsigned ao[2][2], an[2][2];
#define PG8_AOFF(dst, U) do { _Pragma("unroll") for (int h_ = 0; h_ < 2; ++h_) _Pragma("unroll") for (int i_ = 0; i_ < 2; ++i_) { \
        dst[h_][i_] = RM.row((U), h_ * HALF + RA[i_]) * (unsigned)(K * 2) + (unsigned)(CA[i_] * 2); } } while (0)
    const size_t kstep = (size_t)(BK * 2);
    const size_t hstep = (size_t)HALF * K * 2;
    const size_t tstep = 2 * hstep;
    const unsigned ldsw = (unsigned)wid * 1024u;
    const int aoff = lds_byte(wr * 64 + fr, fq * 8), boff = lds_byte(wc * 32 + fr, fq * 8);
#define PG8_SA(b, h) (((b) * 2 + (h)) * HTB)
#define PG8_SB(b, h) ((4 + (b) * 2 + (h)) * HTB)
#define PG8_STAGE(bufoff, gbase, voff) do { _Pragma("unroll") for (int _i = 0; _i < 2; ++_i) \
        __builtin_amdgcn_global_load_lds((const unsigned*)((const char*)(gbase) + (voff)[_i]), (PG8_LAS unsigned*)(lds + (bufoff) + ldsw + _i * 8192), 16, 0, 0); } while (0)
#define PG8_STAGE_A(bufoff, kbase, off) do { _Pragma("unroll") for (int _i = 0; _i < 2; ++_i) \
        __builtin_amdgcn_global_load_lds((const unsigned*)((const char*)(kbase) + (off)[_i]), (PG8_LAS unsigned*)(lds + (bufoff) + ldsw + _i * 8192), 16, 0, 0); } while (0)
#define PG8_LDA(dst, b, h) do { _Pragma("unroll") for (int m = 0; m < 4; ++m) _Pragma("unroll") for (int k = 0; k < 2; ++k) dst[m][k] = *(const PG8_LAS bf16x8*)(lds + PG8_SA(b, h) + aoff + m * 2048 + k * 1024); } while (0)
#define PG8_LDB(dst, b, h) do { _Pragma("unroll") for (int n = 0; n < 2; ++n) _Pragma("unroll") for (int k = 0; k < 2; ++k) dst[n][k] = *(const PG8_LAS bf16x8*)(lds + PG8_SB(b, h) + boff + n * 2048 + k * 1024); } while (0)
#define PG8_MMA(ai, bj, At, Bt) do { __builtin_amdgcn_s_setprio(1); _Pragma("unroll") for (int m = 0; m < 4; ++m) _Pragma("unroll") for (int n = 0; n < 2; ++n) _Pragma("unroll") for (int k = 0; k < 2; ++k) \
        acc[ai][bj][m][n] = __builtin_amdgcn_mfma_f32_16x16x32_bf16(Bt[n][k], At[m][k], acc[ai][bj][m][n], 0, 0, 0); __builtin_amdgcn_s_setprio(0); } while (0)
#define PG8_WAIT_V(n) asm volatile("s_waitcnt vmcnt(" #n ")" ::: "memory")
#define PG8_WAIT_L(n) asm volatile("s_waitcnt lgkmcnt(" #n ")" ::: "memory")
#define PG8_BAR __builtin_amdgcn_s_barrier()
#define PG8_SCHED __builtin_amdgcn_sched_barrier(0)
    Unit cur, nxt; int ui = 0;
    if (!S.next(0, cur)) return;
    f32x4 acc[2][2][4][2];
#pragma unroll
    for (int a = 0; a < 2; ++a)
#pragma unroll
        for (int b = 0; b < 2; ++b)
#pragma unroll
            for (int m = 0; m < 4; ++m)
#pragma unroll
                for (int n = 0; n < 2; ++n) acc[a][b][m][n] = (f32x4){0.f, 0.f, 0.f, 0.f};
    bf16x8 At[4][2], B0[2][2], B1[2][2];
    const char* const Ab = (const char*)g.A; const char* cB = (const char*)g.Bt + (size_t)cur.pn * tstep;
    PG8_AOFF(ao, cur);
    S.a_ready(cur);
    if constexpr (SP2) {
        PG8_STAGE(PG8_SB(0, 0), cB, voffB); PG8_STAGE(PG8_SB(0, 1), cB + hstep, voffB); PG8_STAGE_A(PG8_SA(0, 0), Ab, ao[0]); PG8_STAGE_A(PG8_SA(0, 1), Ab, ao[1]);
        if (wr == 1) PG8_BAR;
        PG8_WAIT_V(2); PG8_BAR;
        PG8_STAGE(PG8_SB(1, 0), cB + kstep, voffB); PG8_STAGE_A(PG8_SA(1, 0), Ab + kstep, ao[0]); PG8_STAGE(PG8_SB(1, 1), cB + hstep + kstep, voffB);
        PG8_WAIT_V(6); PG8_BAR;
    } else {
        PG8_STAGE(PG8_SB(0, 0), cB, voffB); PG8_STAGE_A(PG8_SA(0, 0), Ab, ao[0]); PG8_STAGE(PG8_SB(0, 1), cB + hstep, voffB); PG8_STAGE_A(PG8_SA(0, 1), Ab, ao[1]);
        if (wr == 1) PG8_BAR;
        PG8_WAIT_V(4); PG8_BAR;
        PG8_STAGE(PG8_SB(1, 0), cB + kstep, voffB); PG8_STAGE_A(PG8_SA(1, 0), Ab + kstep, ao[0]); PG8_STAGE(PG8_SB(1, 1), cB + hstep + kstep, voffB);
        PG8_WAIT_V(6); PG8_BAR;
    }
    for (;;) {
        const bool has_next = S.next(ui + 1, nxt);
        const char* nB = has_next ? (const char*)g.Bt + (size_t)nxt.pn * tstep : cB;
        if (has_next) { PG8_AOFF(an, nxt); } else { _Pragma("unroll") for (int h_ = 0; h_ < 2; ++h_) _Pragma("unroll") for (int i_ = 0; i_ < 2; ++i_) an[h_][i_] = ao[h_][i_]; }
        for (int t = 0; t < nt; t += 2) {
            const bool last = (t == nt - 2);
            const char* a1 = Ab + (size_t)(t + 1) * kstep;
            const char* a2 = last ? Ab : Ab + (size_t)(t + 2) * kstep; const char* b2 = last ? nB : cB + (size_t)(t + 2) * kstep;
            const char* a3 = a2 + kstep; const char* b3 = b2 + kstep;
            unsigned as[2][2];
#pragma unroll
            for (int h_ = 0; h_ < 2; ++h_)
#pragma unroll
                for (int i_ = 0; i_ < 2; ++i_) as[h_][i_] = last ? an[h_][i_] : ao[h_][i_];
            if (last && has_next) S.a_ready(nxt);
            if constexpr (SP2) {
            PG8_LDB(B0, 0, 0); PG8_LDB(B1, 0, 1); PG8_SCHED; PG8_LDA(At, 0, 0); PG8_STAGE_A(PG8_SA(1, 1), a1, ao[1]);
            PG8_WAIT_V(8); PG8_WAIT_L(0); PG8_BAR; PG8_MMA(0, 0, At, B0); PG8_MMA(0, 1, At, B1); PG8_BAR; PG8_SCHED;
            PG8_LDA(At, 0, 1); PG8_STAGE(PG8_SB(0, 0), b2, voffB); PG8_STAGE(PG8_SB(0, 1), b2 + hstep, voffB); PG8_STAGE_A(PG8_SA(0, 0), a2, as[0]);
            PG8_WAIT_V(8); PG8_WAIT_L(0); PG8_BAR; PG8_MMA(1, 0, At, B0); PG8_MMA(1, 1, At, B1); PG8_BAR; PG8_SCHED;
            PG8_LDB(B0, 1, 0); PG8_LDB(B1, 1, 1); PG8_SCHED; PG8_LDA(At, 1, 0); PG8_STAGE_A(PG8_SA(0, 1), a2, as[1]);
            PG8_WAIT_V(8); PG8_WAIT_L(0); PG8_BAR; PG8_MMA(0, 0, At, B0); PG8_MMA(0, 1, At, B1); PG8_BAR; PG8_SCHED;
            PG8_LDA(At, 1, 1); PG8_STAGE(PG8_SB(1, 0), b3, voffB); PG8_STAGE(PG8_SB(1, 1), b3 + hstep, voffB); PG8_STAGE_A(PG8_SA(1, 0), a3, as[0]);
            PG8_WAIT_V(8); PG8_WAIT_L(0); PG8_BAR; PG8_MMA(1, 0, At, B0); PG8_MMA(1, 1, At, B1); PG8_BAR; PG8_SCHED;
            } else {
            PG8_LDB(B0, 0, 0); PG8_SCHED; PG8_LDA(At, 0, 0); PG8_STAGE_A(PG8_SA(1, 1), a1, ao[1]);
            PG8_WAIT_L(8); PG8_BAR; PG8_WAIT_L(0); PG8_MMA(0, 0, At, B0); PG8_BAR; PG8_SCHED;
            PG8_LDB(B1, 0, 1); PG8_STAGE(PG8_SB(0, 0), b2, voffB);
            PG8_BAR; PG8_WAIT_L(0); PG8_MMA(0, 1, At, B1); PG8_BAR;
            PG8_LDA(At, 0, 1); PG8_STAGE_A(PG8_SA(0, 0), a2, as[0]);
            PG8_BAR; PG8_WAIT_L(0); PG8_MMA(1, 0, At, B0); PG8_BAR; PG8_SCHED;
            PG8_STAGE(PG8_SB(0, 1), b2 + hstep, voffB);
            PG8_WAIT_V(6); PG8_BAR; PG8_MMA(1, 1, At, B1); PG8_BAR;
            PG8_LDB(B0, 1, 0); PG8_SCHED; PG8_LDA(At, 1, 0); PG8_STAGE_A(PG8_SA(0, 1), a2, as[1]);
            PG8_WAIT_L(8); PG8_BAR; PG8_WAIT_L(0); PG8_MMA(0, 0, At, B0); PG8_BAR; PG8_SCHED;
            PG8_LDB(B1, 1, 1); PG8_STAGE(PG8_SB(1, 0), b3, voffB);
            PG8_BAR; PG8_WAIT_L(0); PG8_MMA(0, 1, At, B1); PG8_BAR;
            PG8_LDA(At, 1, 1); PG8_STAGE_A(PG8_SA(1, 0), a3, as[0]);
            PG8_BAR; PG8_WAIT_L(0); PG8_MMA(1, 0, At, B0); PG8_BAR; PG8_SCHED;
            PG8_STAGE(PG8_SB(1, 1), b3 + hstep, voffB);
            PG8_WAIT_V(6); PG8_BAR; PG8_MMA(1, 1, At, B1); PG8_BAR;
            }
        }
        if constexpr (ALIGN_EPI) { if (wr == 0) PG8_BAR; }
        if constexpr (!Epi::AFTER_DRAIN) { E(acc, cur, wr, wc, fr, fq); S.done(cur); }
        if (!has_next) break;
#pragma unroll
        for (int a = 0; a < 2; ++a)
#pragma unroll
            for (int b = 0; b < 2; ++b)
#pragma unroll
                for (int m = 0; m < 4; ++m)
#pragma unroll
                    for (int n = 0; n < 2; ++n) acc[a][b][m][n] = (f32x4){0.f, 0.f, 0.f, 0.f};
        cur = nxt; cB = nB; ++ui;
#pragma unroll
        for (int h_ = 0; h_ < 2; ++h_)
#pragma unroll
            for (int i_ = 0; i_ < 2; ++i_) ao[h_][i_] = an[h_][i_];
        if constexpr (ALIGN_EPI) { if (wr == 1) PG8_BAR; }
    }
    PG8_WAIT_V(0);
    if constexpr (!ALIGN_EPI) { if (wr == 0) PG8_BAR; }
    PG8_BAR;
    if constexpr (Epi::AFTER_DRAIN) { E.fused(acc, cur, wr, wc, fr, fq, lds, wid, lane); S.done(cur); }
#undef PG8_SA
#undef PG8_SB
#undef PG8_STAGE
#undef PG8_STAGE_A
#undef PG8_AOFF
#undef PG8_LDA
#undef PG8_LDB
#undef PG8_MMA
#undef PG8_WAIT_V
#undef PG8_WAIT_L
#undef PG8_BAR
#undef PG8_SCHED
}
}
constexpr int NWAVES = 8;
constexpr int RING_OFF = 0, RING_BYTES = 131072;
constexpr int LDSCTL_OFF = 150 * 1024, MISC_OFF = LDSCTL_OFF + 320;
constexpr int LDS_BYTES = 160 * 1024;
constexpr size_t MiB = 1u << 20;
constexpr size_t WS_CTL = 0, CTL_ZERO_BYTES = 1 * MiB;
constexpr size_t WS_MOD = 1 * MiB;
constexpr size_t WS_RWP = WS_MOD + 128 * 1024;
constexpr size_t WS_CS = 2 * MiB;
constexpr size_t WS_LOGF = 4 * MiB;
constexpr size_t WS_CB = WS_LOGF + 256 * 1024;
constexpr size_t WS_Z = WS_CB + 256 * 1024;
constexpr size_t WS_WIN = 6 * MiB;
constexpr size_t WS_WOUT = 34 * MiB;
constexpr size_t WS_HB = 42 * MiB;
constexpr size_t WS_QKV = 74 * MiB;
constexpr size_t TSZ = (size_t)16 * 4096 * 128;
constexpr size_t WS_FAST_END = 186 * MiB;
constexpr size_t WS_YB = 74 * MiB;
constexpr size_t WS_GB = 74 * MiB;
constexpr size_t WS_YS = 110 * MiB;
constexpr size_t WS_W13 = 266 * MiB;
constexpr size_t WS_W2 = 394 * MiB;
constexpr size_t WS_LIST = 458 * MiB;
constexpr size_t WS_SLOT = 459 * MiB;
constexpr size_t WS_END = 460 * MiB;
constexpr int ECAP = 8192, CW_CNT = 32768;
constexpr int CW_BAR = 4096;

struct Frame {
    LAS unsigned char* lds; char* ldsg;
    volatile LAS unsigned* MISC;
    gu32* ctl;
    int tid, lane, wave, G, gw, NGW, cnt_off;
    const float* in[22]; float* out; unsigned char* ws;
};
struct Args { const float* in[22]; float* out; unsigned char* ws; int ph_lo, ph_hi, cnt_off, pad; };

template <int CTRL> __device__ __forceinline__ float dppa(float v) { const int t = __builtin_amdgcn_update_dpp(0, __float_as_int(v), CTRL, 0xf, 0xf, true); return v + __int_as_float(t); }
__device__ __forceinline__ float row16_sum(float v) { v = dppa<0xB1>(v); v = dppa<0x4E>(v); v = dppa<0x141>(v); v = dppa<0x140>(v); return v; }
__device__ __forceinline__ float half32_sum(float v) { v = row16_sum(v); return v + __shfl_xor(v, 16); }
__device__ __forceinline__ float wave_sum(float v) {
    v = row16_sum(v);
    const float s0 = __int_as_float(__builtin_amdgcn_readlane(__float_as_int(v), 0)), s1 = __int_as_float(__builtin_amdgcn_readlane(__float_as_int(v), 16));
    const float s2 = __int_as_float(__builtin_amdgcn_readlane(__float_as_int(v), 32)), s3 = __int_as_float(__builtin_amdgcn_readlane(__float_as_int(v), 48));
    return (s0 + s1) + (s2 + s3);
}
__device__ __forceinline__ float silu_f(float v) { return v / (1.f + __expf(-v)); }

__device__ __forceinline__ void p0_mod(Frame& F) {
    const float* c = F.in[1]; const float* ada_w = F.in[2]; const float* ada_b = F.in[3];
    float* mod = (float*)(F.ws + WS_MOD);
    LAS float* ca = (LAS float*)(F.lds);
    LAS f32x4* red = (LAS f32x4*)(ca + 2 * DM);
    for (int i = F.tid; i < 2 * DM; i += NWAVES * 64) ca[i] = silu_f(c[i]);
    __syncthreads();
    const int rs = F.lane / 12, c4 = F.lane % 12;
    for (int cb = blockIdx.x; cb < 256; cb += F.G) {
        const int j0 = cb * 48;
        f32x4 a0 = {0.f, 0.f, 0.f, 0.f}, a1 = {0.f, 0.f, 0.f, 0.f};
        if (F.lane < 60) {
            const float* wp = ada_w + (size_t)(F.wave * 256) * (6 * DM) + j0 + 4 * c4;
#pragma unroll 1
            for (int i0 = 0; i0 < 52; i0 += 13) {
                f32x4 wv[13];
#pragma unroll
                for (int i = 0; i < 13; ++i) { const int kl = 5 * (i0 + i) + rs; wv[i] = kl < 256 ? *(const f32x4*)(wp + (size_t)kl * (6 * DM)) : (f32x4){0.f, 0.f, 0.f, 0.f}; }
#pragma unroll
                for (int i = 0; i < 13; ++i) { const int kl = 5 * (i0 + i) + rs; const int k = F.wave * 256 + (kl < 256 ? kl : 0); a0 += wv[i] * ca[k]; a1 += wv[i] * ca[DM + k]; }
            }
        }
        red[(F.wave * 64 + F.lane) * 2] = a0; red[(F.wave * 64 + F.lane) * 2 + 1] = a1;
        __syncthreads();
        if (F.tid < 96) { const int b = F.tid / 48, jj = F.tid % 48, cc = jj >> 2, el = jj & 3; float s = 0.f;
            for (int w = 0; w < NWAVES; ++w)
#pragma unroll
                for (int r = 0; r < 5; ++r) s += red[(w * 64 + r * 12 + cc) * 2 + b][el];
            mod[b * 6 * DM + j0 + jj] = s + ada_b[j0 + jj]; }
        __syncthreads();
    }
}
template <bool ROPE = false>
__device__ __forceinline__ void tr_tile(const float* __restrict__ src, int ldn, int k0, int n0, bf16* __restrict__ dst, int ldk, int drow0, LAS float* scr, int lane) {
#pragma unroll 4
    for (int i = 0; i < 16; ++i) { const int kk = 4 * i + (lane >> 4);
        const f32x4 v = *(const f32x4*)(src + (size_t)(k0 + kk) * ldn + n0 + 4 * (lane & 15));
        LAS float* p = scr + kk * 65 + 4 * (lane & 15); p[0] = v.x; p[1] = v.y; p[2] = v.z; p[3] = v.w; }
    LDS_WAIT(); asm volatile("" ::: "memory");
    const int c = lane & 7;
#pragma unroll
    for (int jj = 0; jj < 8; ++jj) { const int n = (lane >> 3) + 8 * jj; const LAS float* s = scr + (8 * c) * 65 + n;
        v4u o; o.x = pk2(s[0], s[65]); o.y = pk2(s[130], s[195]); o.z = pk2(s[260], s[325]); o.w = pk2(s[390], s[455]);
        int drow = drow0 + n;
        if (ROPE) { const int d = (n0 & 127) + n; drow = drow0 + 32 * ((d >> 4) & 3) + 8 * ((d >> 2) & 3) + 4 * (d >> 6) + (d & 3); }
        *(v4u*)(dst + (size_t)drow * ldk + k0 + 8 * c) = o; }
    LDS_WAIT(); asm volatile("" ::: "memory");
}
constexpr int CW_CONVQ = 2112, CW_DONE = 2176;
constexpr int I_E = 256 * NE, CONV_PER_WAVE = 2, N_CONV_BI = 3 * I_E / (NWAVES * CONV_PER_WAVE);
struct ConvTile { const float* src; bf16* dst; int ldn, ldk; };
__device__ __forceinline__ ConvTile conv_decode(Frame& F, int r) {
    ConvTile t;
    if (r < 2 * I_E) { const int which = r / I_E, rr = r % I_E, e = rr >> 8, q = rr & 255, kt = q >> 3, nt = q & 7;
        t.src = (which == 0 ? F.in[19] : F.in[20]) + (size_t)e * DM * DE + (size_t)(64 * kt) * DE + 64 * nt; t.ldn = DE;
        t.dst = (bf16*)(F.ws + WS_W13) + (size_t)(e * 1024 + (nt >> 1) * 256 + which * 128 + (nt & 1) * 64) * DM + 64 * kt; t.ldk = DM; return t; }
    r -= 2 * I_E;
    { const int e = r >> 8, q = r & 255, kt = q >> 5, nt = q & 31;
      t.src = F.in[21] + (size_t)e * DE * DM + (size_t)(64 * kt) * DM + 64 * nt; t.ldn = DM;
      t.dst = (bf16*)(F.ws + WS_W2) + (size_t)(e * 2048 + 64 * nt) * DE + 64 * kt; t.ldk = DE; }
    return t;
}
__device__ __forceinline__ void conv_load(const ConvTile& t, f32x4 (&v)[16], int lane) {
#pragma unroll
    for (int i = 0; i < 16; ++i) v[i] = *(const f32x4*)(t.src + (size_t)(4 * i + (lane >> 4)) * t.ldn + 4 * (lane & 15));
}
__device__ __forceinline__ void conv_store(const ConvTile& t, const f32x4 (&v)[16], LAS float* scr, int lane) {
#pragma unroll
    for (int i = 0; i < 16; ++i) { LAS float* p = scr + (4 * i + (lane >> 4)) * 65 + 4 * (lane & 15); p[0] = v[i].x; p[1] = v[i].y; p[2] = v[i].z; p[3] = v[i].w; }
    LDS_WAIT(); asm volatile("" ::: "memory");
    const int c = lane & 7;
#pragma unroll
    for (int jj = 0; jj < 8; ++jj) { const int n = (lane >> 3) + 8 * jj; const LAS float* s = scr + (8 * c) * 65 + n;
        v4u o; o.x = pk2(s[0], s[65]); o.y = pk2(s[130], s[195]); o.z = pk2(s[260], s[325]); o.w = pk2(s[390], s[455]);
        *(v4u*)(t.dst + (size_t)n * t.ldk + 8 * c) = o; }
    LDS_WAIT(); asm volatile("" ::: "memory");
}
constexpr int N_CONV_13 = 2 * I_E / (NWAVES * CONV_PER_WAVE);
__device__ __forceinline__ unsigned conv_pull(Frame& F, unsigned qlimit) {
    return __hip_atomic_fetch_add(F.ctl + CW_CONVQ, 1u, RLX_AGENT);
}
__device__ __forceinline__ void filler(Frame& F, int ph, int mode, unsigned nfin, unsigned early, unsigned qlimit) {
    __syncthreads();
    LAS float* scr = (LAS float*)(F.lds) + F.wave * (64 * 65);
    unsigned nxt = 0xffffffffu;
    if (F.tid == 0) { bool go = true;
        if (mode == 0) go = __hip_atomic_fetch_add(F.ctl + CW_DONE + 64 * ph, 1u, RLX_AGENT) < early;
        if (mode == 1) go = __hip_atomic_load(F.ctl + CW_DONE + 64 * ph, RLX_AGENT) < nfin;
        if (go) nxt = conv_pull(F, qlimit); }
    for (;;) {
        if (F.tid == 0) F.MISC[1] = nxt;
        __syncthreads();
        const unsigned it = F.MISC[1];
        __syncthreads();
        if (it >= (unsigned)N_CONV_BI) break;
        if (F.tid == 0) { const bool stop = mode != 2 && __hip_atomic_load(F.ctl + CW_DONE + 64 * ph, RLX_AGENT) >= nfin;
            nxt = stop ? 0xffffffffu : conv_pull(F, qlimit); }
        const int r0 = ((int)it * NWAVES + F.wave) * CONV_PER_WAVE;
        const ConvTile t0 = conv_decode(F, r0), t1 = conv_decode(F, r0 + 1);
        f32x4 va[16], vb[16];
        conv_load(t0, va, F.lane); conv_load(t1, vb, F.lane);
        conv_store(t0, va, scr, F.lane); conv_store(t1, vb, scr, F.lane);
    }
}
template <bool EXPERTS>
__device__ __forceinline__ void p0_prologue(Frame& F) {
    p0_mod(F);
    __syncthreads();
    LAS float* scr = (LAS float*)(F.lds) + F.wave * (64 * 65);
    bf16* WinT = (bf16*)(F.ws + WS_WIN); bf16* WoutT = (bf16*)(F.ws + WS_WOUT);
    constexpr int I_IN = 32 * 112, I_OUT = 32 * 32;
    constexpr int NIT = I_IN + I_OUT;
    for (int it = F.gw; it < NIT; it += F.NGW) {
        int r = it;
        if (r < I_IN) { const int nt = r % 112;
            if (nt < 32) tr_tile<true>(F.in[6], INC, 64 * (r / 112), 64 * nt, WinT, DM, 128 * (nt >> 1), scr, F.lane);
            else tr_tile<false>(F.in[6], INC, 64 * (r / 112), 64 * nt, WinT, DM, 64 * nt, scr, F.lane);
            continue; } r -= I_IN;
        if (r < I_OUT) { tr_tile<false>(F.in[12], DM, 64 * (r / 32), 64 * (r % 32), WoutT, DM, 64 * (r % 32), scr, F.lane); continue; } r -= I_OUT;
    }
    { bf16* rh = (bf16*)(F.ws + WS_RWP); bf16* rl = rh + 48 * DM; const float* rcw = F.in[15]; const float* rfw = F.in[17];
      for (int idx = blockIdx.x * (NWAVES * 64) + F.tid; idx < 48 * DM; idx += F.G * NWAVES * 64) {
          const int o = idx >> 11, k = idx & 2047; const float v = o < 4 ? rcw[k * 4 + o] : (o < 36 ? rfw[k * 32 + (o - 4)] : 0.f);
          const unsigned h = f2bf(v); const float hf = __uint_as_float(h << 16);
          rh[idx] = (bf16)h; rl[idx] = (bf16)f2bf(v - hf); } }
    { float* cs = (float*)(F.ws + WS_CS);
      for (int idx = blockIdx.x * (NWAVES * 64) + F.tid; idx < SEQ * 64; idx += F.G * NWAVES * 64) {
          const int i = idx & 63, s = idx >> 6; const float inv_freq = powf(10000.f, -(float)(2 * i) / 128.f); const float ang = (float)s * inv_freq;
          cs[2 * idx] = cosf(ang); cs[2 * idx + 1] = sinf(ang); } }
}

__device__ __forceinline__ void p1_row(Frame& F, int row, const f32x4 (&v)[8], const LAS f32x4* wf, const LAS f32x4* par, bf16* Hb, float* logf, float* zb, const float* fbias) {
    const int b = row >> 12, s = row & 4095;
    float ss = 0.f;
#pragma unroll
    for (int j = 0; j < 8; ++j) ss += (v[j].x * v[j].x + v[j].y * v[j].y) + (v[j].z * v[j].z + v[j].w * v[j].w);
    const float rstd = rsqrtf(wave_sum(ss) * (1.f / DM) + EPS);
    float acc[8];
#pragma unroll
    for (int o = 0; o < 8; ++o) acc[o] = 0.f;
    unsigned long long* o8 = (unsigned long long*)(Hb + (size_t)row * DM) + F.lane;
#pragma unroll
    for (int j = 0; j < 8; ++j) {
        const f32x4 h = v[j] * rstd * par[(b * 2) * 512 + 64 * j + F.lane] + par[(b * 2 + 1) * 512 + 64 * j + F.lane];
        o8[64 * j] = (unsigned long long)pk2(h.x, h.y) | ((unsigned long long)pk2(h.z, h.w) << 32);
#pragma unroll
        for (int i = 0; i < 4; ++i) { const f32x4 wa = wf[((j * 4 + i) * 2 + 0) * 64 + F.lane], wb = wf[((j * 4 + i) * 2 + 1) * 64 + F.lane]; const float hv = h[i];
            acc[0] = fmaf(hv, wa.x, acc[0]); acc[1] = fmaf(hv, wa.y, acc[1]); acc[2] = fmaf(hv, wa.z, acc[2]); acc[3] = fmaf(hv, wa.w, acc[3]);
            acc[4] = fmaf(hv, wb.x, acc[4]); acc[5] = fmaf(hv, wb.y, acc[5]); acc[6] = fmaf(hv, wb.z, acc[6]); acc[7] = fmaf(hv, wb.w, acc[7]); }
        asm volatile("" ::: "memory");
    }
    float z = 0.f;
#pragma unroll
    for (int o = 0; o < 8; ++o) { const float t = wave_sum(acc[o]); z = (F.lane == o) ? t : z; }
    if (F.lane < 8) { const float zz = z + fbias[F.lane];
        logf[((size_t)b * NH + F.lane) * SEQ + s] = fminf(zz, 0.f) - log1pf(expf(-fabsf(zz)));
        zb[(size_t)row * 8 + F.lane] = z; }
}
__device__ __forceinline__ void p1_prenorm(Frame& F) {
    const float* x = F.in[0]; const float* wpre = F.in[4]; const float* w_in = F.in[6]; const float* fbias = F.in[7];
    const float* mod = (const float*)(F.ws + WS_MOD);
    bf16* Hb = (bf16*)(F.ws + WS_HB); float* logf = (float*)(F.ws + WS_LOGF); float* zb = (float*)(F.ws + WS_Z);
    LAS f32x4* wf = (LAS f32x4*)F.lds;
    LAS f32x4* par = wf + 4096;
    for (int idx = F.tid; idx < 4096; idx += NWAVES * 64) { const int l = idx & 63, half = (idx >> 6) & 1, i = (idx >> 7) & 3, j = idx >> 9;
        wf[idx] = *(const f32x4*)(w_in + (size_t)(256 * j + 4 * l + i) * INC + INCM + 4 * half); }
    for (int c = F.tid; c < 1024; c += NWAVES * 64) { const int b = c >> 9, cc = c & 511; const f32x4* mb = (const f32x4*)(mod + (size_t)b * 6 * DM);
        par[(b * 2) * 512 + cc] = ((const f32x4*)wpre)[cc] * (mb[512 + cc] + 1.0f); par[(b * 2 + 1) * 512 + cc] = mb[cc]; }
    LDS_WAIT(); __syncthreads();
    int row = F.gw; if (row >= T) return;
    f32x4 va[8], vb[8];
    { const f32x4* xr = (const f32x4*)(x + (size_t)row * DM) + F.lane;
#pragma unroll
      for (int j = 0; j < 8; ++j) va[j] = xr[64 * j]; }
    for (;;) {
        const int r1 = row + F.NGW;
        if (r1 < T) { const f32x4* xr = (const f32x4*)(x + (size_t)r1 * DM) + F.lane;
#pragma unroll
            for (int j = 0; j < 8; ++j) vb[j] = xr[64 * j]; }
        p1_row(F, row, va, wf, par, Hb, logf, zb, fbias);
        if (r1 >= T) break;
        const int r2 = r1 + F.NGW;
        if (r2 < T) { const f32x4* xr = (const f32x4*)(x + (size_t)r2 * DM) + F.lane;
#pragma unroll
            for (int j = 0; j < 8; ++j) va[j] = xr[64 * j]; }
        p1_row(F, r1, vb, wf, par, Hb, logf, zb, fbias);
        if (r2 >= T) break;
        row = r2;
    }
}

constexpr int EPI_SCR = RING_BYTES;
struct EpiHeads {
    static constexpr bool PERM = true, AFTER_DRAIN = false;
    bf16* base; const float* cs; const float* qn; const float* kn; LAS unsigned char* lds;
    __device__ __forceinline__ void operator()(const pg8::f32x4 (&acc)[2][2][4][2], const pg8::Unit& u, int wr, int wc, int fr, int fq) const {
        const int type = u.pn >> 2, head0 = (u.pn & 3) * 2; const int row0 = u.pm * 256 + wr * 64 + fr;
        if (type <= 1) {
            const int i0 = 16 * wc + 4 * fq; const float sc = type == 1 ? 0.08838834764831845f : 1.f;
#pragma unroll
            for (int ai = 0; ai < 2; ++ai)
#pragma unroll
                for (int m = 0; m < 4; ++m) { const int r = row0 + ai * 128 + m * 16, b = r >> 12, s = r & 4095;
                    const pg8::f32x4 c0 = *(const pg8::f32x4*)(cs + ((size_t)s * 64 + i0) * 2), c1 = *(const pg8::f32x4*)(cs + ((size_t)s * 64 + i0) * 2 + 4);
                    const float cv[4] = {c0[0], c0[2], c1[0], c1[2]}, sv[4] = {c0[1], c0[3], c1[1], c1[3]};
#pragma unroll
                    for (int bj = 0; bj < 2; ++bj) { const pg8::f32x4 x1 = acc[ai][bj][m][0], x2 = acc[ai][bj][m][1]; float o1[4], o2[4];
#pragma unroll
                        for (int j = 0; j < 4; ++j) { o1[j] = (x1[j] * cv[j] - x2[j] * sv[j]) * sc; o2[j] = (x1[j] * sv[j] + x2[j] * cv[j]) * sc; }
                        bf16* dst = base + (size_t)type * TSZ + ((size_t)((b * 8 + head0 + bj) * SEQ + s)) * HD + i0;
                        uint2 w1, w2; w1.x = pg8::cvt_pk_bf16(o1[0], o1[1]); w1.y = pg8::cvt_pk_bf16(o1[2], o1[3]); w2.x = pg8::cvt_pk_bf16(o2[0], o2[1]); w2.y = pg8::cvt_pk_bf16(o2[2], o2[3]);
                        *(uint2*)dst = w1; *(uint2*)(dst + 64) = w2; } }
            return;
        }
        float rs[2][4][2];
        if (type == 4 || type == 5) {
            LAS float* P = (LAS float*)(lds + EPI_SCR);
#pragma unroll
            for (int ai = 0; ai < 2; ++ai)
#pragma unroll
                for (int m = 0; m < 4; ++m)
#pragma unroll
                    for (int bj = 0; bj < 2; ++bj) { const pg8::f32x4 v0 = acc[ai][bj][m][0], v1 = acc[ai][bj][m][1];
                        float q = ((v0[0] * v0[0] + v0[1] * v0[1]) + (v0[2] * v0[2] + v0[3] * v0[3])) + ((v1[0] * v1[0] + v1[1] * v1[1]) + (v1[2] * v1[2] + v1[3] * v1[3]));
                        q += __shfl_xor(q, 16); q += __shfl_xor(q, 32);
                        if (fq == 0) P[((ai * 128 + wr * 64 + m * 16 + fr) * 2 + bj) * 4 + wc] = q; }
            asm volatile("s_waitcnt lgkmcnt(0)" ::: "memory"); __builtin_amdgcn_s_barrier(); asm volatile("" ::: "memory");
#pragma unroll
            for (int ai = 0; ai < 2; ++ai)
#pragma unroll
                for (int m = 0; m < 4; ++m)
#pragma unroll
                    for (int bj = 0; bj < 2; ++bj) { const pg8::f32x4 p4 = *(const LAS pg8::f32x4*)(P + ((ai * 128 + wr * 64 + m * 16 + fr) * 2 + bj) * 4);
                        rs[ai][m][bj] = rsqrtf(((p4[0] + p4[1]) + (p4[2] + p4[3])) * (1.f / 128.f) + EPS); }
            asm volatile("s_waitcnt lgkmcnt(0)" ::: "memory"); __builtin_amdgcn_s_barrier(); asm volatile("" ::: "memory");
        }
        pg8::f32x4 g0 = {1.f, 1.f, 1.f, 1.f}, g1 = {1.f, 1.f, 1.f, 1.f};
        if (type == 4 || type == 5) { const float* gp = (type == 4 ? qn : kn) + wc * 32 + 8 * fq; g0 = *(const pg8::f32x4*)gp; g1 = *(const pg8::f32x4*)(gp + 4); }
#pragma unroll
        for (int ai = 0; ai < 2; ++ai)
#pragma unroll
            for (int m = 0; m < 4; ++m) { const int r = row0 + ai * 128 + m * 16, b = r >> 12, s = r & 4095;
#pragma unroll
                for (int bj = 0; bj < 2; ++bj) { pg8::f32x4 v0 = acc[ai][bj][m][0], v1 = acc[ai][bj][m][1];
                    if (type == 4 || type == 5) { v0 = v0 * rs[ai][m][bj] * g0; v1 = v1 * rs[ai][m][bj] * g1; }
                    if (type == 3) {
#pragma unroll
                        for (int j = 0; j < 4; ++j) { v0[j] = v0[j] * __builtin_amdgcn_rcpf(1.f + __expf(-v0[j])); v1[j] = v1[j] * __builtin_amdgcn_rcpf(1.f + __expf(-v1[j])); } }
                    pg8::u32x4 w; w.x = pg8::cvt_pk_bf16(v0[0], v0[1]); w.y = pg8::cvt_pk_bf16(v0[2], v0[3]); w.z = pg8::cvt_pk_bf16(v1[0], v1[1]); w.w = pg8::cvt_pk_bf16(v1[2], v1[3]);
                    *(pg8::u32x4*)(base + (size_t)type * TSZ + ((size_t)((b * 8 + head0 + bj) * SEQ + s)) * HD + wc * 32 + 8 * fq) = w; } }
    }
};

namespace fox {
__device__ __forceinline__ int fox_tid() { int t = threadIdx.x; asm volatile("" : "+v"(t)); return t; }
typedef unsigned short bf16;
constexpr int D = 128, OLD = 2048;
constexpr bool WSKIP = false; constexpr float THR = 8.f;
constexpr float SCALE = 0.08838834764831845f;
constexpr int NW = 8, QBLK = 32, KVBLK = 64, QB = NW * QBLK;
constexpr int SHM_V = KVBLK * D * 2, SHM_K = KVBLK * D * 2;
constexpr int LDS_BYTES = 2 * SHM_V + 2 * SHM_K + NW * 64 * 4 + 2 * 64 * 4;
typedef short bf16x8 __attribute__((ext_vector_type(8)));
typedef short s16x4 __attribute__((ext_vector_type(4)));
typedef float f32x16 __attribute__((ext_vector_type(16)));
typedef float f32x4 __attribute__((ext_vector_type(4)));
typedef unsigned u32x4 __attribute__((ext_vector_type(4)));
template <class A, class Bt> struct same_t { static constexpr bool v = false; };
template <class A> struct same_t<A, A> { static constexpr bool v = true; };

#define KSWZ(row, colB) ((row) * 256 + ((colB) ^ (((row) & 7) << 4)))
#define SBAR() __builtin_amdgcn_sched_barrier(0)
__device__ __forceinline__ int v_st(int k, int c) { const int kk = (k & ~0xC) | ((k & 4) << 1) | ((k & 8) >> 1); return ((kk >> 3) * 4 + (c >> 5)) * 512 + ((kk & 7) * 32 + (c & 31)) * 2; }
__device__ __forceinline__ int v_rd_base(int lane) { return ((lane & 3) << 3) | (((lane >> 2) & 3) << 6) | (((lane >> 4) & 1) << 5) | (((lane >> 5) & 1) << 8); }
constexpr int v_rd_off(int d0, int ks, int half) { return d0 * 512 + ks * 4096 + half * 2048; }
__device__ __forceinline__ int crow(int r, int hi) { return (r & 3) + 8 * (r >> 2) + 4 * hi; }
__device__ __forceinline__ unsigned cvtpk(float lo, float hi) {
    unsigned r; asm volatile("v_cvt_pk_bf16_f32 %0, %1, %2" : "=v"(r) : "v"(lo), "v"(hi)); return r;
}
__device__ __forceinline__ bf16x8 pack8(f32x4 a, f32x4 b) {
    u32x4 w = {cvtpk(a[0], a[1]), cvtpk(a[2], a[3]), cvtpk(b[0], b[1]), cvtpk(b[2], b[3])};
    return *reinterpret_cast<bf16x8*>(&w);
}
template <class T> __device__ __forceinline__ bf16x8 load8(const T* p) {
    if constexpr (same_t<T, float>::v) { return pack8(*(const f32x4*)p, *(const f32x4*)(p + 4)); }
    else { return *reinterpret_cast<const bf16x8*>(p); }
}
__device__ __forceinline__ void mask_tile(f32x16& p0, f32x16& p1, int dq, unsigned W) {
    const float NEG = -__builtin_inff();
#pragma unroll
    for (int r = 0; r < 16; ++r) {
        const int c = (r & 3) + 8 * (r >> 2);
        if ((unsigned)(dq - c) >= W) p0[r] = NEG;
        if ((unsigned)(dq - c - 32) >= W) p1[r] = NEG;
    }
}
__device__ __forceinline__ void partialSM(f32x16& p0, f32x16& p1, float& m_reg, float& mn, float& alpha) {
    float pmax = p0[0]; for (int r = 1; r < 16; ++r) pmax = fmaxf(pmax, p0[r]); for (int r = 0; r < 16; ++r) pmax = fmaxf(pmax, p1[r]);
    { auto rr = __builtin_amdgcn_permlane32_swap(__float_as_uint(pmax), __float_as_uint(pmax), false, false);
      pmax = fmaxf(__uint_as_float(rr[0]), __uint_as_float(rr[1])); }
    constexpr float C2 = 1.4426950408889634f * SCALE;
    if (__builtin_expect(__all((pmax - m_reg) * SCALE <= THR), 1)) { mn = m_reg; alpha = 1.f; }
    else { mn = fmaxf(m_reg, pmax); alpha = __builtin_amdgcn_exp2f((m_reg - mn) * C2); m_reg = mn; }
    const float mnL = -mn * C2;
    for (int r = 0; r < 16; ++r) p0[r] = fmaf(p0[r], C2, mnL); for (int r = 0; r < 16; ++r) p1[r] = fmaf(p1[r], C2, mnL);
    for (int r = 0; r < 16; ++r) p0[r] = __builtin_amdgcn_exp2f(p0[r]);
}
__device__ __forceinline__ void finishSM(f32x16& p0, f32x16& p1, float alpha, float& l_reg, bf16x8& pa0, bf16x8& pa1, bf16x8& pa2, bf16x8& pa3) {
    for (int r = 0; r < 16; ++r) p1[r] = __builtin_amdgcn_exp2f(p1[r]);
    float ps = 0; for (int r = 0; r < 16; ++r) ps += p0[r]; for (int r = 0; r < 16; ++r) ps += p1[r];
    { auto rr = __builtin_amdgcn_permlane32_swap(__float_as_uint(ps), __float_as_uint(ps), false, false);
      ps = __uint_as_float(rr[0]) + __uint_as_float(rr[1]); }
    l_reg = l_reg * alpha + ps;
#define PK4(P, B_, OUT) do { unsigned a0 = cvtpk(P[B_+0], P[B_+1]), a1 = cvtpk(P[B_+2], P[B_+3]);                          \
        unsigned b0 = cvtpk(P[B_+4], P[B_+5]), b1 = cvtpk(P[B_+6], P[B_+7]);                                             \
        auto r0 = __builtin_amdgcn_permlane32_swap(a0, b0, false, false); auto r1 = __builtin_amdgcn_permlane32_swap(a1, b1, false, false); \
        u32x4 w = {r0[0], r1[0], r0[1], r1[1]}; OUT = *reinterpret_cast<bf16x8*>(&w); } while (0)
    PK4(p0, 0, pa0); PK4(p0, 8, pa1); PK4(p1, 0, pa2); PK4(p1, 8, pa3);
#undef PK4
}
template <int KB, bool SK>
__device__ __forceinline__ void qkt(f32x16& p0, f32x16& p1, const char* K_lds, int r32, int hi, const bf16x8* qr, bool act) {
    if (SK && !act) { const float NEG = -__builtin_inff();
#pragma unroll
        for (int r = 0; r < 16; ++r) { p0[r] = NEG; p1[r] = NEG; } return; }
    { const float* bl = (const float*)(K_lds + 2 * SHM_K + NW * 64 * 4) + KB * 64 + 4 * hi;
#pragma unroll
      for (int g = 0; g < 4; ++g) { const f32x4 b0 = *(const f32x4*)(bl + 8 * g), b1 = *(const f32x4*)(bl + 32 + 8 * g);
          p0[4 * g] = b0[0]; p0[4 * g + 1] = b0[1]; p0[4 * g + 2] = b0[2]; p0[4 * g + 3] = b0[3]; p1[4 * g] = b1[0]; p1[4 * g + 1] = b1[1]; p1[4 * g + 2] = b1[2]; p1[4 * g + 3] = b1[3]; } }
    const char* kb[4];
#pragma unroll
    for (int dd = 0; dd < 4; ++dd) kb[dd] = K_lds + KB * SHM_K + KSWZ(r32, (dd * 16 + hi * 8) * 2);
#pragma unroll
    for (int d0 = 0; d0 < 8; ++d0) { const char* a = kb[d0 & 3] + (d0 >> 2) * 128;
        bf16x8 b0 = *reinterpret_cast<const bf16x8*>(a);
        bf16x8 b1 = *reinterpret_cast<const bf16x8*>(a + 32 * 256);
        p0 = __builtin_amdgcn_mfma_f32_32x32x16_bf16(b0, qr[d0], p0, 0, 0, 0);
        p1 = __builtin_amdgcn_mfma_f32_32x32x16_bf16(b1, qr[d0], p1, 0, 0, 0); }
}
template <int VB, bool SK>
__device__ __forceinline__ void pv_tile(f32x16* o, int vb0, bf16x8 pa0, bf16x8 pa1, bf16x8 pa2, bf16x8 pa3, bool act) {
    if (SK && !act) return;
#define TRRD(dst, off) asm volatile("ds_read_b64_tr_b16 %0, %1 offset:%2" : "=&v"(dst) : "v"(vb0), "i"(off) : "memory")
#define PV_D0(d0) do { s16x4 l0, l1, l2, l3, h0, h1, h2, h3; constexpr int b_ = VB * SHM_V + v_rd_off(d0, 0, 0);     \
        TRRD(l0, b_); TRRD(h0, b_ + 2048); TRRD(l1, b_ + 4096); TRRD(h1, b_ + 6144); TRRD(l2, b_ + 8192); TRRD(h2, b_ + 10240); TRRD(l3, b_ + 12288); TRRD(h3, b_ + 14336); \
        asm volatile("s_waitcnt lgkmcnt(0)" ::: "memory"); SBAR();                 \
        o[d0] = __builtin_amdgcn_mfma_f32_32x32x16_bf16(pa0, (bf16x8){l0[0], l0[1], l0[2], l0[3], h0[0], h0[1], h0[2], h0[3]}, o[d0], 0, 0, 0);   \
        o[d0] = __builtin_amdgcn_mfma_f32_32x32x16_bf16(pa1, (bf16x8){l1[0], l1[1], l1[2], l1[3], h1[0], h1[1], h1[2], h1[3]}, o[d0], 0, 0, 0);   \
        o[d0] = __builtin_amdgcn_mfma_f32_32x32x16_bf16(pa2, (bf16x8){l2[0], l2[1], l2[2], l2[3], h2[0], h2[1], h2[2], h2[3]}, o[d0], 0, 0, 0);   \
        o[d0] = __builtin_amdgcn_mfma_f32_32x32x16_bf16(pa3, (bf16x8){l3[0], l3[1], l3[2], l3[3], h3[0], h3[1], h3[2], h3[3]}, o[d0], 0, 0, 0); } while (0)
    PV_D0(0); PV_D0(1); PV_D0(2); PV_D0(3);
#undef PV_D0
#undef TRRD
}

template <class TIn, class TOut> struct BlockRef { const TIn* Q; const TIn* K; const TIn* V; TOut* O; const float* cb; const float* onw; int P0; };
template <class TIn> struct Seam {
    bf16x8 qr[8];
    bf16x8 st_v0, st_v1, st_k0, st_k1; float st_b; f32x4 sf0, sf1, sf2, sf3;
    f32x4 tq[16];
};
__device__ __forceinline__ int swa_jlo(int P0, int W) { const int lowk = P0 - W + 1; return lowk > 0 ? lowk / KVBLK : 0; }
#define ROW(p, k0, rr) ((p) + (size_t)((k0) + (rr)) * D + sc)
#define VMW() asm volatile("s_waitcnt vmcnt(0)" ::: "memory")
#define VMWN(n) asm volatile("s_waitcnt vmcnt(%0)" :: "i"(n) : "memory")
#define SLOAD_H(Kp, Vp, Bp, k0) do { S.st_v0 = load8<TIn>(ROW(Vp, k0, sr)); S.st_v1 = load8<TIn>(ROW(Vp, k0, 32 + sr));              \
                         S.st_k0 = load8<TIn>(ROW(Kp, k0, sr)); S.st_k1 = load8<TIn>(ROW(Kp, k0, 32 + sr)); S.st_b = (Bp)[(k0) + (tid & 63)]; } while (0)
#define SWRITE_HK(bf) do { *(bf16x8*)(K_lds + (bf) * SHM_K + kws) = S.st_k0; *(bf16x8*)(K_lds + (bf) * SHM_K + kws + 32 * 256) = S.st_k1; \
                           if (tid < 64) ((float*)(K_lds + 2 * SHM_K + NW * 64 * 4))[(bf) * 64 + tid] = S.st_b; } while (0)
#define SWRITE_HV(bf) do { *(bf16x8*)(V_lds + (bf) * SHM_V + vst0) = S.st_v0; *(bf16x8*)(V_lds + (bf) * SHM_V + vst1) = S.st_v1; } while (0)
#define SWRITE_H(bf) do { SWRITE_HV(bf); SWRITE_HK(bf); } while (0)
#define SLOAD_F(p, k0) do { S.sf0 = *(const f32x4*)ROW(p, k0, sr); S.sf1 = *(const f32x4*)(ROW(p, k0, sr) + 4);                \
                            S.sf2 = *(const f32x4*)ROW(p, k0, 32 + sr); S.sf3 = *(const f32x4*)(ROW(p, k0, 32 + sr) + 4); } while (0)
#define SWRITE_KF(bf) do { *(bf16x8*)(K_lds + (bf) * SHM_K + kws) = pack8(S.sf0, S.sf1); *(bf16x8*)(K_lds + (bf) * SHM_K + kws + 32 * 256) = pack8(S.sf2, S.sf3); } while (0)
#define SWRITE_VF(bf) do { *(bf16x8*)(V_lds + (bf) * SHM_V + vst0) = pack8(S.sf0, S.sf1); *(bf16x8*)(V_lds + (bf) * SHM_V + vst1) = pack8(S.sf2, S.sf3); } while (0)
template <class TIn, class TOut>
__device__ __forceinline__ void causal_swa_prime(const BlockRef<TIn, TOut>& cur, int W, char* lds, Seam<TIn>& S) {
    constexpr bool F32 = same_t<TIn, float>::v;
    const int tid = fox_tid(), wid = __builtin_amdgcn_readfirstlane(tid >> 6), lane = tid & 63, r32 = lane & 31, hi = lane >> 5;
    const int sr = tid >> 4, sc = (tid & 15) * 8, kws = KSWZ(sr, sc * 2); char* K_lds = lds + 2 * SHM_V;
    const int kb0 = swa_jlo(cur.P0, W) * KVBLK;
    for (int d0 = 0; d0 < 8; ++d0) S.qr[d0] = load8<TIn>(cur.Q + (size_t)(wid * QBLK + r32) * D + d0 * 16 + hi * 8);
    if constexpr (F32) { SLOAD_F((const float*)cur.K, kb0); VMW(); SWRITE_KF(0); SBAR(); SLOAD_F((const float*)cur.V, kb0); }
    else { SLOAD_H(cur.K, cur.V, cur.cb, kb0); VMW(); SWRITE_HK(0); }
    __syncthreads();
}
template <class TIn, class TOut>
__device__ __forceinline__ void causal_swa_block(const BlockRef<TIn, TOut>& cur, const BlockRef<TIn, TOut>& nxt, int skv, int W, char* lds, Seam<TIn>& S) {
    constexpr bool F32 = same_t<TIn, float>::v;
    const int tid = fox_tid(), wid = __builtin_amdgcn_readfirstlane(tid >> 6), lane = tid & 63, r32 = lane & 31, hi = lane >> 5;
    const int j_lo = swa_jlo(cur.P0, W);
    int j_hi = (cur.P0 + QB - 1) / KVBLK + 1; if (j_hi > skv / KVBLK) j_hi = skv / KVBLK;
    const int NT = j_hi - j_lo;
    const int kbn = swa_jlo(nxt.P0, W) * KVBLK;
    const int qlo = cur.P0 + wid * QBLK, qm = qlo + r32 - 4 * hi;
    char* V_lds = lds; char* K_lds = lds + 2 * SHM_V;
    float* ws = (float*)(lds + 2 * SHM_V + 2 * SHM_K) + wid * 64; float* li_l = ws, * al_l = ws + 32;
    float m_reg = -1e30f, l_reg = 0; f32x16 o[4] = {};
    const int sr = tid >> 4, sc = (tid & 15) * 8, vst0 = v_st(sr, sc), vst1 = v_st(32 + sr, sc), kws = KSWZ(sr, sc * 2);
    const int vb0 = (int)(uintptr_t)V_lds + v_rd_base(lane);
    const TIn* Kh = cur.K; const TIn* Vh = cur.V;
#define RESC(a) do { if (__any((a) < 1.f)) { if (hi == 0) al_l[r32] = (a); asm volatile("s_waitcnt lgkmcnt(0)" ::: "memory");              \
                     for (int d_ = 0; d_ < 4; ++d_) for (int r = 0; r < 16; ++r) o[d_][r] *= al_l[crow(r, hi)]; } } while (0)
#define KBASE(t) ((j_lo + (t)) * KVBLK)
#define ACT(t) (KBASE(t) <= qlo + QBLK - 1 && KBASE(t) + KVBLK - 1 >= qlo - W + 1)
#define MASKT(P0_, P1_, t) do { const int kb_ = KBASE(t); if ((!SK || ACT(t)) && (kb_ + KVBLK - 1 > qlo || kb_ <= qlo + QBLK - 1 - W)) mask_tile(P0_, P1_, qm - kb_, (unsigned)W); } while (0)
    constexpr int NQL = F32 ? 16 : 8;
    constexpr bool SK = WSKIP && !F32;
#define SEAM_K0() do { VMWN(NQL); if constexpr (F32) { SWRITE_KF(0); SBAR(); SLOAD_F((const float*)nxt.V, kbn); } else { SWRITE_HK(0); } SBAR(); } while (0)
    f32x16 pA0, pA1, pB0, pB1; float mnA, mnB, alA, alB; bf16x8 pa0, pa1, pa2, pa3;
    if constexpr (F32) { VMW(); SWRITE_VF(0); SBAR(); } else { SWRITE_HV(0); SBAR(); }
    if (NT > 1) { if constexpr (F32) SLOAD_F((const float*)Kh, KBASE(1)); else SLOAD_H(Kh, Vh, cur.cb, KBASE(1)); }
    SBAR(); qkt<0, SK>(pA0, pA1, K_lds, r32, hi, S.qr, ACT(0));
    if constexpr (F32) { if (NT > 1) { VMW(); SWRITE_KF(1); SBAR(); SLOAD_F((const float*)Vh, KBASE(1)); } }
    MASKT(pA0, pA1, 0); partialSM(pA0, pA1, m_reg, mnA, alA);
    if (NT > 1) { VMW(); if constexpr (F32) { SWRITE_VF(1); SBAR(); if (NT > 2) SLOAD_F((const float*)Kh, KBASE(2)); } else SWRITE_H(1); }
    __syncthreads();
#define HALF_STEP(PX0, PX1, mnX, alX, PY0, PY1, alY, t, KB, VB, SB) do {                                                      \
        SBAR(); qkt<KB, SK>(PX0, PX1, K_lds, r32, hi, S.qr, ACT(t));                                             \
        finishSM(PY0, PY1, alY, l_reg, pa0, pa1, pa2, pa3); SBAR();                                                           \
        if ((t) + 1 < NT) { if constexpr (F32) { VMW(); SWRITE_KF(SB); SBAR(); SLOAD_F((const float*)Vh, KBASE((t) + 1)); }  \
                            else { SLOAD_H(Kh, Vh, cur.cb, KBASE((t) + 1)); } SBAR(); }                                               \
        pv_tile<VB, SK>(o, vb0, pa0, pa1, pa2, pa3, ACT((t) - 1)); MASKT(PX0, PX1, (t)); partialSM(PX0, PX1, m_reg, mnX, alX);                                        \
        __syncthreads();                                                                                                      \
        if ((t) + 1 < NT) { VMW(); if constexpr (F32) { SWRITE_VF(SB); SBAR(); if ((t) + 2 < NT) SLOAD_F((const float*)Kh, KBASE((t) + 2)); } \
                            else { SWRITE_H(SB); } }                                                                          \
        RESC(alX); __syncthreads(); } while (0)
    for (int t = 1; t + 1 < NT; t += 2) {
        HALF_STEP(pB0, pB1, mnB, alB, pA0, pA1, alA, t, 1, 0, 0);
        HALF_STEP(pA0, pA1, mnA, alA, pB0, pB1, alB, t + 1, 0, 1, 1);
    }
    const bool even = (NT & 1) == 0;
    if (even) { SBAR(); qkt<1, SK>(pB0, pB1, K_lds, r32, hi, S.qr, ACT(NT - 1)); SBAR(); }
#define QROW(e) (nxt.Q + (size_t)(wid * QBLK + r32) * D + ((e) >> 1) * 16 + hi * 8 + ((e) & 1) * 4)
    if constexpr (F32) { SLOAD_F((const float*)nxt.K, kbn); SBAR();
#pragma unroll
        for (int e = 0; e < 8; ++e) S.tq[e] = *(const f32x4*)QROW(e); }
    else { SLOAD_H(nxt.K, nxt.V, nxt.cb, kbn); SBAR();
#pragma unroll
        for (int d0 = 0; d0 < 8; ++d0) S.qr[d0] = load8<TIn>(nxt.Q + (size_t)(wid * QBLK + r32) * D + d0 * 16 + hi * 8); }
    SBAR();
    finishSM(pA0, pA1, alA, l_reg, pa0, pa1, pa2, pa3); SBAR();
    if constexpr (F32) {
#pragma unroll
        for (int e = 8; e < 16; ++e) S.tq[e] = *(const f32x4*)QROW(e); SBAR(); }
#undef QROW
    pv_tile<0, SK>(o, vb0, pa0, pa1, pa2, pa3, ACT(even ? NT - 2 : NT - 1));
    if (even) { MASKT(pB0, pB1, NT - 1); partialSM(pB0, pB1, m_reg, mnB, alB); __syncthreads(); RESC(alB);
        finishSM(pB0, pB1, alB, l_reg, pa0, pa1, pa2, pa3); SBAR(); pv_tile<1, SK>(o, vb0, pa0, pa1, pa2, pa3, ACT(NT - 1)); }
    SBAR(); SEAM_K0();
    if (hi == 0) li_l[r32] = l_reg; asm volatile("s_waitcnt lgkmcnt(0)" ::: "memory");
    { float gw[4];
#pragma unroll
      for (int d0 = 0; d0 < 4; ++d0) gw[d0] = cur.onw[d0 * 32 + r32];
      TOut* Ow = cur.O + (size_t)(wid * QBLK) * OLD;
#pragma unroll
      for (int r = 0; r < 16; ++r) { const int orow = crow(r, hi); const float rl = __builtin_amdgcn_rcpf(li_l[orow]);
          float v[4]; float ss = 0.f;
#pragma unroll
          for (int d0 = 0; d0 < 4; ++d0) { v[d0] = o[d0][r] * rl; ss += v[d0] * v[d0]; }
          ss = half32_sum(ss);
          const float rs = rsqrtf(ss * (1.f / 128.f) + 1e-6f);
#pragma unroll
          for (int d0 = 0; d0 < 4; ++d0) { const float y = v[d0] * rs * gw[d0]; const float yn = __shfl_xor(y, 1);
              if ((r32 & 1) == 0) *(unsigned*)(Ow + (size_t)orow * OLD + d0 * 32 + r32) = cvtpk(y, yn); } } }
    if constexpr (F32) {
#pragma unroll
        for (int d0 = 0; d0 < 8; ++d0) S.qr[d0] = pack8(S.tq[2 * d0], S.tq[2 * d0 + 1]); }
    __syncthreads();
#undef RESC
#undef KBASE
#undef ACT
#undef MASKT
#undef SEAM_K0
#undef HALF_STEP
}
#undef ROW
#undef VMW
#undef VMWN
#undef SLOAD_H
#undef SWRITE_HK
#undef SWRITE_HV
#undef SWRITE_H
#undef SLOAD_F
#undef SWRITE_KF
#undef SWRITE_VF


#undef KSWZ
#undef SBAR
}
constexpr size_t WS_KV = 186 * MiB;
constexpr size_t WS_SP = 218 * MiB;
constexpr size_t WS_CAT = 234 * MiB;
constexpr size_t WS_P34_END = 266 * MiB;
constexpr int CW_RETQ = 2048;
typedef short v4i16_t __attribute__((ext_vector_type(4)));
typedef float f32x16 __attribute__((ext_vector_type(16)));
constexpr int TLD = 136;
constexpr int TILE_EL = 128 * TLD;

__device__ __forceinline__ bf16x8 frag_row(const LAS bf16* X, int r0, int k0, int lane) {
    return *(const LAS bf16x8*)(X + (r0 + (lane & 31)) * TLD + k0 + 8 * (lane >> 5));
}
__device__ __forceinline__ bf16x8 frag_tr(const LAS bf16* X, int k0, int c0, int lane) {
    const int g = lane >> 4, i = lane & 15, q = i >> 2, p = i & 3, h = g >> 1;
    const LAS bf16* a = X + (k0 + 8 * h + q) * TLD + c0 + 16 * (g & 1) + 4 * p;
    const v4i16_t lo = __builtin_amdgcn_ds_read_tr16_b64_v4i16((LAS v4i16_t*)a);
    const v4i16_t hi = __builtin_amdgcn_ds_read_tr16_b64_v4i16((LAS v4i16_t*)(a + 4 * TLD));
    return (bf16x8){lo[0], lo[1], lo[2], lo[3], hi[0], hi[1], hi[2], hi[3]};
}
__device__ __forceinline__ int crow16(int r, int hi) { return (r & 3) + 8 * (r >> 2) + 4 * hi; }
__device__ __forceinline__ float bf2f(unsigned short v) { return __uint_as_float((unsigned)v << 16); }
__device__ __forceinline__ float ret_lg2(int h) { return log1pf(-exp2f(-5.f - (float)h)) * 1.4426950408889634f; }

__device__ __forceinline__ void p3_item(Frame& F, int bh, int n) {
    const int h = bh & 7, tid = F.tid, lane = F.lane, w = F.wave;
    const bf16* qkv = (const bf16*)(F.ws + WS_QKV);
    const size_t rbase = ((size_t)bh * SEQ + (size_t)n * 128) * HD;
    const bf16* RK = qkv + 1 * TSZ + rbase; const bf16* RV = qkv + 2 * TSZ + rbase;
    LAS bf16* Kz = (LAS bf16*)F.lds; LAS bf16* Vt = Kz + TILE_EL;
    const float lg2 = ret_lg2(h);
#pragma unroll
    for (int j = 0; j < 4; ++j) { const int c = tid + 512 * j, row = c >> 4, col8 = (c & 15) * 8;
        *(LAS v4u*)(Vt + row * TLD + col8) = *(const v4u*)(RV + (size_t)row * HD + col8);
        const bf16x8 k = *(const bf16x8*)(RK + (size_t)row * HD + col8); const float zeta = exp2f(lg2 * (float)(127 - row)); float kv[8];
#pragma unroll
        for (int i = 0; i < 8; ++i) kv[i] = bf2f((unsigned short)k[i]) * zeta;
        v4u o; o.x = pk2(kv[0], kv[1]); o.y = pk2(kv[2], kv[3]); o.z = pk2(kv[4], kv[5]); o.w = pk2(kv[6], kv[7]);
        *(LAS v4u*)(Kz + row * TLD + col8) = o; }
    LDS_WAIT(); __syncthreads();
    { const int db = w >> 1, eb = 2 * (w & 1), hi = lane >> 5;
      f32x16 a0 = {}, a1 = {};
#pragma unroll
      for (int kk = 0; kk < 8; ++kk) { const bf16x8 a = frag_tr(Kz, 16 * kk, 32 * db, lane), b0 = frag_tr(Vt, 16 * kk, 32 * eb, lane), b1 = frag_tr(Vt, 16 * kk, 32 * eb + 32, lane);
          a0 = __builtin_amdgcn_mfma_f32_32x32x16_bf16(a, b0, a0, 0, 0, 0); a1 = __builtin_amdgcn_mfma_f32_32x32x16_bf16(a, b1, a1, 0, 0, 0); }
      float* KV = (float*)(F.ws + WS_KV) + ((size_t)bh * 32 + n) * 16384;
#pragma unroll
      for (int r = 0; r < 16; ++r) { const int d = 32 * db + crow16(r, hi); KV[d * 128 + 32 * eb + (lane & 31)] = a0[r]; KV[d * 128 + 32 * eb + 32 + (lane & 31)] = a1[r]; } }
    LDS_WAIT(); __syncthreads();
}
__device__ __forceinline__ void p3_cumsum(Frame& F, int bh) {
    const float* lf = (const float*)(F.ws + WS_LOGF) + (size_t)bh * SEQ + 64 * F.lane; float* cb = (float*)(F.ws + WS_CB) + (size_t)bh * SEQ + 64 * F.lane;
    float tot = 0.f;
#pragma unroll 8
    for (int i = 0; i < 64; ++i) tot += lf[i];
    float incl = tot;
#pragma unroll
    for (int o = 1; o < 64; o <<= 1) { const float t = __shfl_up(incl, o); if (F.lane >= o) incl += t; }
    float run = incl - tot;
#pragma unroll 8
    for (int i = 0; i < 64; ++i) { run += lf[i]; cb[i] = -run * 11.313708498984761f; }
}
__device__ __forceinline__ void p3_phase(Frame& F) {
    if (F.wave == 0) for (int bh = blockIdx.x; bh < 16; bh += F.G) p3_cumsum(F, bh);
    for (int it = blockIdx.x; it < 512; it += F.G) p3_item(F, it >> 5, it & 31);
}
__device__ __forceinline__ void p3b_scan(Frame& F) {
    const float* KV = (const float*)(F.ws + WS_KV); bf16* SP = (bf16*)(F.ws + WS_SP);
    for (int idx = blockIdx.x * (NWAVES * 64) + F.tid; idx < 16 * 16384; idx += F.G * NWAVES * 64) {
        const int bh = idx >> 14, de = idx & 16383; const float cd = exp2f(ret_lg2(bh & 7) * 128.f);
        float st = 0.f;
        for (int n = 0; n < 32; ++n) { const size_t o = ((size_t)bh * 32 + n) * 16384 + de; SP[o] = (bf16)f2bf(st); st = st * cd + KV[o]; }
    }
}
__device__ __forceinline__ void ret_item(Frame& F, int bh, int n) {
    const int h = bh & 7, b = bh >> 3, tid = F.tid, lane = F.lane, w = F.wave, hi = lane >> 5, c32 = lane & 31;
    const bf16* qkv = (const bf16*)(F.ws + WS_QKV);
    const size_t rbase = ((size_t)bh * SEQ + (size_t)n * 128) * HD;
    const bf16* RQ = qkv + 0 * TSZ + rbase; const bf16* RK = qkv + 1 * TSZ + rbase; const bf16* RV = qkv + 2 * TSZ + rbase; const bf16* RG = qkv + 3 * TSZ + rbase;
    const bf16* SPg = (const bf16*)(F.ws + WS_SP) + ((size_t)bh * 32 + n) * 16384;
    LAS bf16* Qs = (LAS bf16*)F.lds; LAS bf16* Ks = Qs + TILE_EL; LAS bf16* Vs = Ks + TILE_EL; LAS bf16* Ss = Vs + TILE_EL;
    LAS float* st = (LAS float*)(Ss + TILE_EL);
#pragma unroll
    for (int j = 0; j < 4; ++j) { const int c = tid + 512 * j, row = c >> 4, col8 = (c & 15) * 8; const size_t go = (size_t)row * HD + col8; const int lo = row * TLD + col8;
        *(LAS v4u*)(Qs + lo) = *(const v4u*)(RQ + go); *(LAS v4u*)(Ks + lo) = *(const v4u*)(RK + go);
        *(LAS v4u*)(Vs + lo) = *(const v4u*)(RV + go); *(LAS v4u*)(Ss + lo) = *(const v4u*)(SPg + go); }
    LDS_WAIT(); __syncthreads();
    const int qb = w >> 1, cb2 = 2 * (w & 1);
    const float lg2 = ret_lg2(h);
    f32x16 s0 = {}, s1 = {};
#pragma unroll
    for (int kk = 0; kk < 8; ++kk) { const bf16x8 a = frag_row(Qs, 32 * qb, 16 * kk, lane), b0 = frag_row(Ks, 32 * cb2, 16 * kk, lane), b1 = frag_row(Ks, 32 * cb2 + 32, 16 * kk, lane);
        s0 = __builtin_amdgcn_mfma_f32_32x32x16_bf16(a, b0, s0, 0, 0, 0); s1 = __builtin_amdgcn_mfma_f32_32x32x16_bf16(a, b1, s1, 0, 0, 0); }
    const int key0 = 32 * cb2 + c32, key1 = key0 + 32;
    const float f0 = exp2f(-lg2 * (float)(key0 + 1)), f1 = exp2f(-lg2 * (float)(key1 + 1));
    LDS_WAIT(); __syncthreads();
#pragma unroll
    for (int r = 0; r < 16; ++r) { const int q = 32 * qb + crow16(r, hi);
        Ks[q * TLD + key0] = (bf16)f2bf(key0 <= q ? s0[r] * f0 : 0.f); Ks[q * TLD + key1] = (bf16)f2bf(key1 <= q ? s1[r] * f1 : 0.f); }
    LDS_WAIT(); __syncthreads();
    f32x16 o0 = {}, o1 = {};
#pragma unroll
    for (int kk = 0; kk < 8; ++kk) { const bf16x8 a = frag_row(Ks, 32 * qb, 16 * kk, lane), b0 = frag_tr(Vs, 16 * kk, 32 * cb2, lane), b1 = frag_tr(Vs, 16 * kk, 32 * cb2 + 32, lane);
        o0 = __builtin_amdgcn_mfma_f32_32x32x16_bf16(a, b0, o0, 0, 0, 0); o1 = __builtin_amdgcn_mfma_f32_32x32x16_bf16(a, b1, o1, 0, 0, 0); }
#pragma unroll
    for (int kk = 0; kk < 8; ++kk) { const bf16x8 a = frag_row(Qs, 32 * qb, 16 * kk, lane), b0 = frag_tr(Ss, 16 * kk, 32 * cb2, lane), b1 = frag_tr(Ss, 16 * kk, 32 * cb2 + 32, lane);
        o0 = __builtin_amdgcn_mfma_f32_32x32x16_bf16(a, b0, o0, 0, 0, 0); o1 = __builtin_amdgcn_mfma_f32_32x32x16_bf16(a, b1, o1, 0, 0, 0); }
#pragma unroll
    for (int r = 0; r < 16; ++r) { const int q = 32 * qb + crow16(r, hi); const float xi = exp2f(lg2 * (float)(q + 1));
        o0[r] *= xi; o1[r] *= xi;
        float s = o0[r] + o1[r], ss = o0[r] * o0[r] + o1[r] * o1[r];
        s = half32_sum(s); ss = half32_sum(ss);
        if (c32 == 0) { st[q * 4 + (w & 1) * 2] = s; st[q * 4 + (w & 1) * 2 + 1] = ss; } }
    LDS_WAIT(); __syncthreads();
    { const float* gn = F.in[8] + h * 128; const float g0 = gn[key0], g1 = gn[key1];
      bf16* CAT = (bf16*)(F.ws + WS_CAT) + ((size_t)b * SEQ + (size_t)n * 128) * DM + h * 128;
#pragma unroll
      for (int r = 0; r < 16; ++r) { const int q = 32 * qb + crow16(r, hi);
          const float s = st[q * 4] + st[q * 4 + 2], ss = st[q * 4 + 1] + st[q * 4 + 3];
          const float mu = s * (1.f / 128.f), var = fmaxf(ss * (1.f / 128.f) - mu * mu, 0.f), rstd = rsqrtf(var + EPS);
          const float y0 = (o0[r] - mu) * rstd * g0 * bf2f(RG[(size_t)q * HD + key0]), y1 = (o1[r] - mu) * rstd * g1 * bf2f(RG[(size_t)q * HD + key1]);
          CAT[(size_t)q * DM + key0] = (bf16)f2bf(y0); CAT[(size_t)q * DM + key1] = (bf16)f2bf(y1); } }
    LDS_WAIT(); __syncthreads();
}
__device__ __forceinline__ void p4_phase(Frame& F) {
    const int bx = blockIdx.x; const int vcu = (F.G % 8 == 0) ? (bx % 8) * (F.G / 8) + bx / 8 : bx;
    const bf16* qkv = (const bf16*)(F.ws + WS_QKV);
    bf16* CAT = (bf16*)(F.ws + WS_CAT);
    for (int fb = vcu; fb < 256; fb += F.G) {
        const int bh = fb >> 4, qb = fb & 15, h = bh & 7, b = bh >> 3;
        fox::BlockRef<bf16, bf16> cur;
        cur.Q = qkv + 4 * TSZ + ((size_t)bh * SEQ + (size_t)qb * 256) * HD; cur.K = qkv + 5 * TSZ + (size_t)bh * SEQ * HD; cur.V = qkv + 6 * TSZ + (size_t)bh * SEQ * HD;
        cur.O = CAT + ((size_t)b * SEQ + (size_t)qb * 256) * DM + 1024 + h * 128; cur.cb = (const float*)(F.ws + WS_CB) + (size_t)bh * SEQ; cur.onw = F.in[11] + h * 128; cur.P0 = qb * 256;
        fox::Seam<bf16> S;
        fox::causal_swa_prime<bf16, bf16>(cur, SEQ, F.ldsg, S);
        fox::causal_swa_block<bf16, bf16>(cur, cur, SEQ, SEQ, F.ldsg, S);
        asm volatile("s_waitcnt vmcnt(0)" ::: "memory");
        __syncthreads();
    }
    for (;;) {
        if (F.tid == 0) F.MISC[0] = atomicAdd((unsigned*)(F.ws + WS_CTL) + CW_RETQ, 1u);
        __syncthreads();
        const unsigned item = F.MISC[0];
        __syncthreads();
        if (item >= 512u) break;
        ret_item(F, (int)(item >> 5), (int)(item & 31));
    }
}
constexpr int PADROWS = 24576;
constexpr int LTAB_OFF = LDSCTL_OFF + 1024;
constexpr int NSUB = 16, SUBCAP = ECAP / NSUB;
#define LTAB_SB(lds_) ((LAS int*)((lds_) + LTAB_OFF) + 32 + 40)
struct EpiPlain {
    static constexpr bool PERM = true, AFTER_DRAIN = false;
    bf16* O; int ldc; int ntn;
    template <class U> __device__ __forceinline__ void operator()(const pg8::f32x4 (&acc)[2][2][4][2], const U& u, int wr, int wc, int fr, int fq) const {
        const int row0 = u.pm * 256 + wr * 64 + fr, col0 = (u.pn % ntn) * 256 + wc * 32 + 8 * fq;
#pragma unroll
        for (int ai = 0; ai < 2; ++ai)
#pragma unroll
            for (int m = 0; m < 4; ++m) { bf16* rowp = O + (size_t)(row0 + ai * 128 + m * 16) * ldc + col0;
#pragma unroll
                for (int bj = 0; bj < 2; ++bj) { const pg8::f32x4 v0 = acc[ai][bj][m][0], v1 = acc[ai][bj][m][1];
                    pg8::u32x4 w; w.x = pg8::cvt_pk_bf16(v0[0], v0[1]); w.y = pg8::cvt_pk_bf16(v0[2], v0[3]); w.z = pg8::cvt_pk_bf16(v1[0], v1[1]); w.w = pg8::cvt_pk_bf16(v1[2], v1[3]);
                    *(pg8::u32x4*)(rowp + bj * 128) = w; } }
    }
};
struct EpiSwiglu {
    static constexpr bool PERM = true, AFTER_DRAIN = false;
    bf16* O;
    template <class U> __device__ __forceinline__ void operator()(const pg8::f32x4 (&acc)[2][2][4][2], const U& u, int wr, int wc, int fr, int fq) const {
        const int row0 = u.pm * 256 + wr * 64 + fr, col0 = (u.pn & 3) * 128 + wc * 32 + 8 * fq;
#pragma unroll
        for (int ai = 0; ai < 2; ++ai)
#pragma unroll
            for (int m = 0; m < 4; ++m) { float g[8];
#pragma unroll
                for (int n = 0; n < 2; ++n)
#pragma unroll
                    for (int i = 0; i < 4; ++i) { const float a = acc[ai][0][m][n][i], b = acc[ai][1][m][n][i]; g[4 * n + i] = a * __builtin_amdgcn_rcpf(1.f + __expf(-a)) * b; }
                pg8::u32x4 w; w.x = pg8::cvt_pk_bf16(g[0], g[1]); w.y = pg8::cvt_pk_bf16(g[2], g[3]); w.z = pg8::cvt_pk_bf16(g[4], g[5]); w.w = pg8::cvt_pk_bf16(g[6], g[7]);
                *(pg8::u32x4*)(O + (size_t)(row0 + ai * 128 + m * 16) * DE + col0) = w; }
    }
};
struct GUnit { int pm, pn, e, lt; };
template <int NJ> struct GroupedOrder {
    typedef GUnit unit_t;
    const LAS int* ts; int G, c, total;
    __device__ __forceinline__ void init(const LAS int* ts_, int G_, int c_) { ts = ts_; G = G_; c = c_; total = ts_[32] * NJ; }
    __device__ __forceinline__ bool next(int i, GUnit& u) const {
        const int L = i * G + c; if (L >= total) return false;
        const int mt = L / NJ, j = L % NJ; int e = 0;
        while (ts[e + 1] <= mt) ++e;
        u.e = e; u.lt = mt - ts[e]; u.pm = mt; u.pn = e * NJ + j; return true;
    }
    __device__ __forceinline__ void a_ready(const GUnit&) const {}
    __device__ __forceinline__ void done(const GUnit&) const {}
};
struct GatherRows { const int* list; const LAS int* cntL; const LAS int* sb;
    __device__ __forceinline__ unsigned row(const GUnit& u, int r) const { const int lr = u.lt * 256 + r; if (lr >= cntL[u.e]) return 0u;
        const LAS int* p = sb + u.e * 17; int su = 0;
#pragma unroll
        for (int st = 8; st > 0; st >>= 1) if (p[su + st] <= lr) su += st;
        return (unsigned)list[(size_t)(u.e * NSUB + su) * SUBCAP + (lr - p[su])]; } };
__device__ __forceinline__ void moe_tables(Frame& F) {
    LAS int* cntL = (LAS int*)(F.lds + LTAB_OFF); LAS int* ts = cntL + 32;
    __syncthreads();
    LAS int* sb = LTAB_SB(F.lds);
    { const int e = F.tid >> 4, su = F.tid & 15; sb[e * 17 + su + 1] = (int)__hip_atomic_load(F.ctl + F.cnt_off + 64 * F.tid, RLX_AGENT); }
    __syncthreads();
    if (F.tid < 32) { LAS int* p = sb + F.tid * 17; int a = 0; p[0] = 0; for (int su = 1; su <= 16; ++su) { a += p[su]; p[su] = a; } cntL[F.tid] = a; }
    __syncthreads();
    if (F.tid == 0) { int a = 0; for (int e = 0; e < 32; ++e) { ts[e] = a; a += (cntL[e] + 255) >> 8; } ts[32] = a; }
    __syncthreads();
}
__device__ __forceinline__ f32x4 bf4(unsigned lo, unsigned hi) { return (f32x4){__uint_as_float(lo << 16), __uint_as_float(lo & 0xffff0000u), __uint_as_float(hi << 16), __uint_as_float(hi & 0xffff0000u)}; }
constexpr int P6_PAR = 0, P6_AH = 40960, P6_AHLD = 1028, P6_RED = P6_AH + 16 * P6_AHLD * 4, P6_LG = P6_RED + 8 * 768 * 4, P6_END = P6_LG + 16 * 48 * 4;
static_assert(P6_END <= LDSCTL_OFF, "p6 LDS map");
typedef float f32x4v __attribute__((ext_vector_type(4)));
__device__ __forceinline__ void split8(const f32x4 a, const f32x4 b, bf16x8& hi, bf16x8& lo) {
    float v[8] = {a.x, a.y, a.z, a.w, b.x, b.y, b.z, b.w}; unsigned h[8], l[8];
#pragma unroll
    for (int i = 0; i < 8; ++i) { h[i] = f2bf(v[i]); l[i] = f2bf(v[i] - __uint_as_float(h[i] << 16)); }
    hi = (bf16x8){(short)h[0], (short)h[1], (short)h[2], (short)h[3], (short)h[4], (short)h[5], (short)h[6], (short)h[7]};
    lo = (bf16x8){(short)l[0], (short)l[1], (short)l[2], (short)l[3], (short)l[4], (short)l[5], (short)l[6], (short)l[7]};
}
template <int VAR>
__device__ __forceinline__ void p6_phase(Frame& F) {
    const float* x = F.in[0]; const float* wpost = F.in[5]; const float* wpre = F.in[13]; const float* rcb = F.in[16]; const float* rfb = F.in[18];
    const float* mod = (const float*)(F.ws + WS_MOD); const bf16* Yb = (const bf16*)(F.ws + WS_YB); bf16* Hb = (bf16*)(F.ws + WS_HB);
    const bf16* RWH = (const bf16*)(F.ws + WS_RWP); const bf16* RWL = RWH + 48 * DM;
    int* list = (int*)(F.ws + WS_LIST); int* SE = (int*)(F.ws + WS_SLOT); int* SPOS = SE + 2 * T; float* SW = (float*)(SPOS + 2 * T);
    LAS f32x4* PAR = (LAS f32x4*)(F.lds + P6_PAR);
    LAS float* AH = (LAS float*)(F.lds + P6_AH); LAS float* RED = (LAS float*)(F.lds + P6_RED); LAS float* LG = (LAS float*)(F.lds + P6_LG);
    const int lane = F.lane, w = F.wave;
    for (int pass = blockIdx.x; pass < T / 16; pass += F.G) {
        const int row0 = pass * 16 + 2 * w, b = (pass * 16) >> 12;
        f32x4 xv[2][8];
        if (VAR >= 2) {
#pragma unroll
            for (int j = 0; j < 8; ++j) { xv[0][j] = (f32x4){1.f, 2.f, 3.f, (float)lane}; xv[1][j] = (f32x4){2.f, 2.f, 3.f, (float)j}; } }
        __syncthreads();
        { const f32x4* mb = (const f32x4*)(mod + (size_t)b * 6 * DM);
          for (int c = F.tid; c < 512; c += NWAVES * 64) { PAR[c] = mb[2 * 512 + c]; PAR[512 + c] = ((const f32x4*)wpost)[c]; PAR[1024 + c] = ((const f32x4*)wpre)[c]; PAR[1536 + c] = mb[4 * 512 + c] + 1.0f; PAR[2048 + c] = mb[3 * 512 + c]; } }
        LDS_WAIT(); __syncthreads();
#pragma unroll
        for (int rr = 0; rr < (VAR >= 2 ? 0 : 2); ++rr) {
            f32x4* outr = (f32x4*)(F.out + (size_t)(row0 + rr) * DM) + lane; uint2* hr = (uint2*)(Hb + (size_t)(row0 + rr) * DM) + lane;
            uint2 yu[8];
            { const f32x4* xr = (const f32x4*)(x + (size_t)(row0 + rr) * DM) + lane; const uint2* yr = (const uint2*)(Yb + (size_t)(row0 + rr) * DM) + lane;
#pragma unroll
              for (int j = 0; j < 8; ++j) { xv[rr][j] = xr[64 * j]; yu[j] = yr[64 * j]; } }
            f32x4 yv[8]; float ss = 0.f;
#pragma unroll
            for (int j = 0; j < 8; ++j) { yv[j] = bf4(yu[j].x, yu[j].y); ss += (yv[j].x * yv[j].x + yv[j].y * yv[j].y) + (yv[j].z * yv[j].z + yv[j].w * yv[j].w); }
            const float rstd_y = rsqrtf(wave_sum(ss) * (1.f / DM) + EPS);
            float s2 = 0.f;
            asm volatile("" ::: "memory");
#pragma unroll
            for (int j = 0; j < 8; ++j) { const f32x4 x1 = xv[rr][j] + PAR[lane + 64 * j] * (yv[j] * rstd_y * PAR[512 + lane + 64 * j]);
                outr[64 * j] = x1; xv[rr][j] = x1; s2 += (x1.x * x1.x + x1.y * x1.y) + (x1.z * x1.z + x1.w * x1.w); }
            const float rstd = rsqrtf(wave_sum(s2) * (1.f / DM) + EPS);
            asm volatile("" ::: "memory");
#pragma unroll
            for (int j = 0; j < 8; ++j) { const f32x4 h = xv[rr][j] * rstd * PAR[1024 + lane + 64 * j] * PAR[1536 + lane + 64 * j] + PAR[2048 + lane + 64 * j];
                xv[rr][j] = h; uint2 o; o.x = pk2(h.x, h.y); o.y = pk2(h.z, h.w); hr[64 * j] = o; }
            asm volatile("" ::: "memory");
        }
        if (VAR == 1) continue;
        pg8::f32x4 acc[3] = {{0.f, 0.f, 0.f, 0.f}, {0.f, 0.f, 0.f, 0.f}, {0.f, 0.f, 0.f, 0.f}};
#pragma unroll 1
        for (int half = 0; half < 2; ++half) {
            bf16x8 bh[4][3], bl[4][3];
#pragma unroll
            for (int ks = 0; ks < 4; ++ks)
#pragma unroll
                for (int nt = 0; nt < 3; ++nt) { const size_t bo = (size_t)(nt * 16 + (lane & 15)) * DM + 1024 * half + 128 * w + 32 * ks + 8 * (lane >> 4);
                    bh[ks][nt] = *(const bf16x8*)(RWH + bo); bl[ks][nt] = *(const bf16x8*)(RWL + bo); }
            __syncthreads();
#pragma unroll
            for (int rr = 0; rr < 2; ++rr)
#pragma unroll
                for (int j = 0; j < 4; ++j) *(LAS f32x4*)(AH + (2 * w + rr) * P6_AHLD + 256 * j + 4 * lane) = half ? xv[rr][4 + j] : xv[rr][j];
            LDS_WAIT(); __syncthreads();
#pragma unroll
            for (int ks = 0; ks < (VAR == 4 ? 0 : 4); ++ks) {
                const int kh = 128 * w + 32 * ks + 8 * (lane >> 4); const LAS float* ap = AH + (lane & 15) * P6_AHLD + kh;
                const f32x4 a0 = *(const LAS f32x4*)ap, a1 = *(const LAS f32x4*)(ap + 4); bf16x8 ahi, alo; split8(a0, a1, ahi, alo);
#pragma unroll
                for (int nt = 0; nt < 3; ++nt) {
                    acc[nt] = __builtin_amdgcn_mfma_f32_16x16x32_bf16(ahi, bh[ks][nt], acc[nt], 0, 0, 0);
                    acc[nt] = __builtin_amdgcn_mfma_f32_16x16x32_bf16(alo, bh[ks][nt], acc[nt], 0, 0, 0);
                    acc[nt] = __builtin_amdgcn_mfma_f32_16x16x32_bf16(ahi, bl[ks][nt], acc[nt], 0, 0, 0); }
            }
        }
#pragma unroll
        for (int nt = 0; nt < 3; ++nt)
#pragma unroll
            for (int r = 0; r < 4; ++r) RED[w * 768 + (nt * 4 + r) * 64 + lane] = acc[nt][r];
        LDS_WAIT(); __syncthreads();
        for (int idx = F.tid; idx < 768; idx += NWAVES * 64) { float s = 0.f;
#pragma unroll
            for (int ww = 0; ww < NWAVES; ++ww) s += RED[ww * 768 + idx];
            const int nt = idx >> 8, r = (idx >> 6) & 3, l = idx & 63; LG[(4 * (l >> 4) + r) * 48 + nt * 16 + (l & 15)] = s; }
        LDS_WAIT(); __syncthreads();
        {
            const int r = 2 * w + (lane & 1); float lg[36];
#pragma unroll
            for (int o = 0; o < 36; ++o) lg[o] = LG[r * 48 + o] + (o < 4 ? rcb[o] : rfb[o - 4]);
            int g = 0; float mx = lg[0];
#pragma unroll
            for (int j = 1; j < 4; ++j) if (lg[j] > mx) { mx = lg[j]; g = j; }
            float den = 0.f;
#pragma unroll
            for (int j = 0; j < 4; ++j) den += expf(lg[j] - mx);
            const float gprob = 1.f / den;
            float f[8];
#pragma unroll
            for (int i = 0; i < 8; ++i) f[i] = g == 0 ? lg[4 + i] : g == 1 ? lg[12 + i] : g == 2 ? lg[20 + i] : lg[28 + i];
            int i0 = 0; float v0 = f[0];
#pragma unroll
            for (int i = 1; i < 8; ++i) if (f[i] > v0) { v0 = f[i]; i0 = i; }
            int i1 = -1; float v1 = -3.0e38f;
#pragma unroll
            for (int i = 0; i < 8; ++i) if (i != i0 && f[i] > v1) { v1 = f[i]; i1 = i; }
            const float e1 = expf(v1 - v0); const float w0 = gprob / (1.f + e1), w1 = gprob * e1 / (1.f + e1);
            if (VAR == 3) { if (lane == 0) SW[2 * (pass * 16 + r)] = w0 + w1 + (float)(g + i0 + i1); } else
            if (lane < 4) { const int slot = lane >> 1, row = pass * 16 + r, e = g * 8 + (slot ? i1 : i0);
                const int es = e * NSUB + (int)(blockIdx.x & (NSUB - 1));
                const int pos = (int)atomicAdd((unsigned*)(F.ws + WS_CTL) + F.cnt_off + 64 * es, 1u);
                list[(size_t)es * SUBCAP + pos] = row; SE[2 * row + slot] = es; SPOS[2 * row + slot] = pos; SW[2 * row + slot] = slot ? w1 : w0; }
        }
    }
}
__device__ __forceinline__ void p9_final(Frame& F) {
    moe_tables(F);
    const LAS int* ts = (const LAS int*)(F.lds + LTAB_OFF) + 32; const LAS int* sb = LTAB_SB(F.lds);
    const float* wpost = F.in[14]; const float* mod = (const float*)(F.ws + WS_MOD); const bf16* Ys = (const bf16*)(F.ws + WS_YS);
    const int* SE = (const int*)(F.ws + WS_SLOT); const int* SPOS = SE + 2 * T; const float* SW = (const float*)(SPOS + 2 * T);
    const int lane = F.lane;
    for (int row = F.gw; row < T; row += F.NGW) {
        const int b = row >> 12;
        const int es0 = SE[2 * row], es1 = SE[2 * row + 1];
        const int r0 = ts[es0 >> 4] * 256 + sb[(es0 >> 4) * 17 + (es0 & 15)] + SPOS[2 * row], r1 = ts[es1 >> 4] * 256 + sb[(es1 >> 4) * 17 + (es1 & 15)] + SPOS[2 * row + 1]; const float w0 = SW[2 * row], w1 = SW[2 * row + 1];
        const uint2* y0 = (const uint2*)(Ys + (size_t)r0 * DM) + lane; const uint2* y1 = (const uint2*)(Ys + (size_t)r1 * DM) + lane;
        f32x4* outr = (f32x4*)(F.out + (size_t)row * DM) + lane; const f32x4* g2 = (const f32x4*)(mod + (size_t)b * 6 * DM + 5 * DM) + lane;
        f32x4 v[8]; float ss = 0.f;
#pragma unroll
        for (int j = 0; j < 8; ++j) { const uint2 a = y0[64 * j], c = y1[64 * j]; v[j] = bf4(a.x, a.y) * w0 + bf4(c.x, c.y) * w1; ss += (v[j].x * v[j].x + v[j].y * v[j].y) + (v[j].z * v[j].z + v[j].w * v[j].w); }
        const float rstd = rsqrtf(wave_sum(ss) * (1.f / DM) + EPS);
#pragma unroll
        for (int j = 0; j < 8; ++j) outr[64 * j] = outr[64 * j] + g2[64 * j] * (v[j] * rstd * ((const f32x4*)wpost)[lane + 64 * j]);
    }
}
__global__ void __launch_bounds__(NWAVES * 64, 2) mega_fwd(Args args) {
    extern __shared__ __attribute__((aligned(16))) unsigned char lds[];
    Frame F;
    F.lds = (LAS unsigned char*)lds; F.ldsg = (char*)lds;
    F.MISC = (volatile LAS unsigned*)(F.lds + MISC_OFF);
    F.tid = threadIdx.x; F.lane = F.tid & 63; F.wave = __builtin_amdgcn_readfirstlane(F.tid >> 6);
    F.G = gridDim.x; F.gw = blockIdx.x * NWAVES + F.wave; F.NGW = F.G * NWAVES;
    F.cnt_off = args.cnt_off;
    F.ws = args.ws; F.out = args.out; F.ctl = (gu32*)(args.ws + WS_CTL);
#pragma unroll
    for (int i = 0; i < 22; ++i) F.in[i] = args.in[i];
    for (int u = F.tid; u < (LDS_BYTES - LDSCTL_OFF) / 4; u += NWAVES * 64) ((LAS unsigned*)(F.lds + LDSCTL_OFF))[u] = 0u;
    __syncthreads();
    XcdBarrier bar = xcd_barrier_post((unsigned*)(F.ctl + CW_BAR), F.MISC + 8);
    const int lo = args.ph_lo, hi = args.ph_hi;
#define IN(k) (lo <= (k) && (k) < hi)
#define BOTH(k) (IN(k) && IN((k) + 1))
#define GRID_BAR() xcd_barrier(bar)
#define REFRESH() do { int t_ = threadIdx.x; asm volatile("" : "+v"(t_)); F.tid = t_; F.lane = t_ & 63; F.wave = __builtin_amdgcn_readfirstlane(t_ >> 6); F.gw = blockIdx.x * NWAVES + F.wave; } while (0)
#ifdef TS_PHASE
    unsigned long long ts0_ = 0, ts1_ = 0;
#define TS_BEG(k) do { if ((k) == TS_PHASE) ts0_ = __builtin_amdgcn_s_memrealtime(); if ((k) == TS_PHASE + TS_SPAN) ts1_ = __builtin_amdgcn_s_memrealtime(); } while (0)
#else
#define TS_BEG(k) do {} while (0)
#endif
    if (IN(0)) { REFRESH(); TS_BEG(0); p0_prologue<false>(F); if (BOTH(0)) GRID_BAR(); }
    if (IN(1)) { REFRESH(); TS_BEG(1); p1_prenorm(F); if (BOTH(1)) GRID_BAR(); }
    if (IN(2)) { REFRESH(); TS_BEG(2);
        const int NG2 = (F.G == 256) ? 224 : F.G;
        if ((int)blockIdx.x < NG2) {
            pg8::Gemm g{(const bf16*)(F.ws + WS_HB), (const bf16*)(F.ws + WS_WIN), T, INCM, DM}; pg8::StaticOrder S; S.init(T, INCM, NG2, (int)blockIdx.x);
            EpiHeads E{(bf16*)(F.ws + WS_QKV), (const float*)(F.ws + WS_CS), F.in[9], F.in[10], F.lds};
            pg8::gemm_phase<EpiHeads, pg8::StaticOrder, true, true>(F.lds + RING_OFF, g, S, E);
            if (F.tid == 0) __hip_atomic_fetch_add(F.ctl + CW_DONE + 64 * 2, 1u, RLX_AGENT);
        } else filler(F, 2, 1, (unsigned)NG2, 0u, (unsigned)N_CONV_BI);
        if (BOTH(2)) GRID_BAR();
    }
    if (IN(3)) { REFRESH(); TS_BEG(3); p3_phase(F); if (BOTH(3)) GRID_BAR(); }
    if (IN(4)) { REFRESH(); TS_BEG(4); p3b_scan(F); if (BOTH(4)) GRID_BAR(); }
    if (IN(5)) { REFRESH(); TS_BEG(5); p4_phase(F); filler(F, 5, 0, (unsigned)F.G, (unsigned)(F.G - F.G / 8), (unsigned)N_CONV_BI); if (BOTH(5)) GRID_BAR(); }
    if (IN(6)) { REFRESH(); TS_BEG(6);
        pg8::Gemm g{(const bf16*)(F.ws + WS_CAT), (const bf16*)(F.ws + WS_WOUT), T, DM, DM}; pg8::StaticOrder S; S.init(T, DM, F.G, (int)blockIdx.x);
        EpiPlain E{(bf16*)(F.ws + WS_YB), DM, 8};
        pg8::gemm_phase<EpiPlain, pg8::StaticOrder, true, true>(F.lds + RING_OFF, g, S, E);
        if (BOTH(6)) GRID_BAR();
    }
#ifdef PROBE_VARIANTS
    if (lo == 11) p6_phase<1>(F);
    if (lo == 12) p6_phase<2>(F);
    if (lo == 13) p6_phase<3>(F);
    if (lo == 14) p6_phase<4>(F);
#endif
    if (IN(7)) { REFRESH(); TS_BEG(7); p6_phase<0>(F); filler(F, 7, 2, 0u, 0u, (unsigned)N_CONV_BI); if (BOTH(7)) GRID_BAR(); }
    if (IN(8)) { REFRESH(); TS_BEG(8);
        moe_tables(F);
        pg8::Gemm g{(const bf16*)(F.ws + WS_HB), (const bf16*)(F.ws + WS_W13), PADROWS, NE * 1024, DM};
        GroupedOrder<4> S; S.init((const LAS int*)(F.lds + LTAB_OFF) + 32, F.G, (int)blockIdx.x);
        EpiSwiglu E{(bf16*)(F.ws + WS_GB)}; GatherRows R{(const int*)(F.ws + WS_LIST), (const LAS int*)(F.lds + LTAB_OFF), LTAB_SB(F.lds)};
        pg8::gemm_phase<EpiSwiglu, GroupedOrder<4>, true, true, GatherRows>(F.lds + RING_OFF, g, S, E, R);
        if (BOTH(8)) GRID_BAR();
    }
    if (IN(9)) { REFRESH(); TS_BEG(9);
        moe_tables(F);
        pg8::Gemm g{(const bf16*)(F.ws + WS_GB), (const bf16*)(F.ws + WS_W2), PADROWS, NE * 2048, DE};
        GroupedOrder<8> S; S.init((const LAS int*)(F.lds + LTAB_OFF) + 32, F.G, (int)blockIdx.x);
        EpiPlain E{(bf16*)(F.ws + WS_YS), DM, 8};
        pg8::gemm_phase<EpiPlain, GroupedOrder<8>, true, true>(F.lds + RING_OFF, g, S, E);
        if (BOTH(9)) GRID_BAR();
    }
    if (IN(10)) { REFRESH(); TS_BEG(10); p9_final(F); }
#ifdef TS_PHASE
    TS_BEG(11);
    if (blockIdx.x == 0 && threadIdx.x == 0) { const unsigned long long te = __builtin_amdgcn_s_memrealtime(), want = 4ull * (ts1_ - ts0_);
        while (__builtin_amdgcn_s_memrealtime() - te < want) __builtin_amdgcn_s_sleep(8); }
#endif
#undef IN
#undef BOTH
}

__global__ void k_adapt_proj(const bf16* __restrict__ qkv, const float* __restrict__ zb, float* __restrict__ proj) {
    const size_t i = (size_t)blockIdx.x * blockDim.x + threadIdx.x;
    if (i >= (size_t)T * INC) return;
    const int tok = (int)(i / INC), c = (int)(i % INC);
    if (c >= INCM) { proj[i] = zb[(size_t)tok * 8 + (c - INCM)]; return; }
    const int type = c >> 10, hh = (c & 1023) >> 7, d = c & 127, b = tok >> 12, s = tok & 4095;
    const unsigned v = qkv[(size_t)type * TSZ + ((size_t)((b * 8 + hh) * SEQ + s)) * HD + d];
    proj[i] = __uint_as_float(v << 16);
}

__global__ void k_adapt_cat(const bf16* __restrict__ catb, float* __restrict__ cat) {
    const size_t i = (size_t)blockIdx.x * blockDim.x + threadIdx.x;
    if (i < (size_t)T * DM) cat[i] = __uint_as_float((unsigned)catb[i] << 16);
}
extern "C" void kernel_launch(void* const* d_in, const int* in_sizes, int n_in, void* d_out, int out_size, void* d_ws, size_t ws_size, hipStream_t stream) {
    static int grid = 0;
    if (grid == 0) {
        int dev = 0, cus = 0, per_cu = 0;
        (void)hipGetDevice(&dev); (void)hipDeviceGetAttribute(&cus, hipDeviceAttributeMultiprocessorCount, dev);
        (void)hipFuncSetAttribute((const void*)mega_fwd, hipFuncAttributeMaxDynamicSharedMemorySize, LDS_BYTES);
        (void)hipOccupancyMaxActiveBlocksPerMultiprocessor(&per_cu, (const void*)mega_fwd, NWAVES * 64, LDS_BYTES);
        (void)hipGetLastError();
        if (per_cu < 1) { fprintf(stderr, "kernel_launch: occupancy query says %d blocks/CU\n", per_cu); per_cu = 1; }
        grid = cus > 0 ? cus : 256;
        if (ws_size < WS_END) fprintf(stderr, "kernel_launch: workspace too small (%zu < %zu)\n", ws_size, (size_t)WS_END);
    }
    (void)hipMemsetAsync((char*)d_ws + WS_CTL, 0, CTL_ZERO_BYTES, stream);
    Args a{};
    for (int i = 0; i < 22; ++i) a.in[i] = (const float*)d_in[i];
    a.out = (float*)d_out; a.ws = (unsigned char*)d_ws; a.ph_lo = 0; a.ph_hi = 11; a.cnt_off = CW_CNT;
    hipLaunchKernelGGL(mega_fwd, dim3(grid), dim3(NWAVES * 64), LDS_BYTES, stream, a);
}
```

```cpp
#include <hip/hip_runtime.h>
#include <stdint.h>
#include <cstdio>

constexpr int DM = 2048, NB = 2, SEQ = 4096, T = NB * SEQ;
constexpr int HD = 128, NH = 8;
constexpr int INC = 7176, INCM = 7168;
constexpr int NE = 32, DE = 512;
constexpr float EPS = 1e-6f;
#define GAS __attribute__((address_space(1)))
#define LAS __attribute__((address_space(3)))
typedef unsigned short bf16;
typedef unsigned v4u __attribute__((ext_vector_type(4)));
typedef float f32x4 __attribute__((ext_vector_type(4)));
typedef short bf16x8 __attribute__((ext_vector_type(8)));
typedef GAS unsigned gu32;
typedef GAS unsigned long long gu64;
#define RLX_AGENT __ATOMIC_RELAXED, __HIP_MEMORY_SCOPE_AGENT
#define LDS_WAIT() asm volatile("s_waitcnt lgkmcnt(0)" ::: "memory")
#define VM_WAIT() asm volatile("s_waitcnt vmcnt(0)" ::: "memory")
__device__ __forceinline__ unsigned long long rt() { return __builtin_amdgcn_s_memrealtime(); }
__device__ __forceinline__ unsigned f2bf(float f) { unsigned u = __builtin_bit_cast(unsigned, f); return (u + 0x7fffu + ((u >> 16) & 1u)) >> 16; }
__device__ __forceinline__ unsigned pk2(float lo, float hi) { return f2bf(lo) | (f2bf(hi) << 16); }

#define XB_TMO      128
#define XB_XCNT(j)  (256  + 64 * (j))
#define XB_XSUB(j)  (1280 + 64 * (j))
#define XB_XGEN(j)  (2304 + 64 * (j))
#define XB_TOP      3328
#define XB_TOPGEN   3392
#define XCD_BAR_WORDS 3456
#define XB_SPIN_CAP (1u << 18)

__device__ __forceinline__ unsigned xb_ld(unsigned* p)              { return __hip_atomic_load(p, __ATOMIC_RELAXED, __HIP_MEMORY_SCOPE_AGENT); }
__device__ __forceinline__ unsigned xb_add(unsigned* p, unsigned v) { return __hip_atomic_fetch_add(p, v, __ATOMIC_RELAXED, __HIP_MEMORY_SCOPE_AGENT); }
__device__ __forceinline__ unsigned xb_xcc_id() { return (unsigned)__builtin_amdgcn_s_getreg((3 << 11) | 20) & 0xFu; }
#define XB_SPIN(cond, bar) do { unsigned _sp = 0; while (cond) { __builtin_amdgcn_s_sleep(1); \
    if ((++_sp & 255u) == 0u) { if (xb_ld(&(bar)[XB_TMO])) break; if (_sp > XB_SPIN_CAP) { atomicAdd(&(bar)[XB_TMO], 1u); break; } } } } while (0)

struct XcdBarrier {
    unsigned* bar; unsigned x;
    volatile LAS unsigned* st;
};

__device__ __forceinline__ XcdBarrier xcd_barrier_post(unsigned* bar, volatile LAS unsigned* st) {
    XcdBarrier b; b.bar = bar; b.x = xb_xcc_id(); b.st = st;
    if (threadIdx.x == 0) (void)xb_add(&bar[XB_XCNT(b.x)], 1u);
    return b;
}
__device__ __forceinline__ void xcd_barrier_complete(unsigned* bar, unsigned x, unsigned& nloc, unsigned& nx) {
    const unsigned G = gridDim.x * gridDim.y * gridDim.z;
    unsigned sum, cnt, mine, sp = 0u;
    for (;;) {
        sum = 0u; cnt = 0u; mine = 0u;
#pragma unroll
        for (unsigned j = 0; j < 16; ++j) { const unsigned c = xb_ld(&bar[XB_XCNT(j)]); sum += c; cnt += (c > 0u) ? 1u : 0u; mine = (j == x) ? c : mine; }
        if (sum == G) break;
        __builtin_amdgcn_s_sleep(1);
        if ((++sp & 255u) == 0u) { if (xb_ld(&bar[XB_TMO])) break; if (sp > XB_SPIN_CAP) { atomicAdd(&bar[XB_TMO], 1u); break; } }
    }
    nloc = mine > 0u ? mine : 1u; nx = cnt > 0u ? cnt : 1u;
}

__device__ __forceinline__ void xcd_barrier(const XcdBarrier& b) {
    asm volatile("s_waitcnt vmcnt(0)" ::: "memory");
    __syncthreads();
    if (threadIdx.x == 0) {
        unsigned* bar = b.bar;
        __builtin_amdgcn_s_waitcnt(0);
        unsigned nloc = b.st[0], nx = b.st[1];
        if (nloc == 0u) { xcd_barrier_complete(bar, b.x, nloc, nx); b.st[0] = nloc; b.st[1] = nx; }
        const unsigned old = xb_add(&bar[XB_XSUB(b.x)], 1u);
        const unsigned gen = old / nloc;
        if (old + 1u == (gen + 1u) * nloc) {
            __builtin_amdgcn_fence(__ATOMIC_RELEASE, "agent");
            asm volatile("s_waitcnt vmcnt(0)" ::: "memory");
            const unsigned og = xb_add(&bar[XB_TOP], 1u);
            const unsigned tg = og / nx;
            if (og + 1u == (tg + 1u) * nx) xb_add(&bar[XB_TOPGEN], 1u);
            else XB_SPIN(xb_ld(&bar[XB_TOPGEN]) == tg, bar);
            __builtin_amdgcn_fence(__ATOMIC_ACQUIRE, "agent");
            xb_add(&bar[XB_XGEN(b.x)], 1u);
            asm volatile("s_waitcnt vmcnt(0)" ::: "memory");
        } else {
            XB_SPIN(xb_ld(&bar[XB_XGEN(b.x)]) == gen, bar);
            __builtin_amdgcn_fence(__ATOMIC_ACQUIRE, "agent");
            asm volatile("s_waitcnt vmcnt(0)" ::: "memory");
        }
    }
    __syncthreads();
}
namespace pg8 {
#define PG8_LAS __attribute__((address_space(3)))
typedef unsigned short bf16_t;
typedef short bf16x8 __attribute__((ext_vector_type(8)));
typedef float f32x4 __attribute__((ext_vector_type(4)));
typedef unsigned u32x4 __attribute__((ext_vector_type(4)));
constexpr int BM = 256, BK = 64, HALF = 128, HTB = HALF * BK * 2  , STAGE_BYTES = 8 * HTB, NXCD = 8, WGM = 8;

__host__ __device__ __forceinline__ int lds_byte(int r, int c) { const int st = (r >> 4) * 2 + (c >> 5), rr = r & 15, cc = c & 31, ob = rr * 64 + cc * 2; return st * 1024 + (ob ^ (((ob >> 9) & 1) << 5)); }
__host__ __device__ __forceinline__ void stage_rc(int b, int& R, int& C) { const int st = b / 1024, sb = b % 1024, swz = sb ^ (((sb >> 9) & 1) << 5); R = (st >> 1) * 16 + swz / 64; C = (st & 1) * 32 + (swz % 64) / 2; }
__host__ __device__ __forceinline__ int perm32(int rho) { const int n = rho >> 4, i = rho & 15; return 8 * (i >> 2) + 4 * n + (i & 3); }

struct Unit { int pm, pn; };
struct Gemm { const bf16_t* A; const bf16_t* Bt; int M, N, K; };

struct StaticOrder {
    typedef Unit unit_t;
    int nM, nN, nwg, G, c;
    __host__ __device__ void init(int M, int N, int G_, int c_) { nM = M / BM; nN = N / BM; nwg = nM * nN; G = G_; c = c_; }
    __host__ __device__ bool next(int i, Unit& u) const {
        const long L = (long)i * G + c; if (L >= nwg) return false;
        int wgid = (int)L; { const int q = nwg / NXCD, r = nwg % NXCD, xcd = wgid % NXCD, off = wgid / NXCD; wgid = (xcd < r ? xcd * (q + 1) : r * (q + 1) + (xcd - r) * q) + off; }
        const int nig = WGM * nN, gid = wgid / nig, fm = gid * WGM, gsz = (nM - fm) < WGM ? (nM - fm) : WGM;
        u.pm = fm + ((wgid % nig) % gsz); u.pn = (wgid % nig) / gsz; return true;
    }
    __device__ __forceinline__ void a_ready(const Unit&) const {}
    __device__ __forceinline__ void done(const Unit&) const {}
};

__device__ __forceinline__ unsigned cvt_pk_bf16(float lo, float hi) { unsigned r; asm volatile("v_cvt_pk_bf16_f32 %0, %1, %2" : "=v"(r) : "v"(lo), "v"(hi)); return r; }
typedef float f32x2 __attribute__((ext_vector_type(2)));
__device__ __forceinline__ f32x2 gelu_pk(f32x2 v) {
    const f32x2 av = __builtin_elementwise_abs(v), d = av * 0.2316418882f + 1.0f;
    f32x2 t; t.x = __builtin_amdgcn_rcpf(d.x); t.y = __builtin_amdgcn_rcpf(d.y);
    f32x2 q = t * 0.5307027145f + (-0.7265760135f); q = q * t + 0.7107068705f; q = q * t + (-0.142248368f); q = q * t + 0.127414796f; q = q * t;
    const f32x2 s = (v * v) * (-0.72134752044f);
    f32x2 e; e.x = __builtin_amdgcn_exp2f(s.x); e.y = __builtin_amdgcn_exp2f(s.y);
    const f32x2 m = v * (q * e), r = v - m;
    f32x2 o; o.x = v.x < 0.f ? m.x : r.x; o.y = v.y < 0.f ? m.y : r.y; return o;
}

template <int ACT  > struct EpiBf16 {
    static constexpr bool PERM = true, AFTER_DRAIN = false; static_assert(ACT == 0 || ACT == 1, "EpiBf16: ACT is 0 (none) or 1 (gelu_pk)");
    bf16_t* O; int ldc; const float* bias; int split_cols; size_t split_stride; float scale0;
    __device__ __forceinline__ void operator()(const f32x4 (&acc)[2][2][4][2], const Unit& u, int wr, int wc, int fr, int fq) const {
        const int row0 = u.pm * BM + wr * 64 + fr; int colt = u.pn * BM; bf16_t* base = O;
        float sc = 1.f; if (split_cols) { const int t = colt / split_cols; base += (size_t)t * split_stride; colt -= t * split_cols; if (t == 0) sc = scale0; }
        const int col0 = colt + wc * 32 + 8 * fq, bcol0 = u.pn * BM + wc * 32 + 8 * fq;
        f32x4 bv[2][2];
#pragma unroll
        for (int bj = 0; bj < 2; ++bj)
#pragma unroll
            for (int n = 0; n < 2; ++n) bv[bj][n] = bias ? *(const f32x4*)(bias + bcol0 + bj * HALF + 4 * n) : (f32x4){0.f, 0.f, 0.f, 0.f};
#pragma unroll
        for (int ai = 0; ai < 2; ++ai)
#pragma unroll
            for (int m = 0; m < 4; ++m) { bf16_t* rowp = base + (size_t)(row0 + ai * HALF + m * 16) * ldc + col0;
#pragma unroll
                for (int bj = 0; bj < 2; ++bj) { f32x4 v0 = acc[ai][bj][m][0] + bv[bj][0], v1 = acc[ai][bj][m][1] + bv[bj][1];
                    if (ACT == 1) { f32x2 a = gelu_pk((f32x2){v0[0], v0[1]}), b = gelu_pk((f32x2){v0[2], v0[3]}), c = gelu_pk((f32x2){v1[0], v1[1]}), d = gelu_pk((f32x2){v1[2], v1[3]});
                        v0 = (f32x4){a.x, a.y, b.x, b.y}; v1 = (f32x4){c.x, c.y, d.x, d.y}; }
                    v0 = v0 * sc; v1 = v1 * sc; u32x4 w; w.x = cvt_pk_bf16(v0[0], v0[1]); w.y = cvt_pk_bf16(v0[2], v0[3]); w.z = cvt_pk_bf16(v1[0], v1[1]); w.w = cvt_pk_bf16(v1[2], v1[3]);
                    *(u32x4*)(rowp + bj * HALF) = w; } }
    }
};
struct IdentRows { template <class U> __device__ __forceinline__ unsigned row(const U& u, int r) const { return (unsigned)(u.pm * BM + r); } };
typedef int v8i32 __attribute__((ext_vector_type(8))); typedef int v4i32 __attribute__((ext_vector_type(4)));
__device__ __forceinline__ v8i32 cat32(bf16x8 lo, bf16x8 hi) { const v4i32 a = __builtin_bit_cast(v4i32, lo), b = __builtin_bit_cast(v4i32, hi); return __builtin_shufflevector(a, b, 0, 1, 2, 3, 4, 5, 6, 7); }
template <class Epi, class Sched, bool ALIGN_EPI = false, bool SP2 = false, class RowMap = IdentRows, int EB = 2>
__device__ __forceinline__ void gemm_phase(PG8_LAS unsigned char* lds, const Gemm g, const Sched& S, const Epi& E, const RowMap RM = RowMap()) {
    typedef typename Sched::unit_t Unit;
    const int tid = threadIdx.x, wid = __builtin_amdgcn_readfirstlane(tid >> 6), lane = tid & 63, wr = wid >> 2, wc = wid & 3, fr = lane & 15, fq = lane >> 4;
    int K = g.K; asm volatile("" : "+s"(K)); const int nt = K * EB / (BK * 2);
    unsigned voffB[2]; int RA[2], CA[2];
#pragma unroll
    for (int i = 0; i < 2; ++i) { int R, C; stage_rc(tid * 16 + i * 8192, R, C); const int Rb = Epi::PERM ? ((R & ~31) + perm32(R & 31)) : R;
        RA[i] = R; CA[i] = C; voffB[i] = (unsigned)(Rb * K * EB + C * 2); }
    unsigned ao[2][2], an[2][2];
#define PG8_AOFF(dst, U) do { _Pragma("unroll") for (int h_ = 0; h_ < 2; ++h_) _Pragma("unroll") for (int i_ = 0; i_ < 2; ++i_) { \
        dst[h_][i_] = RM.row((U), h_ * HALF + RA[i_]) * (unsigned)(K * EB) + (unsigned)(CA[i_] * 2); } } while (0)
    const size_t kstep = (size_t)(BK * 2);
    const size_t hstep = (size_t)HALF * K * EB;
    const size_t tstep = 2 * hstep;
    const unsigned ldsw = (unsigned)wid * 1024u;
    const int aoff = lds_byte(wr * 64 + fr, fq * 8), boff = lds_byte(wc * 32 + fr, fq * 8);
#define PG8_SA(b, h) (((b) * 2 + (h)) * HTB)
#define PG8_SB(b, h) ((4 + (b) * 2 + (h)) * HTB)
#define PG8_STAGE(bufoff, gbase, voff) do { _Pragma("unroll") for (int _i = 0; _i < 2; ++_i) \
        __builtin_amdgcn_global_load_lds((const unsigned*)((const char*)(gbase) + (voff)[_i]), (PG8_LAS unsigned*)(lds + (bufoff) + ldsw + _i * 8192), 16, 0, 0); } while (0)
#define PG8_STAGE_A(bufoff, kbase, off) do { _Pragma("unroll") for (int _i = 0; _i < 2; ++_i) \
        __builtin_amdgcn_global_load_lds((const unsigned*)((const char*)(kbase) + (off)[_i]), (PG8_LAS unsigned*)(lds + (bufoff) + ldsw + _i * 8192), 16, 0, 0); } while (0)
#define PG8_LDA(dst, b, h) do { _Pragma("unroll") for (int m = 0; m < 4; ++m) { if constexpr (EB == 1) dst##8[m] = cat32(*(const PG8_LAS bf16x8*)(lds + PG8_SA(b, h) + aoff + m * 2048), *(const PG8_LAS bf16x8*)(lds + PG8_SA(b, h) + aoff + m * 2048 + 1024)); \
        else { _Pragma("unroll") for (int k = 0; k < 2; ++k) dst[m][k] = *(const PG8_LAS bf16x8*)(lds + PG8_SA(b, h) + aoff + m * 2048 + k * 1024); } } } while (0)
#define PG8_LDB(dst, b, h) do { _Pragma("unroll") for (int n = 0; n < 2; ++n) { if constexpr (EB == 1) dst##8[n] = cat32(*(const PG8_LAS bf16x8*)(lds + PG8_SB(b, h) + boff + n * 2048), *(const PG8_LAS bf16x8*)(lds + PG8_SB(b, h) + boff + n * 2048 + 1024)); \
        else { _Pragma("unroll") for (int k = 0; k < 2; ++k) dst[n][k] = *(const PG8_LAS bf16x8*)(lds + PG8_SB(b, h) + boff + n * 2048 + k * 1024); } } } while (0)
#define PG8_MMA(ai, bj, At, Bt) do { __builtin_amdgcn_s_setprio(1); _Pragma("unroll") for (int m = 0; m < 4; ++m) _Pragma("unroll") for (int n = 0; n < 2; ++n) { \
        if constexpr (EB == 1) asm volatile("v_mfma_scale_f32_16x16x128_f8f6f4 %0, %1, %2, %0, %3, %4 op_sel_hi:[0,0,0]" : "+v"(acc[ai][bj][m][n]) : "v"(Bt##8[n]), "v"(At##8[m]), "v"(scw_), "v"(sca_)); \
        else { _Pragma("unroll") for (int k = 0; k < 2; ++k) acc[ai][bj][m][n] = __builtin_amdgcn_mfma_f32_16x16x32_bf16(Bt[n][k], At[m][k], acc[ai][bj][m][n], 0, 0, 0); } } \
        __builtin_amdgcn_s_setprio(0); } while (0)
#define PG8_WAIT_V(n) asm volatile("s_waitcnt vmcnt(" #n ")" ::: "memory")
#define PG8_WAIT_L(n) asm volatile("s_waitcnt lgkmcnt(" #n ")" ::: "memory")
#define PG8_BAR __builtin_amdgcn_s_barrier()
#define PG8_SCHED __builtin_amdgcn_sched_barrier(0)
    Unit cur, nxt; int ui = 0;
    if (!S.next(0, cur)) return;
    f32x4 acc[2][2][4][2];
#pragma unroll
    for (int a = 0; a < 2; ++a)
#pragma unroll
        for (int b = 0; b < 2; ++b)
#pragma unroll
            for (int m = 0; m < 4; ++m)
#pragma unroll
                for (int n = 0; n < 2; ++n) acc[a][b][m][n] = (f32x4){0.f, 0.f, 0.f, 0.f};
    int scw_ = 0x79797979, sca_ = 0x7F7F7F7F; asm volatile("" : "+v"(scw_), "+v"(sca_));
    bf16x8 At[4][2], B0[2][2], B1[2][2]; v8i32 At8[4], B08[2], B18[2];
    const char* const Ab = (const char*)g.A; const char* cB = (const char*)g.Bt + (size_t)cur.pn * tstep;
    PG8_AOFF(ao, cur);
    S.a_ready(cur);
    if constexpr (SP2) {
        PG8_STAGE(PG8_SB(0, 0), cB, voffB); PG8_STAGE(PG8_SB(0, 1), cB + hstep, voffB); PG8_STAGE_A(PG8_SA(0, 0), Ab, ao[0]); PG8_STAGE_A(PG8_SA(0, 1), Ab, ao[1]);
        if (wr == 1) PG8_BAR;
        PG8_WAIT_V(2); PG8_BAR;
        PG8_STAGE(PG8_SB(1, 0), cB + kstep, voffB); PG8_STAGE_A(PG8_SA(1, 0), Ab + kstep, ao[0]); PG8_STAGE(PG8_SB(1, 1), cB + hstep + kstep, voffB);
        PG8_WAIT_V(6); PG8_BAR;
    } else {
        PG8_STAGE(PG8_SB(0, 0), cB, voffB); PG8_STAGE_A(PG8_SA(0, 0), Ab, ao[0]); PG8_STAGE(PG8_SB(0, 1), cB + hstep, voffB); PG8_STAGE_A(PG8_SA(0, 1), Ab, ao[1]);
        if (wr == 1) PG8_BAR;
        PG8_WAIT_V(4); PG8_BAR;
        PG8_STAGE(PG8_SB(1, 0), cB + kstep, voffB); PG8_STAGE_A(PG8_SA(1, 0), Ab + kstep, ao[0]); PG8_STAGE(PG8_SB(1, 1), cB + hstep + kstep, voffB);
        PG8_WAIT_V(6); PG8_BAR;
    }
    for (;;) {
        const bool has_next = S.next(ui + 1, nxt);
        const char* nB = has_next ? (const char*)g.Bt + (size_t)nxt.pn * tstep : cB;
        if (has_next) { PG8_AOFF(an, nxt); } else { _Pragma("unroll") for (int h_ = 0; h_ < 2; ++h_) _Pragma("unroll") for (int i_ = 0; i_ < 2; ++i_) an[h_][i_] = ao[h_][i_]; }
        for (int t = 0; t < nt; t += 2) {
            const bool last = (t == nt - 2);
            const char* a1 = Ab + (size_t)(t + 1) * kstep;
            const char* a2 = last ? Ab : Ab + (size_t)(t + 2) * kstep; const char* b2 = last ? nB : cB + (size_t)(t + 2) * kstep;
            const char* a3 = a2 + kstep; const char* b3 = b2 + kstep;
            unsigned as[2][2];
#pragma unroll
            for (int h_ = 0; h_ < 2; ++h_)
#pragma unroll
                for (int i_ = 0; i_ < 2; ++i_) as[h_][i_] = last ? an[h_][i_] : ao[h_][i_];
            if (last && has_next) S.a_ready(nxt);
            if constexpr (SP2) {
            PG8_LDB(B0, 0, 0); PG8_LDB(B1, 0, 1); PG8_SCHED; PG8_LDA(At, 0, 0); PG8_STAGE_A(PG8_SA(1, 1), a1, ao[1]);
            PG8_WAIT_V(8); PG8_WAIT_L(0); PG8_BAR; PG8_MMA(0, 0, At, B0); PG8_MMA(0, 1, At, B1); PG8_BAR; PG8_SCHED;
            PG8_LDA(At, 0, 1); PG8_STAGE(PG8_SB(0, 0), b2, voffB); PG8_STAGE(PG8_SB(0, 1), b2 + hstep, voffB); PG8_STAGE_A(PG8_SA(0, 0), a2, as[0]);
            PG8_WAIT_V(8); PG8_WAIT_L(0); PG8_BAR; PG8_MMA(1, 0, At, B0); PG8_MMA(1, 1, At, B1); PG8_BAR; PG8_SCHED;
            PG8_LDB(B0, 1, 0); PG8_LDB(B1, 1, 1); PG8_SCHED; PG8_LDA(At, 1, 0); PG8_STAGE_A(PG8_SA(0, 1), a2, as[1]);
            PG8_WAIT_V(8); PG8_WAIT_L(0); PG8_BAR; PG8_MMA(0, 0, At, B0); PG8_MMA(0, 1, At, B1); PG8_BAR; PG8_SCHED;
            PG8_LDA(At, 1, 1); PG8_STAGE(PG8_SB(1, 0), b3, voffB); PG8_STAGE(PG8_SB(1, 1), b3 + hstep, voffB); PG8_STAGE_A(PG8_SA(1, 0), a3, as[0]);
            PG8_WAIT_V(8); PG8_WAIT_L(0); PG8_BAR; PG8_MMA(1, 0, At, B0); PG8_MMA(1, 1, At, B1); PG8_BAR; PG8_SCHED;
            } else {
            PG8_LDB(B0, 0, 0); PG8_SCHED; PG8_LDA(At, 0, 0); PG8_STAGE_A(PG8_SA(1, 1), a1, ao[1]);
            PG8_WAIT_L(8); PG8_BAR; PG8_WAIT_L(0); PG8_MMA(0, 0, At, B0); PG8_BAR; PG8_SCHED;
            PG8_LDB(B1, 0, 1); PG8_STAGE(PG8_SB(0, 0), b2, voffB);
            PG8_BAR; PG8_WAIT_L(0); PG8_MMA(0, 1, At, B1); PG8_BAR;
            PG8_LDA(At, 0, 1); PG8_STAGE_A(PG8_SA(0, 0), a2, as[0]);
            PG8_BAR; PG8_WAIT_L(0); PG8_MMA(1, 0, At, B0); PG8_BAR; PG8_SCHED;
            PG8_STAGE(PG8_SB(0, 1), b2 + hstep, voffB);
            PG8_WAIT_V(6); PG8_BAR; PG8_MMA(1, 1, At, B1); PG8_BAR;
            PG8_LDB(B0, 1, 0); PG8_SCHED; PG8_LDA(At, 1, 0); PG8_STAGE_A(PG8_SA(0, 1), a2, as[1]);
            PG8_WAIT_L(8); PG8_BAR; PG8_WAIT_L(0); PG8_MMA(0, 0, At, B0); PG8_BAR; PG8_SCHED;
            PG8_LDB(B1, 1, 1); PG8_STAGE(PG8_SB(1, 0), b3, voffB);
            PG8_BAR; PG8_WAIT_L(0); PG8_MMA(0, 1, At, B1); PG8_BAR;
            PG8_LDA(At, 1, 1); PG8_STAGE_A(PG8_SA(1, 0), a3, as[0]);
            PG8_BAR; PG8_WAIT_L(0); PG8_MMA(1, 0, At, B0); PG8_BAR; PG8_SCHED;
            PG8_STAGE(PG8_SB(1, 1), b3 + hstep, voffB);
            PG8_WAIT_V(6); PG8_BAR; PG8_MMA(1, 1, At, B1); PG8_BAR;
            }
        }
        if constexpr (EB == 1) asm volatile("s_nop 15\n\ts_nop 15" ::: "memory");
        if constexpr (ALIGN_EPI) { if (wr == 0) PG8_BAR; }
        if constexpr (!Epi::AFTER_DRAIN) { E(acc, cur, wr, wc, fr, fq); S.done(cur); }
        if (!has_next) break;
#pragma unroll
        for (int a = 0; a < 2; ++a)
#pragma unroll
            for (int b = 0; b < 2; ++b)
#pragma unroll
                for (int m = 0; m < 4; ++m)
#pragma unroll
                    for (int n = 0; n < 2; ++n) acc[a][b][m][n] = (f32x4){0.f, 0.f, 0.f, 0.f};
        cur = nxt; cB = nB; ++ui;
#pragma unroll
        for (int h_ = 0; h_ < 2; ++h_)
#pragma unroll
            for (int i_ = 0; i_ < 2; ++i_) ao[h_][i_] = an[h_][i_];
        if constexpr (ALIGN_EPI) { if (wr == 1) PG8_BAR; }
    }
    PG8_WAIT_V(0);
    if constexpr (!ALIGN_EPI) { if (wr == 0) PG8_BAR; }
    PG8_BAR;
    if constexpr (Epi::AFTER_DRAIN) { E.fused(acc, cur, wr, wc, fr, fq, lds, wid, lane); S.done(cur); }
#undef PG8_SA
#undef PG8_SB
#undef PG8_STAGE
#undef PG8_STAGE_A
#undef PG8_AOFF
#undef PG8_LDA
#undef PG8_LDB
#undef PG8_MMA
#undef PG8_WAIT_V
#undef PG8_WAIT_L
#undef PG8_BAR
#undef PG8_SCHED
}
}
constexpr int NWAVES = 8;
constexpr int RING_OFF = 0, RING_BYTES = 131072;
constexpr int LDSCTL_OFF = 150 * 1024, MISC_OFF = LDSCTL_OFF + 320;
constexpr int LDS_BYTES = 160 * 1024;
constexpr size_t MiB = 1u << 20;
constexpr size_t WS_CTL = 0, CTL_ZERO_BYTES = 1 * MiB;
constexpr size_t WS_MOD = 1 * MiB;
constexpr size_t WS_RWP = WS_MOD + 128 * 1024;
constexpr size_t WS_CS = 2 * MiB;
constexpr size_t WS_LOGF = 4 * MiB;
constexpr size_t WS_CB = WS_LOGF + 256 * 1024;
constexpr size_t WS_Z = WS_CB + 256 * 1024;
constexpr size_t WS_WIN = 6 * MiB;
constexpr size_t WS_WOUT = 34 * MiB;
constexpr size_t WS_HB = 42 * MiB;
constexpr size_t WS_QKV = 74 * MiB;
constexpr size_t TSZ = (size_t)16 * 4096 * 128;
constexpr size_t WS_FAST_END = 186 * MiB;
constexpr size_t WS_YB = 74 * MiB;
constexpr size_t WS_GB = 74 * MiB;
constexpr size_t WS_YS = 110 * MiB;
constexpr size_t WS_W13 = 266 * MiB;
constexpr size_t WS_W2 = 394 * MiB;
constexpr size_t WS_LIST = 458 * MiB;
constexpr size_t WS_SLOT = 459 * MiB;
constexpr size_t WS_END = 460 * MiB;
constexpr int ECAP = 8192, CW_CNT = 32768;
constexpr int CW_BAR = 4096;

struct Frame {
    LAS unsigned char* lds; char* ldsg;
    volatile LAS unsigned* MISC;
    gu32* ctl;
    int tid, lane, wave, G, gw, NGW, cnt_off;
    const float* in[22]; float* out; unsigned char* ws;
};
struct Args { const float* in[22]; float* out; unsigned char* ws; int ph_lo, ph_hi, cnt_off, pad; };

template <int CTRL> __device__ __forceinline__ float dppa(float v) { const int t = __builtin_amdgcn_update_dpp(0, __float_as_int(v), CTRL, 0xf, 0xf, true); return v + __int_as_float(t); }
__device__ __forceinline__ float row16_sum(float v) { v = dppa<0xB1>(v); v = dppa<0x4E>(v); v = dppa<0x141>(v); v = dppa<0x140>(v); return v; }
__device__ __forceinline__ float half32_sum(float v) { v = row16_sum(v); return v + __shfl_xor(v, 16); }
__device__ __forceinline__ float wave_sum(float v) {
    v = row16_sum(v);
    const float s0 = __int_as_float(__builtin_amdgcn_readlane(__float_as_int(v), 0)), s1 = __int_as_float(__builtin_amdgcn_readlane(__float_as_int(v), 16));
    const float s2 = __int_as_float(__builtin_amdgcn_readlane(__float_as_int(v), 32)), s3 = __int_as_float(__builtin_amdgcn_readlane(__float_as_int(v), 48));
    return (s0 + s1) + (s2 + s3);
}
__device__ __forceinline__ float silu_f(float v) { return v / (1.f + __expf(-v)); }
__device__ __forceinline__ unsigned fp8x4(float a, float b, float c, float d) { unsigned w = 0; w = __builtin_amdgcn_cvt_pk_fp8_f32(a, b, w, false); w = __builtin_amdgcn_cvt_pk_fp8_f32(c, d, w, true); return w; }

__device__ __forceinline__ void p0_mod(Frame& F) {
    const float* c = F.in[1]; const float* ada_w = F.in[2]; const float* ada_b = F.in[3];
    float* mod = (float*)(F.ws + WS_MOD);
    LAS float* ca = (LAS float*)(F.lds);
    LAS f32x4* red = (LAS f32x4*)(ca + 2 * DM);
    for (int i = F.tid; i < 2 * DM; i += NWAVES * 64) ca[i] = silu_f(c[i]);
    __syncthreads();
    const int rs = F.lane / 12, c4 = F.lane % 12;
    for (int cb = blockIdx.x; cb < 256; cb += F.G) {
        const int j0 = cb * 48;
        f32x4 a0 = {0.f, 0.f, 0.f, 0.f}, a1 = {0.f, 0.f, 0.f, 0.f};
        if (F.lane < 60) {
            const float* wp = ada_w + (size_t)(F.wave * 256) * (6 * DM) + j0 + 4 * c4;
#pragma unroll 1
            for (int i0 = 0; i0 < 52; i0 += 13) {
                f32x4 wv[13];
#pragma unroll
                for (int i = 0; i < 13; ++i) { const int kl = 5 * (i0 + i) + rs; wv[i] = kl < 256 ? *(const f32x4*)(wp + (size_t)kl * (6 * DM)) : (f32x4){0.f, 0.f, 0.f, 0.f}; }
#pragma unroll
                for (int i = 0; i < 13; ++i) { const int kl = 5 * (i0 + i) + rs; const int k = F.wave * 256 + (kl < 256 ? kl : 0); a0 += wv[i] * ca[k]; a1 += wv[i] * ca[DM + k]; }
            }
        }
        red[(F.wave * 64 + F.lane) * 2] = a0; red[(F.wave * 64 + F.lane) * 2 + 1] = a1;
        __syncthreads();
        if (F.tid < 96) { const int b = F.tid / 48, jj = F.tid % 48, cc = jj >> 2, el = jj & 3; float s = 0.f;
            for (int w = 0; w < NWAVES; ++w)
#pragma unroll
                for (int r = 0; r < 5; ++r) s += red[(w * 64 + r * 12 + cc) * 2 + b][el];
            mod[b * 6 * DM + j0 + jj] = s + ada_b[j0 + jj]; }
        __syncthreads();
    }
}
template <bool ROPE = false>
__device__ __forceinline__ void tr_tile(const float* __restrict__ src, int ldn, int k0, int n0, bf16* __restrict__ dst, int ldk, int drow0, LAS float* scr, int lane) {
#pragma unroll 4
    for (int i = 0; i < 16; ++i) { const int kk = 4 * i + (lane >> 4);
        const f32x4 v = *(const f32x4*)(src + (size_t)(k0 + kk) * ldn + n0 + 4 * (lane & 15));
        LAS float* p = scr + kk * 65 + 4 * (lane & 15); p[0] = v.x; p[1] = v.y; p[2] = v.z; p[3] = v.w; }
    LDS_WAIT(); asm volatile("" ::: "memory");
    const int c = lane & 7;
#pragma unroll
    for (int jj = 0; jj < 8; ++jj) { const int n = (lane >> 3) + 8 * jj; const LAS float* s = scr + (8 * c) * 65 + n;
        v4u o; o.x = pk2(s[0], s[65]); o.y = pk2(s[130], s[195]); o.z = pk2(s[260], s[325]); o.w = pk2(s[390], s[455]);
        int drow = drow0 + n;
        if (ROPE) { const int d = (n0 & 127) + n; drow = drow0 + 32 * ((d >> 4) & 3) + 8 * ((d >> 2) & 3) + 4 * (d >> 6) + (d & 3); }
        *(v4u*)(dst + (size_t)drow * ldk + k0 + 8 * c) = o; }
    LDS_WAIT(); asm volatile("" ::: "memory");
}
constexpr int CW_CONVQ = 2112, CW_DONE = 2176;
constexpr int I_E = 256 * NE, CONV_PER_WAVE = 2, N_CONV_BI = 3 * I_E / (NWAVES * CONV_PER_WAVE);
struct ConvTile { const float* src; unsigned char* dst; int ldn, ldk; };
__device__ __forceinline__ ConvTile conv_decode(Frame& F, int r) {
    ConvTile t;
    if (r < 2 * I_E) { const int which = r / I_E, rr = r % I_E, e = rr >> 8, q = rr & 255, kt = q >> 3, nt = q & 7;
        t.src = (which == 0 ? F.in[19] : F.in[20]) + (size_t)e * DM * DE + (size_t)(64 * kt) * DE + 64 * nt; t.ldn = DE;
        t.dst = (unsigned char*)(F.ws + WS_W13) + (size_t)(e * 1024 + (nt >> 1) * 256 + which * 128 + (nt & 1) * 64) * DM + 64 * kt; t.ldk = DM; return t; }
    r -= 2 * I_E;
    { const int e = r >> 8, q = r & 255, kt = q >> 5, nt = q & 31;
      t.src = F.in[21] + (size_t)e * DE * DM + (size_t)(64 * kt) * DM + 64 * nt; t.ldn = DM;
      t.dst = (unsigned char*)(F.ws + WS_W2) + (size_t)(e * 2048 + 64 * nt) * DE + 64 * kt; t.ldk = DE; }
    return t;
}
__device__ __forceinline__ void conv_load(const ConvTile& t, f32x4 (&v)[16], int lane) {
#pragma unroll
    for (int i = 0; i < 16; ++i) v[i] = *(const f32x4*)(t.src + (size_t)(4 * i + (lane >> 4)) * t.ldn + 4 * (lane & 15));
}
__device__ __forceinline__ void conv_store(const ConvTile& t, const f32x4 (&v)[16], LAS float* scr, int lane) {
#pragma unroll
    for (int i = 0; i < 16; ++i) { LAS float* p = scr + (4 * i + (lane >> 4)) * 65 + 4 * (lane & 15); p[0] = v[i].x; p[1] = v[i].y; p[2] = v[i].z; p[3] = v[i].w; }
    LDS_WAIT(); asm volatile("" ::: "memory");
    const int c = lane & 7;
#pragma unroll
    for (int jj = 0; jj < 8; ++jj) { const int n = (lane >> 3) + 8 * jj; const LAS float* s = scr + (8 * c) * 65 + n;
        uint2 o; o.x = fp8x4(s[0] * 64.f, s[65] * 64.f, s[130] * 64.f, s[195] * 64.f); o.y = fp8x4(s[260] * 64.f, s[325] * 64.f, s[390] * 64.f, s[455] * 64.f);
        *(uint2*)(t.dst + (size_t)n * t.ldk + 8 * c) = o; }
    LDS_WAIT(); asm volatile("" ::: "memory");
}
constexpr int N_CONV_13 = 2 * I_E / (NWAVES * CONV_PER_WAVE);
__device__ __forceinline__ unsigned conv_pull(Frame& F, unsigned qlimit) {
    return __hip_atomic_fetch_add(F.ctl + CW_CONVQ, 1u, RLX_AGENT);
}
__device__ __forceinline__ void filler(Frame& F, int ph, int mode, unsigned nfin, unsigned early, unsigned qlimit) {
    __syncthreads();
    LAS float* scr = (LAS float*)(F.lds) + F.wave * (64 * 65);
    unsigned nxt = 0xffffffffu;
    if (F.tid == 0) { bool go = true;
        if (mode == 0) go = __hip_atomic_fetch_add(F.ctl + CW_DONE + 64 * ph, 1u, RLX_AGENT) < early;
        if (mode == 1) go = __hip_atomic_load(F.ctl + CW_DONE + 64 * ph, RLX_AGENT) < nfin;
        if (go) nxt = conv_pull(F, qlimit); }
    for (;;) {
        if (F.tid == 0) F.MISC[1] = nxt;
        __syncthreads();
        const unsigned it = F.MISC[1];
        __syncthreads();
        if (it >= (unsigned)N_CONV_BI) break;
        if (F.tid == 0) { const bool stop = mode != 2 && __hip_atomic_load(F.ctl + CW_DONE + 64 * ph, RLX_AGENT) >= nfin;
            nxt = stop ? 0xffffffffu : conv_pull(F, qlimit); }
        const int r0 = ((int)it * NWAVES + F.wave) * CONV_PER_WAVE;
        const ConvTile t0 = conv_decode(F, r0), t1 = conv_decode(F, r0 + 1);
        f32x4 va[16], vb[16];
        conv_load(t0, va, F.lane); conv_load(t1, vb, F.lane);
        conv_store(t0, va, scr, F.lane); conv_store(t1, vb, scr, F.lane);
    }
}
template <bool EXPERTS>
__device__ __forceinline__ void p0_prologue(Frame& F) {
    p0_mod(F);
    __syncthreads();
    LAS float* scr = (LAS float*)(F.lds) + F.wave * (64 * 65);
    bf16* WinT = (bf16*)(F.ws + WS_WIN); bf16* WoutT = (bf16*)(F.ws + WS_WOUT);
    constexpr int I_IN = 32 * 112, I_OUT = 32 * 32;
    constexpr int NIT = I_IN + I_OUT;
    for (int it = F.gw; it < NIT; it += F.NGW) {
        int r = it;
        if (r < I_IN) { const int nt = r % 112;
            if (nt < 32) tr_tile<true>(F.in[6], INC, 64 * (r / 112), 64 * nt, WinT, DM, 128 * (nt >> 1), scr, F.lane);
            else tr_tile<false>(F.in[6], INC, 64 * (r / 112), 64 * nt, WinT, DM, 64 * nt, scr, F.lane);
            continue; } r -= I_IN;
        if (r < I_OUT) { tr_tile<false>(F.in[12], DM, 64 * (r / 32), 64 * (r % 32), WoutT, DM, 64 * (r % 32), scr, F.lane); continue; } r -= I_OUT;
    }
    { bf16* rh = (bf16*)(F.ws + WS_RWP); bf16* rl = rh + 48 * DM; const float* rcw = F.in[15]; const float* rfw = F.in[17];
      for (int idx = blockIdx.x * (NWAVES * 64) + F.tid; idx < 48 * DM; idx += F.G * NWAVES * 64) {
          const int o = idx >> 11, k = idx & 2047; const float v = o < 4 ? rcw[k * 4 + o] : (o < 36 ? rfw[k * 32 + (o - 4)] : 0.f);
          const unsigned h = f2bf(v); const float hf = __uint_as_float(h << 16);
          rh[idx] = (bf16)h; rl[idx] = (bf16)f2bf(v - hf); } }
    { float* cs = (float*)(F.ws + WS_CS);
      for (int idx = blockIdx.x * (NWAVES * 64) + F.tid; idx < SEQ * 64; idx += F.G * NWAVES * 64) {
          const int i = idx & 63, s = idx >> 6; const float inv_freq = powf(10000.f, -(float)(2 * i) / 128.f); const float ang = (float)s * inv_freq;
          cs[2 * idx] = cosf(ang); cs[2 * idx + 1] = sinf(ang); } }
}

__device__ __forceinline__ void p1_row(Frame& F, int row, const f32x4 (&v)[8], const LAS f32x4* wf, const LAS f32x4* par, bf16* Hb, float* logf, float* zb, const float* fbias) {
    const int b = row >> 12, s = row & 4095;
    float ss = 0.f;
#pragma unroll
    for (int j = 0; j < 8; ++j) ss += (v[j].x * v[j].x + v[j].y * v[j].y) + (v[j].z * v[j].z + v[j].w * v[j].w);
    const float rstd = rsqrtf(wave_sum(ss) * (1.f / DM) + EPS);
    float acc[8];
#pragma unroll
    for (int o = 0; o < 8; ++o) acc[o] = 0.f;
    unsigned long long* o8 = (unsigned long long*)(Hb + (size_t)row * DM) + F.lane;
#pragma unroll
    for (int j = 0; j < 8; ++j) {
        const f32x4 h = v[j] * rstd * par[(b * 2) * 512 + 64 * j + F.lane] + par[(b * 2 + 1) * 512 + 64 * j + F.lane];
        o8[64 * j] = (unsigned long long)pk2(h.x, h.y) | ((unsigned long long)pk2(h.z, h.w) << 32);
#pragma unroll
        for (int i = 0; i < 4; ++i) { const f32x4 wa = wf[((j * 4 + i) * 2 + 0) * 64 + F.lane], wb = wf[((j * 4 + i) * 2 + 1) * 64 + F.lane]; const float hv = h[i];
            acc[0] = fmaf(hv, wa.x, acc[0]); acc[1] = fmaf(hv, wa.y, acc[1]); acc[2] = fmaf(hv, wa.z, acc[2]); acc[3] = fmaf(hv, wa.w, acc[3]);
            acc[4] = fmaf(hv, wb.x, acc[4]); acc[5] = fmaf(hv, wb.y, acc[5]); acc[6] = fmaf(hv, wb.z, acc[6]); acc[7] = fmaf(hv, wb.w, acc[7]); }
        asm volatile("" ::: "memory");
    }
    float z = 0.f;
#pragma unroll
    for (int o = 0; o < 8; ++o) { const float t = wave_sum(acc[o]); z = (F.lane == o) ? t : z; }
    if (F.lane < 8) { const float zz = z + fbias[F.lane];
        logf[((size_t)b * NH + F.lane) * SEQ + s] = fminf(zz, 0.f) - log1pf(expf(-fabsf(zz)));
        zb[(size_t)row * 8 + F.lane] = z; }
}
__device__ __forceinline__ void p1_prenorm(Frame& F) {
    const float* x = F.in[0]; const float* wpre = F.in[4]; const float* w_in = F.in[6]; const float* fbias = F.in[7];
    const float* mod = (const float*)(F.ws + WS_MOD);
    bf16* Hb = (bf16*)(F.ws + WS_HB); float* logf = (float*)(F.ws + WS_LOGF); float* zb = (float*)(F.ws + WS_Z);
    LAS f32x4* wf = (LAS f32x4*)F.lds;
    LAS f32x4* par = wf + 4096;
    for (int idx = F.tid; idx < 4096; idx += NWAVES * 64) { const int l = idx & 63, half = (idx >> 6) & 1, i = (idx >> 7) & 3, j = idx >> 9;
        wf[idx] = *(const f32x4*)(w_in + (size_t)(256 * j + 4 * l + i) * INC + INCM + 4 * half); }
    for (int c = F.tid; c < 1024; c += NWAVES * 64) { const int b = c >> 9, cc = c & 511; const f32x4* mb = (const f32x4*)(mod + (size_t)b * 6 * DM);
        par[(b * 2) * 512 + cc] = ((const f32x4*)wpre)[cc] * (mb[512 + cc] + 1.0f); par[(b * 2 + 1) * 512 + cc] = mb[cc]; }
    LDS_WAIT(); __syncthreads();
    int row = F.gw; if (row >= T) return;
    f32x4 va[8], vb[8];
    { const f32x4* xr = (const f32x4*)(x + (size_t)row * DM) + F.lane;
#pragma unroll
      for (int j = 0; j < 8; ++j) va[j] = xr[64 * j]; }
    for (;;) {
        const int r1 = row + F.NGW;
        if (r1 < T) { const f32x4* xr = (const f32x4*)(x + (size_t)r1 * DM) + F.lane;
#pragma unroll
            for (int j = 0; j < 8; ++j) vb[j] = xr[64 * j]; }
        p1_row(F, row, va, wf, par, Hb, logf, zb, fbias);
        if (r1 >= T) break;
        const int r2 = r1 + F.NGW;
        if (r2 < T) { const f32x4* xr = (const f32x4*)(x + (size_t)r2 * DM) + F.lane;
#pragma unroll
            for (int j = 0; j < 8; ++j) va[j] = xr[64 * j]; }
        p1_row(F, r1, vb, wf, par, Hb, logf, zb, fbias);
        if (r2 >= T) break;
        row = r2;
    }
}

constexpr int EPI_SCR = RING_BYTES;
struct EpiHeads {
    static constexpr bool PERM = true, AFTER_DRAIN = false;
    bf16* base; const float* cs; const float* qn; const float* kn; LAS unsigned char* lds;
    __device__ __forceinline__ void operator()(const pg8::f32x4 (&acc)[2][2][4][2], const pg8::Unit& u, int wr, int wc, int fr, int fq) const {
        const int type = u.pn >> 2, head0 = (u.pn & 3) * 2; const int row0 = u.pm * 256 + wr * 64 + fr;
        if (type <= 1) {
            const int i0 = 16 * wc + 4 * fq; const float sc = type == 1 ? 0.08838834764831845f : 1.f;
#pragma unroll
            for (int ai = 0; ai < 2; ++ai)
#pragma unroll
                for (int m = 0; m < 4; ++m) { const int r = row0 + ai * 128 + m * 16, b = r >> 12, s = r & 4095;
                    const pg8::f32x4 c0 = *(const pg8::f32x4*)(cs + ((size_t)s * 64 + i0) * 2), c1 = *(const pg8::f32x4*)(cs + ((size_t)s * 64 + i0) * 2 + 4);
                    const float cv[4] = {c0[0], c0[2], c1[0], c1[2]}, sv[4] = {c0[1], c0[3], c1[1], c1[3]};
#pragma unroll
                    for (int bj = 0; bj < 2; ++bj) { const pg8::f32x4 x1 = acc[ai][bj][m][0], x2 = acc[ai][bj][m][1]; float o1[4], o2[4];
#pragma unroll
                        for (int j = 0; j < 4; ++j) { o1[j] = (x1[j] * cv[j] - x2[j] * sv[j]) * sc; o2[j] = (x1[j] * sv[j] + x2[j] * cv[j]) * sc; }
                        bf16* dst = base + (size_t)type * TSZ + ((size_t)((b * 8 + head0 + bj) * SEQ + s)) * HD + i0;
                        uint2 w1, w2; w1.x = pg8::cvt_pk_bf16(o1[0], o1[1]); w1.y = pg8::cvt_pk_bf16(o1[2], o1[3]); w2.x = pg8::cvt_pk_bf16(o2[0], o2[1]); w2.y = pg8::cvt_pk_bf16(o2[2], o2[3]);
                        *(uint2*)dst = w1; *(uint2*)(dst + 64) = w2; } }
            return;
        }
        float rs[2][4][2];
        if (type == 4 || type == 5) {
            LAS float* P = (LAS float*)(lds + EPI_SCR);
#pragma unroll
            for (int ai = 0; ai < 2; ++ai)
#pragma unroll
                for (int m = 0; m < 4; ++m)
#pragma unroll
                    for (int bj = 0; bj < 2; ++bj) { const pg8::f32x4 v0 = acc[ai][bj][m][0], v1 = acc[ai][bj][m][1];
                        float q = ((v0[0] * v0[0] + v0[1] * v0[1]) + (v0[2] * v0[2] + v0[3] * v0[3])) + ((v1[0] * v1[0] + v1[1] * v1[1]) + (v1[2] * v1[2] + v1[3] * v1[3]));
                        q += __shfl_xor(q, 16); q += __shfl_xor(q, 32);
                        if (fq == 0) P[((ai * 128 + wr * 64 + m * 16 + fr) * 2 + bj) * 4 + wc] = q; }
            asm volatile("s_waitcnt lgkmcnt(0)" ::: "memory"); __builtin_amdgcn_s_barrier(); asm volatile("" ::: "memory");
#pragma unroll
            for (int ai = 0; ai < 2; ++ai)
#pragma unroll
                for (int m = 0; m < 4; ++m)
#pragma unroll
                    for (int bj = 0; bj < 2; ++bj) { const pg8::f32x4 p4 = *(const LAS pg8::f32x4*)(P + ((ai * 128 + wr * 64 + m * 16 + fr) * 2 + bj) * 4);
                        rs[ai][m][bj] = rsqrtf(((p4[0] + p4[1]) + (p4[2] + p4[3])) * (1.f / 128.f) + EPS); }
            asm volatile("s_waitcnt lgkmcnt(0)" ::: "memory"); __builtin_amdgcn_s_barrier(); asm volatile("" ::: "memory");
        }
        pg8::f32x4 g0 = {1.f, 1.f, 1.f, 1.f}, g1 = {1.f, 1.f, 1.f, 1.f};
        if (type == 4 || type == 5) { const float* gp = (type == 4 ? qn : kn) + wc * 32 + 8 * fq; g0 = *(const pg8::f32x4*)gp; g1 = *(const pg8::f32x4*)(gp + 4); }
#pragma unroll
        for (int ai = 0; ai < 2; ++ai)
#pragma unroll
            for (int m = 0; m < 4; ++m) { const int r = row0 + ai * 128 + m * 16, b = r >> 12, s = r & 4095;
#pragma unroll
                for (int bj = 0; bj < 2; ++bj) { pg8::f32x4 v0 = acc[ai][bj][m][0], v1 = acc[ai][bj][m][1];
                    if (type == 4 || type == 5) { v0 = v0 * rs[ai][m][bj] * g0; v1 = v1 * rs[ai][m][bj] * g1; }
                    if (type == 3) {
#pragma unroll
                        for (int j = 0; j < 4; ++j) { v0[j] = v0[j] * __builtin_amdgcn_rcpf(1.f + __expf(-v0[j])); v1[j] = v1[j] * __builtin_amdgcn_rcpf(1.f + __expf(-v1[j])); } }
                    pg8::u32x4 w; w.x = pg8::cvt_pk_bf16(v0[0], v0[1]); w.y = pg8::cvt_pk_bf16(v0[2], v0[3]); w.z = pg8::cvt_pk_bf16(v1[0], v1[1]); w.w = pg8::cvt_pk_bf16(v1[2], v1[3]);
                    *(pg8::u32x4*)(base + (size_t)type * TSZ + ((size_t)((b * 8 + head0 + bj) * SEQ + s)) * HD + wc * 32 + 8 * fq) = w; } }
    }
};

namespace fox {
__device__ __forceinline__ int fox_tid() { int t = threadIdx.x; asm volatile("" : "+v"(t)); return t; }
typedef unsigned short bf16;
constexpr int D = 128, OLD = 2048;
constexpr bool WSKIP = false; constexpr float THR = 8.f;
constexpr float SCALE = 0.08838834764831845f;
constexpr int NW = 8, QBLK = 32, KVBLK = 64, QB = NW * QBLK;
constexpr int SHM_V = KVBLK * D * 2, SHM_K = KVBLK * D * 2;
constexpr int LDS_BYTES = 2 * SHM_V + 2 * SHM_K + NW * 64 * 4 + 2 * 64 * 4;
typedef short bf16x8 __attribute__((ext_vector_type(8)));
typedef short s16x4 __attribute__((ext_vector_type(4)));
typedef float f32x16 __attribute__((ext_vector_type(16)));
typedef float f32x4 __attribute__((ext_vector_type(4)));
typedef unsigned u32x4 __attribute__((ext_vector_type(4)));
template <class A, class Bt> struct same_t { static constexpr bool v = false; };
template <class A> struct same_t<A, A> { static constexpr bool v = true; };

#define KSWZ(row, colB) ((row) * 256 + ((colB) ^ (((row) & 7) << 4)))
#define SBAR() __builtin_amdgcn_sched_barrier(0)
__device__ __forceinline__ int v_st(int k, int c) { const int kk = (k & ~0xC) | ((k & 4) << 1) | ((k & 8) >> 1); return ((kk >> 3) * 4 + (c >> 5)) * 512 + ((kk & 7) * 32 + (c & 31)) * 2; }
__device__ __forceinline__ int v_rd_base(int lane) { return ((lane & 3) << 3) | (((lane >> 2) & 3) << 6) | (((lane >> 4) & 1) << 5) | (((lane >> 5) & 1) << 8); }
constexpr int v_rd_off(int d0, int ks, int half) { return d0 * 512 + ks * 4096 + half * 2048; }
__device__ __forceinline__ int crow(int r, int hi) { return (r & 3) + 8 * (r >> 2) + 4 * hi; }
__device__ __forceinline__ unsigned cvtpk(float lo, float hi) {
    unsigned r; asm volatile("v_cvt_pk_bf16_f32 %0, %1, %2" : "=v"(r) : "v"(lo), "v"(hi)); return r;
}
__device__ __forceinline__ bf16x8 pack8(f32x4 a, f32x4 b) {
    u32x4 w = {cvtpk(a[0], a[1]), cvtpk(a[2], a[3]), cvtpk(b[0], b[1]), cvtpk(b[2], b[3])};
    return *reinterpret_cast<bf16x8*>(&w);
}
template <class T> __device__ __forceinline__ bf16x8 load8(const T* p) {
    if constexpr (same_t<T, float>::v) { return pack8(*(const f32x4*)p, *(const f32x4*)(p + 4)); }
    else { return *reinterpret_cast<const bf16x8*>(p); }
}
__device__ __forceinline__ void mask_tile(f32x16& p0, f32x16& p1, int dq, unsigned W) {
    const float NEG = -__builtin_inff();
#pragma unroll
    for (int r = 0; r < 16; ++r) {
        const int c = (r & 3) + 8 * (r >> 2);
        if ((unsigned)(dq - c) >= W) p0[r] = NEG;
        if ((unsigned)(dq - c - 32) >= W) p1[r] = NEG;
    }
}
__device__ __forceinline__ void partialSM(f32x16& p0, f32x16& p1, float& m_reg, float& mn, float& alpha) {
    float pmax = p0[0]; for (int r = 1; r < 16; ++r) pmax = fmaxf(pmax, p0[r]); for (int r = 0; r < 16; ++r) pmax = fmaxf(pmax, p1[r]);
    { auto rr = __builtin_amdgcn_permlane32_swap(__float_as_uint(pmax), __float_as_uint(pmax), false, false);
      pmax = fmaxf(__uint_as_float(rr[0]), __uint_as_float(rr[1])); }
    constexpr float C2 = 1.4426950408889634f * SCALE;
    if (__builtin_expect(__all((pmax - m_reg) * SCALE <= THR), 1)) { mn = m_reg; alpha = 1.f; }
    else { mn = fmaxf(m_reg, pmax); alpha = __builtin_amdgcn_exp2f((m_reg - mn) * C2); m_reg = mn; }
    const float mnL = -mn * C2;
    for (int r = 0; r < 16; ++r) p0[r] = fmaf(p0[r], C2, mnL); for (int r = 0; r < 16; ++r) p1[r] = fmaf(p1[r], C2, mnL);
    for (int r = 0; r < 16; ++r) p0[r] = __builtin_amdgcn_exp2f(p0[r]);
}
__device__ __forceinline__ void finishSM(f32x16& p0, f32x16& p1, float alpha, float& l_reg, bf16x8& pa0, bf16x8& pa1, bf16x8& pa2, bf16x8& pa3) {
    for (int r = 0; r < 16; ++r) p1[r] = __builtin_amdgcn_exp2f(p1[r]);
    float ps = 0; for (int r = 0; r < 16; ++r) ps += p0[r]; for (int r = 0; r < 16; ++r) ps += p1[r];
    { auto rr = __builtin_amdgcn_permlane32_swap(__float_as_uint(ps), __float_as_uint(ps), false, false);
      ps = __uint_as_float(rr[0]) + __uint_as_float(rr[1]); }
    l_reg = l_reg * alpha + ps;
#define PK4(P, B_, OUT) do { unsigned a0 = cvtpk(P[B_+0], P[B_+1]), a1 = cvtpk(P[B_+2], P[B_+3]);                          \
        unsigned b0 = cvtpk(P[B_+4], P[B_+5]), b1 = cvtpk(P[B_+6], P[B_+7]);                                             \
        auto r0 = __builtin_amdgcn_permlane32_swap(a0, b0, false, false); auto r1 = __builtin_amdgcn_permlane32_swap(a1, b1, false, false); \
        u32x4 w = {r0[0], r1[0], r0[1], r1[1]}; OUT = *reinterpret_cast<bf16x8*>(&w); } while (0)
    PK4(p0, 0, pa0); PK4(p0, 8, pa1); PK4(p1, 0, pa2); PK4(p1, 8, pa3);
#undef PK4
}
template <int KB, bool SK>
__device__ __forceinline__ void qkt(f32x16& p0, f32x16& p1, const char* K_lds, int r32, int hi, const bf16x8* qr, bool act) {
    if (SK && !act) { const float NEG = -__builtin_inff();
#pragma unroll
        for (int r = 0; r < 16; ++r) { p0[r] = NEG; p1[r] = NEG; } return; }
    { const float* bl = (const float*)(K_lds + 2 * SHM_K + NW * 64 * 4) + KB * 64 + 4 * hi;
#pragma unroll
      for (int g = 0; g < 4; ++g) { const f32x4 b0 = *(const f32x4*)(bl + 8 * g), b1 = *(const f32x4*)(bl + 32 + 8 * g);
          p0[4 * g] = b0[0]; p0[4 * g + 1] = b0[1]; p0[4 * g + 2] = b0[2]; p0[4 * g + 3] = b0[3]; p1[4 * g] = b1[0]; p1[4 * g + 1] = b1[1]; p1[4 * g + 2] = b1[2]; p1[4 * g + 3] = b1[3]; } }
    const char* kb[4];
#pragma unroll
    for (int dd = 0; dd < 4; ++dd) kb[dd] = K_lds + KB * SHM_K + KSWZ(r32, (dd * 16 + hi * 8) * 2);
#pragma unroll
    for (int d0 = 0; d0 < 8; ++d0) { const char* a = kb[d0 & 3] + (d0 >> 2) * 128;
        bf16x8 b0 = *reinterpret_cast<const bf16x8*>(a);
        bf16x8 b1 = *reinterpret_cast<const bf16x8*>(a + 32 * 256);
        p0 = __builtin_amdgcn_mfma_f32_32x32x16_bf16(b0, qr[d0], p0, 0, 0, 0);
        p1 = __builtin_amdgcn_mfma_f32_32x32x16_bf16(b1, qr[d0], p1, 0, 0, 0); }
}
template <int VB, bool SK>
__device__ __forceinline__ void pv_tile(f32x16* o, int vb0, bf16x8 pa0, bf16x8 pa1, bf16x8 pa2, bf16x8 pa3, bool act) {
    if (SK && !act) return;
#define TRRD(dst, off) asm volatile("ds_read_b64_tr_b16 %0, %1 offset:%2" : "=&v"(dst) : "v"(vb0), "i"(off) : "memory")
#define PV_D0(d0) do { s16x4 l0, l1, l2, l3, h0, h1, h2, h3; constexpr int b_ = VB * SHM_V + v_rd_off(d0, 0, 0);     \
        TRRD(l0, b_); TRRD(h0, b_ + 2048); TRRD(l1, b_ + 4096); TRRD(h1, b_ + 6144); TRRD(l2, b_ + 8192); TRRD(h2, b_ + 10240); TRRD(l3, b_ + 12288); TRRD(h3, b_ + 14336); \
        asm volatile("s_waitcnt lgkmcnt(0)" ::: "memory"); SBAR();                 \
        o[d0] = __builtin_amdgcn_mfma_f32_32x32x16_bf16(pa0, (bf16x8){l0[0], l0[1], l0[2], l0[3], h0[0], h0[1], h0[2], h0[3]}, o[d0], 0, 0, 0);   \
        o[d0] = __builtin_amdgcn_mfma_f32_32x32x16_bf16(pa1, (bf16x8){l1[0], l1[1], l1[2], l1[3], h1[0], h1[1], h1[2], h1[3]}, o[d0], 0, 0, 0);   \
        o[d0] = __builtin_amdgcn_mfma_f32_32x32x16_bf16(pa2, (bf16x8){l2[0], l2[1], l2[2], l2[3], h2[0], h2[1], h2[2], h2[3]}, o[d0], 0, 0, 0);   \
        o[d0] = __builtin_amdgcn_mfma_f32_32x32x16_bf16(pa3, (bf16x8){l3[0], l3[1], l3[2], l3[3], h3[0], h3[1], h3[2], h3[3]}, o[d0], 0, 0, 0); } while (0)
    PV_D0(0); PV_D0(1); PV_D0(2); PV_D0(3);
#undef PV_D0
#undef TRRD
}

template <class TIn, class TOut> struct BlockRef { const TIn* Q; const TIn* K; const TIn* V; TOut* O; const float* cb; const float* onw; int P0; };
template <class TIn> struct Seam {
    bf16x8 qr[8];
    bf16x8 st_v0, st_v1, st_k0, st_k1; float st_b; f32x4 sf0, sf1, sf2, sf3;
    f32x4 tq[16];
};
__device__ __forceinline__ int swa_jlo(int P0, int W) { const int lowk = P0 - W + 1; return lowk > 0 ? lowk / KVBLK : 0; }
#define ROW(p, k0, rr) ((p) + (size_t)((k0) + (rr)) * D + sc)
#define VMW() asm volatile("s_waitcnt vmcnt(0)" ::: "memory")
#define VMWN(n) asm volatile("s_waitcnt vmcnt(%0)" :: "i"(n) : "memory")
#define SLOAD_H(Kp, Vp, Bp, k0) do { S.st_v0 = load8<TIn>(ROW(Vp, k0, sr)); S.st_v1 = load8<TIn>(ROW(Vp, k0, 32 + sr));              \
                         S.st_k0 = load8<TIn>(ROW(Kp, k0, sr)); S.st_k1 = load8<TIn>(ROW(Kp, k0, 32 + sr)); S.st_b = (Bp)[(k0) + (tid & 63)]; } while (0)
#define SWRITE_HK(bf) do { *(bf16x8*)(K_lds + (bf) * SHM_K + kws) = S.st_k0; *(bf16x8*)(K_lds + (bf) * SHM_K + kws + 32 * 256) = S.st_k1; \
                           if (tid < 64) ((float*)(K_lds + 2 * SHM_K + NW * 64 * 4))[(bf) * 64 + tid] = S.st_b; } while (0)
#define SWRITE_HV(bf) do { *(bf16x8*)(V_lds + (bf) * SHM_V + vst0) = S.st_v0; *(bf16x8*)(V_lds + (bf) * SHM_V + vst1) = S.st_v1; } while (0)
#define SWRITE_H(bf) do { SWRITE_HV(bf); SWRITE_HK(bf); } while (0)
#define SLOAD_F(p, k0) do { S.sf0 = *(const f32x4*)ROW(p, k0, sr); S.sf1 = *(const f32x4*)(ROW(p, k0, sr) + 4);                \
                            S.sf2 = *(const f32x4*)ROW(p, k0, 32 + sr); S.sf3 = *(const f32x4*)(ROW(p, k0, 32 + sr) + 4); } while (0)
#define SWRITE_KF(bf) do { *(bf16x8*)(K_lds + (bf) * SHM_K + kws) = pack8(S.sf0, S.sf1); *(bf16x8*)(K_lds + (bf) * SHM_K + kws + 32 * 256) = pack8(S.sf2, S.sf3); } while (0)
#define SWRITE_VF(bf) do { *(bf16x8*)(V_lds + (bf) * SHM_V + vst0) = pack8(S.sf0, S.sf1); *(bf16x8*)(V_lds + (bf) * SHM_V + vst1) = pack8(S.sf2, S.sf3); } while (0)
template <class TIn, class TOut>
__device__ __forceinline__ void causal_swa_prime(const BlockRef<TIn, TOut>& cur, int W, char* lds, Seam<TIn>& S) {
    constexpr bool F32 = same_t<TIn, float>::v;
    const int tid = fox_tid(), wid = __builtin_amdgcn_readfirstlane(tid >> 6), lane = tid & 63, r32 = lane & 31, hi = lane >> 5;
    const int sr = tid >> 4, sc = (tid & 15) * 8, kws = KSWZ(sr, sc * 2); char* K_lds = lds + 2 * SHM_V;
    const int kb0 = swa_jlo(cur.P0, W) * KVBLK;
    for (int d0 = 0; d0 < 8; ++d0) S.qr[d0] = load8<TIn>(cur.Q + (size_t)(wid * QBLK + r32) * D + d0 * 16 + hi * 8);
    if constexpr (F32) { SLOAD_F((const float*)cur.K, kb0); VMW(); SWRITE_KF(0); SBAR(); SLOAD_F((const float*)cur.V, kb0); }
    else { SLOAD_H(cur.K, cur.V, cur.cb, kb0); VMW(); SWRITE_HK(0); }
    __syncthreads();
}
template <class TIn, class TOut>
__device__ __forceinline__ void causal_swa_block(const BlockRef<TIn, TOut>& cur, const BlockRef<TIn, TOut>& nxt, int skv, int W, char* lds, Seam<TIn>& S) {
    constexpr bool F32 = same_t<TIn, float>::v;
    const int tid = fox_tid(), wid = __builtin_amdgcn_readfirstlane(tid >> 6), lane = tid & 63, r32 = lane & 31, hi = lane >> 5;
    const int j_lo = swa_jlo(cur.P0, W);
    int j_hi = (cur.P0 + QB - 1) / KVBLK + 1; if (j_hi > skv / KVBLK) j_hi = skv / KVBLK;
    const int NT = j_hi - j_lo;
    const int kbn = swa_jlo(nxt.P0, W) * KVBLK;
    const int qlo = cur.P0 + wid * QBLK, qm = qlo + r32 - 4 * hi;
    char* V_lds = lds; char* K_lds = lds + 2 * SHM_V;
    float* ws = (float*)(lds + 2 * SHM_V + 2 * SHM_K) + wid * 64; float* li_l = ws, * al_l = ws + 32;
    float m_reg = -1e30f, l_reg = 0; f32x16 o[4] = {};
    const int sr = tid >> 4, sc = (tid & 15) * 8, vst0 = v_st(sr, sc), vst1 = v_st(32 + sr, sc), kws = KSWZ(sr, sc * 2);
    const int vb0 = (int)(uintptr_t)V_lds + v_rd_base(lane);
    const TIn* Kh = cur.K; const TIn* Vh = cur.V;
#define RESC(a) do { if (__any((a) < 1.f)) { if (hi == 0) al_l[r32] = (a); asm volatile("s_waitcnt lgkmcnt(0)" ::: "memory");              \
                     for (int d_ = 0; d_ < 4; ++d_) for (int r = 0; r < 16; ++r) o[d_][r] *= al_l[crow(r, hi)]; } } while (0)
#define KBASE(t) ((j_lo + (t)) * KVBLK)
#define ACT(t) (KBASE(t) <= qlo + QBLK - 1 && KBASE(t) + KVBLK - 1 >= qlo - W + 1)
#define MASKT(P0_, P1_, t) do { const int kb_ = KBASE(t); if ((!SK || ACT(t)) && (kb_ + KVBLK - 1 > qlo || kb_ <= qlo + QBLK - 1 - W)) mask_tile(P0_, P1_, qm - kb_, (unsigned)W); } while (0)
    constexpr int NQL = F32 ? 16 : 8;
    constexpr bool SK = WSKIP && !F32;
#define SEAM_K0() do { VMWN(NQL); if constexpr (F32) { SWRITE_KF(0); SBAR(); SLOAD_F((const float*)nxt.V, kbn); } else { SWRITE_HK(0); } SBAR(); } while (0)
    f32x16 pA0, pA1, pB0, pB1; float mnA, mnB, alA, alB; bf16x8 pa0, pa1, pa2, pa3;
    if constexpr (F32) { VMW(); SWRITE_VF(0); SBAR(); } else { SWRITE_HV(0); SBAR(); }
    if (NT > 1) { if constexpr (F32) SLOAD_F((const float*)Kh, KBASE(1)); else SLOAD_H(Kh, Vh, cur.cb, KBASE(1)); }
    SBAR(); qkt<0, SK>(pA0, pA1, K_lds, r32, hi, S.qr, ACT(0));
    if constexpr (F32) { if (NT > 1) { VMW(); SWRITE_KF(1); SBAR(); SLOAD_F((const float*)Vh, KBASE(1)); } }
    MASKT(pA0, pA1, 0); partialSM(pA0, pA1, m_reg, mnA, alA);
    if (NT > 1) { VMW(); if constexpr (F32) { SWRITE_VF(1); SBAR(); if (NT > 2) SLOAD_F((const float*)Kh, KBASE(2)); } else SWRITE_H(1); }
    __syncthreads();
#define HALF_STEP(PX0, PX1, mnX, alX, PY0, PY1, alY, t, KB, VB, SB) do {                                                      \
        SBAR(); qkt<KB, SK>(PX0, PX1, K_lds, r32, hi, S.qr, ACT(t));                                             \
        finishSM(PY0, PY1, alY, l_reg, pa0, pa1, pa2, pa3); SBAR();                                                           \
        if ((t) + 1 < NT) { if constexpr (F32) { VMW(); SWRITE_KF(SB); SBAR(); SLOAD_F((const float*)Vh, KBASE((t) + 1)); }  \
                            else { SLOAD_H(Kh, Vh, cur.cb, KBASE((t) + 1)); } SBAR(); }                                               \
        pv_tile<VB, SK>(o, vb0, pa0, pa1, pa2, pa3, ACT((t) - 1)); MASKT(PX0, PX1, (t)); partialSM(PX0, PX1, m_reg, mnX, alX);                                        \
        __syncthreads();                                                                                                      \
        if ((t) + 1 < NT) { VMW(); if constexpr (F32) { SWRITE_VF(SB); SBAR(); if ((t) + 2 < NT) SLOAD_F((const float*)Kh, KBASE((t) + 2)); } \
                            else { SWRITE_H(SB); } }                                                                          \
        RESC(alX); __syncthreads(); } while (0)
    for (int t = 1; t + 1 < NT; t += 2) {
        HALF_STEP(pB0, pB1, mnB, alB, pA0, pA1, alA, t, 1, 0, 0);
        HALF_STEP(pA0, pA1, mnA, alA, pB0, pB1, alB, t + 1, 0, 1, 1);
    }
    const bool even = (NT & 1) == 0;
    if (even) { SBAR(); qkt<1, SK>(pB0, pB1, K_lds, r32, hi, S.qr, ACT(NT - 1)); SBAR(); }
#define QROW(e) (nxt.Q + (size_t)(wid * QBLK + r32) * D + ((e) >> 1) * 16 + hi * 8 + ((e) & 1) * 4)
    if constexpr (F32) { SLOAD_F((const float*)nxt.K, kbn); SBAR();
#pragma unroll
        for (int e = 0; e < 8; ++e) S.tq[e] = *(const f32x4*)QROW(e); }
    else { SLOAD_H(nxt.K, nxt.V, nxt.cb, kbn); SBAR();
#pragma unroll
        for (int d0 = 0; d0 < 8; ++d0) S.qr[d0] = load8<TIn>(nxt.Q + (size_t)(wid * QBLK + r32) * D + d0 * 16 + hi * 8); }
    SBAR();
    finishSM(pA0, pA1, alA, l_reg, pa0, pa1, pa2, pa3); SBAR();
    if constexpr (F32) {
#pragma unroll
        for (int e = 8; e < 16; ++e) S.tq[e] = *(const f32x4*)QROW(e); SBAR(); }
#undef QROW
    pv_tile<0, SK>(o, vb0, pa0, pa1, pa2, pa3, ACT(even ? NT - 2 : NT - 1));
    if (even) { MASKT(pB0, pB1, NT - 1); partialSM(pB0, pB1, m_reg, mnB, alB); __syncthreads(); RESC(alB);
        finishSM(pB0, pB1, alB, l_reg, pa0, pa1, pa2, pa3); SBAR(); pv_tile<1, SK>(o, vb0, pa0, pa1, pa2, pa3, ACT(NT - 1)); }
    SBAR(); SEAM_K0();
    if (hi == 0) li_l[r32] = l_reg; asm volatile("s_waitcnt lgkmcnt(0)" ::: "memory");
    { float gw[4];
#pragma unroll
      for (int d0 = 0; d0 < 4; ++d0) gw[d0] = cur.onw[d0 * 32 + r32];
      TOut* Ow = cur.O + (size_t)(wid * QBLK) * OLD;
#pragma unroll
      for (int r = 0; r < 16; ++r) { const int orow = crow(r, hi); const float rl = __builtin_amdgcn_rcpf(li_l[orow]);
          float v[4]; float ss = 0.f;
#pragma unroll
          for (int d0 = 0; d0 < 4; ++d0) { v[d0] = o[d0][r] * rl; ss += v[d0] * v[d0]; }
          ss = half32_sum(ss);
          const float rs = rsqrtf(ss * (1.f / 128.f) + 1e-6f);
#pragma unroll
          for (int d0 = 0; d0 < 4; ++d0) { const float y = v[d0] * rs * gw[d0]; const float yn = __shfl_xor(y, 1);
              if ((r32 & 1) == 0) *(unsigned*)(Ow + (size_t)orow * OLD + d0 * 32 + r32) = cvtpk(y, yn); } } }
    if constexpr (F32) {
#pragma unroll
        for (int d0 = 0; d0 < 8; ++d0) S.qr[d0] = pack8(S.tq[2 * d0], S.tq[2 * d0 + 1]); }
    __syncthreads();
#undef RESC
#undef KBASE
#undef ACT
#undef MASKT
#undef SEAM_K0
#undef HALF_STEP
}
#undef ROW
#undef VMW
#undef VMWN
#undef SLOAD_H
#undef SWRITE_HK
#undef SWRITE_HV
#undef SWRITE_H
#undef SLOAD_F
#undef SWRITE_KF
#undef SWRITE_VF


#undef KSWZ
#undef SBAR
}
constexpr size_t WS_KV = 186 * MiB;
constexpr size_t WS_SP = 218 * MiB;
constexpr size_t WS_CAT = 234 * MiB;
constexpr size_t WS_P34_END = 266 * MiB;
constexpr int CW_RETQ = 2048;
typedef short v4i16_t __attribute__((ext_vector_type(4)));
typedef float f32x16 __attribute__((ext_vector_type(16)));
constexpr int TLD = 136;
constexpr int TILE_EL = 128 * TLD;

__device__ __forceinline__ bf16x8 frag_row(const LAS bf16* X, int r0, int k0, int lane) {
    return *(const LAS bf16x8*)(X + (r0 + (lane & 31)) * TLD + k0 + 8 * (lane >> 5));
}
__device__ __forceinline__ bf16x8 frag_tr(const LAS bf16* X, int k0, int c0, int lane) {
    const int g = lane >> 4, i = lane & 15, q = i >> 2, p = i & 3, h = g >> 1;
    const LAS bf16* a = X + (k0 + 8 * h + q) * TLD + c0 + 16 * (g & 1) + 4 * p;
    const v4i16_t lo = __builtin_amdgcn_ds_read_tr16_b64_v4i16((LAS v4i16_t*)a);
    const v4i16_t hi = __builtin_amdgcn_ds_read_tr16_b64_v4i16((LAS v4i16_t*)(a + 4 * TLD));
    return (bf16x8){lo[0], lo[1], lo[2], lo[3], hi[0], hi[1], hi[2], hi[3]};
}
__device__ __forceinline__ int crow16(int r, int hi) { return (r & 3) + 8 * (r >> 2) + 4 * hi; }
__device__ __forceinline__ float bf2f(unsigned short v) { return __uint_as_float((unsigned)v << 16); }
__device__ __forceinline__ float ret_lg2(int h) { return log1pf(-exp2f(-5.f - (float)h)) * 1.4426950408889634f; }

__device__ __forceinline__ void p3_item(Frame& F, int bh, int n) {
    const int h = bh & 7, tid = F.tid, lane = F.lane, w = F.wave;
    const bf16* qkv = (const bf16*)(F.ws + WS_QKV);
    const size_t rbase = ((size_t)bh * SEQ + (size_t)n * 128) * HD;
    const bf16* RK = qkv + 1 * TSZ + rbase; const bf16* RV = qkv + 2 * TSZ + rbase;
    LAS bf16* Kz = (LAS bf16*)F.lds; LAS bf16* Vt = Kz + TILE_EL;
    const float lg2 = ret_lg2(h);
#pragma unroll
    for (int j = 0; j < 4; ++j) { const int c = tid + 512 * j, row = c >> 4, col8 = (c & 15) * 8;
        *(LAS v4u*)(Vt + row * TLD + col8) = *(const v4u*)(RV + (size_t)row * HD + col8);
        const bf16x8 k = *(const bf16x8*)(RK + (size_t)row * HD + col8); const float zeta = exp2f(lg2 * (float)(127 - row)); float kv[8];
#pragma unroll
        for (int i = 0; i < 8; ++i) kv[i] = bf2f((unsigned short)k[i]) * zeta;
        v4u o; o.x = pk2(kv[0], kv[1]); o.y = pk2(kv[2], kv[3]); o.z = pk2(kv[4], kv[5]); o.w = pk2(kv[6], kv[7]);
        *(LAS v4u*)(Kz + row * TLD + col8) = o; }
    LDS_WAIT(); __syncthreads();
    { const int db = w >> 1, eb = 2 * (w & 1), hi = lane >> 5;
      f32x16 a0 = {}, a1 = {};
#pragma unroll
      for (int kk = 0; kk < 8; ++kk) { const bf16x8 a = frag_tr(Kz, 16 * kk, 32 * db, lane), b0 = frag_tr(Vt, 16 * kk, 32 * eb, lane), b1 = frag_tr(Vt, 16 * kk, 32 * eb + 32, lane);
          a0 = __builtin_amdgcn_mfma_f32_32x32x16_bf16(a, b0, a0, 0, 0, 0); a1 = __builtin_amdgcn_mfma_f32_32x32x16_bf16(a, b1, a1, 0, 0, 0); }
      float* KV = (float*)(F.ws + WS_KV) + ((size_t)bh * 32 + n) * 16384;
#pragma unroll
      for (int r = 0; r < 16; ++r) { const int d = 32 * db + crow16(r, hi); KV[d * 128 + 32 * eb + (lane & 31)] = a0[r]; KV[d * 128 + 32 * eb + 32 + (lane & 31)] = a1[r]; } }
    LDS_WAIT(); __syncthreads();
}
__device__ __forceinline__ void p3_cumsum(Frame& F, int bh) {
    const float* lf = (const float*)(F.ws + WS_LOGF) + (size_t)bh * SEQ + 64 * F.lane; float* cb = (float*)(F.ws + WS_CB) + (size_t)bh * SEQ + 64 * F.lane;
    float tot = 0.f;
#pragma unroll 8
    for (int i = 0; i < 64; ++i) tot += lf[i];
    float incl = tot;
#pragma unroll
    for (int o = 1; o < 64; o <<= 1) { const float t = __shfl_up(incl, o); if (F.lane >= o) incl += t; }
    float run = incl - tot;
#pragma unroll 8
    for (int i = 0; i < 64; ++i) { run += lf[i]; cb[i] = -run * 11.313708498984761f; }
}
__device__ __forceinline__ void p3_phase(Frame& F) {
    if (F.wave == 0) for (int bh = blockIdx.x; bh < 16; bh += F.G) p3_cumsum(F, bh);
    for (int it = blockIdx.x; it < 512; it += F.G) p3_item(F, it >> 5, it & 31);
}
__device__ __forceinline__ void p3b_scan(Frame& F) {
    const float* KV = (const float*)(F.ws + WS_KV); bf16* SP = (bf16*)(F.ws + WS_SP);
    for (int idx = blockIdx.x * (NWAVES * 64) + F.tid; idx < 16 * 16384; idx += F.G * NWAVES * 64) {
        const int bh = idx >> 14, de = idx & 16383; const float cd = exp2f(ret_lg2(bh & 7) * 128.f);
        float st = 0.f;
        for (int n = 0; n < 32; ++n) { const size_t o = ((size_t)bh * 32 + n) * 16384 + de; SP[o] = (bf16)f2bf(st); st = st * cd + KV[o]; }
    }
}
__device__ __forceinline__ void ret_item(Frame& F, int bh, int n) {
    const int h = bh & 7, b = bh >> 3, tid = F.tid, lane = F.lane, w = F.wave, hi = lane >> 5, c32 = lane & 31;
    const bf16* qkv = (const bf16*)(F.ws + WS_QKV);
    const size_t rbase = ((size_t)bh * SEQ + (size_t)n * 128) * HD;
    const bf16* RQ = qkv + 0 * TSZ + rbase; const bf16* RK = qkv + 1 * TSZ + rbase; const bf16* RV = qkv + 2 * TSZ + rbase; const bf16* RG = qkv + 3 * TSZ + rbase;
    const bf16* SPg = (const bf16*)(F.ws + WS_SP) + ((size_t)bh * 32 + n) * 16384;
    LAS bf16* Qs = (LAS bf16*)F.lds; LAS bf16* Ks = Qs + TILE_EL; LAS bf16* Vs = Ks + TILE_EL; LAS bf16* Ss = Vs + TILE_EL;
    LAS float* st = (LAS float*)(Ss + TILE_EL);
#pragma unroll
    for (int j = 0; j < 4; ++j) { const int c = tid + 512 * j, row = c >> 4, col8 = (c & 15) * 8; const size_t go = (size_t)row * HD + col8; const int lo = row * TLD + col8;
        *(LAS v4u*)(Qs + lo) = *(const v4u*)(RQ + go); *(LAS v4u*)(Ks + lo) = *(const v4u*)(RK + go);
        *(LAS v4u*)(Vs + lo) = *(const v4u*)(RV + go); *(LAS v4u*)(Ss + lo) = *(const v4u*)(SPg + go); }
    LDS_WAIT(); __syncthreads();
    const int qb = w >> 1, cb2 = 2 * (w & 1);
    const float lg2 = ret_lg2(h);
    f32x16 s0 = {}, s1 = {};
#pragma unroll
    for (int kk = 0; kk < 8; ++kk) { const bf16x8 a = frag_row(Qs, 32 * qb, 16 * kk, lane), b0 = frag_row(Ks, 32 * cb2, 16 * kk, lane), b1 = frag_row(Ks, 32 * cb2 + 32, 16 * kk, lane);
        s0 = __builtin_amdgcn_mfma_f32_32x32x16_bf16(a, b0, s0, 0, 0, 0); s1 = __builtin_amdgcn_mfma_f32_32x32x16_bf16(a, b1, s1, 0, 0, 0); }
    const int key0 = 32 * cb2 + c32, key1 = key0 + 32;
    const float f0 = exp2f(-lg2 * (float)(key0 + 1)), f1 = exp2f(-lg2 * (float)(key1 + 1));
    LDS_WAIT(); __syncthreads();
#pragma unroll
    for (int r = 0; r < 16; ++r) { const int q = 32 * qb + crow16(r, hi);
        Ks[q * TLD + key0] = (bf16)f2bf(key0 <= q ? s0[r] * f0 : 0.f); Ks[q * TLD + key1] = (bf16)f2bf(key1 <= q ? s1[r] * f1 : 0.f); }
    LDS_WAIT(); __syncthreads();
    f32x16 o0 = {}, o1 = {};
#pragma unroll
    for (int kk = 0; kk < 8; ++kk) { const bf16x8 a = frag_row(Ks, 32 * qb, 16 * kk, lane), b0 = frag_tr(Vs, 16 * kk, 32 * cb2, lane), b1 = frag_tr(Vs, 16 * kk, 32 * cb2 + 32, lane);
        o0 = __builtin_amdgcn_mfma_f32_32x32x16_bf16(a, b0, o0, 0, 0, 0); o1 = __builtin_amdgcn_mfma_f32_32x32x16_bf16(a, b1, o1, 0, 0, 0); }
#pragma unroll
    for (int kk = 0; kk < 8; ++kk) { const bf16x8 a = frag_row(Qs, 32 * qb, 16 * kk, lane), b0 = frag_tr(Ss, 16 * kk, 32 * cb2, lane), b1 = frag_tr(Ss, 16 * kk, 32 * cb2 + 32, lane);
        o0 = __builtin_amdgcn_mfma_f32_32x32x16_bf16(a, b0, o0, 0, 0, 0); o1 = __builtin_amdgcn_mfma_f32_32x32x16_bf16(a, b1, o1, 0, 0, 0); }
#pragma unroll
    for (int r = 0; r < 16; ++r) { const int q = 32 * qb + crow16(r, hi); const float xi = exp2f(lg2 * (float)(q + 1));
        o0[r] *= xi; o1[r] *= xi;
        float s = o0[r] + o1[r], ss = o0[r] * o0[r] + o1[r] * o1[r];
        s = half32_sum(s); ss = half32_sum(ss);
        if (c32 == 0) { st[q * 4 + (w & 1) * 2] = s; st[q * 4 + (w & 1) * 2 + 1] = ss; } }
    LDS_WAIT(); __syncthreads();
    { const float* gn = F.in[8] + h * 128; const float g0 = gn[key0], g1 = gn[key1];
      bf16* CAT = (bf16*)(F.ws + WS_CAT) + ((size_t)b * SEQ + (size_t)n * 128) * DM + h * 128;
#pragma unroll
      for (int r = 0; r < 16; ++r) { const int q = 32 * qb + crow16(r, hi);
          const float s = st[q * 4] + st[q * 4 + 2], ss = st[q * 4 + 1] + st[q * 4 + 3];
          const float mu = s * (1.f / 128.f), var = fmaxf(ss * (1.f / 128.f) - mu * mu, 0.f), rstd = rsqrtf(var + EPS);
          const float y0 = (o0[r] - mu) * rstd * g0 * bf2f(RG[(size_t)q * HD + key0]), y1 = (o1[r] - mu) * rstd * g1 * bf2f(RG[(size_t)q * HD + key1]);
          CAT[(size_t)q * DM + key0] = (bf16)f2bf(y0); CAT[(size_t)q * DM + key1] = (bf16)f2bf(y1); } }
    LDS_WAIT(); __syncthreads();
}
__device__ __forceinline__ void p4_phase(Frame& F) {
    const int bx = blockIdx.x; const int vcu = (F.G % 8 == 0) ? (bx % 8) * (F.G / 8) + bx / 8 : bx;
    const bf16* qkv = (const bf16*)(F.ws + WS_QKV);
    bf16* CAT = (bf16*)(F.ws + WS_CAT);
    for (int fb = vcu; fb < 256; fb += F.G) {
        const int bh = fb >> 4, qb = fb & 15, h = bh & 7, b = bh >> 3;
        fox::BlockRef<bf16, bf16> cur;
        cur.Q = qkv + 4 * TSZ + ((size_t)bh * SEQ + (size_t)qb * 256) * HD; cur.K = qkv + 5 * TSZ + (size_t)bh * SEQ * HD; cur.V = qkv + 6 * TSZ + (size_t)bh * SEQ * HD;
        cur.O = CAT + ((size_t)b * SEQ + (size_t)qb * 256) * DM + 1024 + h * 128; cur.cb = (const float*)(F.ws + WS_CB) + (size_t)bh * SEQ; cur.onw = F.in[11] + h * 128; cur.P0 = qb * 256;
        fox::Seam<bf16> S;
        fox::causal_swa_prime<bf16, bf16>(cur, SEQ, F.ldsg, S);
        fox::causal_swa_block<bf16, bf16>(cur, cur, SEQ, SEQ, F.ldsg, S);
        asm volatile("s_waitcnt vmcnt(0)" ::: "memory");
        __syncthreads();
    }
    for (;;) {
        if (F.tid == 0) F.MISC[0] = atomicAdd((unsigned*)(F.ws + WS_CTL) + CW_RETQ, 1u);
        __syncthreads();
        const unsigned item = F.MISC[0];
        __syncthreads();
        if (item >= 512u) break;
        ret_item(F, (int)(item >> 5), (int)(item & 31));
    }
}
constexpr int PADROWS = 24576;
constexpr int LTAB_OFF = LDSCTL_OFF + 1024;
constexpr int NSUB = 16, SUBCAP = ECAP / NSUB;
#define LTAB_SB(lds_) ((LAS int*)((lds_) + LTAB_OFF) + 32 + 40)
struct EpiPlain {
    static constexpr bool PERM = true, AFTER_DRAIN = false;
    bf16* O; int ldc; int ntn;
    template <class U> __device__ __forceinline__ void operator()(const pg8::f32x4 (&acc)[2][2][4][2], const U& u, int wr, int wc, int fr, int fq) const {
        const int row0 = u.pm * 256 + wr * 64 + fr, col0 = (u.pn % ntn) * 256 + wc * 32 + 8 * fq;
#pragma unroll
        for (int ai = 0; ai < 2; ++ai)
#pragma unroll
            for (int m = 0; m < 4; ++m) { bf16* rowp = O + (size_t)(row0 + ai * 128 + m * 16) * ldc + col0;
#pragma unroll
                for (int bj = 0; bj < 2; ++bj) { const pg8::f32x4 v0 = acc[ai][bj][m][0], v1 = acc[ai][bj][m][1];
                    pg8::u32x4 w; w.x = pg8::cvt_pk_bf16(v0[0], v0[1]); w.y = pg8::cvt_pk_bf16(v0[2], v0[3]); w.z = pg8::cvt_pk_bf16(v1[0], v1[1]); w.w = pg8::cvt_pk_bf16(v1[2], v1[3]);
                    *(pg8::u32x4*)(rowp + bj * 128) = w; } }
    }
};
struct EpiSwiglu {
    static constexpr bool PERM = true, AFTER_DRAIN = false;
    unsigned char* O;
    template <class U> __device__ __forceinline__ void operator()(const pg8::f32x4 (&acc)[2][2][4][2], const U& u, int wr, int wc, int fr, int fq) const {
        const int row0 = u.pm * 256 + wr * 64 + fr, col0 = (u.pn & 3) * 128 + wc * 32 + 8 * fq;
#pragma unroll
        for (int ai = 0; ai < 2; ++ai)
#pragma unroll
            for (int m = 0; m < 4; ++m) { float g[8];
#pragma unroll
                for (int n = 0; n < 2; ++n)
#pragma unroll
                    for (int i = 0; i < 4; ++i) { const float a = acc[ai][0][m][n][i], b = acc[ai][1][m][n][i]; g[4 * n + i] = a * __builtin_amdgcn_rcpf(1.f + __expf(-a)) * b; }
                uint2 w; w.x = fp8x4(g[0], g[1], g[2], g[3]); w.y = fp8x4(g[4], g[5], g[6], g[7]);
                *(uint2*)(O + (size_t)(row0 + ai * 128 + m * 16) * DE + col0) = w; }
    }
};
struct GUnit { int pm, pn, e, lt; };
template <int NJ> struct GroupedOrder {
    typedef GUnit unit_t;
    const LAS int* ts; int G, c, total;
    __device__ __forceinline__ void init(const LAS int* ts_, int G_, int c_) { ts = ts_; G = G_; c = c_; total = ts_[32] * NJ; }
    __device__ __forceinline__ bool next(int i, GUnit& u) const {
        const int L = i * G + c; if (L >= total) return false;
        const int mt = L / NJ, j = L % NJ; int e = 0;
        while (ts[e + 1] <= mt) ++e;
        u.e = e; u.lt = mt - ts[e]; u.pm = mt; u.pn = e * NJ + j; return true;
    }
    __device__ __forceinline__ void a_ready(const GUnit&) const {}
    __device__ __forceinline__ void done(const GUnit&) const {}
};
struct GatherRows { const int* list; const LAS int* cntL; const LAS int* sb;
    __device__ __forceinline__ unsigned row(const GUnit& u, int r) const { const int lr = u.lt * 256 + r; if (lr >= cntL[u.e]) return 0u;
        const LAS int* p = sb + u.e * 17; int su = 0;
#pragma unroll
        for (int st = 8; st > 0; st >>= 1) if (p[su + st] <= lr) su += st;
        return (unsigned)list[(size_t)(u.e * NSUB + su) * SUBCAP + (lr - p[su])]; } };
__device__ __forceinline__ void moe_tables(Frame& F) {
    LAS int* cntL = (LAS int*)(F.lds + LTAB_OFF); LAS int* ts = cntL + 32;
    __syncthreads();
    LAS int* sb = LTAB_SB(F.lds);
    { const int e = F.tid >> 4, su = F.tid & 15; sb[e * 17 + su + 1] = (int)__hip_atomic_load(F.ctl + F.cnt_off + 64 * F.tid, RLX_AGENT); }
    __syncthreads();
    if (F.tid < 32) { LAS int* p = sb + F.tid * 17; int a = 0; p[0] = 0; for (int su = 1; su <= 16; ++su) { a += p[su]; p[su] = a; } cntL[F.tid] = a; }
    __syncthreads();
    if (F.tid == 0) { int a = 0; for (int e = 0; e < 32; ++e) { ts[e] = a; a += (cntL[e] + 255) >> 8; } ts[32] = a; }
    __syncthreads();
}
__device__ __forceinline__ f32x4 bf4(unsigned lo, unsigned hi) { return (f32x4){__uint_as_float(lo << 16), __uint_as_float(lo & 0xffff0000u), __uint_as_float(hi << 16), __uint_as_float(hi & 0xffff0000u)}; }
constexpr int P6_PAR = 0, P6_AH = 40960, P6_AHLD = 1028, P6_RED = P6_AH + 16 * P6_AHLD * 4, P6_LG = P6_RED + 8 * 768 * 4, P6_END = P6_LG + 16 * 48 * 4;
static_assert(P6_END <= LDSCTL_OFF, "p6 LDS map");
typedef float f32x4v __attribute__((ext_vector_type(4)));
__device__ __forceinline__ void split8(const f32x4 a, const f32x4 b, bf16x8& hi, bf16x8& lo) {
    float v[8] = {a.x, a.y, a.z, a.w, b.x, b.y, b.z, b.w}; unsigned h[8], l[8];
#pragma unroll
    for (int i = 0; i < 8; ++i) { h[i] = f2bf(v[i]); l[i] = f2bf(v[i] - __uint_as_float(h[i] << 16)); }
    hi = (bf16x8){(short)h[0], (short)h[1], (short)h[2], (short)h[3], (short)h[4], (short)h[5], (short)h[6], (short)h[7]};
    lo = (bf16x8){(short)l[0], (short)l[1], (short)l[2], (short)l[3], (short)l[4], (short)l[5], (short)l[6], (short)l[7]};
}
template <int VAR>
__device__ __forceinline__ void p6_phase(Frame& F) {
    const float* x = F.in[0]; const float* wpost = F.in[5]; const float* wpre = F.in[13]; const float* rcb = F.in[16]; const float* rfb = F.in[18];
    const float* mod = (const float*)(F.ws + WS_MOD); const bf16* Yb = (const bf16*)(F.ws + WS_YB); bf16* Hb = (bf16*)(F.ws + WS_HB);
    const bf16* RWH = (const bf16*)(F.ws + WS_RWP); const bf16* RWL = RWH + 48 * DM;
    int* list = (int*)(F.ws + WS_LIST); int* SE = (int*)(F.ws + WS_SLOT); int* SPOS = SE + 2 * T; float* SW = (float*)(SPOS + 2 * T);
    LAS f32x4* PAR = (LAS f32x4*)(F.lds + P6_PAR);
    LAS float* AH = (LAS float*)(F.lds + P6_AH); LAS float* RED = (LAS float*)(F.lds + P6_RED); LAS float* LG = (LAS float*)(F.lds + P6_LG);
    const int lane = F.lane, w = F.wave;
    for (int pass = blockIdx.x; pass < T / 16; pass += F.G) {
        const int row0 = pass * 16 + 2 * w, b = (pass * 16) >> 12;
        f32x4 xv[2][8];
        if (VAR >= 2) {
#pragma unroll
            for (int j = 0; j < 8; ++j) { xv[0][j] = (f32x4){1.f, 2.f, 3.f, (float)lane}; xv[1][j] = (f32x4){2.f, 2.f, 3.f, (float)j}; } }
        __syncthreads();
        { const f32x4* mb = (const f32x4*)(mod + (size_t)b * 6 * DM);
          for (int c = F.tid; c < 512; c += NWAVES * 64) { PAR[c] = mb[2 * 512 + c]; PAR[512 + c] = ((const f32x4*)wpost)[c]; PAR[1024 + c] = ((const f32x4*)wpre)[c]; PAR[1536 + c] = mb[4 * 512 + c] + 1.0f; PAR[2048 + c] = mb[3 * 512 + c]; } }
        LDS_WAIT(); __syncthreads();
#pragma unroll
        for (int rr = 0; rr < (VAR >= 2 ? 0 : 2); ++rr) {
            f32x4* outr = (f32x4*)(F.out + (size_t)(row0 + rr) * DM) + lane; unsigned* hr = (unsigned*)((unsigned char*)Hb + (size_t)(row0 + rr) * DM) + lane;
            uint2 yu[8];
            { const f32x4* xr = (const f32x4*)(x + (size_t)(row0 + rr) * DM) + lane; const uint2* yr = (const uint2*)(Yb + (size_t)(row0 + rr) * DM) + lane;
#pragma unroll
              for (int j = 0; j < 8; ++j) { xv[rr][j] = xr[64 * j]; yu[j] = yr[64 * j]; } }
            f32x4 yv[8]; float ss = 0.f;
#pragma unroll
            for (int j = 0; j < 8; ++j) { yv[j] = bf4(yu[j].x, yu[j].y); ss += (yv[j].x * yv[j].x + yv[j].y * yv[j].y) + (yv[j].z * yv[j].z + yv[j].w * yv[j].w); }
            const float rstd_y = rsqrtf(wave_sum(ss) * (1.f / DM) + EPS);
            float s2 = 0.f;
            asm volatile("" ::: "memory");
#pragma unroll
            for (int j = 0; j < 8; ++j) { const f32x4 x1 = xv[rr][j] + PAR[lane + 64 * j] * (yv[j] * rstd_y * PAR[512 + lane + 64 * j]);
                outr[64 * j] = x1; xv[rr][j] = x1; s2 += (x1.x * x1.x + x1.y * x1.y) + (x1.z * x1.z + x1.w * x1.w); }
            const float rstd = rsqrtf(wave_sum(s2) * (1.f / DM) + EPS);
            asm volatile("" ::: "memory");
#pragma unroll
            for (int j = 0; j < 8; ++j) { const f32x4 h = xv[rr][j] * rstd * PAR[1024 + lane + 64 * j] * PAR[1536 + lane + 64 * j] + PAR[2048 + lane + 64 * j];
                xv[rr][j] = h; hr[64 * j] = fp8x4(h.x, h.y, h.z, h.w); }
            asm volatile("" ::: "memory");
        }
        if (VAR == 1) continue;
        pg8::f32x4 acc[3] = {{0.f, 0.f, 0.f, 0.f}, {0.f, 0.f, 0.f, 0.f}, {0.f, 0.f, 0.f, 0.f}};
#pragma unroll 1
        for (int half = 0; half < 2; ++half) {
            bf16x8 bh[4][3], bl[4][3];
#pragma unroll
            for (int ks = 0; ks < 4; ++ks)
#pragma unroll
                for (int nt = 0; nt < 3; ++nt) { const size_t bo = (size_t)(nt * 16 + (lane & 15)) * DM + 1024 * half + 128 * w + 32 * ks + 8 * (lane >> 4);
                    bh[ks][nt] = *(const bf16x8*)(RWH + bo); bl[ks][nt] = *(const bf16x8*)(RWL + bo); }
            __syncthreads();
#pragma unroll
            for (int rr = 0; rr < 2; ++rr)
#pragma unroll
                for (int j = 0; j < 4; ++j) *(LAS f32x4*)(AH + (2 * w + rr) * P6_AHLD + 256 * j + 4 * lane) = half ? xv[rr][4 + j] : xv[rr][j];
            LDS_WAIT(); __syncthreads();
#pragma unroll
            for (int ks = 0; ks < (VAR == 4 ? 0 : 4); ++ks) {
                const int kh = 128 * w + 32 * ks + 8 * (lane >> 4); const LAS float* ap = AH + (lane & 15) * P6_AHLD + kh;
                const f32x4 a0 = *(const LAS f32x4*)ap, a1 = *(const LAS f32x4*)(ap + 4); bf16x8 ahi, alo; split8(a0, a1, ahi, alo);
#pragma unroll
                for (int nt = 0; nt < 3; ++nt) {
                    acc[nt] = __builtin_amdgcn_mfma_f32_16x16x32_bf16(ahi, bh[ks][nt], acc[nt], 0, 0, 0);
                    acc[nt] = __builtin_amdgcn_mfma_f32_16x16x32_bf16(alo, bh[ks][nt], acc[nt], 0, 0, 0);
                    acc[nt] = __builtin_amdgcn_mfma_f32_16x16x32_bf16(ahi, bl[ks][nt], acc[nt], 0, 0, 0); }
            }
        }
#pragma unroll
        for (int nt = 0; nt < 3; ++nt)
#pragma unroll
            for (int r = 0; r < 4; ++r) RED[w * 768 + (nt * 4 + r) * 64 + lane] = acc[nt][r];
        LDS_WAIT(); __syncthreads();
        for (int idx = F.tid; idx < 768; idx += NWAVES * 64) { float s = 0.f;
#pragma unroll
            for (int ww = 0; ww < NWAVES; ++ww) s += RED[ww * 768 + idx];
            const int nt = idx >> 8, r = (idx >> 6) & 3, l = idx & 63; LG[(4 * (l >> 4) + r) * 48 + nt * 16 + (l & 15)] = s; }
        LDS_WAIT(); __syncthreads();
        {
            const int r = 2 * w + (lane & 1); float lg[36];
#pragma unroll
            for (int o = 0; o < 36; ++o) lg[o] = LG[r * 48 + o] + (o < 4 ? rcb[o] : rfb[o - 4]);
            int g = 0; float mx = lg[0];
#pragma unroll
            for (int j = 1; j < 4; ++j) if (lg[j] > mx) { mx = lg[j]; g = j; }
            float den = 0.f;
#pragma unroll
            for (int j = 0; j < 4; ++j) den += expf(lg[j] - mx);
            const float gprob = 1.f / den;
            float f[8];
#pragma unroll
            for (int i = 0; i < 8; ++i) f[i] = g == 0 ? lg[4 + i] : g == 1 ? lg[12 + i] : g == 2 ? lg[20 + i] : lg[28 + i];
            int i0 = 0; float v0 = f[0];
#pragma unroll
            for (int i = 1; i < 8; ++i) if (f[i] > v0) { v0 = f[i]; i0 = i; }
            int i1 = -1; float v1 = -3.0e38f;
#pragma unroll
            for (int i = 0; i < 8; ++i) if (i != i0 && f[i] > v1) { v1 = f[i]; i1 = i; }
            const float e1 = expf(v1 - v0); const float w0 = gprob / (1.f + e1), w1 = gprob * e1 / (1.f + e1);
            if (VAR == 3) { if (lane == 0) SW[2 * (pass * 16 + r)] = w0 + w1 + (float)(g + i0 + i1); } else
            if (lane < 4) { const int slot = lane >> 1, row = pass * 16 + r, e = g * 8 + (slot ? i1 : i0);
                const int es = e * NSUB + (int)(blockIdx.x & (NSUB - 1));
                const int pos = (int)atomicAdd((unsigned*)(F.ws + WS_CTL) + F.cnt_off + 64 * es, 1u);
                list[(size_t)es * SUBCAP + pos] = row; SE[2 * row + slot] = es; SPOS[2 * row + slot] = pos; SW[2 * row + slot] = slot ? w1 : w0; }
        }
    }
}
__device__ __forceinline__ void p9_final(Frame& F) {
    moe_tables(F);
    const LAS int* ts = (const LAS int*)(F.lds + LTAB_OFF) + 32; const LAS int* sb = LTAB_SB(F.lds);
    const float* wpost = F.in[14]; const float* mod = (const float*)(F.ws + WS_MOD); const bf16* Ys = (const bf16*)(F.ws + WS_YS);
    const int* SE = (const int*)(F.ws + WS_SLOT); const int* SPOS = SE + 2 * T; const float* SW = (const float*)(SPOS + 2 * T);
    const int lane = F.lane;
    for (int row = F.gw; row < T; row += F.NGW) {
        const int b = row >> 12;
        const int es0 = SE[2 * row], es1 = SE[2 * row + 1];
        const int r0 = ts[es0 >> 4] * 256 + sb[(es0 >> 4) * 17 + (es0 & 15)] + SPOS[2 * row], r1 = ts[es1 >> 4] * 256 + sb[(es1 >> 4) * 17 + (es1 & 15)] + SPOS[2 * row + 1]; const float w0 = SW[2 * row], w1 = SW[2 * row + 1];
        const uint2* y0 = (const uint2*)(Ys + (size_t)r0 * DM) + lane; const uint2* y1 = (const uint2*)(Ys + (size_t)r1 * DM) + lane;
        f32x4* outr = (f32x4*)(F.out + (size_t)row * DM) + lane; const f32x4* g2 = (const f32x4*)(mod + (size_t)b * 6 * DM + 5 * DM) + lane;
        f32x4 v[8]; float ss = 0.f;
#pragma unroll
        for (int j = 0; j < 8; ++j) { const uint2 a = y0[64 * j], c = y1[64 * j]; v[j] = bf4(a.x, a.y) * w0 + bf4(c.x, c.y) * w1; ss += (v[j].x * v[j].x + v[j].y * v[j].y) + (v[j].z * v[j].z + v[j].w * v[j].w); }
        const float rstd = rsqrtf(wave_sum(ss) * (1.f / DM) + EPS);
#pragma unroll
        for (int j = 0; j < 8; ++j) outr[64 * j] = outr[64 * j] + g2[64 * j] * (v[j] * rstd * ((const f32x4*)wpost)[lane + 64 * j]);
    }
}
__global__ void __launch_bounds__(NWAVES * 64, 2) mega_fwd(Args args) {
    extern __shared__ __attribute__((aligned(16))) unsigned char lds[];
    Frame F;
    F.lds = (LAS unsigned char*)lds; F.ldsg = (char*)lds;
    F.MISC = (volatile LAS unsigned*)(F.lds + MISC_OFF);
    F.tid = threadIdx.x; F.lane = F.tid & 63; F.wave = __builtin_amdgcn_readfirstlane(F.tid >> 6);
    F.G = gridDim.x; F.gw = blockIdx.x * NWAVES + F.wave; F.NGW = F.G * NWAVES;
    F.cnt_off = args.cnt_off;
    F.ws = args.ws; F.out = args.out; F.ctl = (gu32*)(args.ws + WS_CTL);
#pragma unroll
    for (int i = 0; i < 22; ++i) F.in[i] = args.in[i];
    for (int u = F.tid; u < (LDS_BYTES - LDSCTL_OFF) / 4; u += NWAVES * 64) ((LAS unsigned*)(F.lds + LDSCTL_OFF))[u] = 0u;
    __syncthreads();
    XcdBarrier bar = xcd_barrier_post((unsigned*)(F.ctl + CW_BAR), F.MISC + 8);
    const int lo = args.ph_lo, hi = args.ph_hi;
#define IN(k) (lo <= (k) && (k) < hi)
#define BOTH(k) (IN(k) && IN((k) + 1))
#define GRID_BAR() xcd_barrier(bar)
#define REFRESH() do { int t_ = threadIdx.x; asm volatile("" : "+v"(t_)); F.tid = t_; F.lane = t_ & 63; F.wave = __builtin_amdgcn_readfirstlane(t_ >> 6); F.gw = blockIdx.x * NWAVES + F.wave; } while (0)
#ifdef TS_PHASE
    unsigned long long ts0_ = 0, ts1_ = 0;
#define TS_BEG(k) do { if ((k) == TS_PHASE) ts0_ = __builtin_amdgcn_s_memrealtime(); if ((k) == TS_PHASE + TS_SPAN) ts1_ = __builtin_amdgcn_s_memrealtime(); } while (0)
#else
#define TS_BEG(k) do {} while (0)
#endif
    if (IN(0)) { REFRESH(); TS_BEG(0); p0_prologue<false>(F); if (BOTH(0)) GRID_BAR(); }
    if (IN(1)) { REFRESH(); TS_BEG(1); p1_prenorm(F); if (BOTH(1)) GRID_BAR(); }
    if (IN(2)) { REFRESH(); TS_BEG(2);
        const int NG2 = (F.G == 256) ? 224 : F.G;
        if ((int)blockIdx.x < NG2) {
            pg8::Gemm g{(const bf16*)(F.ws + WS_HB), (const bf16*)(F.ws + WS_WIN), T, INCM, DM}; pg8::StaticOrder S; S.init(T, INCM, NG2, (int)blockIdx.x);
            EpiHeads E{(bf16*)(F.ws + WS_QKV), (const float*)(F.ws + WS_CS), F.in[9], F.in[10], F.lds};
            pg8::gemm_phase<EpiHeads, pg8::StaticOrder, true, true>(F.lds + RING_OFF, g, S, E);
            if (F.tid == 0) __hip_atomic_fetch_add(F.ctl + CW_DONE + 64 * 2, 1u, RLX_AGENT);
        } else filler(F, 2, 1, (unsigned)NG2, 0u, (unsigned)N_CONV_BI);
        if (BOTH(2)) GRID_BAR();
    }
    if (IN(3)) { REFRESH(); TS_BEG(3); p3_phase(F); if (BOTH(3)) GRID_BAR(); }
    if (IN(4)) { REFRESH(); TS_BEG(4); p3b_scan(F); if (BOTH(4)) GRID_BAR(); }
    if (IN(5)) { REFRESH(); TS_BEG(5); p4_phase(F); filler(F, 5, 0, (unsigned)F.G, (unsigned)(F.G - F.G / 8), (unsigned)N_CONV_BI); if (BOTH(5)) GRID_BAR(); }
    if (IN(6)) { REFRESH(); TS_BEG(6);
        pg8::Gemm g{(const bf16*)(F.ws + WS_CAT), (const bf16*)(F.ws + WS_WOUT), T, DM, DM}; pg8::StaticOrder S; S.init(T, DM, F.G, (int)blockIdx.x);
        EpiPlain E{(bf16*)(F.ws + WS_YB), DM, 8};
        pg8::gemm_phase<EpiPlain, pg8::StaticOrder, true, true>(F.lds + RING_OFF, g, S, E);
        if (BOTH(6)) GRID_BAR();
    }
#ifdef PROBE_VARIANTS
    if (lo == 11) p6_phase<1>(F);
    if (lo == 12) p6_phase<2>(F);
    if (lo == 13) p6_phase<3>(F);
    if (lo == 14) p6_phase<4>(F);
#endif
    if (IN(7)) { REFRESH(); TS_BEG(7); p6_phase<0>(F); filler(F, 7, 2, 0u, 0u, (unsigned)N_CONV_BI); if (BOTH(7)) GRID_BAR(); }
    if (IN(8)) { REFRESH(); TS_BEG(8);
        moe_tables(F);
        pg8::Gemm g{(const bf16*)(F.ws + WS_HB), (const bf16*)(F.ws + WS_W13), PADROWS, NE * 1024, DM};
        GroupedOrder<4> S; S.init((const LAS int*)(F.lds + LTAB_OFF) + 32, F.G, (int)blockIdx.x);
        EpiSwiglu E{(unsigned char*)(F.ws + WS_GB)}; GatherRows R{(const int*)(F.ws + WS_LIST), (const LAS int*)(F.lds + LTAB_OFF), LTAB_SB(F.lds)};
        pg8::gemm_phase<EpiSwiglu, GroupedOrder<4>, true, true, GatherRows, 1>(F.lds + RING_OFF, g, S, E, R);
        if (BOTH(8)) GRID_BAR();
    }
    if (IN(9)) { REFRESH(); TS_BEG(9);
        moe_tables(F);
        pg8::Gemm g{(const bf16*)(F.ws + WS_GB), (const bf16*)(F.ws + WS_W2), PADROWS, NE * 2048, DE};
        GroupedOrder<8> S; S.init((const LAS int*)(F.lds + LTAB_OFF) + 32, F.G, (int)blockIdx.x);
        EpiPlain E{(bf16*)(F.ws + WS_YS), DM, 8};
        pg8::gemm_phase<EpiPlain, GroupedOrder<8>, true, true, pg8::IdentRows, 1>(F.lds + RING_OFF, g, S, E);
        if (BOTH(9)) GRID_BAR();
    }
    if (IN(10)) { REFRESH(); TS_BEG(10); p9_final(F); }
#ifdef TS_PHASE
    TS_BEG(11);
    if (blockIdx.x == 0 && threadIdx.x == 0) { const unsigned long long te = __builtin_amdgcn_s_memrealtime(), want = 4ull * (ts1_ - ts0_);
        while (__builtin_amdgcn_s_memrealtime() - te < want) __builtin_amdgcn_s_sleep(8); }
#endif
#undef IN
#undef BOTH
}

__global__ void k_adapt_proj(const bf16* __restrict__ qkv, const float* __restrict__ zb, float* __restrict__ proj) {
    const size_t i = (size_t)blockIdx.x * blockDim.x + threadIdx.x;
    if (i >= (size_t)T * INC) return;
    const int tok = (int)(i / INC), c = (int)(i % INC);
    if (c >= INCM) { proj[i] = zb[(size_t)tok * 8 + (c - INCM)]; return; }
    const int type = c >> 10, hh = (c & 1023) >> 7, d = c & 127, b = tok >> 12, s = tok & 4095;
    const unsigned v = qkv[(size_t)type * TSZ + ((size_t)((b * 8 + hh) * SEQ + s)) * HD + d];
    proj[i] = __uint_as_float(v << 16);
}

__global__ void k_adapt_cat(const bf16* __restrict__ catb, float* __restrict__ cat) {
    const size_t i = (size_t)blockIdx.x * blockDim.x + threadIdx.x;
    if (i < (size_t)T * DM) cat[i] = __uint_as_float((unsigned)catb[i] << 16);
}
extern "C" void kernel_launch(void* const* d_in, const int* in_sizes, int n_in, void* d_out, int out_size, void* d_ws, size_t ws_size, hipStream_t stream) {
    static int grid = 0;
    if (grid == 0) {
        int dev = 0, cus = 0, per_cu = 0;
        (void)hipGetDevice(&dev); (void)hipDeviceGetAttribute(&cus, hipDeviceAttributeMultiprocessorCount, dev);
        (void)hipFuncSetAttribute((const void*)mega_fwd, hipFuncAttributeMaxDynamicSharedMemorySize, LDS_BYTES);
        (void)hipOccupancyMaxActiveBlocksPerMultiprocessor(&per_cu, (const void*)mega_fwd, NWAVES * 64, LDS_BYTES);
        (void)hipGetLastError();
        if (per_cu < 1) { fprintf(stderr, "kernel_launch: occupancy query says %d blocks/CU\n", per_cu); per_cu = 1; }
        grid = cus > 0 ? cus : 256;
        if (ws_size < WS_END) fprintf(stderr, "kernel_launch: workspace too small (%zu < %zu)\n", ws_size, (size_t)WS_END);
    }
    (void)hipMemsetAsync((char*)d_ws + WS_CTL, 0, CTL_ZERO_BYTES, stream);
    Args a{};
    for (int i = 0; i < 22; ++i) a.in[i] = (const float*)d_in[i];
    a.out = (float*)d_out; a.ws = (unsigned char*)d_ws; a.ph_lo = 0; a.ph_hi = 11; a.cnt_off = CW_CNT;
    hipLaunchKernelGGL(mega_fwd, dim3(grid), dim3(NWAVES * 64), LDS_BYTES, stream, a);
}
```

```cpp
#include <hip/hip_runtime.h>
#include <stdint.h>
#include <cstdio>

constexpr int DM = 2048, NB = 2, SEQ = 4096, T = NB * SEQ;
constexpr int HD = 128, NH = 8;
constexpr int INC = 7176, INCM = 7168;
constexpr int NE = 32, DE = 512;
constexpr float EPS = 1e-6f;
#define GAS __attribute__((address_space(1)))
#define LAS __attribute__((address_space(3)))
typedef unsigned short bf16;
typedef unsigned v4u __attribute__((ext_vector_type(4)));
typedef float f32x4 __attribute__((ext_vector_type(4)));
typedef short bf16x8 __attribute__((ext_vector_type(8)));
typedef GAS unsigned gu32;
typedef GAS unsigned long long gu64;
#define RLX_AGENT __ATOMIC_RELAXED, __HIP_MEMORY_SCOPE_AGENT
#define LDS_WAIT() asm volatile("s_waitcnt lgkmcnt(0)" ::: "memory")
#define VM_WAIT() asm volatile("s_waitcnt vmcnt(0)" ::: "memory")
__device__ __forceinline__ unsigned long long rt() { return __builtin_amdgcn_s_memrealtime(); }
__device__ __forceinline__ unsigned f2bf(float f) { unsigned u = __builtin_bit_cast(unsigned, f); return (u + 0x7fffu + ((u >> 16) & 1u)) >> 16; }
__device__ __forceinline__ unsigned pk2(float lo, float hi) { return f2bf(lo) | (f2bf(hi) << 16); }

#define XB_TMO      128
#define XB_XCNT(j)  (256  + 64 * (j))
#define XB_XSUB(j)  (1280 + 64 * (j))
#define XB_XGEN(j)  (2304 + 64 * (j))
#define XB_TOP      3328
#define XB_TOPGEN   3392
#define XCD_BAR_WORDS 3456
#define XB_SPIN_CAP (1u << 18)

__device__ __forceinline__ unsigned xb_ld(unsigned* p)              { return __hip_atomic_load(p, __ATOMIC_RELAXED, __HIP_MEMORY_SCOPE_AGENT); }
__device__ __forceinline__ unsigned xb_add(unsigned* p, unsigned v) { return __hip_atomic_fetch_add(p, v, __ATOMIC_RELAXED, __HIP_MEMORY_SCOPE_AGENT); }
__device__ __forceinline__ unsigned xb_xcc_id() { return (unsigned)__builtin_amdgcn_s_getreg((3 << 11) | 20) & 0xFu; }
#define XB_SPIN(cond, bar) do { unsigned _sp = 0; while (cond) { __builtin_amdgcn_s_sleep(1); \
    if ((++_sp & 255u) == 0u) { if (xb_ld(&(bar)[XB_TMO])) break; if (_sp > XB_SPIN_CAP) { atomicAdd(&(bar)[XB_TMO], 1u); break; } } } } while (0)

struct XcdBarrier {
    unsigned* bar; unsigned x;
    volatile LAS unsigned* st;
};

__device__ __forceinline__ XcdBarrier xcd_barrier_post(unsigned* bar, volatile LAS unsigned* st) {
    XcdBarrier b; b.bar = bar; b.x = xb_xcc_id(); b.st = st;
    if (threadIdx.x == 0) (void)xb_add(&bar[XB_XCNT(b.x)], 1u);
    return b;
}
__device__ __forceinline__ void xcd_barrier_complete(unsigned* bar, unsigned x, unsigned& nloc, unsigned& nx) {
    const unsigned G = gridDim.x * gridDim.y * gridDim.z;
    unsigned sum, cnt, mine, sp = 0u;
    for (;;) {
        sum = 0u; cnt = 0u; mine = 0u;
#pragma unroll
        for (unsigned j = 0; j < 16; ++j) { const unsigned c = xb_ld(&bar[XB_XCNT(j)]); sum += c; cnt += (c > 0u) ? 1u : 0u; mine = (j == x) ? c : mine; }
        if (sum == G) break;
        __builtin_amdgcn_s_sleep(1);
        if ((++sp & 255u) == 0u) { if (xb_ld(&bar[XB_TMO])) break; if (sp > XB_SPIN_CAP) { atomicAdd(&bar[XB_TMO], 1u); break; } }
    }
    nloc = mine > 0u ? mine : 1u; nx = cnt > 0u ? cnt : 1u;
}

__device__ __forceinline__ void xcd_barrier(const XcdBarrier& b) {
    asm volatile("s_waitcnt vmcnt(0)" ::: "memory");
    __syncthreads();
    if (threadIdx.x == 0) {
        unsigned* bar = b.bar;
        __builtin_amdgcn_s_waitcnt(0);
        unsigned nloc = b.st[0], nx = b.st[1];
        if (nloc == 0u) { xcd_barrier_complete(bar, b.x, nloc, nx); b.st[0] = nloc; b.st[1] = nx; }
        const unsigned old = xb_add(&bar[XB_XSUB(b.x)], 1u);
        const unsigned gen = old / nloc;
        if (old + 1u == (gen + 1u) * nloc) {
            __builtin_amdgcn_fence(__ATOMIC_RELEASE, "agent");
            asm volatile("s_waitcnt vmcnt(0)" ::: "memory");
            const unsigned og = xb_add(&bar[XB_TOP], 1u);
            const unsigned tg = og / nx;
            if (og + 1u == (tg + 1u) * nx) xb_add(&bar[XB_TOPGEN], 1u);
            else XB_SPIN(xb_ld(&bar[XB_TOPGEN]) == tg, bar);
            __builtin_amdgcn_fence(__ATOMIC_ACQUIRE, "agent");
            xb_add(&bar[XB_XGEN(b.x)], 1u);
            asm volatile("s_waitcnt vmcnt(0)" ::: "memory");
        } else {
            XB_SPIN(xb_ld(&bar[XB_XGEN(b.x)]) == gen, bar);
            __builtin_amdgcn_fence(__ATOMIC_ACQUIRE, "agent");
            asm volatile("s_waitcnt vmcnt(0)" ::: "memory");
        }
    }
    __syncthreads();
}
namespace pg8 {
#define PG8_LAS __attribute__((address_space(3)))
typedef unsigned short bf16_t;
typedef short bf16x8 __attribute__((ext_vector_type(8)));
typedef float f32x4 __attribute__((ext_vector_type(4)));
typedef unsigned u32x4 __attribute__((ext_vector_type(4)));
constexpr int BM = 256, BK = 64, HALF = 128, HTB = HALF * BK * 2  , STAGE_BYTES = 8 * HTB, NXCD = 8, WGM = 8;

__host__ __device__ __forceinline__ int lds_byte(int r, int c) { const int st = (r >> 4) * 2 + (c >> 5), rr = r & 15, cc = c & 31, ob = rr * 64 + cc * 2; return st * 1024 + (ob ^ (((ob >> 9) & 1) << 5)); }
__host__ __device__ __forceinline__ void stage_rc(int b, int& R, int& C) { const int st = b / 1024, sb = b % 1024, swz = sb ^ (((sb >> 9) & 1) << 5); R = (st >> 1) * 16 + swz / 64; C = (st & 1) * 32 + (swz % 64) / 2; }
__host__ __device__ __forceinline__ int perm32(int rho) { const int n = rho >> 4, i = rho & 15; return 8 * (i >> 2) + 4 * n + (i & 3); }

struct Unit { int pm, pn; };
struct Gemm { const bf16_t* A; const bf16_t* Bt; int M, N, K; };

struct StaticOrder {
    typedef Unit unit_t;
    int nM, nN, nwg, G, c;
    __host__ __device__ void init(int M, int N, int G_, int c_) { nM = M / BM; nN = N / BM; nwg = nM * nN; G = G_; c = c_; }
    __host__ __device__ bool next(int i, Unit& u) const {
        const long L = (long)i * G + c; if (L >= nwg) return false;
        int wgid = (int)L; { const int q = nwg / NXCD, r = nwg % NXCD, xcd = wgid % NXCD, off = wgid / NXCD; wgid = (xcd < r ? xcd * (q + 1) : r * (q + 1) + (xcd - r) * q) + off; }
        const int nig = WGM * nN, gid = wgid / nig, fm = gid * WGM, gsz = (nM - fm) < WGM ? (nM - fm) : WGM;
        u.pm = fm + ((wgid % nig) % gsz); u.pn = (wgid % nig) / gsz; return true;
    }
    __device__ __forceinline__ void a_ready(const Unit&) const {}
    __device__ __forceinline__ void done(const Unit&) const {}
};

__device__ __forceinline__ unsigned cvt_pk_bf16(float lo, float hi) { unsigned r; asm volatile("v_cvt_pk_bf16_f32 %0, %1, %2" : "=v"(r) : "v"(lo), "v"(hi)); return r; }
typedef float f32x2 __attribute__((ext_vector_type(2)));
__device__ __forceinline__ f32x2 gelu_pk(f32x2 v) {
    const f32x2 av = __builtin_elementwise_abs(v), d = av * 0.2316418882f + 1.0f;
    f32x2 t; t.x = __builtin_amdgcn_rcpf(d.x); t.y = __builtin_amdgcn_rcpf(d.y);
    f32x2 q = t * 0.5307027145f + (-0.7265760135f); q = q * t + 0.7107068705f; q = q * t + (-0.142248368f); q = q * t + 0.127414796f; q = q * t;
    const f32x2 s = (v * v) * (-0.72134752044f);
    f32x2 e; e.x = __builtin_amdgcn_exp2f(s.x); e.y = __builtin_amdgcn_exp2f(s.y);
    const f32x2 m = v * (q * e), r = v - m;
    f32x2 o; o.x = v.x < 0.f ? m.x : r.x; o.y = v.y < 0.f ? m.y : r.y; return o;
}

template <int ACT  > struct EpiBf16 {
    static constexpr bool PERM = true, AFTER_DRAIN = false; static_assert(ACT == 0 || ACT == 1, "EpiBf16: ACT is 0 (none) or 1 (gelu_pk)");
    bf16_t* O; int ldc; const float* bias; int split_cols; size_t split_stride; float scale0;
    __device__ __forceinline__ void operator()(const f32x4 (&acc)[2][2][4][2], const Unit& u, int wr, int wc, int fr, int fq) const {
        const int row0 = u.pm * BM + wr * 64 + fr; int colt = u.pn * BM; bf16_t* base = O;
        float sc = 1.f; if (split_cols) { const int t = colt / split_cols; base += (size_t)t * split_stride; colt -= t * split_cols; if (t == 0) sc = scale0; }
        const int col0 = colt + wc * 32 + 8 * fq, bcol0 = u.pn * BM + wc * 32 + 8 * fq;
        f32x4 bv[2][2];
#pragma unroll
        for (int bj = 0; bj < 2; ++bj)
#pragma unroll
            for (int n = 0; n < 2; ++n) bv[bj][n] = bias ? *(const f32x4*)(bias + bcol0 + bj * HALF + 4 * n) : (f32x4){0.f, 0.f, 0.f, 0.f};
#pragma unroll
        for (int ai = 0; ai < 2; ++ai)
#pragma unroll
            for (int m = 0; m < 4; ++m) { bf16_t* rowp = base + (size_t)(row0 + ai * HALF + m * 16) * ldc + col0;
#pragma unroll
                for (int bj = 0; bj < 2; ++bj) { f32x4 v0 = acc[ai][bj][m][0] + bv[bj][0], v1 = acc[ai][bj][m][1] + bv[bj][1];
                    if (ACT == 1) { f32x2 a = gelu_pk((f32x2){v0[0], v0[1]}), b = gelu_pk((f32x2){v0[2], v0[3]}), c = gelu_pk((f32x2){v1[0], v1[1]}), d = gelu_pk((f32x2){v1[2], v1[3]});
                        v0 = (f32x4){a.x, a.y, b.x, b.y}; v1 = (f32x4){c.x, c.y, d.x, d.y}; }
                    v0 = v0 * sc; v1 = v1 * sc; u32x4 w; w.x = cvt_pk_bf16(v0[0], v0[1]); w.y = cvt_pk_bf16(v0[2], v0[3]); w.z = cvt_pk_bf16(v1[0], v1[1]); w.w = cvt_pk_bf16(v1[2], v1[3]);
                    *(u32x4*)(rowp + bj * HALF) = w; } }
    }
};
struct IdentRows { template <class U> __device__ __forceinline__ unsigned row(const U& u, int r) const { return (unsigned)(u.pm * BM + r); } };
typedef int v8i32 __attribute__((ext_vector_type(8))); typedef int v4i32 __attribute__((ext_vector_type(4)));
__device__ __forceinline__ v8i32 cat32(bf16x8 lo, bf16x8 hi) { const v4i32 a = __builtin_bit_cast(v4i32, lo), b = __builtin_bit_cast(v4i32, hi); return __builtin_shufflevector(a, b, 0, 1, 2, 3, 4, 5, 6, 7); }
template <class Epi, class Sched, bool ALIGN_EPI = false, bool SP2 = false, class RowMap = IdentRows, int EB = 2>
__device__ __forceinline__ void gemm_phase(PG8_LAS unsigned char* lds, const Gemm g, const Sched& S, const Epi& E, const RowMap RM = RowMap()) {
    typedef typename Sched::unit_t Unit;
    const int tid = threadIdx.x, wid = __builtin_amdgcn_readfirstlane(tid >> 6), lane = tid & 63, wr = wid >> 2, wc = wid & 3, fr = lane & 15, fq = lane >> 4;
    int K = g.K; asm volatile("" : "+s"(K)); const int nt = K * EB / (BK * 2);
    unsigned voffB[2]; int RA[2], CA[2];
#pragma unroll
    for (int i = 0; i < 2; ++i) { int R, C; stage_rc(tid * 16 + i * 8192, R, C); const int Rb = Epi::PERM ? ((R & ~31) + perm32(R & 31)) : R;
        RA[i] = R; CA[i] = C; voffB[i] = (unsigned)(Rb * K * EB + C * 2); }
    unsigned ao[2][2], an[2][2];
#define PG8_AOFF(dst, U) do { _Pragma("unroll") for (int h_ = 0; h_ < 2; ++h_) _Pragma("unroll") for (int i_ = 0; i_ < 2; ++i_) { \
        dst[h_][i_] = RM.row((U), h_ * HALF + RA[i_]) * (unsigned)(K * EB) + (unsigned)(CA[i_] * 2); } } while (0)
    const size_t kstep = (size_t)(BK * 2);
    const size_t hstep = (size_t)HALF * K * EB;
    const size_t tstep = 2 * hstep;
    const unsigned ldsw = (unsigned)wid * 1024u;
    const int aoff = lds_byte(wr * 64 + fr, fq * 8), boff = lds_byte(wc * 32 + fr, fq * 8);
#define PG8_SA(b, h) (((b) * 2 + (h)) * HTB)
#define PG8_SB(b, h) ((4 + (b) * 2 + (h)) * HTB)
#define PG8_STAGE(bufoff, gbase, voff) do { _Pragma("unroll") for (int _i = 0; _i < 2; ++_i) \
        __builtin_amdgcn_global_load_lds((const unsigned*)((const char*)(gbase) + (voff)[_i]), (PG8_LAS unsigned*)(lds + (bufoff) + ldsw + _i * 8192), 16, 0, 0); } while (0)
#define PG8_STAGE_A(bufoff, kbase, off) do { _Pragma("unroll") for (int _i = 0; _i < 2; ++_i) \
        __builtin_amdgcn_global_load_lds((const unsigned*)((const char*)(kbase) + (off)[_i]), (PG8_LAS unsigned*)(lds + (bufoff) + ldsw + _i * 8192), 16, 0, 0); } while (0)
#define PG8_LDA(dst, b, h) do { _Pragma("unroll") for (int m = 0; m < 4; ++m) { if constexpr (EB == 1) dst##8[m] = cat32(*(const PG8_LAS bf16x8*)(lds + PG8_SA(b, h) + aoff + m * 2048), *(const PG8_LAS bf16x8*)(lds + PG8_SA(b, h) + aoff + m * 2048 + 1024)); \
        else { _Pragma("unroll") for (int k = 0; k < 2; ++k) dst[m][k] = *(const PG8_LAS bf16x8*)(lds + PG8_SA(b, h) + aoff + m * 2048 + k * 1024); } } } while (0)
#define PG8_LDB(dst, b, h) do { _Pragma("unroll") for (int n = 0; n < 2; ++n) { if constexpr (EB == 1) dst##8[n] = cat32(*(const PG8_LAS bf16x8*)(lds + PG8_SB(b, h) + boff + n * 2048), *(const PG8_LAS bf16x8*)(lds + PG8_SB(b, h) + boff + n * 2048 + 1024)); \
        else { _Pragma("unroll") for (int k = 0; k < 2; ++k) dst[n][k] = *(const PG8_LAS bf16x8*)(lds + PG8_SB(b, h) + boff + n * 2048 + k * 1024); } } } while (0)
#define PG8_MMA(ai, bj, At, Bt) do { __builtin_amdgcn_s_setprio(1); _Pragma("unroll") for (int m = 0; m < 4; ++m) _Pragma("unroll") for (int n = 0; n < 2; ++n) { \
        if constexpr (EB == 1) asm volatile("v_mfma_scale_f32_16x16x128_f8f6f4 %0, %1, %2, %0, %3, %4 op_sel_hi:[0,0,0]" : "+v"(acc[ai][bj][m][n]) : "v"(Bt##8[n]), "v"(At##8[m]), "v"(scw_), "v"(sca_)); \
        else { _Pragma("unroll") for (int k = 0; k < 2; ++k) acc[ai][bj][m][n] = __builtin_amdgcn_mfma_f32_16x16x32_bf16(Bt[n][k], At[m][k], acc[ai][bj][m][n], 0, 0, 0); } } \
        __builtin_amdgcn_s_setprio(0); } while (0)
#define PG8_WAIT_V(n) asm volatile("s_waitcnt vmcnt(" #n ")" ::: "memory")
#define PG8_WAIT_L(n) asm volatile("s_waitcnt lgkmcnt(" #n ")" ::: "memory")
#define PG8_BAR __builtin_amdgcn_s_barrier()
#define PG8_SCHED __builtin_amdgcn_sched_barrier(0)
    Unit cur, nxt; int ui = 0;
    if (!S.next(0, cur)) return;
    f32x4 acc[2][2][4][2];
#pragma unroll
    for (int a = 0; a < 2; ++a)
#pragma unroll
        for (int b = 0; b < 2; ++b)
#pragma unroll
            for (int m = 0; m < 4; ++m)
#pragma unroll
                for (int n = 0; n < 2; ++n) acc[a][b][m][n] = (f32x4){0.f, 0.f, 0.f, 0.f};
    int scw_ = 0x79797979, sca_ = 0x7F7F7F7F; asm volatile("" : "+v"(scw_), "+v"(sca_));
    bf16x8 At[4][2], B0[2][2], B1[2][2]; v8i32 At8[4], B08[2], B18[2];
    const char* const Ab = (const char*)g.A; const char* cB = (const char*)g.Bt + (size_t)cur.pn * tstep;
    PG8_AOFF(ao, cur);
    S.a_ready(cur);
    if constexpr (SP2) {
        PG8_STAGE(PG8_SB(0, 0), cB, voffB); PG8_STAGE(PG8_SB(0, 1), cB + hstep, voffB); PG8_STAGE_A(PG8_SA(0, 0), Ab, ao[0]); PG8_STAGE_A(PG8_SA(0, 1), Ab, ao[1]);
        if (wr == 1) PG8_BAR;
        PG8_WAIT_V(2); PG8_BAR;
        PG8_STAGE(PG8_SB(1, 0), cB + kstep, voffB); PG8_STAGE_A(PG8_SA(1, 0), Ab + kstep, ao[0]); PG8_STAGE(PG8_SB(1, 1), cB + hstep + kstep, voffB);
        PG8_WAIT_V(6); PG8_BAR;
    } else {
        PG8_STAGE(PG8_SB(0, 0), cB, voffB); PG8_STAGE_A(PG8_SA(0, 0), Ab, ao[0]); PG8_STAGE(PG8_SB(0, 1), cB + hstep, voffB); PG8_STAGE_A(PG8_SA(0, 1), Ab, ao[1]);
        if (wr == 1) PG8_BAR;
        PG8_WAIT_V(4); PG8_BAR;
        PG8_STAGE(PG8_SB(1, 0), cB + kstep, voffB); PG8_STAGE_A(PG8_SA(1, 0), Ab + kstep, ao[0]); PG8_STAGE(PG8_SB(1, 1), cB + hstep + kstep, voffB);
        PG8_WAIT_V(6); PG8_BAR;
    }
    for (;;) {
        const bool has_next = S.next(ui + 1, nxt);
        const char* nB = has_next ? (const char*)g.Bt + (size_t)nxt.pn * tstep : cB;
        if (has_next) { PG8_AOFF(an, nxt); } else { _Pragma("unroll") for (int h_ = 0; h_ < 2; ++h_) _Pragma("unroll") for (int i_ = 0; i_ < 2; ++i_) an[h_][i_] = ao[h_][i_]; }
        for (int t = 0; t < nt; t += 2) {
            const bool last = (t == nt - 2);
            const char* a1 = Ab + (size_t)(t + 1) * kstep;
            const char* a2 = last ? Ab : Ab + (size_t)(t + 2) * kstep; const char* b2 = last ? nB : cB + (size_t)(t + 2) * kstep;
            const char* a3 = a2 + kstep; const char* b3 = b2 + kstep;
            unsigned as[2][2];
#pragma unroll
            for (int h_ = 0; h_ < 2; ++h_)
#pragma unroll
                for (int i_ = 0; i_ < 2; ++i_) as[h_][i_] = last ? an[h_][i_] : ao[h_][i_];
            if (last && has_next) S.a_ready(nxt);
            if constexpr (SP2) {
            PG8_LDB(B0, 0, 0); PG8_LDB(B1, 0, 1); PG8_SCHED; PG8_LDA(At, 0, 0); PG8_STAGE_A(PG8_SA(1, 1), a1, ao[1]);
            PG8_WAIT_V(8); PG8_WAIT_L(0); PG8_BAR; PG8_MMA(0, 0, At, B0); PG8_MMA(0, 1, At, B1); PG8_BAR; PG8_SCHED;
            PG8_LDA(At, 0, 1); PG8_STAGE(PG8_SB(0, 0), b2, voffB); PG8_STAGE(PG8_SB(0, 1), b2 + hstep, voffB); PG8_STAGE_A(PG8_SA(0, 0), a2, as[0]);
            PG8_WAIT_V(8); PG8_WAIT_L(0); PG8_BAR; PG8_MMA(1, 0, At, B0); PG8_MMA(1, 1, At, B1); PG8_BAR; PG8_SCHED;
            PG8_LDB(B0, 1, 0); PG8_LDB(B1, 1, 1); PG8_SCHED; PG8_LDA(At, 1, 0); PG8_STAGE_A(PG8_SA(0, 1), a2, as[1]);
            PG8_WAIT_V(8); PG8_WAIT_L(0); PG8_BAR; PG8_MMA(0, 0, At, B0); PG8_MMA(0, 1, At, B1); PG8_BAR; PG8_SCHED;
            PG8_LDA(At, 1, 1); PG8_STAGE(PG8_SB(1, 0), b3, voffB); PG8_STAGE(PG8_SB(1, 1), b3 + hstep, voffB); PG8_STAGE_A(PG8_SA(1, 0), a3, as[0]);
            PG8_WAIT_V(8); PG8_WAIT_L(0); PG8_BAR; PG8_MMA(1, 0, At, B0); PG8_MMA(1, 1, At, B1); PG8_BAR; PG8_SCHED;
            } else {
            PG8_LDB(B0, 0, 0); PG8_SCHED; PG8_LDA(At, 0, 0); PG8_STAGE_A(PG8_SA(1, 1), a1, ao[1]);
            PG8_WAIT_L(8); PG8_BAR; PG8_WAIT_L(0); PG8_MMA(0, 0, At, B0); PG8_BAR; PG8_SCHED;
            PG8_LDB(B1, 0, 1); PG8_STAGE(PG8_SB(0, 0), b2, voffB);
            PG8_BAR; PG8_WAIT_L(0); PG8_MMA(0, 1, At, B1); PG8_BAR;
            PG8_LDA(At, 0, 1); PG8_STAGE_A(PG8_SA(0, 0), a2, as[0]);
            PG8_BAR; PG8_WAIT_L(0); PG8_MMA(1, 0, At, B0); PG8_BAR; PG8_SCHED;
            PG8_STAGE(PG8_SB(0, 1), b2 + hstep, voffB);
            PG8_WAIT_V(6); PG8_BAR; PG8_MMA(1, 1, At, B1); PG8_BAR;
            PG8_LDB(B0, 1, 0); PG8_SCHED; PG8_LDA(At, 1, 0); PG8_STAGE_A(PG8_SA(0, 1), a2, as[1]);
            PG8_WAIT_L(8); PG8_BAR; PG8_WAIT_L(0); PG8_MMA(0, 0, At, B0); PG8_BAR; PG8_SCHED;
            PG8_LDB(B1, 1, 1); PG8_STAGE(PG8_SB(1, 0), b3, voffB);
            PG8_BAR; PG8_WAIT_L(0); PG8_MMA(0, 1, At, B1); PG8_BAR;
            PG8_LDA(At, 1, 1); PG8_STAGE_A(PG8_SA(1, 0), a3, as[0]);
            PG8_BAR; PG8_WAIT_L(0); PG8_MMA(1, 0, At, B0); PG8_BAR; PG8_SCHED;
            PG8_STAGE(PG8_SB(1, 1), b3 + hstep, voffB);
            PG8_WAIT_V(6); PG8_BAR; PG8_MMA(1, 1, At, B1); PG8_BAR;
            }
        }
        if constexpr (EB == 1) asm volatile("s_nop 15\n\ts_nop 15" ::: "memory");
        if constexpr (ALIGN_EPI) { if (wr == 0) PG8_BAR; }
        if constexpr (!Epi::AFTER_DRAIN) { E(acc, cur, wr, wc, fr, fq); S.done(cur); }
        if (!has_next) break;
#pragma unroll
        for (int a = 0; a < 2; ++a)
#pragma unroll
            for (int b = 0; b < 2; ++b)
#pragma unroll
                for (int m = 0; m < 4; ++m)
#pragma unroll
                    for (int n = 0; n < 2; ++n) acc[a][b][m][n] = (f32x4){0.f, 0.f, 0.f, 0.f};
        cur = nxt; cB = nB; ++ui;
#pragma unroll
        for (int h_ = 0; h_ < 2; ++h_)
#pragma unroll
            for (int i_ = 0; i_ < 2; ++i_) ao[h_][i_] = an[h_][i_];
        if constexpr (ALIGN_EPI) { if (wr == 1) PG8_BAR; }
    }
    PG8_WAIT_V(0);
    if constexpr (!ALIGN_EPI) { if (wr == 0) PG8_BAR; }
    PG8_BAR;
    if constexpr (Epi::AFTER_DRAIN) { E.fused(acc, cur, wr, wc, fr, fq, lds, wid, lane); S.done(cur); }
#undef PG8_SA
#undef PG8_SB
#undef PG8_STAGE
#undef PG8_STAGE_A
#undef PG8_AOFF
#undef PG8_LDA
#undef PG8_LDB
#undef PG8_MMA
#undef PG8_WAIT_V
#undef PG8_WAIT_L
#undef PG8_BAR
#undef PG8_SCHED
}
}
constexpr int NWAVES = 8;
constexpr int RING_OFF = 0, RING_BYTES = 131072;
constexpr int LDSCTL_OFF = 150 * 1024, MISC_OFF = LDSCTL_OFF + 320;
constexpr int LDS_BYTES = 160 * 1024;
constexpr size_t MiB = 1u << 20;
constexpr size_t WS_CTL = 0, CTL_ZERO_BYTES = 1 * MiB;
constexpr size_t WS_MOD = 1 * MiB;
constexpr size_t WS_RWP = WS_MOD + 128 * 1024;
constexpr size_t WS_CS = 2 * MiB;
constexpr size_t WS_LOGF = 4 * MiB;
constexpr size_t WS_CB = WS_LOGF + 256 * 1024;
constexpr size_t WS_Z = WS_CB + 256 * 1024;
constexpr size_t WS_WIN = 6 * MiB;
constexpr size_t WS_WOUT = 34 * MiB;
constexpr size_t WS_HB = 42 * MiB;
constexpr size_t WS_QKV = 74 * MiB;
constexpr size_t TSZ = (size_t)16 * 4096 * 128;
constexpr size_t WS_FAST_END = 186 * MiB;
constexpr size_t WS_YB = 74 * MiB;
constexpr size_t WS_GB = 74 * MiB;
constexpr size_t WS_YS = 110 * MiB;
constexpr size_t WS_W13 = 266 * MiB;
constexpr size_t WS_W2 = 394 * MiB;
constexpr size_t WS_LIST = 458 * MiB;
constexpr size_t WS_SLOT = 459 * MiB;
constexpr size_t WS_END = 460 * MiB;
constexpr int ECAP = 8192, CW_CNT = 32768;
constexpr int CW_BAR = 4096;

struct Frame {
    LAS unsigned char* lds; char* ldsg;
    volatile LAS unsigned* MISC;
    gu32* ctl;
    int tid, lane, wave, G, gw, NGW, cnt_off;
    const float* in[22]; float* out; unsigned char* ws;
};
struct Args { const float* in[22]; float* out; unsigned char* ws; int ph_lo, ph_hi, cnt_off, pad; };

template <int CTRL> __device__ __forceinline__ float dppa(float v) { const int t = __builtin_amdgcn_update_dpp(0, __float_as_int(v), CTRL, 0xf, 0xf, true); return v + __int_as_float(t); }
__device__ __forceinline__ float row16_sum(float v) { v = dppa<0xB1>(v); v = dppa<0x4E>(v); v = dppa<0x141>(v); v = dppa<0x140>(v); return v; }
__device__ __forceinline__ float half32_sum(float v) { v = row16_sum(v); return v + __shfl_xor(v, 16); }
__device__ __forceinline__ float wave_sum(float v) {
    v = row16_sum(v);
    const float s0 = __int_as_float(__builtin_amdgcn_readlane(__float_as_int(v), 0)), s1 = __int_as_float(__builtin_amdgcn_readlane(__float_as_int(v), 16));
    const float s2 = __int_as_float(__builtin_amdgcn_readlane(__float_as_int(v), 32)), s3 = __int_as_float(__builtin_amdgcn_readlane(__float_as_int(v), 48));
    return (s0 + s1) + (s2 + s3);
}
__device__ __forceinline__ float silu_f(float v) { return v / (1.f + __expf(-v)); }
__device__ __forceinline__ unsigned fp8x4(float a, float b, float c, float d) { unsigned w = 0; w = __builtin_amdgcn_cvt_pk_fp8_f32(a, b, w, false); w = __builtin_amdgcn_cvt_pk_fp8_f32(c, d, w, true); return w; }

__device__ __forceinline__ void p0_mod(Frame& F) {
    const float* c = F.in[1]; const float* ada_w = F.in[2]; const float* ada_b = F.in[3];
    float* mod = (float*)(F.ws + WS_MOD);
    LAS float* ca = (LAS float*)(F.lds);
    LAS f32x4* red = (LAS f32x4*)(ca + 2 * DM);
    for (int i = F.tid; i < 2 * DM; i += NWAVES * 64) ca[i] = silu_f(c[i]);
    __syncthreads();
    const int rs = F.lane / 12, c4 = F.lane % 12;
    for (int cb = blockIdx.x; cb < 256; cb += F.G) {
        const int j0 = cb * 48;
        f32x4 a0 = {0.f, 0.f, 0.f, 0.f}, a1 = {0.f, 0.f, 0.f, 0.f};
        if (F.lane < 60) {
            const float* wp = ada_w + (size_t)(F.wave * 256) * (6 * DM) + j0 + 4 * c4;
#pragma unroll 1
            for (int i0 = 0; i0 < 52; i0 += 13) {
                f32x4 wv[13];
#pragma unroll
                for (int i = 0; i < 13; ++i) { const int kl = 5 * (i0 + i) + rs; wv[i] = kl < 256 ? *(const f32x4*)(wp + (size_t)kl * (6 * DM)) : (f32x4){0.f, 0.f, 0.f, 0.f}; }
#pragma unroll
                for (int i = 0; i < 13; ++i) { const int kl = 5 * (i0 + i) + rs; const int k = F.wave * 256 + (kl < 256 ? kl : 0); a0 += wv[i] * ca[k]; a1 += wv[i] * ca[DM + k]; }
            }
        }
        red[(F.wave * 64 + F.lane) * 2] = a0; red[(F.wave * 64 + F.lane) * 2 + 1] = a1;
        __syncthreads();
        if (F.tid < 96) { const int b = F.tid / 48, jj = F.tid % 48, cc = jj >> 2, el = jj & 3; float s = 0.f;
            for (int w = 0; w < NWAVES; ++w)
#pragma unroll
                for (int r = 0; r < 5; ++r) s += red[(w * 64 + r * 12 + cc) * 2 + b][el];
            mod[b * 6 * DM + j0 + jj] = s + ada_b[j0 + jj]; }
        __syncthreads();
    }
}
template <bool ROPE = false, bool FP8 = false>
__device__ __forceinline__ void tr_tile(const float* __restrict__ src, int ldn, int k0, int n0, bf16* __restrict__ dst, int ldk, int drow0, LAS float* scr, int lane) {
#pragma unroll 4
    for (int i = 0; i < 16; ++i) { const int kk = 4 * i + (lane >> 4);
        const f32x4 v = *(const f32x4*)(src + (size_t)(k0 + kk) * ldn + n0 + 4 * (lane & 15));
        LAS float* p = scr + kk * 65 + 4 * (lane & 15); p[0] = v.x; p[1] = v.y; p[2] = v.z; p[3] = v.w; }
    LDS_WAIT(); asm volatile("" ::: "memory");
    const int c = lane & 7;
#pragma unroll
    for (int jj = 0; jj < 8; ++jj) { const int n = (lane >> 3) + 8 * jj; const LAS float* s = scr + (8 * c) * 65 + n;
        v4u o; o.x = pk2(s[0], s[65]); o.y = pk2(s[130], s[195]); o.z = pk2(s[260], s[325]); o.w = pk2(s[390], s[455]);
        int drow = drow0 + n;
        if (ROPE) { const int d = (n0 & 127) + n; drow = drow0 + 32 * ((d >> 4) & 3) + 8 * ((d >> 2) & 3) + 4 * (d >> 6) + (d & 3); }
        if (FP8) { uint2 q; q.x = fp8x4(s[0] * 64.f, s[65] * 64.f, s[130] * 64.f, s[195] * 64.f); q.y = fp8x4(s[260] * 64.f, s[325] * 64.f, s[390] * 64.f, s[455] * 64.f);
                   *(uint2*)((unsigned char*)dst + (size_t)drow * ldk + k0 + 8 * c) = q; }
        else *(v4u*)(dst + (size_t)drow * ldk + k0 + 8 * c) = o; }
    LDS_WAIT(); asm volatile("" ::: "memory");
}
constexpr int CW_CONVQ = 2112, CW_DONE = 2176;
constexpr int I_E = 256 * NE, CONV_PER_WAVE = 2, N_CONV_BI = 3 * I_E / (NWAVES * CONV_PER_WAVE);
struct ConvTile { const float* src; unsigned char* dst; int ldn, ldk; };
__device__ __forceinline__ ConvTile conv_decode(Frame& F, int r) {
    ConvTile t;
    if (r < 2 * I_E) { const int which = r / I_E, rr = r % I_E, e = rr >> 8, q = rr & 255, kt = q >> 3, nt = q & 7;
        t.src = (which == 0 ? F.in[19] : F.in[20]) + (size_t)e * DM * DE + (size_t)(64 * kt) * DE + 64 * nt; t.ldn = DE;
        t.dst = (unsigned char*)(F.ws + WS_W13) + (size_t)(e * 1024 + (nt >> 1) * 256 + which * 128 + (nt & 1) * 64) * DM + 64 * kt; t.ldk = DM; return t; }
    r -= 2 * I_E;
    { const int e = r >> 8, q = r & 255, kt = q >> 5, nt = q & 31;
      t.src = F.in[21] + (size_t)e * DE * DM + (size_t)(64 * kt) * DM + 64 * nt; t.ldn = DM;
      t.dst = (unsigned char*)(F.ws + WS_W2) + (size_t)(e * 2048 + 64 * nt) * DE + 64 * kt; t.ldk = DE; }
    return t;
}
__device__ __forceinline__ void conv_load(const ConvTile& t, f32x4 (&v)[16], int lane) {
#pragma unroll
    for (int i = 0; i < 16; ++i) v[i] = *(const f32x4*)(t.src + (size_t)(4 * i + (lane >> 4)) * t.ldn + 4 * (lane & 15));
}
__device__ __forceinline__ void conv_store(const ConvTile& t, const f32x4 (&v)[16], LAS float* scr, int lane) {
#pragma unroll
    for (int i = 0; i < 16; ++i) { LAS float* p = scr + (4 * i + (lane >> 4)) * 65 + 4 * (lane & 15); p[0] = v[i].x; p[1] = v[i].y; p[2] = v[i].z; p[3] = v[i].w; }
    LDS_WAIT(); asm volatile("" ::: "memory");
    const int c = lane & 7;
#pragma unroll
    for (int jj = 0; jj < 8; ++jj) { const int n = (lane >> 3) + 8 * jj; const LAS float* s = scr + (8 * c) * 65 + n;
        uint2 o; o.x = fp8x4(s[0] * 64.f, s[65] * 64.f, s[130] * 64.f, s[195] * 64.f); o.y = fp8x4(s[260] * 64.f, s[325] * 64.f, s[390] * 64.f, s[455] * 64.f);
        *(uint2*)(t.dst + (size_t)n * t.ldk + 8 * c) = o; }
    LDS_WAIT(); asm volatile("" ::: "memory");
}
constexpr int N_CONV_13 = 2 * I_E / (NWAVES * CONV_PER_WAVE);
__device__ __forceinline__ unsigned conv_pull(Frame& F, unsigned qlimit) {
    return __hip_atomic_fetch_add(F.ctl + CW_CONVQ, 1u, RLX_AGENT);
}
__device__ __forceinline__ void filler(Frame& F, int ph, int mode, unsigned nfin, unsigned early, unsigned qlimit) {
    __syncthreads();
    LAS float* scr = (LAS float*)(F.lds) + F.wave * (64 * 65);
    unsigned nxt = 0xffffffffu;
    if (F.tid == 0) { bool go = true;
        if (mode == 0) go = __hip_atomic_fetch_add(F.ctl + CW_DONE + 64 * ph, 1u, RLX_AGENT) < early;
        if (mode == 1) go = __hip_atomic_load(F.ctl + CW_DONE + 64 * ph, RLX_AGENT) < nfin;
        if (go) nxt = conv_pull(F, qlimit); }
    for (;;) {
        if (F.tid == 0) F.MISC[1] = nxt;
        __syncthreads();
        const unsigned it = F.MISC[1];
        __syncthreads();
        if (it >= (unsigned)N_CONV_BI) break;
        if (F.tid == 0) { const bool stop = mode != 2 && __hip_atomic_load(F.ctl + CW_DONE + 64 * ph, RLX_AGENT) >= nfin;
            nxt = stop ? 0xffffffffu : conv_pull(F, qlimit); }
        const int r0 = ((int)it * NWAVES + F.wave) * CONV_PER_WAVE;
        const ConvTile t0 = conv_decode(F, r0), t1 = conv_decode(F, r0 + 1);
        f32x4 va[16], vb[16];
        conv_load(t0, va, F.lane); conv_load(t1, vb, F.lane);
        conv_store(t0, va, scr, F.lane); conv_store(t1, vb, scr, F.lane);
    }
}
template <bool EXPERTS>
__device__ __forceinline__ void p0_prologue(Frame& F) {
    p0_mod(F);
    __syncthreads();
    LAS float* scr = (LAS float*)(F.lds) + F.wave * (64 * 65);
    bf16* WinT = (bf16*)(F.ws + WS_WIN); bf16* WoutT = (bf16*)(F.ws + WS_WOUT);
    constexpr int I_IN = 32 * 112, I_OUT = 32 * 32;
    constexpr int NIT = I_IN + I_OUT;
    for (int it = F.gw; it < NIT; it += F.NGW) {
        int r = it;
        if (r < I_IN) { const int nt = r % 112;
            if (nt < 32) tr_tile<true, true>(F.in[6], INC, 64 * (r / 112), 64 * nt, WinT, DM, 128 * (nt >> 1), scr, F.lane);
            else tr_tile<false, true>(F.in[6], INC, 64 * (r / 112), 64 * nt, WinT, DM, 64 * nt, scr, F.lane);
            continue; } r -= I_IN;
        if (r < I_OUT) { tr_tile<false>(F.in[12], DM, 64 * (r / 32), 64 * (r % 32), WoutT, DM, 64 * (r % 32), scr, F.lane); continue; } r -= I_OUT;
    }
    { bf16* rh = (bf16*)(F.ws + WS_RWP); bf16* rl = rh + 48 * DM; const float* rcw = F.in[15]; const float* rfw = F.in[17];
      for (int idx = blockIdx.x * (NWAVES * 64) + F.tid; idx < 48 * DM; idx += F.G * NWAVES * 64) {
          const int o = idx >> 11, k = idx & 2047; const float v = o < 4 ? rcw[k * 4 + o] : (o < 36 ? rfw[k * 32 + (o - 4)] : 0.f);
          const unsigned h = f2bf(v); const float hf = __uint_as_float(h << 16);
          rh[idx] = (bf16)h; rl[idx] = (bf16)f2bf(v - hf); } }
    { float* cs = (float*)(F.ws + WS_CS);
      for (int idx = blockIdx.x * (NWAVES * 64) + F.tid; idx < SEQ * 64; idx += F.G * NWAVES * 64) {
          const int i = idx & 63, s = idx >> 6; const float inv_freq = powf(10000.f, -(float)(2 * i) / 128.f); const float ang = (float)s * inv_freq;
          cs[2 * idx] = cosf(ang); cs[2 * idx + 1] = sinf(ang); } }
}

__device__ __forceinline__ void p1_row(Frame& F, int row, const f32x4 (&v)[8], const LAS f32x4* wf, const LAS f32x4* par, bf16* Hb, float* logf, float* zb, const float* fbias) {
    const int b = row >> 12, s = row & 4095;
    float ss = 0.f;
#pragma unroll
    for (int j = 0; j < 8; ++j) ss += (v[j].x * v[j].x + v[j].y * v[j].y) + (v[j].z * v[j].z + v[j].w * v[j].w);
    const float rstd = rsqrtf(wave_sum(ss) * (1.f / DM) + EPS);
    float acc[8];
#pragma unroll
    for (int o = 0; o < 8; ++o) acc[o] = 0.f;
    unsigned* o4 = (unsigned*)((unsigned char*)Hb + (size_t)row * DM) + F.lane;
#pragma unroll
    for (int j = 0; j < 8; ++j) {
        const f32x4 h = v[j] * rstd * par[(b * 2) * 512 + 64 * j + F.lane] + par[(b * 2 + 1) * 512 + 64 * j + F.lane];
        o4[64 * j] = fp8x4(h.x, h.y, h.z, h.w);
#pragma unroll
        for (int i = 0; i < 4; ++i) { const f32x4 wa = wf[((j * 4 + i) * 2 + 0) * 64 + F.lane], wb = wf[((j * 4 + i) * 2 + 1) * 64 + F.lane]; const float hv = h[i];
            acc[0] = fmaf(hv, wa.x, acc[0]); acc[1] = fmaf(hv, wa.y, acc[1]); acc[2] = fmaf(hv, wa.z, acc[2]); acc[3] = fmaf(hv, wa.w, acc[3]);
            acc[4] = fmaf(hv, wb.x, acc[4]); acc[5] = fmaf(hv, wb.y, acc[5]); acc[6] = fmaf(hv, wb.z, acc[6]); acc[7] = fmaf(hv, wb.w, acc[7]); }
        asm volatile("" ::: "memory");
    }
    float z = 0.f;
#pragma unroll
    for (int o = 0; o < 8; ++o) { const float t = wave_sum(acc[o]); z = (F.lane == o) ? t : z; }
    if (F.lane < 8) { const float zz = z + fbias[F.lane];
        logf[((size_t)b * NH + F.lane) * SEQ + s] = fminf(zz, 0.f) - log1pf(expf(-fabsf(zz)));
        zb[(size_t)row * 8 + F.lane] = z; }
}
__device__ __forceinline__ void p1_prenorm(Frame& F) {
    const float* x = F.in[0]; const float* wpre = F.in[4]; const float* w_in = F.in[6]; const float* fbias = F.in[7];
    const float* mod = (const float*)(F.ws + WS_MOD);
    bf16* Hb = (bf16*)(F.ws + WS_HB); float* logf = (float*)(F.ws + WS_LOGF); float* zb = (float*)(F.ws + WS_Z);
    LAS f32x4* wf = (LAS f32x4*)F.lds;
    LAS f32x4* par = wf + 4096;
    for (int idx = F.tid; idx < 4096; idx += NWAVES * 64) { const int l = idx & 63, half = (idx >> 6) & 1, i = (idx >> 7) & 3, j = idx >> 9;
        wf[idx] = *(const f32x4*)(w_in + (size_t)(256 * j + 4 * l + i) * INC + INCM + 4 * half); }
    for (int c = F.tid; c < 1024; c += NWAVES * 64) { const int b = c >> 9, cc = c & 511; const f32x4* mb = (const f32x4*)(mod + (size_t)b * 6 * DM);
        par[(b * 2) * 512 + cc] = ((const f32x4*)wpre)[cc] * (mb[512 + cc] + 1.0f); par[(b * 2 + 1) * 512 + cc] = mb[cc]; }
    LDS_WAIT(); __syncthreads();
    int row = F.gw; if (row >= T) return;
    f32x4 va[8], vb[8];
    { const f32x4* xr = (const f32x4*)(x + (size_t)row * DM) + F.lane;
#pragma unroll
      for (int j = 0; j < 8; ++j) va[j] = xr[64 * j]; }
    for (;;) {
        const int r1 = row + F.NGW;
        if (r1 < T) { const f32x4* xr = (const f32x4*)(x + (size_t)r1 * DM) + F.lane;
#pragma unroll
            for (int j = 0; j < 8; ++j) vb[j] = xr[64 * j]; }
        p1_row(F, row, va, wf, par, Hb, logf, zb, fbias);
        if (r1 >= T) break;
        const int r2 = r1 + F.NGW;
        if (r2 < T) { const f32x4* xr = (const f32x4*)(x + (size_t)r2 * DM) + F.lane;
#pragma unroll
            for (int j = 0; j < 8; ++j) va[j] = xr[64 * j]; }
        p1_row(F, r1, vb, wf, par, Hb, logf, zb, fbias);
        if (r2 >= T) break;
        row = r2;
    }
}

constexpr int EPI_SCR = RING_BYTES;
struct EpiHeads {
    static constexpr bool PERM = true, AFTER_DRAIN = false;
    bf16* base; const float* cs; const float* qn; const float* kn; LAS unsigned char* lds;
    __device__ __forceinline__ void operator()(const pg8::f32x4 (&acc)[2][2][4][2], const pg8::Unit& u, int wr, int wc, int fr, int fq) const {
        const int type = u.pn >> 2, head0 = (u.pn & 3) * 2; const int row0 = u.pm * 256 + wr * 64 + fr;
        if (type <= 1) {
            const int i0 = 16 * wc + 4 * fq; const float sc = type == 1 ? 0.08838834764831845f : 1.f;
#pragma unroll
            for (int ai = 0; ai < 2; ++ai)
#pragma unroll
                for (int m = 0; m < 4; ++m) { const int r = row0 + ai * 128 + m * 16, b = r >> 12, s = r & 4095;
                    const pg8::f32x4 c0 = *(const pg8::f32x4*)(cs + ((size_t)s * 64 + i0) * 2), c1 = *(const pg8::f32x4*)(cs + ((size_t)s * 64 + i0) * 2 + 4);
                    const float cv[4] = {c0[0], c0[2], c1[0], c1[2]}, sv[4] = {c0[1], c0[3], c1[1], c1[3]};
#pragma unroll
                    for (int bj = 0; bj < 2; ++bj) { const pg8::f32x4 x1 = acc[ai][bj][m][0], x2 = acc[ai][bj][m][1]; float o1[4], o2[4];
#pragma unroll
                        for (int j = 0; j < 4; ++j) { o1[j] = (x1[j] * cv[j] - x2[j] * sv[j]) * sc; o2[j] = (x1[j] * sv[j] + x2[j] * cv[j]) * sc; }
                        bf16* dst = base + (size_t)type * TSZ + ((size_t)((b * 8 + head0 + bj) * SEQ + s)) * HD + i0;
                        uint2 w1, w2; w1.x = pg8::cvt_pk_bf16(o1[0], o1[1]); w1.y = pg8::cvt_pk_bf16(o1[2], o1[3]); w2.x = pg8::cvt_pk_bf16(o2[0], o2[1]); w2.y = pg8::cvt_pk_bf16(o2[2], o2[3]);
                        *(uint2*)dst = w1; *(uint2*)(dst + 64) = w2; } }
            return;
        }
        float rs[2][4][2];
        if (type == 4 || type == 5) {
            LAS float* P = (LAS float*)(lds + EPI_SCR);
#pragma unroll
            for (int ai = 0; ai < 2; ++ai)
#pragma unroll
                for (int m = 0; m < 4; ++m)
#pragma unroll
                    for (int bj = 0; bj < 2; ++bj) { const pg8::f32x4 v0 = acc[ai][bj][m][0], v1 = acc[ai][bj][m][1];
                        float q = ((v0[0] * v0[0] + v0[1] * v0[1]) + (v0[2] * v0[2] + v0[3] * v0[3])) + ((v1[0] * v1[0] + v1[1] * v1[1]) + (v1[2] * v1[2] + v1[3] * v1[3]));
                        q += __shfl_xor(q, 16); q += __shfl_xor(q, 32);
                        if (fq == 0) P[((ai * 128 + wr * 64 + m * 16 + fr) * 2 + bj) * 4 + wc] = q; }
            asm volatile("s_waitcnt lgkmcnt(0)" ::: "memory"); __builtin_amdgcn_s_barrier(); asm volatile("" ::: "memory");
#pragma unroll
            for (int ai = 0; ai < 2; ++ai)
#pragma unroll
                for (int m = 0; m < 4; ++m)
#pragma unroll
                    for (int bj = 0; bj < 2; ++bj) { const pg8::f32x4 p4 = *(const LAS pg8::f32x4*)(P + ((ai * 128 + wr * 64 + m * 16 + fr) * 2 + bj) * 4);
                        rs[ai][m][bj] = rsqrtf(((p4[0] + p4[1]) + (p4[2] + p4[3])) * (1.f / 128.f) + EPS); }
            asm volatile("s_waitcnt lgkmcnt(0)" ::: "memory"); __builtin_amdgcn_s_barrier(); asm volatile("" ::: "memory");
        }
        pg8::f32x4 g0 = {1.f, 1.f, 1.f, 1.f}, g1 = {1.f, 1.f, 1.f, 1.f};
        if (type == 4 || type == 5) { const float* gp = (type == 4 ? qn : kn) + wc * 32 + 8 * fq; g0 = *(const pg8::f32x4*)gp; g1 = *(const pg8::f32x4*)(gp + 4); }
#pragma unroll
        for (int ai = 0; ai < 2; ++ai)
#pragma unroll
            for (int m = 0; m < 4; ++m) { const int r = row0 + ai * 128 + m * 16, b = r >> 12, s = r & 4095;
#pragma unroll
                for (int bj = 0; bj < 2; ++bj) { pg8::f32x4 v0 = acc[ai][bj][m][0], v1 = acc[ai][bj][m][1];
                    if (type == 4 || type == 5) { v0 = v0 * rs[ai][m][bj] * g0; v1 = v1 * rs[ai][m][bj] * g1; }
                    if (type == 3) {
#pragma unroll
                        for (int j = 0; j < 4; ++j) { v0[j] = v0[j] * __builtin_amdgcn_rcpf(1.f + __expf(-v0[j])); v1[j] = v1[j] * __builtin_amdgcn_rcpf(1.f + __expf(-v1[j])); } }
                    pg8::u32x4 w; w.x = pg8::cvt_pk_bf16(v0[0], v0[1]); w.y = pg8::cvt_pk_bf16(v0[2], v0[3]); w.z = pg8::cvt_pk_bf16(v1[0], v1[1]); w.w = pg8::cvt_pk_bf16(v1[2], v1[3]);
                    *(pg8::u32x4*)(base + (size_t)type * TSZ + ((size_t)((b * 8 + head0 + bj) * SEQ + s)) * HD + wc * 32 + 8 * fq) = w; } }
    }
};

namespace fox {
__device__ __forceinline__ int fox_tid() { int t = threadIdx.x; asm volatile("" : "+v"(t)); return t; }
typedef unsigned short bf16;
constexpr int D = 128, OLD = 2048;
constexpr bool WSKIP = false; constexpr float THR = 8.f;
constexpr float SCALE = 0.08838834764831845f;
constexpr int NW = 8, QBLK = 32, KVBLK = 64, QB = NW * QBLK;
constexpr int SHM_V = KVBLK * D * 2, SHM_K = KVBLK * D * 2;
constexpr int LDS_BYTES = 2 * SHM_V + 2 * SHM_K + NW * 64 * 4 + 2 * 64 * 4;
typedef short bf16x8 __attribute__((ext_vector_type(8)));
typedef short s16x4 __attribute__((ext_vector_type(4)));
typedef float f32x16 __attribute__((ext_vector_type(16)));
typedef float f32x4 __attribute__((ext_vector_type(4)));
typedef unsigned u32x4 __attribute__((ext_vector_type(4)));
template <class A, class Bt> struct same_t { static constexpr bool v = false; };
template <class A> struct same_t<A, A> { static constexpr bool v = true; };

#define KSWZ(row, colB) ((row) * 256 + ((colB) ^ (((row) & 7) << 4)))
#define SBAR() __builtin_amdgcn_sched_barrier(0)
__device__ __forceinline__ int v_st(int k, int c) { const int kk = (k & ~0xC) | ((k & 4) << 1) | ((k & 8) >> 1); return ((kk >> 3) * 4 + (c >> 5)) * 512 + ((kk & 7) * 32 + (c & 31)) * 2; }
__device__ __forceinline__ int v_rd_base(int lane) { return ((lane & 3) << 3) | (((lane >> 2) & 3) << 6) | (((lane >> 4) & 1) << 5) | (((lane >> 5) & 1) << 8); }
constexpr int v_rd_off(int d0, int ks, int half) { return d0 * 512 + ks * 4096 + half * 2048; }
__device__ __forceinline__ int crow(int r, int hi) { return (r & 3) + 8 * (r >> 2) + 4 * hi; }
__device__ __forceinline__ unsigned cvtpk(float lo, float hi) {
    unsigned r; asm volatile("v_cvt_pk_bf16_f32 %0, %1, %2" : "=v"(r) : "v"(lo), "v"(hi)); return r;
}
__device__ __forceinline__ bf16x8 pack8(f32x4 a, f32x4 b) {
    u32x4 w = {cvtpk(a[0], a[1]), cvtpk(a[2], a[3]), cvtpk(b[0], b[1]), cvtpk(b[2], b[3])};
    return *reinterpret_cast<bf16x8*>(&w);
}
template <class T> __device__ __forceinline__ bf16x8 load8(const T* p) {
    if constexpr (same_t<T, float>::v) { return pack8(*(const f32x4*)p, *(const f32x4*)(p + 4)); }
    else { return *reinterpret_cast<const bf16x8*>(p); }
}
__device__ __forceinline__ void mask_tile(f32x16& p0, f32x16& p1, int dq, unsigned W) {
    const float NEG = -__builtin_inff();
#pragma unroll
    for (int r = 0; r < 16; ++r) {
        const int c = (r & 3) + 8 * (r >> 2);
        if ((unsigned)(dq - c) >= W) p0[r] = NEG;
        if ((unsigned)(dq - c - 32) >= W) p1[r] = NEG;
    }
}
__device__ __forceinline__ void partialSM(f32x16& p0, f32x16& p1, float& m_reg, float& mn, float& alpha) {
    float pmax = p0[0]; for (int r = 1; r < 16; ++r) pmax = fmaxf(pmax, p0[r]); for (int r = 0; r < 16; ++r) pmax = fmaxf(pmax, p1[r]);
    { auto rr = __builtin_amdgcn_permlane32_swap(__float_as_uint(pmax), __float_as_uint(pmax), false, false);
      pmax = fmaxf(__uint_as_float(rr[0]), __uint_as_float(rr[1])); }
    constexpr float C2 = 1.4426950408889634f * SCALE;
    if (__builtin_expect(__all((pmax - m_reg) * SCALE <= THR), 1)) { mn = m_reg; alpha = 1.f; }
    else { mn = fmaxf(m_reg, pmax); alpha = __builtin_amdgcn_exp2f((m_reg - mn) * C2); m_reg = mn; }
    const float mnL = -mn * C2;
    for (int r = 0; r < 16; ++r) p0[r] = fmaf(p0[r], C2, mnL); for (int r = 0; r < 16; ++r) p1[r] = fmaf(p1[r], C2, mnL);
    for (int r = 0; r < 16; ++r) p0[r] = __builtin_amdgcn_exp2f(p0[r]);
}
__device__ __forceinline__ void finishSM(f32x16& p0, f32x16& p1, float alpha, float& l_reg, bf16x8& pa0, bf16x8& pa1, bf16x8& pa2, bf16x8& pa3) {
    for (int r = 0; r < 16; ++r) p1[r] = __builtin_amdgcn_exp2f(p1[r]);
    float ps = 0; for (int r = 0; r < 16; ++r) ps += p0[r]; for (int r = 0; r < 16; ++r) ps += p1[r];
    { auto rr = __builtin_amdgcn_permlane32_swap(__float_as_uint(ps), __float_as_uint(ps), false, false);
      ps = __uint_as_float(rr[0]) + __uint_as_float(rr[1]); }
    l_reg = l_reg * alpha + ps;
#define PK4(P, B_, OUT) do { unsigned a0 = cvtpk(P[B_+0], P[B_+1]), a1 = cvtpk(P[B_+2], P[B_+3]);                          \
        unsigned b0 = cvtpk(P[B_+4], P[B_+5]), b1 = cvtpk(P[B_+6], P[B_+7]);                                             \
        auto r0 = __builtin_amdgcn_permlane32_swap(a0, b0, false, false); auto r1 = __builtin_amdgcn_permlane32_swap(a1, b1, false, false); \
        u32x4 w = {r0[0], r1[0], r0[1], r1[1]}; OUT = *reinterpret_cast<bf16x8*>(&w); } while (0)
    PK4(p0, 0, pa0); PK4(p0, 8, pa1); PK4(p1, 0, pa2); PK4(p1, 8, pa3);
#undef PK4
}
template <int KB, bool SK>
__device__ __forceinline__ void qkt(f32x16& p0, f32x16& p1, const char* K_lds, int r32, int hi, const bf16x8* qr, bool act) {
    if (SK && !act) { const float NEG = -__builtin_inff();
#pragma unroll
        for (int r = 0; r < 16; ++r) { p0[r] = NEG; p1[r] = NEG; } return; }
    { const float* bl = (const float*)(K_lds + 2 * SHM_K + NW * 64 * 4) + KB * 64 + 4 * hi;
#pragma unroll
      for (int g = 0; g < 4; ++g) { const f32x4 b0 = *(const f32x4*)(bl + 8 * g), b1 = *(const f32x4*)(bl + 32 + 8 * g);
          p0[4 * g] = b0[0]; p0[4 * g + 1] = b0[1]; p0[4 * g + 2] = b0[2]; p0[4 * g + 3] = b0[3]; p1[4 * g] = b1[0]; p1[4 * g + 1] = b1[1]; p1[4 * g + 2] = b1[2]; p1[4 * g + 3] = b1[3]; } }
    const char* kb[4];
#pragma unroll
    for (int dd = 0; dd < 4; ++dd) kb[dd] = K_lds + KB * SHM_K + KSWZ(r32, (dd * 16 + hi * 8) * 2);
#pragma unroll
    for (int d0 = 0; d0 < 8; ++d0) { const char* a = kb[d0 & 3] + (d0 >> 2) * 128;
        bf16x8 b0 = *reinterpret_cast<const bf16x8*>(a);
        bf16x8 b1 = *reinterpret_cast<const bf16x8*>(a + 32 * 256);
        p0 = __builtin_amdgcn_mfma_f32_32x32x16_bf16(b0, qr[d0], p0, 0, 0, 0);
        p1 = __builtin_amdgcn_mfma_f32_32x32x16_bf16(b1, qr[d0], p1, 0, 0, 0); }
}
template <int VB, bool SK>
__device__ __forceinline__ void pv_tile(f32x16* o, int vb0, bf16x8 pa0, bf16x8 pa1, bf16x8 pa2, bf16x8 pa3, bool act) {
    if (SK && !act) return;
#define TRRD(dst, off) asm volatile("ds_read_b64_tr_b16 %0, %1 offset:%2" : "=&v"(dst) : "v"(vb0), "i"(off) : "memory")
#define PV_D0(d0) do { s16x4 l0, l1, l2, l3, h0, h1, h2, h3; constexpr int b_ = VB * SHM_V + v_rd_off(d0, 0, 0);     \
        TRRD(l0, b_); TRRD(h0, b_ + 2048); TRRD(l1, b_ + 4096); TRRD(h1, b_ + 6144); TRRD(l2, b_ + 8192); TRRD(h2, b_ + 10240); TRRD(l3, b_ + 12288); TRRD(h3, b_ + 14336); \
        asm volatile("s_waitcnt lgkmcnt(0)" ::: "memory"); SBAR();                 \
        o[d0] = __builtin_amdgcn_mfma_f32_32x32x16_bf16(pa0, (bf16x8){l0[0], l0[1], l0[2], l0[3], h0[0], h0[1], h0[2], h0[3]}, o[d0], 0, 0, 0);   \
        o[d0] = __builtin_amdgcn_mfma_f32_32x32x16_bf16(pa1, (bf16x8){l1[0], l1[1], l1[2], l1[3], h1[0], h1[1], h1[2], h1[3]}, o[d0], 0, 0, 0);   \
        o[d0] = __builtin_amdgcn_mfma_f32_32x32x16_bf16(pa2, (bf16x8){l2[0], l2[1], l2[2], l2[3], h2[0], h2[1], h2[2], h2[3]}, o[d0], 0, 0, 0);   \
        o[d0] = __builtin_amdgcn_mfma_f32_32x32x16_bf16(pa3, (bf16x8){l3[0], l3[1], l3[2], l3[3], h3[0], h3[1], h3[2], h3[3]}, o[d0], 0, 0, 0); } while (0)
    PV_D0(0); PV_D0(1); PV_D0(2); PV_D0(3);
#undef PV_D0
#undef TRRD
}

template <class TIn, class TOut> struct BlockRef { const TIn* Q; const TIn* K; const TIn* V; TOut* O; const float* cb; const float* onw; int P0; };
template <class TIn> struct Seam {
    bf16x8 qr[8];
    bf16x8 st_v0, st_v1, st_k0, st_k1; float st_b; f32x4 sf0, sf1, sf2, sf3;
    f32x4 tq[16];
};
__device__ __forceinline__ int swa_jlo(int P0, int W) { const int lowk = P0 - W + 1; return lowk > 0 ? lowk / KVBLK : 0; }
#define ROW(p, k0, rr) ((p) + (size_t)((k0) + (rr)) * D + sc)
#define VMW() asm volatile("s_waitcnt vmcnt(0)" ::: "memory")
#define VMWN(n) asm volatile("s_waitcnt vmcnt(%0)" :: "i"(n) : "memory")
#define SLOAD_H(Kp, Vp, Bp, k0) do { S.st_v0 = load8<TIn>(ROW(Vp, k0, sr)); S.st_v1 = load8<TIn>(ROW(Vp, k0, 32 + sr));              \
                         S.st_k0 = load8<TIn>(ROW(Kp, k0, sr)); S.st_k1 = load8<TIn>(ROW(Kp, k0, 32 + sr)); S.st_b = (Bp)[(k0) + (tid & 63)]; } while (0)
#define SWRITE_HK(bf) do { *(bf16x8*)(K_lds + (bf) * SHM_K + kws) = S.st_k0; *(bf16x8*)(K_lds + (bf) * SHM_K + kws + 32 * 256) = S.st_k1; \
                           if (tid < 64) ((float*)(K_lds + 2 * SHM_K + NW * 64 * 4))[(bf) * 64 + tid] = S.st_b; } while (0)
#define SWRITE_HV(bf) do { *(bf16x8*)(V_lds + (bf) * SHM_V + vst0) = S.st_v0; *(bf16x8*)(V_lds + (bf) * SHM_V + vst1) = S.st_v1; } while (0)
#define SWRITE_H(bf) do { SWRITE_HV(bf); SWRITE_HK(bf); } while (0)
#define SLOAD_F(p, k0) do { S.sf0 = *(const f32x4*)ROW(p, k0, sr); S.sf1 = *(const f32x4*)(ROW(p, k0, sr) + 4);                \
                            S.sf2 = *(const f32x4*)ROW(p, k0, 32 + sr); S.sf3 = *(const f32x4*)(ROW(p, k0, 32 + sr) + 4); } while (0)
#define SWRITE_KF(bf) do { *(bf16x8*)(K_lds + (bf) * SHM_K + kws) = pack8(S.sf0, S.sf1); *(bf16x8*)(K_lds + (bf) * SHM_K + kws + 32 * 256) = pack8(S.sf2, S.sf3); } while (0)
#define SWRITE_VF(bf) do { *(bf16x8*)(V_lds + (bf) * SHM_V + vst0) = pack8(S.sf0, S.sf1); *(bf16x8*)(V_lds + (bf) * SHM_V + vst1) = pack8(S.sf2, S.sf3); } while (0)
template <class TIn, class TOut>
__device__ __forceinline__ void causal_swa_prime(const BlockRef<TIn, TOut>& cur, int W, char* lds, Seam<TIn>& S) {
    constexpr bool F32 = same_t<TIn, float>::v;
    const int tid = fox_tid(), wid = __builtin_amdgcn_readfirstlane(tid >> 6), lane = tid & 63, r32 = lane & 31, hi = lane >> 5;
    const int sr = tid >> 4, sc = (tid & 15) * 8, kws = KSWZ(sr, sc * 2); char* K_lds = lds + 2 * SHM_V;
    const int kb0 = swa_jlo(cur.P0, W) * KVBLK;
    for (int d0 = 0; d0 < 8; ++d0) S.qr[d0] = load8<TIn>(cur.Q + (size_t)(wid * QBLK + r32) * D + d0 * 16 + hi * 8);
    if constexpr (F32) { SLOAD_F((const float*)cur.K, kb0); VMW(); SWRITE_KF(0); SBAR(); SLOAD_F((const float*)cur.V, kb0); }
    else { SLOAD_H(cur.K, cur.V, cur.cb, kb0); VMW(); SWRITE_HK(0); }
    __syncthreads();
}
template <class TIn, class TOut>
__device__ __forceinline__ void causal_swa_block(const BlockRef<TIn, TOut>& cur, const BlockRef<TIn, TOut>& nxt, int skv, int W, char* lds, Seam<TIn>& S) {
    constexpr bool F32 = same_t<TIn, float>::v;
    const int tid = fox_tid(), wid = __builtin_amdgcn_readfirstlane(tid >> 6), lane = tid & 63, r32 = lane & 31, hi = lane >> 5;
    const int j_lo = swa_jlo(cur.P0, W);
    int j_hi = (cur.P0 + QB - 1) / KVBLK + 1; if (j_hi > skv / KVBLK) j_hi = skv / KVBLK;
    const int NT = j_hi - j_lo;
    const int kbn = swa_jlo(nxt.P0, W) * KVBLK;
    const int qlo = cur.P0 + wid * QBLK, qm = qlo + r32 - 4 * hi;
    char* V_lds = lds; char* K_lds = lds + 2 * SHM_V;
    float* ws = (float*)(lds + 2 * SHM_V + 2 * SHM_K) + wid * 64; float* li_l = ws, * al_l = ws + 32;
    float m_reg = -1e30f, l_reg = 0; f32x16 o[4] = {};
    const int sr = tid >> 4, sc = (tid & 15) * 8, vst0 = v_st(sr, sc), vst1 = v_st(32 + sr, sc), kws = KSWZ(sr, sc * 2);
    const int vb0 = (int)(uintptr_t)V_lds + v_rd_base(lane);
    const TIn* Kh = cur.K; const TIn* Vh = cur.V;
#define RESC(a) do { if (__any((a) < 1.f)) { if (hi == 0) al_l[r32] = (a); asm volatile("s_waitcnt lgkmcnt(0)" ::: "memory");              \
                     for (int d_ = 0; d_ < 4; ++d_) for (int r = 0; r < 16; ++r) o[d_][r] *= al_l[crow(r, hi)]; } } while (0)
#define KBASE(t) ((j_lo + (t)) * KVBLK)
#define ACT(t) (KBASE(t) <= qlo + QBLK - 1 && KBASE(t) + KVBLK - 1 >= qlo - W + 1)
#define MASKT(P0_, P1_, t) do { const int kb_ = KBASE(t); if ((!SK || ACT(t)) && (kb_ + KVBLK - 1 > qlo || kb_ <= qlo + QBLK - 1 - W)) mask_tile(P0_, P1_, qm - kb_, (unsigned)W); } while (0)
    constexpr int NQL = F32 ? 16 : 8;
    constexpr bool SK = WSKIP && !F32;
#define SEAM_K0() do { VMWN(NQL); if constexpr (F32) { SWRITE_KF(0); SBAR(); SLOAD_F((const float*)nxt.V, kbn); } else { SWRITE_HK(0); } SBAR(); } while (0)
    f32x16 pA0, pA1, pB0, pB1; float mnA, mnB, alA, alB; bf16x8 pa0, pa1, pa2, pa3;
    if constexpr (F32) { VMW(); SWRITE_VF(0); SBAR(); } else { SWRITE_HV(0); SBAR(); }
    if (NT > 1) { if constexpr (F32) SLOAD_F((const float*)Kh, KBASE(1)); else SLOAD_H(Kh, Vh, cur.cb, KBASE(1)); }
    SBAR(); qkt<0, SK>(pA0, pA1, K_lds, r32, hi, S.qr, ACT(0));
    if constexpr (F32) { if (NT > 1) { VMW(); SWRITE_KF(1); SBAR(); SLOAD_F((const float*)Vh, KBASE(1)); } }
    MASKT(pA0, pA1, 0); partialSM(pA0, pA1, m_reg, mnA, alA);
    if (NT > 1) { VMW(); if constexpr (F32) { SWRITE_VF(1); SBAR(); if (NT > 2) SLOAD_F((const float*)Kh, KBASE(2)); } else SWRITE_H(1); }
    __syncthreads();
#define HALF_STEP(PX0, PX1, mnX, alX, PY0, PY1, alY, t, KB, VB, SB) do {                                                      \
        SBAR(); qkt<KB, SK>(PX0, PX1, K_lds, r32, hi, S.qr, ACT(t));                                             \
        finishSM(PY0, PY1, alY, l_reg, pa0, pa1, pa2, pa3); SBAR();                                                           \
        if ((t) + 1 < NT) { if constexpr (F32) { VMW(); SWRITE_KF(SB); SBAR(); SLOAD_F((const float*)Vh, KBASE((t) + 1)); }  \
                            else { SLOAD_H(Kh, Vh, cur.cb, KBASE((t) + 1)); } SBAR(); }                                               \
        pv_tile<VB, SK>(o, vb0, pa0, pa1, pa2, pa3, ACT((t) - 1)); MASKT(PX0, PX1, (t)); partialSM(PX0, PX1, m_reg, mnX, alX);                                        \
        __syncthreads();                                                                                                      \
        if ((t) + 1 < NT) { VMW(); if constexpr (F32) { SWRITE_VF(SB); SBAR(); if ((t) + 2 < NT) SLOAD_F((const float*)Kh, KBASE((t) + 2)); } \
                            else { SWRITE_H(SB); } }                                                                          \
        RESC(alX); __syncthreads(); } while (0)
    for (int t = 1; t + 1 < NT; t += 2) {
        HALF_STEP(pB0, pB1, mnB, alB, pA0, pA1, alA, t, 1, 0, 0);
        HALF_STEP(pA0, pA1, mnA, alA, pB0, pB1, alB, t + 1, 0, 1, 1);
    }
    const bool even = (NT & 1) == 0;
    if (even) { SBAR(); qkt<1, SK>(pB0, pB1, K_lds, r32, hi, S.qr, ACT(NT - 1)); SBAR(); }
#define QROW(e) (nxt.Q + (size_t)(wid * QBLK + r32) * D + ((e) >> 1) * 16 + hi * 8 + ((e) & 1) * 4)
    if constexpr (F32) { SLOAD_F((const float*)nxt.K, kbn); SBAR();
#pragma unroll
        for (int e = 0; e < 8; ++e) S.tq[e] = *(const f32x4*)QROW(e); }
    else { SLOAD_H(nxt.K, nxt.V, nxt.cb, kbn); SBAR();
#pragma unroll
        for (int d0 = 0; d0 < 8; ++d0) S.qr[d0] = load8<TIn>(nxt.Q + (size_t)(wid * QBLK + r32) * D + d0 * 16 + hi * 8); }
    SBAR();
    finishSM(pA0, pA1, alA, l_reg, pa0, pa1, pa2, pa3); SBAR();
    if constexpr (F32) {
#pragma unroll
        for (int e = 8; e < 16; ++e) S.tq[e] = *(const f32x4*)QROW(e); SBAR(); }
#undef QROW
    pv_tile<0, SK>(o, vb0, pa0, pa1, pa2, pa3, ACT(even ? NT - 2 : NT - 1));
    if (even) { MASKT(pB0, pB1, NT - 1); partialSM(pB0, pB1, m_reg, mnB, alB); __syncthreads(); RESC(alB);
        finishSM(pB0, pB1, alB, l_reg, pa0, pa1, pa2, pa3); SBAR(); pv_tile<1, SK>(o, vb0, pa0, pa1, pa2, pa3, ACT(NT - 1)); }
    SBAR(); SEAM_K0();
    if (hi == 0) li_l[r32] = l_reg; asm volatile("s_waitcnt lgkmcnt(0)" ::: "memory");
    { float gw[4];
#pragma unroll
      for (int d0 = 0; d0 < 4; ++d0) gw[d0] = cur.onw[d0 * 32 + r32];
      TOut* Ow = cur.O + (size_t)(wid * QBLK) * OLD;
#pragma unroll
      for (int r = 0; r < 16; ++r) { const int orow = crow(r, hi); const float rl = __builtin_amdgcn_rcpf(li_l[orow]);
          float v[4]; float ss = 0.f;
#pragma unroll
          for (int d0 = 0; d0 < 4; ++d0) { v[d0] = o[d0][r] * rl; ss += v[d0] * v[d0]; }
          ss = half32_sum(ss);
          const float rs = rsqrtf(ss * (1.f / 128.f) + 1e-6f);
#pragma unroll
          for (int d0 = 0; d0 < 4; ++d0) { const float y = v[d0] * rs * gw[d0]; const float yn = __shfl_xor(y, 1);
              if ((r32 & 1) == 0) *(unsigned*)(Ow + (size_t)orow * OLD + d0 * 32 + r32) = cvtpk(y, yn); } } }
    if constexpr (F32) {
#pragma unroll
        for (int d0 = 0; d0 < 8; ++d0) S.qr[d0] = pack8(S.tq[2 * d0], S.tq[2 * d0 + 1]); }
    __syncthreads();
#undef RESC
#undef KBASE
#undef ACT
#undef MASKT
#undef SEAM_K0
#undef HALF_STEP
}
#undef ROW
#undef VMW
#undef VMWN
#undef SLOAD_H
#undef SWRITE_HK
#undef SWRITE_HV
#undef SWRITE_H
#undef SLOAD_F
#undef SWRITE_KF
#undef SWRITE_VF


#undef KSWZ
#undef SBAR
}
constexpr size_t WS_KV = 186 * MiB;
constexpr size_t WS_SP = 218 * MiB;
constexpr size_t WS_CAT = 234 * MiB;
constexpr size_t WS_P34_END = 266 * MiB;
constexpr int CW_RETQ = 2048;
typedef short v4i16_t __attribute__((ext_vector_type(4)));
typedef float f32x16 __attribute__((ext_vector_type(16)));
constexpr int TLD = 136;
constexpr int TILE_EL = 128 * TLD;

__device__ __forceinline__ bf16x8 frag_row(const LAS bf16* X, int r0, int k0, int lane) {
    return *(const LAS bf16x8*)(X + (r0 + (lane & 31)) * TLD + k0 + 8 * (lane >> 5));
}
__device__ __forceinline__ bf16x8 frag_tr(const LAS bf16* X, int k0, int c0, int lane) {
    const int g = lane >> 4, i = lane & 15, q = i >> 2, p = i & 3, h = g >> 1;
    const LAS bf16* a = X + (k0 + 8 * h + q) * TLD + c0 + 16 * (g & 1) + 4 * p;
    const v4i16_t lo = __builtin_amdgcn_ds_read_tr16_b64_v4i16((LAS v4i16_t*)a);
    const v4i16_t hi = __builtin_amdgcn_ds_read_tr16_b64_v4i16((LAS v4i16_t*)(a + 4 * TLD));
    return (bf16x8){lo[0], lo[1], lo[2], lo[3], hi[0], hi[1], hi[2], hi[3]};
}
__device__ __forceinline__ int crow16(int r, int hi) { return (r & 3) + 8 * (r >> 2) + 4 * hi; }
__device__ __forceinline__ float bf2f(unsigned short v) { return __uint_as_float((unsigned)v << 16); }
__device__ __forceinline__ float ret_lg2(int h) { return log1pf(-exp2f(-5.f - (float)h)) * 1.4426950408889634f; }

__device__ __forceinline__ void p3_item(Frame& F, int bh, int n) {
    const int h = bh & 7, tid = F.tid, lane = F.lane, w = F.wave;
    const bf16* qkv = (const bf16*)(F.ws + WS_QKV);
    const size_t rbase = ((size_t)bh * SEQ + (size_t)n * 128) * HD;
    const bf16* RK = qkv + 1 * TSZ + rbase; const bf16* RV = qkv + 2 * TSZ + rbase;
    LAS bf16* Kz = (LAS bf16*)F.lds; LAS bf16* Vt = Kz + TILE_EL;
    const float lg2 = ret_lg2(h);
#pragma unroll
    for (int j = 0; j < 4; ++j) { const int c = tid + 512 * j, row = c >> 4, col8 = (c & 15) * 8;
        *(LAS v4u*)(Vt + row * TLD + col8) = *(const v4u*)(RV + (size_t)row * HD + col8);
        const bf16x8 k = *(const bf16x8*)(RK + (size_t)row * HD + col8); const float zeta = exp2f(lg2 * (float)(127 - row)); float kv[8];
#pragma unroll
        for (int i = 0; i < 8; ++i) kv[i] = bf2f((unsigned short)k[i]) * zeta;
        v4u o; o.x = pk2(kv[0], kv[1]); o.y = pk2(kv[2], kv[3]); o.z = pk2(kv[4], kv[5]); o.w = pk2(kv[6], kv[7]);
        *(LAS v4u*)(Kz + row * TLD + col8) = o; }
    LDS_WAIT(); __syncthreads();
    { const int db = w >> 1, eb = 2 * (w & 1), hi = lane >> 5;
      f32x16 a0 = {}, a1 = {};
#pragma unroll
      for (int kk = 0; kk < 8; ++kk) { const bf16x8 a = frag_tr(Kz, 16 * kk, 32 * db, lane), b0 = frag_tr(Vt, 16 * kk, 32 * eb, lane), b1 = frag_tr(Vt, 16 * kk, 32 * eb + 32, lane);
          a0 = __builtin_amdgcn_mfma_f32_32x32x16_bf16(a, b0, a0, 0, 0, 0); a1 = __builtin_amdgcn_mfma_f32_32x32x16_bf16(a, b1, a1, 0, 0, 0); }
      float* KV = (float*)(F.ws + WS_KV) + ((size_t)bh * 32 + n) * 16384;
#pragma unroll
      for (int r = 0; r < 16; ++r) { const int d = 32 * db + crow16(r, hi); KV[d * 128 + 32 * eb + (lane & 31)] = a0[r]; KV[d * 128 + 32 * eb + 32 + (lane & 31)] = a1[r]; } }
    LDS_WAIT(); __syncthreads();
}
__device__ __forceinline__ void p3_cumsum(Frame& F, int bh) {
    const float* lf = (const float*)(F.ws + WS_LOGF) + (size_t)bh * SEQ + 64 * F.lane; float* cb = (float*)(F.ws + WS_CB) + (size_t)bh * SEQ + 64 * F.lane;
    float tot = 0.f;
#pragma unroll 8
    for (int i = 0; i < 64; ++i) tot += lf[i];
    float incl = tot;
#pragma unroll
    for (int o = 1; o < 64; o <<= 1) { const float t = __shfl_up(incl, o); if (F.lane >= o) incl += t; }
    float run = incl - tot;
#pragma unroll 8
    for (int i = 0; i < 64; ++i) { run += lf[i]; cb[i] = -run * 11.313708498984761f; }
}
__device__ __forceinline__ void p3_phase(Frame& F) {
    if (F.wave == 0) for (int bh = blockIdx.x; bh < 16; bh += F.G) p3_cumsum(F, bh);
    for (int it = blockIdx.x; it < 512; it += F.G) p3_item(F, it >> 5, it & 31);
}
__device__ __forceinline__ void p3b_scan(Frame& F) {
    const float* KV = (const float*)(F.ws + WS_KV); bf16* SP = (bf16*)(F.ws + WS_SP);
    for (int idx = blockIdx.x * (NWAVES * 64) + F.tid; idx < 16 * 16384; idx += F.G * NWAVES * 64) {
        const int bh = idx >> 14, de = idx & 16383; const float cd = exp2f(ret_lg2(bh & 7) * 128.f);
        float st = 0.f;
        for (int n = 0; n < 32; ++n) { const size_t o = ((size_t)bh * 32 + n) * 16384 + de; SP[o] = (bf16)f2bf(st); st = st * cd + KV[o]; }
    }
}
__device__ __forceinline__ void ret_item(Frame& F, int bh, int n) {
    const int h = bh & 7, b = bh >> 3, tid = F.tid, lane = F.lane, w = F.wave, hi = lane >> 5, c32 = lane & 31;
    const bf16* qkv = (const bf16*)(F.ws + WS_QKV);
    const size_t rbase = ((size_t)bh * SEQ + (size_t)n * 128) * HD;
    const bf16* RQ = qkv + 0 * TSZ + rbase; const bf16* RK = qkv + 1 * TSZ + rbase; const bf16* RV = qkv + 2 * TSZ + rbase; const bf16* RG = qkv + 3 * TSZ + rbase;
    const bf16* SPg = (const bf16*)(F.ws + WS_SP) + ((size_t)bh * 32 + n) * 16384;
    LAS bf16* Qs = (LAS bf16*)F.lds; LAS bf16* Ks = Qs + TILE_EL; LAS bf16* Vs = Ks + TILE_EL; LAS bf16* Ss = Vs + TILE_EL;
    LAS float* st = (LAS float*)(Ss + TILE_EL);
#pragma unroll
    for (int j = 0; j < 4; ++j) { const int c = tid + 512 * j, row = c >> 4, col8 = (c & 15) * 8; const size_t go = (size_t)row * HD + col8; const int lo = row * TLD + col8;
        *(LAS v4u*)(Qs + lo) = *(const v4u*)(RQ + go); *(LAS v4u*)(Ks + lo) = *(const v4u*)(RK + go);
        *(LAS v4u*)(Vs + lo) = *(const v4u*)(RV + go); *(LAS v4u*)(Ss + lo) = *(const v4u*)(SPg + go); }
    LDS_WAIT(); __syncthreads();
    const int qb = w >> 1, cb2 = 2 * (w & 1);
    const float lg2 = ret_lg2(h);
    f32x16 s0 = {}, s1 = {};
#pragma unroll
    for (int kk = 0; kk < 8; ++kk) { const bf16x8 a = frag_row(Qs, 32 * qb, 16 * kk, lane), b0 = frag_row(Ks, 32 * cb2, 16 * kk, lane), b1 = frag_row(Ks, 32 * cb2 + 32, 16 * kk, lane);
        s0 = __builtin_amdgcn_mfma_f32_32x32x16_bf16(a, b0, s0, 0, 0, 0); s1 = __builtin_amdgcn_mfma_f32_32x32x16_bf16(a, b1, s1, 0, 0, 0); }
    const int key0 = 32 * cb2 + c32, key1 = key0 + 32;
    const float f0 = exp2f(-lg2 * (float)(key0 + 1)), f1 = exp2f(-lg2 * (float)(key1 + 1));
    LDS_WAIT(); __syncthreads();
#pragma unroll
    for (int r = 0; r < 16; ++r) { const int q = 32 * qb + crow16(r, hi);
        Ks[q * TLD + key0] = (bf16)f2bf(key0 <= q ? s0[r] * f0 : 0.f); Ks[q * TLD + key1] = (bf16)f2bf(key1 <= q ? s1[r] * f1 : 0.f); }
    LDS_WAIT(); __syncthreads();
    f32x16 o0 = {}, o1 = {};
#pragma unroll
    for (int kk = 0; kk < 8; ++kk) { const bf16x8 a = frag_row(Ks, 32 * qb, 16 * kk, lane), b0 = frag_tr(Vs, 16 * kk, 32 * cb2, lane), b1 = frag_tr(Vs, 16 * kk, 32 * cb2 + 32, lane);
        o0 = __builtin_amdgcn_mfma_f32_32x32x16_bf16(a, b0, o0, 0, 0, 0); o1 = __builtin_amdgcn_mfma_f32_32x32x16_bf16(a, b1, o1, 0, 0, 0); }
#pragma unroll
    for (int kk = 0; kk < 8; ++kk) { const bf16x8 a = frag_row(Qs, 32 * qb, 16 * kk, lane), b0 = frag_tr(Ss, 16 * kk, 32 * cb2, lane), b1 = frag_tr(Ss, 16 * kk, 32 * cb2 + 32, lane);
        o0 = __builtin_amdgcn_mfma_f32_32x32x16_bf16(a, b0, o0, 0, 0, 0); o1 = __builtin_amdgcn_mfma_f32_32x32x16_bf16(a, b1, o1, 0, 0, 0); }
#pragma unroll
    for (int r = 0; r < 16; ++r) { const int q = 32 * qb + crow16(r, hi); const float xi = exp2f(lg2 * (float)(q + 1));
        o0[r] *= xi; o1[r] *= xi;
        float s = o0[r] + o1[r], ss = o0[r] * o0[r] + o1[r] * o1[r];
        s = half32_sum(s); ss = half32_sum(ss);
        if (c32 == 0) { st[q * 4 + (w & 1) * 2] = s; st[q * 4 + (w & 1) * 2 + 1] = ss; } }
    LDS_WAIT(); __syncthreads();
    { const float* gn = F.in[8] + h * 128; const float g0 = gn[key0], g1 = gn[key1];
      bf16* CAT = (bf16*)(F.ws + WS_CAT) + ((size_t)b * SEQ + (size_t)n * 128) * DM + h * 128;
#pragma unroll
      for (int r = 0; r < 16; ++r) { const int q = 32 * qb + crow16(r, hi);
          const float s = st[q * 4] + st[q * 4 + 2], ss = st[q * 4 + 1] + st[q * 4 + 3];
          const float mu = s * (1.f / 128.f), var = fmaxf(ss * (1.f / 128.f) - mu * mu, 0.f), rstd = rsqrtf(var + EPS);
          const float y0 = (o0[r] - mu) * rstd * g0 * bf2f(RG[(size_t)q * HD + key0]), y1 = (o1[r] - mu) * rstd * g1 * bf2f(RG[(size_t)q * HD + key1]);
          CAT[(size_t)q * DM + key0] = (bf16)f2bf(y0); CAT[(size_t)q * DM + key1] = (bf16)f2bf(y1); } }
    LDS_WAIT(); __syncthreads();
}
__device__ __forceinline__ void p4_phase(Frame& F) {
    const int bx = blockIdx.x; const int vcu = (F.G % 8 == 0) ? (bx % 8) * (F.G / 8) + bx / 8 : bx;
    const bf16* qkv = (const bf16*)(F.ws + WS_QKV);
    bf16* CAT = (bf16*)(F.ws + WS_CAT);
    for (int fb = vcu; fb < 256; fb += F.G) {
        const int bh = fb >> 4, qb = fb & 15, h = bh & 7, b = bh >> 3;
        fox::BlockRef<bf16, bf16> cur;
        cur.Q = qkv + 4 * TSZ + ((size_t)bh * SEQ + (size_t)qb * 256) * HD; cur.K = qkv + 5 * TSZ + (size_t)bh * SEQ * HD; cur.V = qkv + 6 * TSZ + (size_t)bh * SEQ * HD;
        cur.O = CAT + ((size_t)b * SEQ + (size_t)qb * 256) * DM + 1024 + h * 128; cur.cb = (const float*)(F.ws + WS_CB) + (size_t)bh * SEQ; cur.onw = F.in[11] + h * 128; cur.P0 = qb * 256;
        fox::Seam<bf16> S;
        fox::causal_swa_prime<bf16, bf16>(cur, SEQ, F.ldsg, S);
        fox::causal_swa_block<bf16, bf16>(cur, cur, SEQ, SEQ, F.ldsg, S);
        asm volatile("s_waitcnt vmcnt(0)" ::: "memory");
        __syncthreads();
    }
    for (;;) {
        if (F.tid == 0) F.MISC[0] = atomicAdd((unsigned*)(F.ws + WS_CTL) + CW_RETQ, 1u);
        __syncthreads();
        const unsigned item = F.MISC[0];
        __syncthreads();
        if (item >= 512u) break;
        ret_item(F, (int)(item >> 5), (int)(item & 31));
    }
}
constexpr int PADROWS = 24576;
constexpr int LTAB_OFF = LDSCTL_OFF + 1024;
constexpr int NSUB = 16, SUBCAP = ECAP / NSUB;
#define LTAB_SB(lds_) ((LAS int*)((lds_) + LTAB_OFF) + 32 + 40)
struct EpiPlain {
    static constexpr bool PERM = true, AFTER_DRAIN = false;
    bf16* O; int ldc; int ntn;
    template <class U> __device__ __forceinline__ void operator()(const pg8::f32x4 (&acc)[2][2][4][2], const U& u, int wr, int wc, int fr, int fq) const {
        const int row0 = u.pm * 256 + wr * 64 + fr, col0 = (u.pn % ntn) * 256 + wc * 32 + 8 * fq;
#pragma unroll
        for (int ai = 0; ai < 2; ++ai)
#pragma unroll
            for (int m = 0; m < 4; ++m) { bf16* rowp = O + (size_t)(row0 + ai * 128 + m * 16) * ldc + col0;
#pragma unroll
                for (int bj = 0; bj < 2; ++bj) { const pg8::f32x4 v0 = acc[ai][bj][m][0], v1 = acc[ai][bj][m][1];
                    pg8::u32x4 w; w.x = pg8::cvt_pk_bf16(v0[0], v0[1]); w.y = pg8::cvt_pk_bf16(v0[2], v0[3]); w.z = pg8::cvt_pk_bf16(v1[0], v1[1]); w.w = pg8::cvt_pk_bf16(v1[2], v1[3]);
                    *(pg8::u32x4*)(rowp + bj * 128) = w; } }
    }
};
struct EpiSwiglu {
    static constexpr bool PERM = true, AFTER_DRAIN = false;
    unsigned char* O;
    template <class U> __device__ __forceinline__ void operator()(const pg8::f32x4 (&acc)[2][2][4][2], const U& u, int wr, int wc, int fr, int fq) const {
        const int row0 = u.pm * 256 + wr * 64 + fr, col0 = (u.pn & 3) * 128 + wc * 32 + 8 * fq;
#pragma unroll
        for (int ai = 0; ai < 2; ++ai)
#pragma unroll
            for (int m = 0; m < 4; ++m) { float g[8];
#pragma unroll
                for (int n = 0; n < 2; ++n)
#pragma unroll
                    for (int i = 0; i < 4; ++i) { const float a = acc[ai][0][m][n][i], b = acc[ai][1][m][n][i]; g[4 * n + i] = a * __builtin_amdgcn_rcpf(1.f + __expf(-a)) * b; }
                uint2 w; w.x = fp8x4(g[0], g[1], g[2], g[3]); w.y = fp8x4(g[4], g[5], g[6], g[7]);
                *(uint2*)(O + (size_t)(row0 + ai * 128 + m * 16) * DE + col0) = w; }
    }
};
struct GUnit { int pm, pn, e, lt; };
template <int NJ> struct GroupedOrder {
    typedef GUnit unit_t;
    const LAS int* ts; int G, c, total;
    __device__ __forceinline__ void init(const LAS int* ts_, int G_, int c_) { ts = ts_; G = G_; c = c_; total = ts_[32] * NJ; }
    __device__ __forceinline__ bool next(int i, GUnit& u) const {
        const int L = i * G + c; if (L >= total) return false;
        const int mt = L / NJ, j = L % NJ; int e = 0;
        while (ts[e + 1] <= mt) ++e;
        u.e = e; u.lt = mt - ts[e]; u.pm = mt; u.pn = e * NJ + j; return true;
    }
    __device__ __forceinline__ void a_ready(const GUnit&) const {}
    __device__ __forceinline__ void done(const GUnit&) const {}
};
struct GatherRows { const int* list; const LAS int* cntL; const LAS int* sb;
    __device__ __forceinline__ unsigned row(const GUnit& u, int r) const { const int lr = u.lt * 256 + r; if (lr >= cntL[u.e]) return 0u;
        const LAS int* p = sb + u.e * 17; int su = 0;
#pragma unroll
        for (int st = 8; st > 0; st >>= 1) if (p[su + st] <= lr) su += st;
        return (unsigned)list[(size_t)(u.e * NSUB + su) * SUBCAP + (lr - p[su])]; } };
__device__ __forceinline__ void moe_tables(Frame& F) {
    LAS int* cntL = (LAS int*)(F.lds + LTAB_OFF); LAS int* ts = cntL + 32;
    __syncthreads();
    LAS int* sb = LTAB_SB(F.lds);
    { const int e = F.tid >> 4, su = F.tid & 15; sb[e * 17 + su + 1] = (int)__hip_atomic_load(F.ctl + F.cnt_off + 64 * F.tid, RLX_AGENT); }
    __syncthreads();
    if (F.tid < 32) { LAS int* p = sb + F.tid * 17; int a = 0; p[0] = 0; for (int su = 1; su <= 16; ++su) { a += p[su]; p[su] = a; } cntL[F.tid] = a; }
    __syncthreads();
    if (F.tid == 0) { int a = 0; for (int e = 0; e < 32; ++e) { ts[e] = a; a += (cntL[e] + 255) >> 8; } ts[32] = a; }
    __syncthreads();
}
__device__ __forceinline__ f32x4 bf4(unsigned lo, unsigned hi) { return (f32x4){__uint_as_float(lo << 16), __uint_as_float(lo & 0xffff0000u), __uint_as_float(hi << 16), __uint_as_float(hi & 0xffff0000u)}; }
constexpr int P6_PAR = 0, P6_AH = 40960, P6_AHLD = 1028, P6_RED = P6_AH + 16 * P6_AHLD * 4, P6_LG = P6_RED + 8 * 768 * 4, P6_END = P6_LG + 16 * 48 * 4;
static_assert(P6_END <= LDSCTL_OFF, "p6 LDS map");
typedef float f32x4v __attribute__((ext_vector_type(4)));
__device__ __forceinline__ void split8(const f32x4 a, const f32x4 b, bf16x8& hi, bf16x8& lo) {
    float v[8] = {a.x, a.y, a.z, a.w, b.x, b.y, b.z, b.w}; unsigned h[8], l[8];
#pragma unroll
    for (int i = 0; i < 8; ++i) { h[i] = f2bf(v[i]); l[i] = f2bf(v[i] - __uint_as_float(h[i] << 16)); }
    hi = (bf16x8){(short)h[0], (short)h[1], (short)h[2], (short)h[3], (short)h[4], (short)h[5], (short)h[6], (short)h[7]};
    lo = (bf16x8){(short)l[0], (short)l[1], (short)l[2], (short)l[3], (short)l[4], (short)l[5], (short)l[6], (short)l[7]};
}
template <int VAR>
__device__ __forceinline__ void p6_phase(Frame& F) {
    const float* x = F.in[0]; const float* wpost = F.in[5]; const float* wpre = F.in[13]; const float* rcb = F.in[16]; const float* rfb = F.in[18];
    const float* mod = (const float*)(F.ws + WS_MOD); const bf16* Yb = (const bf16*)(F.ws + WS_YB); bf16* Hb = (bf16*)(F.ws + WS_HB);
    const bf16* RWH = (const bf16*)(F.ws + WS_RWP); const bf16* RWL = RWH + 48 * DM;
    int* list = (int*)(F.ws + WS_LIST); int* SE = (int*)(F.ws + WS_SLOT); int* SPOS = SE + 2 * T; float* SW = (float*)(SPOS + 2 * T);
    LAS f32x4* PAR = (LAS f32x4*)(F.lds + P6_PAR);
    LAS float* AH = (LAS float*)(F.lds + P6_AH); LAS float* RED = (LAS float*)(F.lds + P6_RED); LAS float* LG = (LAS float*)(F.lds + P6_LG);
    const int lane = F.lane, w = F.wave;
    for (int pass = blockIdx.x; pass < T / 16; pass += F.G) {
        const int row0 = pass * 16 + 2 * w, b = (pass * 16) >> 12;
        f32x4 xv[2][8];
        if (VAR >= 2) {
#pragma unroll
            for (int j = 0; j < 8; ++j) { xv[0][j] = (f32x4){1.f, 2.f, 3.f, (float)lane}; xv[1][j] = (f32x4){2.f, 2.f, 3.f, (float)j}; } }
        __syncthreads();
        { const f32x4* mb = (const f32x4*)(mod + (size_t)b * 6 * DM);
          for (int c = F.tid; c < 512; c += NWAVES * 64) { PAR[c] = mb[2 * 512 + c]; PAR[512 + c] = ((const f32x4*)wpost)[c]; PAR[1024 + c] = ((const f32x4*)wpre)[c]; PAR[1536 + c] = mb[4 * 512 + c] + 1.0f; PAR[2048 + c] = mb[3 * 512 + c]; } }
        LDS_WAIT(); __syncthreads();
#pragma unroll
        for (int rr = 0; rr < (VAR >= 2 ? 0 : 2); ++rr) {
            f32x4* outr = (f32x4*)(F.out + (size_t)(row0 + rr) * DM) + lane; unsigned* hr = (unsigned*)((unsigned char*)Hb + (size_t)(row0 + rr) * DM) + lane;
            uint2 yu[8];
            { const f32x4* xr = (const f32x4*)(x + (size_t)(row0 + rr) * DM) + lane; const uint2* yr = (const uint2*)(Yb + (size_t)(row0 + rr) * DM) + lane;
#pragma unroll
              for (int j = 0; j < 8; ++j) { xv[rr][j] = xr[64 * j]; yu[j] = yr[64 * j]; } }
            f32x4 yv[8]; float ss = 0.f;
#pragma unroll
            for (int j = 0; j < 8; ++j) { yv[j] = bf4(yu[j].x, yu[j].y); ss += (yv[j].x * yv[j].x + yv[j].y * yv[j].y) + (yv[j].z * yv[j].z + yv[j].w * yv[j].w); }
            const float rstd_y = rsqrtf(wave_sum(ss) * (1.f / DM) + EPS);
            float s2 = 0.f;
            asm volatile("" ::: "memory");
#pragma unroll
            for (int j = 0; j < 8; ++j) { const f32x4 x1 = xv[rr][j] + PAR[lane + 64 * j] * (yv[j] * rstd_y * PAR[512 + lane + 64 * j]);
                outr[64 * j] = x1; xv[rr][j] = x1; s2 += (x1.x * x1.x + x1.y * x1.y) + (x1.z * x1.z + x1.w * x1.w); }
            const float rstd = rsqrtf(wave_sum(s2) * (1.f / DM) + EPS);
            asm volatile("" ::: "memory");
#pragma unroll
            for (int j = 0; j < 8; ++j) { const f32x4 h = xv[rr][j] * rstd * PAR[1024 + lane + 64 * j] * PAR[1536 + lane + 64 * j] + PAR[2048 + lane + 64 * j];
                xv[rr][j] = h; hr[64 * j] = fp8x4(h.x, h.y, h.z, h.w); }
            asm volatile("" ::: "memory");
        }
        if (VAR == 1) continue;
        pg8::f32x4 acc[3] = {{0.f, 0.f, 0.f, 0.f}, {0.f, 0.f, 0.f, 0.f}, {0.f, 0.f, 0.f, 0.f}};
#pragma unroll 1
        for (int half = 0; half < 2; ++half) {
            bf16x8 bh[4][3], bl[4][3];
#pragma unroll
            for (int ks = 0; ks < 4; ++ks)
#pragma unroll
                for (int nt = 0; nt < 3; ++nt) { const size_t bo = (size_t)(nt * 16 + (lane & 15)) * DM + 1024 * half + 128 * w + 32 * ks + 8 * (lane >> 4);
                    bh[ks][nt] = *(const bf16x8*)(RWH + bo); bl[ks][nt] = *(const bf16x8*)(RWL + bo); }
            __syncthreads();
#pragma unroll
            for (int rr = 0; rr < 2; ++rr)
#pragma unroll
                for (int j = 0; j < 4; ++j) *(LAS f32x4*)(AH + (2 * w + rr) * P6_AHLD + 256 * j + 4 * lane) = half ? xv[rr][4 + j] : xv[rr][j];
            LDS_WAIT(); __syncthreads();
#pragma unroll
            for (int ks = 0; ks < (VAR == 4 ? 0 : 4); ++ks) {
                const int kh = 128 * w + 32 * ks + 8 * (lane >> 4); const LAS float* ap = AH + (lane & 15) * P6_AHLD + kh;
                const f32x4 a0 = *(const LAS f32x4*)ap, a1 = *(const LAS f32x4*)(ap + 4); bf16x8 ahi, alo; split8(a0, a1, ahi, alo);
#pragma unroll
                for (int nt = 0; nt < 3; ++nt) {
                    acc[nt] = __builtin_amdgcn_mfma_f32_16x16x32_bf16(ahi, bh[ks][nt], acc[nt], 0, 0, 0);
                    acc[nt] = __builtin_amdgcn_mfma_f32_16x16x32_bf16(alo, bh[ks][nt], acc[nt], 0, 0, 0);
                    acc[nt] = __builtin_amdgcn_mfma_f32_16x16x32_bf16(ahi, bl[ks][nt], acc[nt], 0, 0, 0); }
            }
        }
#pragma unroll
        for (int nt = 0; nt < 3; ++nt)
#pragma unroll
            for (int r = 0; r < 4; ++r) RED[w * 768 + (nt * 4 + r) * 64 + lane] = acc[nt][r];
        LDS_WAIT(); __syncthreads();
        for (int idx = F.tid; idx < 768; idx += NWAVES * 64) { float s = 0.f;
#pragma unroll
            for (int ww = 0; ww < NWAVES; ++ww) s += RED[ww * 768 + idx];
            const int nt = idx >> 8, r = (idx >> 6) & 3, l = idx & 63; LG[(4 * (l >> 4) + r) * 48 + nt * 16 + (l & 15)] = s; }
        LDS_WAIT(); __syncthreads();
        {
            const int r = 2 * w + (lane & 1); float lg[36];
#pragma unroll
            for (int o = 0; o < 36; ++o) lg[o] = LG[r * 48 + o] + (o < 4 ? rcb[o] : rfb[o - 4]);
            int g = 0; float mx = lg[0];
#pragma unroll
            for (int j = 1; j < 4; ++j) if (lg[j] > mx) { mx = lg[j]; g = j; }
            float den = 0.f;
#pragma unroll
            for (int j = 0; j < 4; ++j) den += expf(lg[j] - mx);
            const float gprob = 1.f / den;
            float f[8];
#pragma unroll
            for (int i = 0; i < 8; ++i) f[i] = g == 0 ? lg[4 + i] : g == 1 ? lg[12 + i] : g == 2 ? lg[20 + i] : lg[28 + i];
            int i0 = 0; float v0 = f[0];
#pragma unroll
            for (int i = 1; i < 8; ++i) if (f[i] > v0) { v0 = f[i]; i0 = i; }
            int i1 = -1; float v1 = -3.0e38f;
#pragma unroll
            for (int i = 0; i < 8; ++i) if (i != i0 && f[i] > v1) { v1 = f[i]; i1 = i; }
            const float e1 = expf(v1 - v0); const float w0 = gprob / (1.f + e1), w1 = gprob * e1 / (1.f + e1);
            if (VAR == 3) { if (lane == 0) SW[2 * (pass * 16 + r)] = w0 + w1 + (float)(g + i0 + i1); } else
            if (lane < 4) { const int slot = lane >> 1, row = pass * 16 + r, e = g * 8 + (slot ? i1 : i0);
                const int es = e * NSUB + (int)(blockIdx.x & (NSUB - 1));
                const int pos = (int)atomicAdd((unsigned*)(F.ws + WS_CTL) + F.cnt_off + 64 * es, 1u);
                list[(size_t)es * SUBCAP + pos] = row; SE[2 * row + slot] = es; SPOS[2 * row + slot] = pos; SW[2 * row + slot] = slot ? w1 : w0; }
        }
    }
}
__device__ __forceinline__ void p9_final(Frame& F) {
    moe_tables(F);
    const LAS int* ts = (const LAS int*)(F.lds + LTAB_OFF) + 32; const LAS int* sb = LTAB_SB(F.lds);
    const float* wpost = F.in[14]; const float* mod = (const float*)(F.ws + WS_MOD); const bf16* Ys = (const bf16*)(F.ws + WS_YS);
    const int* SE = (const int*)(F.ws + WS_SLOT); const int* SPOS = SE + 2 * T; const float* SW = (const float*)(SPOS + 2 * T);
    const int lane = F.lane;
    for (int row = F.gw; row < T; row += F.NGW) {
        const int b = row >> 12;
        const int es0 = SE[2 * row], es1 = SE[2 * row + 1];
        const int r0 = ts[es0 >> 4] * 256 + sb[(es0 >> 4) * 17 + (es0 & 15)] + SPOS[2 * row], r1 = ts[es1 >> 4] * 256 + sb[(es1 >> 4) * 17 + (es1 & 15)] + SPOS[2 * row + 1]; const float w0 = SW[2 * row], w1 = SW[2 * row + 1];
        const uint2* y0 = (const uint2*)(Ys + (size_t)r0 * DM) + lane; const uint2* y1 = (const uint2*)(Ys + (size_t)r1 * DM) + lane;
        f32x4* outr = (f32x4*)(F.out + (size_t)row * DM) + lane; const f32x4* g2 = (const f32x4*)(mod + (size_t)b * 6 * DM + 5 * DM) + lane;
        f32x4 v[8]; float ss = 0.f;
#pragma unroll
        for (int j = 0; j < 8; ++j) { const uint2 a = y0[64 * j], c = y1[64 * j]; v[j] = bf4(a.x, a.y) * w0 + bf4(c.x, c.y) * w1; ss += (v[j].x * v[j].x + v[j].y * v[j].y) + (v[j].z * v[j].z + v[j].w * v[j].w); }
        const float rstd = rsqrtf(wave_sum(ss) * (1.f / DM) + EPS);
#pragma unroll
        for (int j = 0; j < 8; ++j) outr[64 * j] = outr[64 * j] + g2[64 * j] * (v[j] * rstd * ((const f32x4*)wpost)[lane + 64 * j]);
    }
}
__global__ void __launch_bounds__(NWAVES * 64, 2) mega_fwd(Args args) {
    extern __shared__ __attribute__((aligned(16))) unsigned char lds[];
    Frame F;
    F.lds = (LAS unsigned char*)lds; F.ldsg = (char*)lds;
    F.MISC = (volatile LAS unsigned*)(F.lds + MISC_OFF);
    F.tid = threadIdx.x; F.lane = F.tid & 63; F.wave = __builtin_amdgcn_readfirstlane(F.tid >> 6);
    F.G = gridDim.x; F.gw = blockIdx.x * NWAVES + F.wave; F.NGW = F.G * NWAVES;
    F.cnt_off = args.cnt_off;
    F.ws = args.ws; F.out = args.out; F.ctl = (gu32*)(args.ws + WS_CTL);
#pragma unroll
    for (int i = 0; i < 22; ++i) F.in[i] = args.in[i];
    for (int u = F.tid; u < (LDS_BYTES - LDSCTL_OFF) / 4; u += NWAVES * 64) ((LAS unsigned*)(F.lds + LDSCTL_OFF))[u] = 0u;
    __syncthreads();
    XcdBarrier bar = xcd_barrier_post((unsigned*)(F.ctl + CW_BAR), F.MISC + 8);
    const int lo = args.ph_lo, hi = args.ph_hi;
#define IN(k) (lo <= (k) && (k) < hi)
#define BOTH(k) (IN(k) && IN((k) + 1))
#define GRID_BAR() xcd_barrier(bar)
#define REFRESH() do { int t_ = threadIdx.x; asm volatile("" : "+v"(t_)); F.tid = t_; F.lane = t_ & 63; F.wave = __builtin_amdgcn_readfirstlane(t_ >> 6); F.gw = blockIdx.x * NWAVES + F.wave; } while (0)
#ifdef TS_PHASE
    unsigned long long ts0_ = 0, ts1_ = 0;
#define TS_BEG(k) do { if ((k) == TS_PHASE) ts0_ = __builtin_amdgcn_s_memrealtime(); if ((k) == TS_PHASE + TS_SPAN) ts1_ = __builtin_amdgcn_s_memrealtime(); } while (0)
#else
#define TS_BEG(k) do {} while (0)
#endif
    if (IN(0)) { REFRESH(); TS_BEG(0); p0_prologue<false>(F); if (BOTH(0)) GRID_BAR(); }
    if (IN(1)) { REFRESH(); TS_BEG(1); p1_prenorm(F); if (BOTH(1)) GRID_BAR(); }
    if (IN(2)) { REFRESH(); TS_BEG(2);
        const int NG2 = (F.G == 256) ? 224 : F.G;
        if ((int)blockIdx.x < NG2) {
            pg8::Gemm g{(const bf16*)(F.ws + WS_HB), (const bf16*)(F.ws + WS_WIN), T, INCM, DM}; pg8::StaticOrder S; S.init(T, INCM, NG2, (int)blockIdx.x);
            EpiHeads E{(bf16*)(F.ws + WS_QKV), (const float*)(F.ws + WS_CS), F.in[9], F.in[10], F.lds};
            pg8::gemm_phase<EpiHeads, pg8::StaticOrder, true, true, pg8::IdentRows, 1>(F.lds + RING_OFF, g, S, E);
            if (F.tid == 0) __hip_atomic_fetch_add(F.ctl + CW_DONE + 64 * 2, 1u, RLX_AGENT);
        } else filler(F, 2, 1, (unsigned)NG2, 0u, (unsigned)N_CONV_BI);
        if (BOTH(2)) GRID_BAR();
    }
    if (IN(3)) { REFRESH(); TS_BEG(3); p3_phase(F); if (BOTH(3)) GRID_BAR(); }
    if (IN(4)) { REFRESH(); TS_BEG(4); p3b_scan(F); if (BOTH(4)) GRID_BAR(); }
    if (IN(5)) { REFRESH(); TS_BEG(5); p4_phase(F); filler(F, 5, 0, (unsigned)F.G, (unsigned)(F.G - F.G / 8), (unsigned)N_CONV_BI); if (BOTH(5)) GRID_BAR(); }
    if (IN(6)) { REFRESH(); TS_BEG(6);
        pg8::Gemm g{(const bf16*)(F.ws + WS_CAT), (const bf16*)(F.ws + WS_WOUT), T, DM, DM}; pg8::StaticOrder S; S.init(T, DM, F.G, (int)blockIdx.x);
        EpiPlain E{(bf16*)(F.ws + WS_YB), DM, 8};
        pg8::gemm_phase<EpiPlain, pg8::StaticOrder, true, true>(F.lds + RING_OFF, g, S, E);
        if (BOTH(6)) GRID_BAR();
    }
#ifdef PROBE_VARIANTS
    if (lo == 11) p6_phase<1>(F);
    if (lo == 12) p6_phase<2>(F);
    if (lo == 13) p6_phase<3>(F);
    if (lo == 14) p6_phase<4>(F);
#endif
    if (IN(7)) { REFRESH(); TS_BEG(7); p6_phase<0>(F); filler(F, 7, 2, 0u, 0u, (unsigned)N_CONV_BI); if (BOTH(7)) GRID_BAR(); }
    if (IN(8)) { REFRESH(); TS_BEG(8);
        moe_tables(F);
        pg8::Gemm g{(const bf16*)(F.ws + WS_HB), (const bf16*)(F.ws + WS_W13), PADROWS, NE * 1024, DM};
        GroupedOrder<4> S; S.init((const LAS int*)(F.lds + LTAB_OFF) + 32, F.G, (int)blockIdx.x);
        EpiSwiglu E{(unsigned char*)(F.ws + WS_GB)}; GatherRows R{(const int*)(F.ws + WS_LIST), (const LAS int*)(F.lds + LTAB_OFF), LTAB_SB(F.lds)};
        pg8::gemm_phase<EpiSwiglu, GroupedOrder<4>, true, true, GatherRows, 1>(F.lds + RING_OFF, g, S, E, R);
        if (BOTH(8)) GRID_BAR();
    }
    if (IN(9)) { REFRESH(); TS_BEG(9);
        moe_tables(F);
        pg8::Gemm g{(const bf16*)(F.ws + WS_GB), (const bf16*)(F.ws + WS_W2), PADROWS, NE * 2048, DE};
        GroupedOrder<8> S; S.init((const LAS int*)(F.lds + LTAB_OFF) + 32, F.G, (int)blockIdx.x);
        EpiPlain E{(bf16*)(F.ws + WS_YS), DM, 8};
        pg8::gemm_phase<EpiPlain, GroupedOrder<8>, true, true, pg8::IdentRows, 1>(F.lds + RING_OFF, g, S, E);
        if (BOTH(9)) GRID_BAR();
    }
    if (IN(10)) { REFRESH(); TS_BEG(10); p9_final(F); }
#ifdef TS_PHASE
    TS_BEG(11);
    if (blockIdx.x == 0 && threadIdx.x == 0) { const unsigned long long te = __builtin_amdgcn_s_memrealtime(), want = 4ull * (ts1_ - ts0_);
        while (__builtin_amdgcn_s_memrealtime() - te < want) __builtin_amdgcn_s_sleep(8); }
#endif
#undef IN
#undef BOTH
}

__global__ void k_adapt_proj(const bf16* __restrict__ qkv, const float* __restrict__ zb, float* __restrict__ proj) {
    const size_t i = (size_t)blockIdx.x * blockDim.x + threadIdx.x;
    if (i >= (size_t)T * INC) return;
    const int tok = (int)(i / INC), c = (int)(i % INC);
    if (c >= INCM) { proj[i] = zb[(size_t)tok * 8 + (c - INCM)]; return; }
    const int type = c >> 10, hh = (c & 1023) >> 7, d = c & 127, b = tok >> 12, s = tok & 4095;
    const unsigned v = qkv[(size_t)type * TSZ + ((size_t)((b * 8 + hh) * SEQ + s)) * HD + d];
    proj[i] = __uint_as_float(v << 16);
}

__global__ void k_adapt_cat(const bf16* __restrict__ catb, float* __restrict__ cat) {
    const size_t i = (size_t)blockIdx.x * blockDim.x + threadIdx.x;
    if (i < (size_t)T * DM) cat[i] = __uint_as_float((unsigned)catb[i] << 16);
}
extern "C" void kernel_launch(void* const* d_in, const int* in_sizes, int n_in, void* d_out, int out_size, void* d_ws, size_t ws_size, hipStream_t stream) {
    static int grid = 0;
    if (grid == 0) {
        int dev = 0, cus = 0, per_cu = 0;
        (void)hipGetDevice(&dev); (void)hipDeviceGetAttribute(&cus, hipDeviceAttributeMultiprocessorCount, dev);
        (void)hipFuncSetAttribute((const void*)mega_fwd, hipFuncAttributeMaxDynamicSharedMemorySize, LDS_BYTES);
        (void)hipOccupancyMaxActiveBlocksPerMultiprocessor(&per_cu, (const void*)mega_fwd, NWAVES * 64, LDS_BYTES);
        (void)hipGetLastError();
        if (per_cu < 1) { fprintf(stderr, "kernel_launch: occupancy query says %d blocks/CU\n", per_cu); per_cu = 1; }
        grid = cus > 0 ? cus : 256;
        if (ws_size < WS_END) fprintf(stderr, "kernel_launch: workspace too small (%zu < %zu)\n", ws_size, (size_t)WS_END);
    }
    (void)hipMemsetAsync((char*)d_ws + WS_CTL, 0, CTL_ZERO_BYTES, stream);
    Args a{};
    for (int i = 0; i < 22; ++i) a.in[i] = (const float*)d_in[i];
    a.out = (float*)d_out; a.ws = (unsigned char*)d_ws; a.ph_lo = 0; a.ph_hi = 11; a.cnt_off = CW_CNT;
    hipLaunchKernelGGL(mega_fwd, dim3(grid), dim3(NWAVES * 64), LDS_BYTES, stream, a);
}
```

```cpp
#include <hip/hip_runtime.h>
#include <stdint.h>
#include <cstdio>

constexpr int DM = 2048, NB = 2, SEQ = 4096, T = NB * SEQ;
constexpr int HD = 128, NH = 8;
constexpr int INC = 7176, INCM = 7168;
constexpr int NE = 32, DE = 512;
constexpr float EPS = 1e-6f;
#define GAS __attribute__((address_space(1)))
#define LAS __attribute__((address_space(3)))
typedef unsigned short bf16;
typedef unsigned v4u __attribute__((ext_vector_type(4)));
typedef float f32x4 __attribute__((ext_vector_type(4)));
typedef short bf16x8 __attribute__((ext_vector_type(8)));
typedef GAS unsigned gu32;
typedef GAS unsigned long long gu64;
#define RLX_AGENT __ATOMIC_RELAXED, __HIP_MEMORY_SCOPE_AGENT
#define LDS_WAIT() asm volatile("s_waitcnt lgkmcnt(0)" ::: "memory")
#define VM_WAIT() asm volatile("s_waitcnt vmcnt(0)" ::: "memory")
__device__ __forceinline__ unsigned long long rt() { return __builtin_amdgcn_s_memrealtime(); }
__device__ __forceinline__ unsigned f2bf(float f) { unsigned u = __builtin_bit_cast(unsigned, f); return (u + 0x7fffu + ((u >> 16) & 1u)) >> 16; }
__device__ __forceinline__ unsigned pk2(float lo, float hi) { return f2bf(lo) | (f2bf(hi) << 16); }

#define XB_TMO      128
#define XB_XCNT(j)  (256  + 64 * (j))
#define XB_XSUB(j)  (1280 + 64 * (j))
#define XB_XGEN(j)  (2304 + 64 * (j))
#define XB_TOP      3328
#define XB_TOPGEN   3392
#define XCD_BAR_WORDS 3456
#define XB_SPIN_CAP (1u << 18)

__device__ __forceinline__ unsigned xb_ld(unsigned* p)              { return __hip_atomic_load(p, __ATOMIC_RELAXED, __HIP_MEMORY_SCOPE_AGENT); }
__device__ __forceinline__ unsigned xb_add(unsigned* p, unsigned v) { return __hip_atomic_fetch_add(p, v, __ATOMIC_RELAXED, __HIP_MEMORY_SCOPE_AGENT); }
__device__ __forceinline__ unsigned xb_xcc_id() { return (unsigned)__builtin_amdgcn_s_getreg((3 << 11) | 20) & 0xFu; }
#define XB_SPIN(cond, bar) do { unsigned _sp = 0; while (cond) { __builtin_amdgcn_s_sleep(1); \
    if ((++_sp & 255u) == 0u) { if (xb_ld(&(bar)[XB_TMO])) break; if (_sp > XB_SPIN_CAP) { atomicAdd(&(bar)[XB_TMO], 1u); break; } } } } while (0)

struct XcdBarrier {
    unsigned* bar; unsigned x;
    volatile LAS unsigned* st;
};

__device__ __forceinline__ XcdBarrier xcd_barrier_post(unsigned* bar, volatile LAS unsigned* st) {
    XcdBarrier b; b.bar = bar; b.x = xb_xcc_id(); b.st = st;
    if (threadIdx.x == 0) (void)xb_add(&bar[XB_XCNT(b.x)], 1u);
    return b;
}
__device__ __forceinline__ void xcd_barrier_complete(unsigned* bar, unsigned x, unsigned& nloc, unsigned& nx) {
    const unsigned G = gridDim.x * gridDim.y * gridDim.z;
    unsigned sum, cnt, mine, sp = 0u;
    for (;;) {
        sum = 0u; cnt = 0u; mine = 0u;
#pragma unroll
        for (unsigned j = 0; j < 16; ++j) { const unsigned c = xb_ld(&bar[XB_XCNT(j)]); sum += c; cnt += (c > 0u) ? 1u : 0u; mine = (j == x) ? c : mine; }
        if (sum == G) break;
        __builtin_amdgcn_s_sleep(1);
        if ((++sp & 255u) == 0u) { if (xb_ld(&bar[XB_TMO])) break; if (sp > XB_SPIN_CAP) { atomicAdd(&bar[XB_TMO], 1u); break; } }
    }
    nloc = mine > 0u ? mine : 1u; nx = cnt > 0u ? cnt : 1u;
}

__device__ __forceinline__ void xcd_barrier(const XcdBarrier& b) {
    asm volatile("s_waitcnt vmcnt(0)" ::: "memory");
    __syncthreads();
    if (threadIdx.x == 0) {
        unsigned* bar = b.bar;
        __builtin_amdgcn_s_waitcnt(0);
        unsigned nloc = b.st[0], nx = b.st[1];
        if (nloc == 0u) { xcd_barrier_complete(bar, b.x, nloc, nx); b.st[0] = nloc; b.st[1] = nx; }
        const unsigned old = xb_add(&bar[XB_XSUB(b.x)], 1u);
        const unsigned gen = old / nloc;
        if (old + 1u == (gen + 1u) * nloc) {
            __builtin_amdgcn_fence(__ATOMIC_RELEASE, "agent");
            asm volatile("s_waitcnt vmcnt(0)" ::: "memory");
            const unsigned og = xb_add(&bar[XB_TOP], 1u);
            const unsigned tg = og / nx;
            if (og + 1u == (tg + 1u) * nx) xb_add(&bar[XB_TOPGEN], 1u);
            else XB_SPIN(xb_ld(&bar[XB_TOPGEN]) == tg, bar);
            __builtin_amdgcn_fence(__ATOMIC_ACQUIRE, "agent");
            xb_add(&bar[XB_XGEN(b.x)], 1u);
            asm volatile("s_waitcnt vmcnt(0)" ::: "memory");
        } else {
            XB_SPIN(xb_ld(&bar[XB_XGEN(b.x)]) == gen, bar);
            __builtin_amdgcn_fence(__ATOMIC_ACQUIRE, "agent");
            asm volatile("s_waitcnt vmcnt(0)" ::: "memory");
        }
    }
    __syncthreads();
}
namespace pg8 {
#define PG8_LAS __attribute__((address_space(3)))
typedef unsigned short bf16_t;
typedef short bf16x8 __attribute__((ext_vector_type(8)));
typedef float f32x4 __attribute__((ext_vector_type(4)));
typedef unsigned u32x4 __attribute__((ext_vector_type(4)));
constexpr int BM = 256, BK = 64, HALF = 128, HTB = HALF * BK * 2  , STAGE_BYTES = 8 * HTB, NXCD = 8, WGM = 8;

__host__ __device__ __forceinline__ int lds_byte(int r, int c) { const int st = (r >> 4) * 2 + (c >> 5), rr = r & 15, cc = c & 31, ob = rr * 64 + cc * 2; return st * 1024 + (ob ^ (((ob >> 9) & 1) << 5)); }
__host__ __device__ __forceinline__ void stage_rc(int b, int& R, int& C) { const int st = b / 1024, sb = b % 1024, swz = sb ^ (((sb >> 9) & 1) << 5); R = (st >> 1) * 16 + swz / 64; C = (st & 1) * 32 + (swz % 64) / 2; }
__host__ __device__ __forceinline__ int perm32(int rho) { const int n = rho >> 4, i = rho & 15; return 8 * (i >> 2) + 4 * n + (i & 3); }

struct Unit { int pm, pn; };
struct Gemm { const bf16_t* A; const bf16_t* Bt; int M, N, K; };

struct StaticOrder {
    typedef Unit unit_t;
    int nM, nN, nwg, G, c;
    __host__ __device__ void init(int M, int N, int G_, int c_) { nM = M / BM; nN = N / BM; nwg = nM * nN; G = G_; c = c_; }
    __host__ __device__ bool next(int i, Unit& u) const {
        const long L = (long)i * G + c; if (L >= nwg) return false;
        int wgid = (int)L; { const int q = nwg / NXCD, r = nwg % NXCD, xcd = wgid % NXCD, off = wgid / NXCD; wgid = (xcd < r ? xcd * (q + 1) : r * (q + 1) + (xcd - r) * q) + off; }
        const int nig = WGM * nN, gid = wgid / nig, fm = gid * WGM, gsz = (nM - fm) < WGM ? (nM - fm) : WGM;
        u.pm = fm + ((wgid % nig) % gsz); u.pn = (wgid % nig) / gsz; return true;
    }
    __device__ __forceinline__ void a_ready(const Unit&) const {}
    __device__ __forceinline__ void done(const Unit&) const {}
};

__device__ __forceinline__ unsigned cvt_pk_bf16(float lo, float hi) { unsigned r; asm volatile("v_cvt_pk_bf16_f32 %0, %1, %2" : "=v"(r) : "v"(lo), "v"(hi)); return r; }
typedef float f32x2 __attribute__((ext_vector_type(2)));
__device__ __forceinline__ f32x2 gelu_pk(f32x2 v) {
    const f32x2 av = __builtin_elementwise_abs(v), d = av * 0.2316418882f + 1.0f;
    f32x2 t; t.x = __builtin_amdgcn_rcpf(d.x); t.y = __builtin_amdgcn_rcpf(d.y);
    f32x2 q = t * 0.5307027145f + (-0.7265760135f); q = q * t + 0.7107068705f; q = q * t + (-0.142248368f); q = q * t + 0.127414796f; q = q * t;
    const f32x2 s = (v * v) * (-0.72134752044f);
    f32x2 e; e.x = __builtin_amdgcn_exp2f(s.x); e.y = __builtin_amdgcn_exp2f(s.y);
    const f32x2 m = v * (q * e), r = v - m;
    f32x2 o; o.x = v.x < 0.f ? m.x : r.x; o.y = v.y < 0.f ? m.y : r.y; return o;
}

template <int ACT  > struct EpiBf16 {
    static constexpr bool PERM = true, AFTER_DRAIN = false; static_assert(ACT == 0 || ACT == 1, "EpiBf16: ACT is 0 (none) or 1 (gelu_pk)");
    bf16_t* O; int ldc; const float* bias; int split_cols; size_t split_stride; float scale0;
    __device__ __forceinline__ void operator()(const f32x4 (&acc)[2][2][4][2], const Unit& u, int wr, int wc, int fr, int fq) const {
        const int row0 = u.pm * BM + wr * 64 + fr; int colt = u.pn * BM; bf16_t* base = O;
        float sc = 1.f; if (split_cols) { const int t = colt / split_cols; base += (size_t)t * split_stride; colt -= t * split_cols; if (t == 0) sc = scale0; }
        const int col0 = colt + wc * 32 + 8 * fq, bcol0 = u.pn * BM + wc * 32 + 8 * fq;
        f32x4 bv[2][2];
#pragma unroll
        for (int bj = 0; bj < 2; ++bj)
#pragma unroll
            for (int n = 0; n < 2; ++n) bv[bj][n] = bias ? *(const f32x4*)(bias + bcol0 + bj * HALF + 4 * n) : (f32x4){0.f, 0.f, 0.f, 0.f};
#pragma unroll
        for (int ai = 0; ai < 2; ++ai)
#pragma unroll
            for (int m = 0; m < 4; ++m) { bf16_t* rowp = base + (size_t)(row0 + ai * HALF + m * 16) * ldc + col0;
#pragma unroll
                for (int bj = 0; bj < 2; ++bj) { f32x4 v0 = acc[ai][bj][m][0] + bv[bj][0], v1 = acc[ai][bj][m][1] + bv[bj][1];
                    if (ACT == 1) { f32x2 a = gelu_pk((f32x2){v0[0], v0[1]}), b = gelu_pk((f32x2){v0[2], v0[3]}), c = gelu_pk((f32x2){v1[0], v1[1]}), d = gelu_pk((f32x2){v1[2], v1[3]});
                        v0 = (f32x4){a.x, a.y, b.x, b.y}; v1 = (f32x4){c.x, c.y, d.x, d.y}; }
                    v0 = v0 * sc; v1 = v1 * sc; u32x4 w; w.x = cvt_pk_bf16(v0[0], v0[1]); w.y = cvt_pk_bf16(v0[2], v0[3]); w.z = cvt_pk_bf16(v1[0], v1[1]); w.w = cvt_pk_bf16(v1[2], v1[3]);
                    *(u32x4*)(rowp + bj * HALF) = w; } }
    }
};
struct IdentRows { template <class U> __device__ __forceinline__ unsigned row(const U& u, int r) const { return (unsigned)(u.pm * BM + r); } };
typedef int v8i32 __attribute__((ext_vector_type(8))); typedef int v4i32 __attribute__((ext_vector_type(4)));
__device__ __forceinline__ v8i32 cat32(bf16x8 lo, bf16x8 hi) { const v4i32 a = __builtin_bit_cast(v4i32, lo), b = __builtin_bit_cast(v4i32, hi); return __builtin_shufflevector(a, b, 0, 1, 2, 3, 4, 5, 6, 7); }
template <class Epi, class Sched, bool ALIGN_EPI = false, bool SP2 = false, class RowMap = IdentRows, int EB = 2>
__device__ __forceinline__ void gemm_phase(PG8_LAS unsigned char* lds, const Gemm g, const Sched& S, const Epi& E, const RowMap RM = RowMap()) {
    typedef typename Sched::unit_t Unit;
    const int tid = threadIdx.x, wid = __builtin_amdgcn_readfirstlane(tid >> 6), lane = tid & 63, wr = wid >> 2, wc = wid & 3, fr = lane & 15, fq = lane >> 4;
    int K = g.K; asm volatile("" : "+s"(K)); const int nt = K * EB / (BK * 2);
    unsigned voffB[2]; int RA[2], CA[2];
#pragma unroll
    for (int i = 0; i < 2; ++i) { int R, C; stage_rc(tid * 16 + i * 8192, R, C); const int Rb = Epi::PERM ? ((R & ~31) + perm32(R & 31)) : R;
        RA[i] = R; CA[i] = C; voffB[i] = (unsigned)(Rb * K * EB + C * 2); }
    unsigned ao[2][2], an[2][2];
#define PG8_AOFF(dst, U) do { _Pragma("unroll") for (int h_ = 0; h_ < 2; ++h_) _Pragma("unroll") for (int i_ = 0; i_ < 2; ++i_) { \
        dst[h_][i_] = RM.row((U), h_ * HALF + RA[i_]) * (unsigned)(K * EB) + (unsigned)(CA[i_] * 2); } } while (0)
    const size_t kstep = (size_t)(BK * 2);
    const size_t hstep = (size_t)HALF * K * EB;
    const size_t tstep = 2 * hstep;
    const unsigned ldsw = (unsigned)wid * 1024u;
    const int aoff = lds_byte(wr * 64 + fr, fq * 8), boff = lds_byte(wc * 32 + fr, fq * 8);
#define PG8_SA(b, h) (((b) * 2 + (h)) * HTB)
#define PG8_SB(b, h) ((4 + (b) * 2 + (h)) * HTB)
#define PG8_STAGE(bufoff, gbase, voff) do { _Pragma("unroll") for (int _i = 0; _i < 2; ++_i) \
        __builtin_amdgcn_global_load_lds((const unsigned*)((const char*)(gbase) + (voff)[_i]), (PG8_LAS unsigned*)(lds + (bufoff) + ldsw + _i * 8192), 16, 0, 0); } while (0)
#define PG8_STAGE_A(bufoff, kbase, off) do { _Pragma("unroll") for (int _i = 0; _i < 2; ++_i) \
        __builtin_amdgcn_global_load_lds((const unsigned*)((const char*)(kbase) + (off)[_i]), (PG8_LAS unsigned*)(lds + (bufoff) + ldsw + _i * 8192), 16, 0, 0); } while (0)
#define PG8_LDA(dst, b, h) do { _Pragma("unroll") for (int m = 0; m < 4; ++m) { if constexpr (EB == 1) dst##8[m] = cat32(*(const PG8_LAS bf16x8*)(lds + PG8_SA(b, h) + aoff + m * 2048), *(const PG8_LAS bf16x8*)(lds + PG8_SA(b, h) + aoff + m * 2048 + 1024)); \
        else { _Pragma("unroll") for (int k = 0; k < 2; ++k) dst[m][k] = *(const PG8_LAS bf16x8*)(lds + PG8_SA(b, h) + aoff + m * 2048 + k * 1024); } } } while (0)
#define PG8_LDB(dst, b, h) do { _Pragma("unroll") for (int n = 0; n < 2; ++n) { if constexpr (EB == 1) dst##8[n] = cat32(*(const PG8_LAS bf16x8*)(lds + PG8_SB(b, h) + boff + n * 2048), *(const PG8_LAS bf16x8*)(lds + PG8_SB(b, h) + boff + n * 2048 + 1024)); \
        else { _Pragma("unroll") for (int k = 0; k < 2; ++k) dst[n][k] = *(const PG8_LAS bf16x8*)(lds + PG8_SB(b, h) + boff + n * 2048 + k * 1024); } } } while (0)
#define PG8_MMA(ai, bj, At, Bt) do { __builtin_amdgcn_s_setprio(1); _Pragma("unroll") for (int m = 0; m < 4; ++m) _Pragma("unroll") for (int n = 0; n < 2; ++n) { \
        if constexpr (EB == 1) asm volatile("v_mfma_scale_f32_16x16x128_f8f6f4 %0, %1, %2, %0, %3, %4 op_sel_hi:[0,0,0]" : "+v"(acc[ai][bj][m][n]) : "v"(Bt##8[n]), "v"(At##8[m]), "v"(scw_), "v"(sca_)); \
        else { _Pragma("unroll") for (int k = 0; k < 2; ++k) acc[ai][bj][m][n] = __builtin_amdgcn_mfma_f32_16x16x32_bf16(Bt[n][k], At[m][k], acc[ai][bj][m][n], 0, 0, 0); } } \
        __builtin_amdgcn_s_setprio(0); } while (0)
#define PG8_WAIT_V(n) asm volatile("s_waitcnt vmcnt(" #n ")" ::: "memory")
#define PG8_WAIT_L(n) asm volatile("s_waitcnt lgkmcnt(" #n ")" ::: "memory")
#define PG8_BAR __builtin_amdgcn_s_barrier()
#define PG8_SCHED __builtin_amdgcn_sched_barrier(0)
    Unit cur, nxt; int ui = 0;
    if (!S.next(0, cur)) return;
    f32x4 acc[2][2][4][2];
#pragma unroll
    for (int a = 0; a < 2; ++a)
#pragma unroll
        for (int b = 0; b < 2; ++b)
#pragma unroll
            for (int m = 0; m < 4; ++m)
#pragma unroll
                for (int n = 0; n < 2; ++n) acc[a][b][m][n] = (f32x4){0.f, 0.f, 0.f, 0.f};
    int scw_ = 0x79797979, sca_ = 0x7F7F7F7F; asm volatile("" : "+v"(scw_), "+v"(sca_));
    bf16x8 At[4][2], B0[2][2], B1[2][2]; v8i32 At8[4], B08[2], B18[2];
    const char* const Ab = (const char*)g.A; const char* cB = (const char*)g.Bt + (size_t)cur.pn * tstep;
    PG8_AOFF(ao, cur);
    S.a_ready(cur);
    if constexpr (SP2) {
        PG8_STAGE(PG8_SB(0, 0), cB, voffB); PG8_STAGE(PG8_SB(0, 1), cB + hstep, voffB); PG8_STAGE_A(PG8_SA(0, 0), Ab, ao[0]); PG8_STAGE_A(PG8_SA(0, 1), Ab, ao[1]);
        if (wr == 1) PG8_BAR;
        PG8_WAIT_V(2); PG8_BAR;
        PG8_STAGE(PG8_SB(1, 0), cB + kstep, voffB); PG8_STAGE_A(PG8_SA(1, 0), Ab + kstep, ao[0]); PG8_STAGE(PG8_SB(1, 1), cB + hstep + kstep, voffB);
        PG8_WAIT_V(6); PG8_BAR;
    } else {
        PG8_STAGE(PG8_SB(0, 0), cB, voffB); PG8_STAGE_A(PG8_SA(0, 0), Ab, ao[0]); PG8_STAGE(PG8_SB(0, 1), cB + hstep, voffB); PG8_STAGE_A(PG8_SA(0, 1), Ab, ao[1]);
        if (wr == 1) PG8_BAR;
        PG8_WAIT_V(4); PG8_BAR;
        PG8_STAGE(PG8_SB(1, 0), cB + kstep, voffB); PG8_STAGE_A(PG8_SA(1, 0), Ab + kstep, ao[0]); PG8_STAGE(PG8_SB(1, 1), cB + hstep + kstep, voffB);
        PG8_WAIT_V(6); PG8_BAR;
    }
    for (;;) {
        const bool has_next = S.next(ui + 1, nxt);
        const char* nB = has_next ? (const char*)g.Bt + (size_t)nxt.pn * tstep : cB;
        if (has_next) { PG8_AOFF(an, nxt); } else { _Pragma("unroll") for (int h_ = 0; h_ < 2; ++h_) _Pragma("unroll") for (int i_ = 0; i_ < 2; ++i_) an[h_][i_] = ao[h_][i_]; }
        for (int t = 0; t < nt; t += 2) {
            const bool last = (t == nt - 2);
            const char* a1 = Ab + (size_t)(t + 1) * kstep;
            const char* a2 = last ? Ab : Ab + (size_t)(t + 2) * kstep; const char* b2 = last ? nB : cB + (size_t)(t + 2) * kstep;
            const char* a3 = a2 + kstep; const char* b3 = b2 + kstep;
            unsigned as[2][2];
#pragma unroll
            for (int h_ = 0; h_ < 2; ++h_)
#pragma unroll
                for (int i_ = 0; i_ < 2; ++i_) as[h_][i_] = last ? an[h_][i_] : ao[h_][i_];
            if (last && has_next) S.a_ready(nxt);
            if constexpr (SP2) {
            PG8_LDB(B0, 0, 0); PG8_LDB(B1, 0, 1); PG8_SCHED; PG8_LDA(At, 0, 0); PG8_STAGE_A(PG8_SA(1, 1), a1, ao[1]);
            PG8_WAIT_V(8); PG8_WAIT_L(0); PG8_BAR; PG8_MMA(0, 0, At, B0); PG8_MMA(0, 1, At, B1); PG8_BAR; PG8_SCHED;
            PG8_LDA(At, 0, 1); PG8_STAGE(PG8_SB(0, 0), b2, voffB); PG8_STAGE(PG8_SB(0, 1), b2 + hstep, voffB); PG8_STAGE_A(PG8_SA(0, 0), a2, as[0]);
            PG8_WAIT_V(8); PG8_WAIT_L(0); PG8_BAR; PG8_MMA(1, 0, At, B0); PG8_MMA(1, 1, At, B1); PG8_BAR; PG8_SCHED;
            PG8_LDB(B0, 1, 0); PG8_LDB(B1, 1, 1); PG8_SCHED; PG8_LDA(At, 1, 0); PG8_STAGE_A(PG8_SA(0, 1), a2, as[1]);
            PG8_WAIT_V(8); PG8_WAIT_L(0); PG8_BAR; PG8_MMA(0, 0, At, B0); PG8_MMA(0, 1, At, B1); PG8_BAR; PG8_SCHED;
            PG8_LDA(At, 1, 1); PG8_STAGE(PG8_SB(1, 0), b3, voffB); PG8_STAGE(PG8_SB(1, 1), b3 + hstep, voffB); PG8_STAGE_A(PG8_SA(1, 0), a3, as[0]);
            PG8_WAIT_V(8); PG8_WAIT_L(0); PG8_BAR; PG8_MMA(1, 0, At, B0); PG8_MMA(1, 1, At, B1); PG8_BAR; PG8_SCHED;
            } else {
            PG8_LDB(B0, 0, 0); PG8_SCHED; PG8_LDA(At, 0, 0); PG8_STAGE_A(PG8_SA(1, 1), a1, ao[1]);
            PG8_WAIT_L(8); PG8_BAR; PG8_WAIT_L(0); PG8_MMA(0, 0, At, B0); PG8_BAR; PG8_SCHED;
            PG8_LDB(B1, 0, 1); PG8_STAGE(PG8_SB(0, 0), b2, voffB);
            PG8_BAR; PG8_WAIT_L(0); PG8_MMA(0, 1, At, B1); PG8_BAR;
            PG8_LDA(At, 0, 1); PG8_STAGE_A(PG8_SA(0, 0), a2, as[0]);
            PG8_BAR; PG8_WAIT_L(0); PG8_MMA(1, 0, At, B0); PG8_BAR; PG8_SCHED;
            PG8_STAGE(PG8_SB(0, 1), b2 + hstep, voffB);
            PG8_WAIT_V(6); PG8_BAR; PG8_MMA(1, 1, At, B1); PG8_BAR;
            PG8_LDB(B0, 1, 0); PG8_SCHED; PG8_LDA(At, 1, 0); PG8_STAGE_A(PG8_SA(0, 1), a2, as[1]);
            PG8_WAIT_L(8); PG8_BAR; PG8_WAIT_L(0); PG8_MMA(0, 0, At, B0); PG8_BAR; PG8_SCHED;
            PG8_LDB(B1, 1, 1); PG8_STAGE(PG8_SB(1, 0), b3, voffB);
            PG8_BAR; PG8_WAIT_L(0); PG8_MMA(0, 1, At, B1); PG8_BAR;
            PG8_LDA(At, 1, 1); PG8_STAGE_A(PG8_SA(1, 0), a3, as[0]);
            PG8_BAR; PG8_WAIT_L(0); PG8_MMA(1, 0, At, B0); PG8_BAR; PG8_SCHED;
            PG8_STAGE(PG8_SB(1, 1), b3 + hstep, voffB);
            PG8_WAIT_V(6); PG8_BAR; PG8_MMA(1, 1, At, B1); PG8_BAR;
            }
        }
        if constexpr (EB == 1) asm volatile("s_nop 15\n\ts_nop 15" ::: "memory");
        if constexpr (ALIGN_EPI) { if (wr == 0) PG8_BAR; }
        if constexpr (!Epi::AFTER_DRAIN) { E(acc, cur, wr, wc, fr, fq); S.done(cur); }
        if (!has_next) break;
#pragma unroll
        for (int a = 0; a < 2; ++a)
#pragma unroll
            for (int b = 0; b < 2; ++b)
#pragma unroll
                for (int m = 0; m < 4; ++m)
#pragma unroll
                    for (int n = 0; n < 2; ++n) acc[a][b][m][n] = (f32x4){0.f, 0.f, 0.f, 0.f};
        cur = nxt; cB = nB; ++ui;
#pragma unroll
        for (int h_ = 0; h_ < 2; ++h_)
#pragma unroll
            for (int i_ = 0; i_ < 2; ++i_) ao[h_][i_] = an[h_][i_];
        if constexpr (ALIGN_EPI) { if (wr == 1) PG8_BAR; }
    }
    PG8_WAIT_V(0);
    if constexpr (!ALIGN_EPI) { if (wr == 0) PG8_BAR; }
    PG8_BAR;
    if constexpr (Epi::AFTER_DRAIN) { E.fused(acc, cur, wr, wc, fr, fq, lds, wid, lane); S.done(cur); }
#undef PG8_SA
#undef PG8_SB
#undef PG8_STAGE
#undef PG8_STAGE_A
#undef PG8_AOFF
#undef PG8_LDA
#undef PG8_LDB
#undef PG8_MMA
#undef PG8_WAIT_V
#undef PG8_WAIT_L
#undef PG8_BAR
#undef PG8_SCHED
}
}
constexpr int NWAVES = 8;
constexpr int RING_OFF = 0, RING_BYTES = 131072;
constexpr int LDSCTL_OFF = 150 * 1024, MISC_OFF = LDSCTL_OFF + 320;
constexpr int LDS_BYTES = 160 * 1024;
constexpr size_t MiB = 1u << 20;
constexpr size_t WS_CTL = 0, CTL_ZERO_BYTES = 1 * MiB;
constexpr size_t WS_MOD = 1 * MiB;
constexpr size_t WS_RWP = WS_MOD + 128 * 1024;
constexpr size_t WS_CS = 2 * MiB;
constexpr size_t WS_LOGF = 4 * MiB;
constexpr size_t WS_CB = WS_LOGF + 256 * 1024;
constexpr size_t WS_Z = WS_CB + 256 * 1024;
constexpr size_t WS_WIN = 6 * MiB;
constexpr size_t WS_WOUT = 34 * MiB;
constexpr size_t WS_HB = 42 * MiB;
constexpr size_t WS_QKV = 74 * MiB;
constexpr size_t TSZ = (size_t)16 * 4096 * 128;
constexpr size_t WS_FAST_END = 186 * MiB;
constexpr size_t WS_YB = 74 * MiB;
constexpr size_t WS_GB = 74 * MiB;
constexpr size_t WS_YS = 110 * MiB;
constexpr size_t WS_W13 = 266 * MiB;
constexpr size_t WS_W2 = 394 * MiB;
constexpr size_t WS_LIST = 458 * MiB;
constexpr size_t WS_SLOT = 459 * MiB;
constexpr size_t WS_END = 460 * MiB;
constexpr int ECAP = 8192, CW_CNT = 32768;
constexpr int CW_BAR = 4096;

struct Frame {
    LAS unsigned char* lds; char* ldsg;
    volatile LAS unsigned* MISC;
    gu32* ctl;
    int tid, lane, wave, G, gw, NGW, cnt_off;
    const float* in[22]; float* out; unsigned char* ws;
};
#ifdef SW_ID
__device__ unsigned long long sw_acc_ = 0ull, sw_t0_ = 0ull;
#define SW_BEG(id) do { if ((id) == SW_ID && blockIdx.x == 0 && threadIdx.x == 0) sw_t0_ = __builtin_amdgcn_s_memrealtime(); } while (0)
#define SW_END(id) do { if ((id) == SW_ID && blockIdx.x == 0 && threadIdx.x == 0) sw_acc_ += __builtin_amdgcn_s_memrealtime() - sw_t0_; } while (0)
#else
#define SW_BEG(id) do {} while (0)
#define SW_END(id) do {} while (0)
#endif
struct Args { const float* in[22]; float* out; unsigned char* ws; int ph_lo, ph_hi, cnt_off, pad; };

template <int CTRL> __device__ __forceinline__ float dppa(float v) { const int t = __builtin_amdgcn_update_dpp(0, __float_as_int(v), CTRL, 0xf, 0xf, true); return v + __int_as_float(t); }
__device__ __forceinline__ float row16_sum(float v) { v = dppa<0xB1>(v); v = dppa<0x4E>(v); v = dppa<0x141>(v); v = dppa<0x140>(v); return v; }
__device__ __forceinline__ float half32_sum(float v) { v = row16_sum(v); return v + __shfl_xor(v, 16); }
__device__ __forceinline__ float wave_sum(float v) {
    v = row16_sum(v);
    const float s0 = __int_as_float(__builtin_amdgcn_readlane(__float_as_int(v), 0)), s1 = __int_as_float(__builtin_amdgcn_readlane(__float_as_int(v), 16));
    const float s2 = __int_as_float(__builtin_amdgcn_readlane(__float_as_int(v), 32)), s3 = __int_as_float(__builtin_amdgcn_readlane(__float_as_int(v), 48));
    return (s0 + s1) + (s2 + s3);
}
__device__ __forceinline__ float silu_f(float v) { return v / (1.f + __expf(-v)); }
__device__ __forceinline__ unsigned fp8x4(float a, float b, float c, float d) { unsigned w = 0; w = __builtin_amdgcn_cvt_pk_fp8_f32(a, b, w, false); w = __builtin_amdgcn_cvt_pk_fp8_f32(c, d, w, true); return w; }

__device__ __forceinline__ void p0_mod(Frame& F) {
    const float* c = F.in[1]; const float* ada_w = F.in[2]; const float* ada_b = F.in[3];
    float* mod = (float*)(F.ws + WS_MOD);
    LAS float* ca = (LAS float*)(F.lds);
    LAS f32x4* red = (LAS f32x4*)(ca + 2 * DM);
    for (int i = F.tid; i < 2 * DM; i += NWAVES * 64) ca[i] = silu_f(c[i]);
    __syncthreads();
    const int rs = F.lane / 12, c4 = F.lane % 12;
    for (int cb = blockIdx.x; cb < 256; cb += F.G) {
        const int j0 = cb * 48;
        f32x4 a0 = {0.f, 0.f, 0.f, 0.f}, a1 = {0.f, 0.f, 0.f, 0.f};
        if (F.lane < 60) {
            const float* wp = ada_w + (size_t)(F.wave * 256) * (6 * DM) + j0 + 4 * c4;
#pragma unroll 1
            for (int i0 = 0; i0 < 52; i0 += 13) {
                f32x4 wv[13];
#pragma unroll
                for (int i = 0; i < 13; ++i) { const int kl = 5 * (i0 + i) + rs; wv[i] = kl < 256 ? *(const f32x4*)(wp + (size_t)kl * (6 * DM)) : (f32x4){0.f, 0.f, 0.f, 0.f}; }
#pragma unroll
                for (int i = 0; i < 13; ++i) { const int kl = 5 * (i0 + i) + rs; const int k = F.wave * 256 + (kl < 256 ? kl : 0); a0 += wv[i] * ca[k]; a1 += wv[i] * ca[DM + k]; }
            }
        }
        red[(F.wave * 64 + F.lane) * 2] = a0; red[(F.wave * 64 + F.lane) * 2 + 1] = a1;
        __syncthreads();
        if (F.tid < 96) { const int b = F.tid / 48, jj = F.tid % 48, cc = jj >> 2, el = jj & 3; float s = 0.f;
            for (int w = 0; w < NWAVES; ++w)
#pragma unroll
                for (int r = 0; r < 5; ++r) s += red[(w * 64 + r * 12 + cc) * 2 + b][el];
            mod[b * 6 * DM + j0 + jj] = s + ada_b[j0 + jj]; }
        __syncthreads();
    }
}
template <bool ROPE = false, bool FP8 = false>
__device__ __forceinline__ void tr_tile(const float* __restrict__ src, int ldn, int k0, int n0, bf16* __restrict__ dst, int ldk, int drow0, LAS float* scr, int lane) {
#pragma unroll 4
    for (int i = 0; i < 16; ++i) { const int kk = 4 * i + (lane >> 4);
        const f32x4 v = *(const f32x4*)(src + (size_t)(k0 + kk) * ldn + n0 + 4 * (lane & 15));
        LAS float* p = scr + kk * 65 + 4 * (lane & 15); p[0] = v.x; p[1] = v.y; p[2] = v.z; p[3] = v.w; }
    LDS_WAIT(); asm volatile("" ::: "memory");
    const int c = lane & 7;
#pragma unroll
    for (int jj = 0; jj < 8; ++jj) { const int n = (lane >> 3) + 8 * jj; const LAS float* s = scr + (8 * c) * 65 + n;
        v4u o; o.x = pk2(s[0], s[65]); o.y = pk2(s[130], s[195]); o.z = pk2(s[260], s[325]); o.w = pk2(s[390], s[455]);
        int drow = drow0 + n;
        if (ROPE) { const int d = (n0 & 127) + n; drow = drow0 + 32 * ((d >> 4) & 3) + 8 * ((d >> 2) & 3) + 4 * (d >> 6) + (d & 3); }
        if (FP8) { uint2 q; q.x = fp8x4(s[0] * 64.f, s[65] * 64.f, s[130] * 64.f, s[195] * 64.f); q.y = fp8x4(s[260] * 64.f, s[325] * 64.f, s[390] * 64.f, s[455] * 64.f);
                   *(uint2*)((unsigned char*)dst + (size_t)drow * ldk + k0 + 8 * c) = q; }
        else *(v4u*)(dst + (size_t)drow * ldk + k0 + 8 * c) = o; }
    LDS_WAIT(); asm volatile("" ::: "memory");
}
constexpr int CW_CONVQ = 2112, CW_DONE = 2176;
constexpr int I_E = 256 * NE, CONV_PER_WAVE = 2, N_CONV_BI = 3 * I_E / (NWAVES * CONV_PER_WAVE);
struct ConvTile { const float* src; unsigned char* dst; int ldn, ldk; };
__device__ __forceinline__ ConvTile conv_decode(Frame& F, int r) {
    ConvTile t;
    if (r < 2 * I_E) { const int which = r / I_E, rr = r % I_E, e = rr >> 8, q = rr & 255, kt = q >> 3, nt = q & 7;
        t.src = (which == 0 ? F.in[19] : F.in[20]) + (size_t)e * DM * DE + (size_t)(64 * kt) * DE + 64 * nt; t.ldn = DE;
        t.dst = (unsigned char*)(F.ws + WS_W13) + (size_t)(e * 1024 + (nt >> 1) * 256 + which * 128 + (nt & 1) * 64) * DM + 64 * kt; t.ldk = DM; return t; }
    r -= 2 * I_E;
    { const int e = r >> 8, q = r & 255, kt = q >> 5, nt = q & 31;
      t.src = F.in[21] + (size_t)e * DE * DM + (size_t)(64 * kt) * DM + 64 * nt; t.ldn = DM;
      t.dst = (unsigned char*)(F.ws + WS_W2) + (size_t)(e * 2048 + 64 * nt) * DE + 64 * kt; t.ldk = DE; }
    return t;
}
__device__ __forceinline__ void conv_load(const ConvTile& t, f32x4 (&v)[16], int lane) {
#pragma unroll
    for (int i = 0; i < 16; ++i) v[i] = *(const f32x4*)(t.src + (size_t)(4 * i + (lane >> 4)) * t.ldn + 4 * (lane & 15));
}
__device__ __forceinline__ void conv_store(const ConvTile& t, const f32x4 (&v)[16], LAS float* scr, int lane) {
#pragma unroll
    for (int i = 0; i < 16; ++i) { LAS float* p = scr + (4 * i + (lane >> 4)) * 65 + 4 * (lane & 15); p[0] = v[i].x; p[1] = v[i].y; p[2] = v[i].z; p[3] = v[i].w; }
    LDS_WAIT(); asm volatile("" ::: "memory");
    const int c = lane & 7;
#pragma unroll
    for (int jj = 0; jj < 8; ++jj) { const int n = (lane >> 3) + 8 * jj; const LAS float* s = scr + (8 * c) * 65 + n;
        uint2 o; o.x = fp8x4(s[0] * 64.f, s[65] * 64.f, s[130] * 64.f, s[195] * 64.f); o.y = fp8x4(s[260] * 64.f, s[325] * 64.f, s[390] * 64.f, s[455] * 64.f);
        *(uint2*)(t.dst + (size_t)n * t.ldk + 8 * c) = o; }
    LDS_WAIT(); asm volatile("" ::: "memory");
}
constexpr int N_CONV_13 = 2 * I_E / (NWAVES * CONV_PER_WAVE);
__device__ __forceinline__ unsigned conv_pull(Frame& F, unsigned qlimit) {
    return __hip_atomic_fetch_add(F.ctl + CW_CONVQ, 1u, RLX_AGENT);
}
__device__ __forceinline__ void filler(Frame& F, int ph, int mode, unsigned nfin, unsigned early, unsigned qlimit) {
    __syncthreads();
    LAS float* scr = (LAS float*)(F.lds) + F.wave * (64 * 65);
    unsigned nxt = 0xffffffffu;
    if (F.tid == 0) { bool go = true;
        if (mode == 0) go = __hip_atomic_fetch_add(F.ctl + CW_DONE + 64 * ph, 1u, RLX_AGENT) < early;
        if (mode == 1) go = __hip_atomic_load(F.ctl + CW_DONE + 64 * ph, RLX_AGENT) < nfin;
        if (go) nxt = conv_pull(F, qlimit); }
    for (;;) {
        if (F.tid == 0) F.MISC[1] = nxt;
        __syncthreads();
        const unsigned it = (unsigned)__builtin_amdgcn_readfirstlane((int)F.MISC[1]);
        __syncthreads();
        if (it >= (unsigned)N_CONV_BI) break;
        if (F.tid == 0) { const bool stop = mode != 2 && __hip_atomic_load(F.ctl + CW_DONE + 64 * ph, RLX_AGENT) >= nfin;
            nxt = stop ? 0xffffffffu : conv_pull(F, qlimit); }
        const int r0 = ((int)it * NWAVES + F.wave) * CONV_PER_WAVE;
        const ConvTile t0 = conv_decode(F, r0), t1 = conv_decode(F, r0 + 1);
        f32x4 va[16], vb[16];
        conv_load(t0, va, F.lane); conv_load(t1, vb, F.lane);
        conv_store(t0, va, scr, F.lane); conv_store(t1, vb, scr, F.lane);
    }
}
template <bool EXPERTS>
__device__ __forceinline__ void p0_prologue(Frame& F) {
    p0_mod(F);
    __syncthreads();
    LAS float* scr = (LAS float*)(F.lds) + F.wave * (64 * 65);
    bf16* WinT = (bf16*)(F.ws + WS_WIN); bf16* WoutT = (bf16*)(F.ws + WS_WOUT);
    constexpr int I_IN = 32 * 112, I_OUT = 32 * 32;
    constexpr int NIT = I_IN + I_OUT;
    for (int it = F.gw; it < NIT; it += F.NGW) {
        int r = it;
        if (r < I_IN) { const int nt = r % 112;
            if (nt < 32) tr_tile<true, true>(F.in[6], INC, 64 * (r / 112), 64 * nt, WinT, DM, 128 * (nt >> 1), scr, F.lane);
            else tr_tile<false, true>(F.in[6], INC, 64 * (r / 112), 64 * nt, WinT, DM, 64 * nt, scr, F.lane);
            continue; } r -= I_IN;
        if (r < I_OUT) { tr_tile<false>(F.in[12], DM, 64 * (r / 32), 64 * (r % 32), WoutT, DM, 64 * (r % 32), scr, F.lane); continue; } r -= I_OUT;
    }
    { bf16* rh = (bf16*)(F.ws + WS_RWP); bf16* rl = rh + 48 * DM; const float* rcw = F.in[15]; const float* rfw = F.in[17];
      for (int idx = blockIdx.x * (NWAVES * 64) + F.tid; idx < 48 * DM; idx += F.G * NWAVES * 64) {
          const int o = idx >> 11, k = idx & 2047; const float v = o < 4 ? rcw[k * 4 + o] : (o < 36 ? rfw[k * 32 + (o - 4)] : 0.f);
          const unsigned h = f2bf(v); const float hf = __uint_as_float(h << 16);
          rh[idx] = (bf16)h; rl[idx] = (bf16)f2bf(v - hf); } }
    { float* cs = (float*)(F.ws + WS_CS);
      for (int idx = blockIdx.x * (NWAVES * 64) + F.tid; idx < SEQ * 64; idx += F.G * NWAVES * 64) {
          const int i = idx & 63, s = idx >> 6; const float inv_freq = powf(10000.f, -(float)(2 * i) / 128.f); const float ang = (float)s * inv_freq;
          cs[2 * idx] = cosf(ang); cs[2 * idx + 1] = sinf(ang); } }
}

__device__ __forceinline__ void p1_row(Frame& F, int row, const f32x4 (&v)[8], const LAS f32x4* wf, const LAS f32x4* par, bf16* Hb, float* logf, float* zb, const float* fbias) {
    const int b = row >> 12, s = row & 4095;
    float ss = 0.f;
#pragma unroll
    for (int j = 0; j < 8; ++j) ss += (v[j].x * v[j].x + v[j].y * v[j].y) + (v[j].z * v[j].z + v[j].w * v[j].w);
    const float rstd = rsqrtf(wave_sum(ss) * (1.f / DM) + EPS);
    float acc[8];
#pragma unroll
    for (int o = 0; o < 8; ++o) acc[o] = 0.f;
    unsigned* o4 = (unsigned*)((unsigned char*)Hb + (size_t)row * DM) + F.lane;
#pragma unroll
    for (int j = 0; j < 8; ++j) {
        const f32x4 h = v[j] * rstd * par[(b * 2) * 512 + 64 * j + F.lane] + par[(b * 2 + 1) * 512 + 64 * j + F.lane];
        o4[64 * j] = fp8x4(h.x, h.y, h.z, h.w);
#pragma unroll
        for (int i = 0; i < 4; ++i) { const f32x4 wa = wf[((j * 4 + i) * 2 + 0) * 64 + F.lane], wb = wf[((j * 4 + i) * 2 + 1) * 64 + F.lane]; const float hv = h[i];
            acc[0] = fmaf(hv, wa.x, acc[0]); acc[1] = fmaf(hv, wa.y, acc[1]); acc[2] = fmaf(hv, wa.z, acc[2]); acc[3] = fmaf(hv, wa.w, acc[3]);
            acc[4] = fmaf(hv, wb.x, acc[4]); acc[5] = fmaf(hv, wb.y, acc[5]); acc[6] = fmaf(hv, wb.z, acc[6]); acc[7] = fmaf(hv, wb.w, acc[7]); }
        asm volatile("" ::: "memory");
    }
    float z = 0.f;
#pragma unroll
    for (int o = 0; o < 8; ++o) { const float t = wave_sum(acc[o]); z = (F.lane == o) ? t : z; }
    if (F.lane < 8) { const float zz = z + fbias[F.lane];
        logf[((size_t)b * NH + F.lane) * SEQ + s] = fminf(zz, 0.f) - log1pf(expf(-fabsf(zz)));
        zb[(size_t)row * 8 + F.lane] = z; }
}
__device__ __forceinline__ void p1_prenorm(Frame& F) {
    const float* x = F.in[0]; const float* wpre = F.in[4]; const float* w_in = F.in[6]; const float* fbias = F.in[7];
    const float* mod = (const float*)(F.ws + WS_MOD);
    bf16* Hb = (bf16*)(F.ws + WS_HB); float* logf = (float*)(F.ws + WS_LOGF); float* zb = (float*)(F.ws + WS_Z);
    LAS f32x4* wf = (LAS f32x4*)F.lds;
    LAS f32x4* par = wf + 4096;
    for (int idx = F.tid; idx < 4096; idx += NWAVES * 64) { const int l = idx & 63, half = (idx >> 6) & 1, i = (idx >> 7) & 3, j = idx >> 9;
        wf[idx] = *(const f32x4*)(w_in + (size_t)(256 * j + 4 * l + i) * INC + INCM + 4 * half); }
    for (int c = F.tid; c < 1024; c += NWAVES * 64) { const int b = c >> 9, cc = c & 511; const f32x4* mb = (const f32x4*)(mod + (size_t)b * 6 * DM);
        par[(b * 2) * 512 + cc] = ((const f32x4*)wpre)[cc] * (mb[512 + cc] + 1.0f); par[(b * 2 + 1) * 512 + cc] = mb[cc]; }
    LDS_WAIT(); __syncthreads();
    int row = F.gw; if (row >= T) return;
    f32x4 va[8], vb[8];
    { const f32x4* xr = (const f32x4*)(x + (size_t)row * DM) + F.lane;
#pragma unroll
      for (int j = 0; j < 8; ++j) va[j] = xr[64 * j]; }
    for (;;) {
        const int r1 = row + F.NGW;
        if (r1 < T) { const f32x4* xr = (const f32x4*)(x + (size_t)r1 * DM) + F.lane;
#pragma unroll
            for (int j = 0; j < 8; ++j) vb[j] = xr[64 * j]; }
        p1_row(F, row, va, wf, par, Hb, logf, zb, fbias);
        if (r1 >= T) break;
        const int r2 = r1 + F.NGW;
        if (r2 < T) { const f32x4* xr = (const f32x4*)(x + (size_t)r2 * DM) + F.lane;
#pragma unroll
            for (int j = 0; j < 8; ++j) va[j] = xr[64 * j]; }
        p1_row(F, r1, vb, wf, par, Hb, logf, zb, fbias);
        if (r2 >= T) break;
        row = r2;
    }
}

constexpr int EPI_SCR = RING_BYTES;
struct EpiHeads {
    static constexpr bool PERM = true, AFTER_DRAIN = false;
    bf16* base; const float* cs; const float* qn; const float* kn; LAS unsigned char* lds;
    __device__ __forceinline__ void operator()(const pg8::f32x4 (&acc)[2][2][4][2], const pg8::Unit& u, int wr, int wc, int fr, int fq) const {
        const int type = u.pn >> 2, head0 = (u.pn & 3) * 2; const int row0 = u.pm * 256 + wr * 64 + fr;
        if (type <= 1) {
            const int i0 = 16 * wc + 4 * fq; const float sc = type == 1 ? 0.08838834764831845f : 1.f;
#pragma unroll
            for (int ai = 0; ai < 2; ++ai)
#pragma unroll
                for (int m = 0; m < 4; ++m) { const int r = row0 + ai * 128 + m * 16, b = r >> 12, s = r & 4095;
                    const pg8::f32x4 c0 = *(const pg8::f32x4*)(cs + ((size_t)s * 64 + i0) * 2), c1 = *(const pg8::f32x4*)(cs + ((size_t)s * 64 + i0) * 2 + 4);
                    const float cv[4] = {c0[0], c0[2], c1[0], c1[2]}, sv[4] = {c0[1], c0[3], c1[1], c1[3]};
#pragma unroll
                    for (int bj = 0; bj < 2; ++bj) { const pg8::f32x4 x1 = acc[ai][bj][m][0], x2 = acc[ai][bj][m][1]; float o1[4], o2[4];
#pragma unroll
                        for (int j = 0; j < 4; ++j) { o1[j] = (x1[j] * cv[j] - x2[j] * sv[j]) * sc; o2[j] = (x1[j] * sv[j] + x2[j] * cv[j]) * sc; }
                        bf16* dst = base + (size_t)type * TSZ + ((size_t)((b * 8 + head0 + bj) * SEQ + s)) * HD + i0;
                        uint2 w1, w2; w1.x = pg8::cvt_pk_bf16(o1[0], o1[1]); w1.y = pg8::cvt_pk_bf16(o1[2], o1[3]); w2.x = pg8::cvt_pk_bf16(o2[0], o2[1]); w2.y = pg8::cvt_pk_bf16(o2[2], o2[3]);
                        *(uint2*)dst = w1; *(uint2*)(dst + 64) = w2; } }
            return;
        }
        float rs[2][4][2];
        if (type == 4 || type == 5) {
            LAS float* P = (LAS float*)(lds + EPI_SCR);
#pragma unroll
            for (int ai = 0; ai < 2; ++ai)
#pragma unroll
                for (int m = 0; m < 4; ++m)
#pragma unroll
                    for (int bj = 0; bj < 2; ++bj) { const pg8::f32x4 v0 = acc[ai][bj][m][0], v1 = acc[ai][bj][m][1];
                        float q = ((v0[0] * v0[0] + v0[1] * v0[1]) + (v0[2] * v0[2] + v0[3] * v0[3])) + ((v1[0] * v1[0] + v1[1] * v1[1]) + (v1[2] * v1[2] + v1[3] * v1[3]));
                        q += __shfl_xor(q, 16); q += __shfl_xor(q, 32);
                        if (fq == 0) P[((ai * 128 + wr * 64 + m * 16 + fr) * 2 + bj) * 4 + wc] = q; }
            asm volatile("s_waitcnt lgkmcnt(0)" ::: "memory"); __builtin_amdgcn_s_barrier(); asm volatile("" ::: "memory");
#pragma unroll
            for (int ai = 0; ai < 2; ++ai)
#pragma unroll
                for (int m = 0; m < 4; ++m)
#pragma unroll
                    for (int bj = 0; bj < 2; ++bj) { const pg8::f32x4 p4 = *(const LAS pg8::f32x4*)(P + ((ai * 128 + wr * 64 + m * 16 + fr) * 2 + bj) * 4);
                        rs[ai][m][bj] = rsqrtf(((p4[0] + p4[1]) + (p4[2] + p4[3])) * (1.f / 128.f) + EPS); }
            asm volatile("s_waitcnt lgkmcnt(0)" ::: "memory"); __builtin_amdgcn_s_barrier(); asm volatile("" ::: "memory");
        }
        pg8::f32x4 g0 = {1.f, 1.f, 1.f, 1.f}, g1 = {1.f, 1.f, 1.f, 1.f};
        if (type == 4 || type == 5) { const float* gp = (type == 4 ? qn : kn) + wc * 32 + 8 * fq; g0 = *(const pg8::f32x4*)gp; g1 = *(const pg8::f32x4*)(gp + 4); }
#pragma unroll
        for (int ai = 0; ai < 2; ++ai)
#pragma unroll
            for (int m = 0; m < 4; ++m) { const int r = row0 + ai * 128 + m * 16, b = r >> 12, s = r & 4095;
#pragma unroll
                for (int bj = 0; bj < 2; ++bj) { pg8::f32x4 v0 = acc[ai][bj][m][0], v1 = acc[ai][bj][m][1];
                    if (type == 4 || type == 5) { v0 = v0 * rs[ai][m][bj] * g0; v1 = v1 * rs[ai][m][bj] * g1; }
                    if (type == 3) {
#pragma unroll
                        for (int j = 0; j < 4; ++j) { v0[j] = v0[j] * __builtin_amdgcn_rcpf(1.f + __expf(-v0[j])); v1[j] = v1[j] * __builtin_amdgcn_rcpf(1.f + __expf(-v1[j])); } }
                    pg8::u32x4 w; w.x = pg8::cvt_pk_bf16(v0[0], v0[1]); w.y = pg8::cvt_pk_bf16(v0[2], v0[3]); w.z = pg8::cvt_pk_bf16(v1[0], v1[1]); w.w = pg8::cvt_pk_bf16(v1[2], v1[3]);
                    *(pg8::u32x4*)(base + (size_t)type * TSZ + ((size_t)((b * 8 + head0 + bj) * SEQ + s)) * HD + wc * 32 + 8 * fq) = w; } }
    }
};

namespace fox {
__device__ __forceinline__ int fox_tid() { int t = threadIdx.x; asm volatile("" : "+v"(t)); return t; }
typedef unsigned short bf16;
constexpr int D = 128, OLD = 2048;
constexpr bool WSKIP = false; constexpr float THR = 8.f;
constexpr float SCALE = 0.08838834764831845f;
constexpr int NW = 8, QBLK = 32, KVBLK = 64, QB = NW * QBLK;
constexpr int SHM_V = KVBLK * D * 2, SHM_K = KVBLK * D * 2;
constexpr int LDS_BYTES = 2 * SHM_V + 2 * SHM_K + NW * 64 * 4 + 2 * 64 * 4;
typedef short bf16x8 __attribute__((ext_vector_type(8)));
typedef short s16x4 __attribute__((ext_vector_type(4)));
typedef float f32x16 __attribute__((ext_vector_type(16)));
typedef float f32x4 __attribute__((ext_vector_type(4)));
typedef unsigned u32x4 __attribute__((ext_vector_type(4)));
template <class A, class Bt> struct same_t { static constexpr bool v = false; };
template <class A> struct same_t<A, A> { static constexpr bool v = true; };

#define KSWZ(row, colB) ((row) * 256 + ((colB) ^ (((row) & 7) << 4)))
#define SBAR() __builtin_amdgcn_sched_barrier(0)
__device__ __forceinline__ int v_st(int k, int c) { const int kk = (k & ~0xC) | ((k & 4) << 1) | ((k & 8) >> 1); return ((kk >> 3) * 4 + (c >> 5)) * 512 + ((kk & 7) * 32 + (c & 31)) * 2; }
__device__ __forceinline__ int v_rd_base(int lane) { return ((lane & 3) << 3) | (((lane >> 2) & 3) << 6) | (((lane >> 4) & 1) << 5) | (((lane >> 5) & 1) << 8); }
constexpr int v_rd_off(int d0, int ks, int half) { return d0 * 512 + ks * 4096 + half * 2048; }
__device__ __forceinline__ int crow(int r, int hi) { return (r & 3) + 8 * (r >> 2) + 4 * hi; }
__device__ __forceinline__ unsigned cvtpk(float lo, float hi) {
    unsigned r; asm volatile("v_cvt_pk_bf16_f32 %0, %1, %2" : "=v"(r) : "v"(lo), "v"(hi)); return r;
}
__device__ __forceinline__ bf16x8 pack8(f32x4 a, f32x4 b) {
    u32x4 w = {cvtpk(a[0], a[1]), cvtpk(a[2], a[3]), cvtpk(b[0], b[1]), cvtpk(b[2], b[3])};
    return *reinterpret_cast<bf16x8*>(&w);
}
template <class T> __device__ __forceinline__ bf16x8 load8(const T* p) {
    if constexpr (same_t<T, float>::v) { return pack8(*(const f32x4*)p, *(const f32x4*)(p + 4)); }
    else { return *reinterpret_cast<const bf16x8*>(p); }
}
__device__ __forceinline__ void mask_tile(f32x16& p0, f32x16& p1, int dq, unsigned W) {
    const float NEG = -__builtin_inff();
#pragma unroll
    for (int r = 0; r < 16; ++r) {
        const int c = (r & 3) + 8 * (r >> 2);
        if ((unsigned)(dq - c) >= W) p0[r] = NEG;
        if ((unsigned)(dq - c - 32) >= W) p1[r] = NEG;
    }
}
__device__ __forceinline__ void partialSM(f32x16& p0, f32x16& p1, float& m_reg, float& mn, float& alpha) {
    float pmax = p0[0]; for (int r = 1; r < 16; ++r) pmax = fmaxf(pmax, p0[r]); for (int r = 0; r < 16; ++r) pmax = fmaxf(pmax, p1[r]);
    { auto rr = __builtin_amdgcn_permlane32_swap(__float_as_uint(pmax), __float_as_uint(pmax), false, false);
      pmax = fmaxf(__uint_as_float(rr[0]), __uint_as_float(rr[1])); }
    constexpr float C2 = 1.4426950408889634f * SCALE;
    if (__builtin_expect(__all((pmax - m_reg) * SCALE <= THR), 1)) { mn = m_reg; alpha = 1.f; }
    else { mn = fmaxf(m_reg, pmax); alpha = __builtin_amdgcn_exp2f((m_reg - mn) * C2); m_reg = mn; }
    const float mnL = -mn * C2;
    for (int r = 0; r < 16; ++r) p0[r] = fmaf(p0[r], C2, mnL); for (int r = 0; r < 16; ++r) p1[r] = fmaf(p1[r], C2, mnL);
    for (int r = 0; r < 16; ++r) p0[r] = __builtin_amdgcn_exp2f(p0[r]);
}
__device__ __forceinline__ void finishSM(f32x16& p0, f32x16& p1, float alpha, float& l_reg, bf16x8& pa0, bf16x8& pa1, bf16x8& pa2, bf16x8& pa3) {
    for (int r = 0; r < 16; ++r) p1[r] = __builtin_amdgcn_exp2f(p1[r]);
    float ps = 0; for (int r = 0; r < 16; ++r) ps += p0[r]; for (int r = 0; r < 16; ++r) ps += p1[r];
    { auto rr = __builtin_amdgcn_permlane32_swap(__float_as_uint(ps), __float_as_uint(ps), false, false);
      ps = __uint_as_float(rr[0]) + __uint_as_float(rr[1]); }
    l_reg = l_reg * alpha + ps;
#define PK4(P, B_, OUT) do { unsigned a0 = cvtpk(P[B_+0], P[B_+1]), a1 = cvtpk(P[B_+2], P[B_+3]);                          \
        unsigned b0 = cvtpk(P[B_+4], P[B_+5]), b1 = cvtpk(P[B_+6], P[B_+7]);                                             \
        auto r0 = __builtin_amdgcn_permlane32_swap(a0, b0, false, false); auto r1 = __builtin_amdgcn_permlane32_swap(a1, b1, false, false); \
        u32x4 w = {r0[0], r1[0], r0[1], r1[1]}; OUT = *reinterpret_cast<bf16x8*>(&w); } while (0)
    PK4(p0, 0, pa0); PK4(p0, 8, pa1); PK4(p1, 0, pa2); PK4(p1, 8, pa3);
#undef PK4
}
template <int KB, bool SK>
__device__ __forceinline__ void qkt(f32x16& p0, f32x16& p1, const char* K_lds, int r32, int hi, const bf16x8* qr, bool act) {
    if (SK && !act) { const float NEG = -__builtin_inff();
#pragma unroll
        for (int r = 0; r < 16; ++r) { p0[r] = NEG; p1[r] = NEG; } return; }
    { const float* bl = (const float*)(K_lds + 2 * SHM_K + NW * 64 * 4) + KB * 64 + 4 * hi;
#pragma unroll
      for (int g = 0; g < 4; ++g) { const f32x4 b0 = *(const f32x4*)(bl + 8 * g), b1 = *(const f32x4*)(bl + 32 + 8 * g);
          p0[4 * g] = b0[0]; p0[4 * g + 1] = b0[1]; p0[4 * g + 2] = b0[2]; p0[4 * g + 3] = b0[3]; p1[4 * g] = b1[0]; p1[4 * g + 1] = b1[1]; p1[4 * g + 2] = b1[2]; p1[4 * g + 3] = b1[3]; } }
    const char* kb[4];
#pragma unroll
    for (int dd = 0; dd < 4; ++dd) kb[dd] = K_lds + KB * SHM_K + KSWZ(r32, (dd * 16 + hi * 8) * 2);
#pragma unroll
    for (int d0 = 0; d0 < 8; ++d0) { const char* a = kb[d0 & 3] + (d0 >> 2) * 128;
        bf16x8 b0 = *reinterpret_cast<const bf16x8*>(a);
        bf16x8 b1 = *reinterpret_cast<const bf16x8*>(a + 32 * 256);
        p0 = __builtin_amdgcn_mfma_f32_32x32x16_bf16(b0, qr[d0], p0, 0, 0, 0);
        p1 = __builtin_amdgcn_mfma_f32_32x32x16_bf16(b1, qr[d0], p1, 0, 0, 0); }
}
template <int VB, bool SK>
__device__ __forceinline__ void pv_tile(f32x16* o, int vb0, bf16x8 pa0, bf16x8 pa1, bf16x8 pa2, bf16x8 pa3, bool act) {
    if (SK && !act) return;
#define TRRD(dst, off) asm volatile("ds_read_b64_tr_b16 %0, %1 offset:%2" : "=&v"(dst) : "v"(vb0), "i"(off) : "memory")
#define PV_D0(d0) do { s16x4 l0, l1, l2, l3, h0, h1, h2, h3; constexpr int b_ = VB * SHM_V + v_rd_off(d0, 0, 0);     \
        TRRD(l0, b_); TRRD(h0, b_ + 2048); TRRD(l1, b_ + 4096); TRRD(h1, b_ + 6144); TRRD(l2, b_ + 8192); TRRD(h2, b_ + 10240); TRRD(l3, b_ + 12288); TRRD(h3, b_ + 14336); \
        asm volatile("s_waitcnt lgkmcnt(0)" ::: "memory"); SBAR();                 \
        o[d0] = __builtin_amdgcn_mfma_f32_32x32x16_bf16(pa0, (bf16x8){l0[0], l0[1], l0[2], l0[3], h0[0], h0[1], h0[2], h0[3]}, o[d0], 0, 0, 0);   \
        o[d0] = __builtin_amdgcn_mfma_f32_32x32x16_bf16(pa1, (bf16x8){l1[0], l1[1], l1[2], l1[3], h1[0], h1[1], h1[2], h1[3]}, o[d0], 0, 0, 0);   \
        o[d0] = __builtin_amdgcn_mfma_f32_32x32x16_bf16(pa2, (bf16x8){l2[0], l2[1], l2[2], l2[3], h2[0], h2[1], h2[2], h2[3]}, o[d0], 0, 0, 0);   \
        o[d0] = __builtin_amdgcn_mfma_f32_32x32x16_bf16(pa3, (bf16x8){l3[0], l3[1], l3[2], l3[3], h3[0], h3[1], h3[2], h3[3]}, o[d0], 0, 0, 0); } while (0)
    PV_D0(0); PV_D0(1); PV_D0(2); PV_D0(3);
#undef PV_D0
#undef TRRD
}

template <class TIn, class TOut> struct BlockRef { const TIn* Q; const TIn* K; const TIn* V; TOut* O; const float* cb; const float* onw; int P0; int jlo, jhi; float* part; };
template <class TIn> struct Seam {
    bf16x8 qr[8];
    bf16x8 st_v0, st_v1, st_k0, st_k1; float st_b; f32x4 sf0, sf1, sf2, sf3;
    f32x4 tq[16];
};
__device__ __forceinline__ int swa_jlo(int P0, int W) { const int lowk = P0 - W + 1; return lowk > 0 ? lowk / KVBLK : 0; }
#define ROW(p, k0, rr) ((p) + (size_t)((k0) + (rr)) * D + sc)
#define VMW() asm volatile("s_waitcnt vmcnt(0)" ::: "memory")
#define VMWN(n) asm volatile("s_waitcnt vmcnt(%0)" :: "i"(n) : "memory")
#define SLOAD_H(Kp, Vp, Bp, k0) do { S.st_v0 = load8<TIn>(ROW(Vp, k0, sr)); S.st_v1 = load8<TIn>(ROW(Vp, k0, 32 + sr));              \
                         S.st_k0 = load8<TIn>(ROW(Kp, k0, sr)); S.st_k1 = load8<TIn>(ROW(Kp, k0, 32 + sr)); S.st_b = (Bp)[(k0) + (tid & 63)]; } while (0)
#define SWRITE_HK(bf) do { *(bf16x8*)(K_lds + (bf) * SHM_K + kws) = S.st_k0; *(bf16x8*)(K_lds + (bf) * SHM_K + kws + 32 * 256) = S.st_k1; \
                           if (tid < 64) ((float*)(K_lds + 2 * SHM_K + NW * 64 * 4))[(bf) * 64 + tid] = S.st_b; } while (0)
#define SWRITE_HV(bf) do { *(bf16x8*)(V_lds + (bf) * SHM_V + vst0) = S.st_v0; *(bf16x8*)(V_lds + (bf) * SHM_V + vst1) = S.st_v1; } while (0)
#define SWRITE_H(bf) do { SWRITE_HV(bf); SWRITE_HK(bf); } while (0)
#define SLOAD_F(p, k0) do { S.sf0 = *(const f32x4*)ROW(p, k0, sr); S.sf1 = *(const f32x4*)(ROW(p, k0, sr) + 4);                \
                            S.sf2 = *(const f32x4*)ROW(p, k0, 32 + sr); S.sf3 = *(const f32x4*)(ROW(p, k0, 32 + sr) + 4); } while (0)
#define SWRITE_KF(bf) do { *(bf16x8*)(K_lds + (bf) * SHM_K + kws) = pack8(S.sf0, S.sf1); *(bf16x8*)(K_lds + (bf) * SHM_K + kws + 32 * 256) = pack8(S.sf2, S.sf3); } while (0)
#define SWRITE_VF(bf) do { *(bf16x8*)(V_lds + (bf) * SHM_V + vst0) = pack8(S.sf0, S.sf1); *(bf16x8*)(V_lds + (bf) * SHM_V + vst1) = pack8(S.sf2, S.sf3); } while (0)
template <class TIn, class TOut>
__device__ __forceinline__ void causal_swa_prime(const BlockRef<TIn, TOut>& cur, int W, char* lds, Seam<TIn>& S) {
    constexpr bool F32 = same_t<TIn, float>::v;
    const int tid = fox_tid(), wid = __builtin_amdgcn_readfirstlane(tid >> 6), lane = tid & 63, r32 = lane & 31, hi = lane >> 5;
    const int sr = tid >> 4, sc = (tid & 15) * 8, kws = KSWZ(sr, sc * 2); char* K_lds = lds + 2 * SHM_V;
    const int kb0 = cur.jlo * KVBLK;
    for (int d0 = 0; d0 < 8; ++d0) S.qr[d0] = load8<TIn>(cur.Q + (size_t)(wid * QBLK + r32) * D + d0 * 16 + hi * 8);
    if constexpr (F32) { SLOAD_F((const float*)cur.K, kb0); VMW(); SWRITE_KF(0); SBAR(); SLOAD_F((const float*)cur.V, kb0); }
    else { SLOAD_H(cur.K, cur.V, cur.cb, kb0); VMW(); SWRITE_HK(0); }
    __syncthreads();
}
template <class TIn, class TOut>
__device__ __forceinline__ void causal_swa_block(const BlockRef<TIn, TOut>& cur, const BlockRef<TIn, TOut>& nxt, int skv, int W, char* lds, Seam<TIn>& S) {
    constexpr bool F32 = same_t<TIn, float>::v;
    const int tid = fox_tid(), wid = __builtin_amdgcn_readfirstlane(tid >> 6), lane = tid & 63, r32 = lane & 31, hi = lane >> 5;
    const int j_lo = cur.jlo, j_hi = cur.jhi;
    const int NT = j_hi - j_lo;
    const int kbn = nxt.jlo * KVBLK;
    const int qlo = cur.P0 + wid * QBLK, qm = qlo + r32 - 4 * hi;
    char* V_lds = lds; char* K_lds = lds + 2 * SHM_V;
    float* ws = (float*)(lds + 2 * SHM_V + 2 * SHM_K) + wid * 64; float* li_l = ws, * al_l = ws + 32;
    float m_reg = -1e30f, l_reg = 0; f32x16 o[4] = {};
    const int sr = tid >> 4, sc = (tid & 15) * 8, vst0 = v_st(sr, sc), vst1 = v_st(32 + sr, sc), kws = KSWZ(sr, sc * 2);
    const int vb0 = (int)(uintptr_t)V_lds + v_rd_base(lane);
    const TIn* Kh = cur.K; const TIn* Vh = cur.V;
#define RESC(a) do { if (__any((a) < 1.f)) { if (hi == 0) al_l[r32] = (a); asm volatile("s_waitcnt lgkmcnt(0)" ::: "memory");              \
                     for (int d_ = 0; d_ < 4; ++d_) for (int r = 0; r < 16; ++r) o[d_][r] *= al_l[crow(r, hi)]; } } while (0)
#define KBASE(t) ((j_lo + (t)) * KVBLK)
#define ACT(t) (KBASE(t) <= qlo + QBLK - 1 && KBASE(t) + KVBLK - 1 >= qlo - W + 1)
#define MASKT(P0_, P1_, t) do { const int kb_ = KBASE(t); if ((!SK || ACT(t)) && (kb_ + KVBLK - 1 > qlo || kb_ <= qlo + QBLK - 1 - W)) mask_tile(P0_, P1_, qm - kb_, (unsigned)W); } while (0)
    constexpr int NQL = F32 ? 16 : 8;
    constexpr bool SK = WSKIP && !F32;
#define SEAM_K0() do { VMWN(NQL); if constexpr (F32) { SWRITE_KF(0); SBAR(); SLOAD_F((const float*)nxt.V, kbn); } else { SWRITE_HK(0); } SBAR(); } while (0)
    f32x16 pA0, pA1, pB0, pB1; float mnA, mnB, alA, alB; bf16x8 pa0, pa1, pa2, pa3;
    if constexpr (F32) { VMW(); SWRITE_VF(0); SBAR(); } else { SWRITE_HV(0); SBAR(); }
    if (NT > 1) { if constexpr (F32) SLOAD_F((const float*)Kh, KBASE(1)); else SLOAD_H(Kh, Vh, cur.cb, KBASE(1)); }
    SBAR(); qkt<0, SK>(pA0, pA1, K_lds, r32, hi, S.qr, ACT(0));
    if constexpr (F32) { if (NT > 1) { VMW(); SWRITE_KF(1); SBAR(); SLOAD_F((const float*)Vh, KBASE(1)); } }
    MASKT(pA0, pA1, 0); partialSM(pA0, pA1, m_reg, mnA, alA);
    if (NT > 1) { VMW(); if constexpr (F32) { SWRITE_VF(1); SBAR(); if (NT > 2) SLOAD_F((const float*)Kh, KBASE(2)); } else SWRITE_H(1); }
    __syncthreads();
#define HALF_STEP(PX0, PX1, mnX, alX, PY0, PY1, alY, t, KB, VB, SB) do {                                                      \
        SBAR(); qkt<KB, SK>(PX0, PX1, K_lds, r32, hi, S.qr, ACT(t));                                             \
        finishSM(PY0, PY1, alY, l_reg, pa0, pa1, pa2, pa3); SBAR();                                                           \
        if ((t) + 1 < NT) { if constexpr (F32) { VMW(); SWRITE_KF(SB); SBAR(); SLOAD_F((const float*)Vh, KBASE((t) + 1)); }  \
                            else { SLOAD_H(Kh, Vh, cur.cb, KBASE((t) + 1)); } SBAR(); }                                               \
        pv_tile<VB, SK>(o, vb0, pa0, pa1, pa2, pa3, ACT((t) - 1)); MASKT(PX0, PX1, (t)); partialSM(PX0, PX1, m_reg, mnX, alX);                                        \
        __syncthreads();                                                                                                      \
        if ((t) + 1 < NT) { VMW(); if constexpr (F32) { SWRITE_VF(SB); SBAR(); if ((t) + 2 < NT) SLOAD_F((const float*)Kh, KBASE((t) + 2)); } \
                            else { SWRITE_H(SB); } }                                                                          \
        RESC(alX); __syncthreads(); } while (0)
    for (int t = 1; t + 1 < NT; t += 2) {
        HALF_STEP(pB0, pB1, mnB, alB, pA0, pA1, alA, t, 1, 0, 0);
        HALF_STEP(pA0, pA1, mnA, alA, pB0, pB1, alB, t + 1, 0, 1, 1);
    }
    const bool even = (NT & 1) == 0;
    if (even) { SBAR(); qkt<1, SK>(pB0, pB1, K_lds, r32, hi, S.qr, ACT(NT - 1)); SBAR(); }
#define QROW(e) (nxt.Q + (size_t)(wid * QBLK + r32) * D + ((e) >> 1) * 16 + hi * 8 + ((e) & 1) * 4)
    if constexpr (F32) { SLOAD_F((const float*)nxt.K, kbn); SBAR();
#pragma unroll
        for (int e = 0; e < 8; ++e) S.tq[e] = *(const f32x4*)QROW(e); }
    else { SLOAD_H(nxt.K, nxt.V, nxt.cb, kbn); SBAR();
#pragma unroll
        for (int d0 = 0; d0 < 8; ++d0) S.qr[d0] = load8<TIn>(nxt.Q + (size_t)(wid * QBLK + r32) * D + d0 * 16 + hi * 8); }
    SBAR();
    finishSM(pA0, pA1, alA, l_reg, pa0, pa1, pa2, pa3); SBAR();
    if constexpr (F32) {
#pragma unroll
        for (int e = 8; e < 16; ++e) S.tq[e] = *(const f32x4*)QROW(e); SBAR(); }
#undef QROW
    pv_tile<0, SK>(o, vb0, pa0, pa1, pa2, pa3, ACT(even ? NT - 2 : NT - 1));
    if (even) { MASKT(pB0, pB1, NT - 1); partialSM(pB0, pB1, m_reg, mnB, alB); __syncthreads(); RESC(alB);
        finishSM(pB0, pB1, alB, l_reg, pa0, pa1, pa2, pa3); SBAR(); pv_tile<1, SK>(o, vb0, pa0, pa1, pa2, pa3, ACT(NT - 1)); }
    SBAR(); SEAM_K0();
    if (cur.part) {
        float* po = cur.part + (size_t)(wid * QBLK) * D;
#pragma unroll
        for (int r = 0; r < 16; ++r) { const int orow = crow(r, hi);
#pragma unroll
            for (int d0 = 0; d0 < 4; ++d0) po[(size_t)orow * D + d0 * 32 + r32] = o[d0][r]; }
        if (hi == 0) { float* ml = cur.part + (size_t)QB * D + (size_t)(wid * QBLK + r32) * 2; ml[0] = m_reg; ml[1] = l_reg; }
    } else {
    if (hi == 0) li_l[r32] = l_reg; asm volatile("s_waitcnt lgkmcnt(0)" ::: "memory");
    { float gw[4];
#pragma unroll
      for (int d0 = 0; d0 < 4; ++d0) gw[d0] = cur.onw[d0 * 32 + r32];
      TOut* Ow = cur.O + (size_t)(wid * QBLK) * OLD;
#pragma unroll
      for (int r = 0; r < 16; ++r) { const int orow = crow(r, hi); const float rl = __builtin_amdgcn_rcpf(li_l[orow]);
          float v[4]; float ss = 0.f;
#pragma unroll
          for (int d0 = 0; d0 < 4; ++d0) { v[d0] = o[d0][r] * rl; ss += v[d0] * v[d0]; }
          ss = half32_sum(ss);
          const float rs = rsqrtf(ss * (1.f / 128.f) + 1e-6f);
#pragma unroll
          for (int d0 = 0; d0 < 4; ++d0) { const float y = v[d0] * rs * gw[d0]; const float yn = __shfl_xor(y, 1);
              if ((r32 & 1) == 0) *(unsigned*)(Ow + (size_t)orow * OLD + d0 * 32 + r32) = cvtpk(y, yn); } } }
    }
    if constexpr (F32) {
#pragma unroll
        for (int d0 = 0; d0 < 8; ++d0) S.qr[d0] = pack8(S.tq[2 * d0], S.tq[2 * d0 + 1]); }
    __syncthreads();
#undef RESC
#undef KBASE
#undef ACT
#undef MASKT
#undef SEAM_K0
#undef HALF_STEP
}
#undef ROW
#undef VMW
#undef VMWN
#undef SLOAD_H
#undef SWRITE_HK
#undef SWRITE_HV
#undef SWRITE_H
#undef SLOAD_F
#undef SWRITE_KF
#undef SWRITE_VF


#undef KSWZ
#undef SBAR
}
constexpr size_t WS_KV = 186 * MiB;
constexpr size_t WS_SP = 218 * MiB;
constexpr size_t WS_CAT = 234 * MiB;
constexpr size_t WS_P34_END = 266 * MiB;
constexpr int CW_RETQ = 2048;
typedef short v4i16_t __attribute__((ext_vector_type(4)));
typedef float f32x16 __attribute__((ext_vector_type(16)));
constexpr int TLD = 136;
constexpr int TILE_EL = 128 * TLD;

__device__ __forceinline__ bf16x8 frag_row(const LAS bf16* X, int r0, int k0, int lane) {
    return *(const LAS bf16x8*)(X + (r0 + (lane & 31)) * TLD + k0 + 8 * (lane >> 5));
}
__device__ __forceinline__ bf16x8 frag_tr(const LAS bf16* X, int k0, int c0, int lane) {
    const int g = lane >> 4, i = lane & 15, q = i >> 2, p = i & 3, h = g >> 1;
    const LAS bf16* a = X + (k0 + 8 * h + q) * TLD + c0 + 16 * (g & 1) + 4 * p;
    const v4i16_t lo = __builtin_amdgcn_ds_read_tr16_b64_v4i16((LAS v4i16_t*)a);
    const v4i16_t hi = __builtin_amdgcn_ds_read_tr16_b64_v4i16((LAS v4i16_t*)(a + 4 * TLD));
    return (bf16x8){lo[0], lo[1], lo[2], lo[3], hi[0], hi[1], hi[2], hi[3]};
}
__device__ __forceinline__ int crow16(int r, int hi) { return (r & 3) + 8 * (r >> 2) + 4 * hi; }
__device__ __forceinline__ float bf2f(unsigned short v) { return __uint_as_float((unsigned)v << 16); }
__device__ __forceinline__ float ret_lg2(int h) { return log1pf(-exp2f(-5.f - (float)h)) * 1.4426950408889634f; }

__device__ __forceinline__ void p3_item(Frame& F, int bh, int n) {
    const int h = bh & 7, tid = F.tid, lane = F.lane, w = F.wave;
    const bf16* qkv = (const bf16*)(F.ws + WS_QKV);
    const size_t rbase = ((size_t)bh * SEQ + (size_t)n * 128) * HD;
    const bf16* RK = qkv + 1 * TSZ + rbase; const bf16* RV = qkv + 2 * TSZ + rbase;
    LAS bf16* Kz = (LAS bf16*)F.lds; LAS bf16* Vt = Kz + TILE_EL;
    const float lg2 = ret_lg2(h);
#pragma unroll
    for (int j = 0; j < 4; ++j) { const int c = tid + 512 * j, row = c >> 4, col8 = (c & 15) * 8;
        *(LAS v4u*)(Vt + row * TLD + col8) = *(const v4u*)(RV + (size_t)row * HD + col8);
        const bf16x8 k = *(const bf16x8*)(RK + (size_t)row * HD + col8); const float zeta = exp2f(lg2 * (float)(127 - row)); float kv[8];
#pragma unroll
        for (int i = 0; i < 8; ++i) kv[i] = bf2f((unsigned short)k[i]) * zeta;
        v4u o; o.x = pk2(kv[0], kv[1]); o.y = pk2(kv[2], kv[3]); o.z = pk2(kv[4], kv[5]); o.w = pk2(kv[6], kv[7]);
        *(LAS v4u*)(Kz + row * TLD + col8) = o; }
    LDS_WAIT(); __syncthreads();
    { const int db = w >> 1, eb = 2 * (w & 1), hi = lane >> 5;
      f32x16 a0 = {}, a1 = {};
#pragma unroll
      for (int kk = 0; kk < 8; ++kk) { const bf16x8 a = frag_tr(Kz, 16 * kk, 32 * db, lane), b0 = frag_tr(Vt, 16 * kk, 32 * eb, lane), b1 = frag_tr(Vt, 16 * kk, 32 * eb + 32, lane);
          a0 = __builtin_amdgcn_mfma_f32_32x32x16_bf16(a, b0, a0, 0, 0, 0); a1 = __builtin_amdgcn_mfma_f32_32x32x16_bf16(a, b1, a1, 0, 0, 0); }
      float* KV = (float*)(F.ws + WS_KV) + ((size_t)bh * 32 + n) * 16384;
#pragma unroll
      for (int r = 0; r < 16; ++r) { const int d = 32 * db + crow16(r, hi); KV[d * 128 + 32 * eb + (lane & 31)] = a0[r]; KV[d * 128 + 32 * eb + 32 + (lane & 31)] = a1[r]; } }
    LDS_WAIT(); __syncthreads();
}
__device__ __forceinline__ void p3_cumsum(Frame& F, int bh) {
    const float* lf = (const float*)(F.ws + WS_LOGF) + (size_t)bh * SEQ + 64 * F.lane; float* cb = (float*)(F.ws + WS_CB) + (size_t)bh * SEQ + 64 * F.lane;
    float tot = 0.f;
#pragma unroll 8
    for (int i = 0; i < 64; ++i) tot += lf[i];
    float incl = tot;
#pragma unroll
    for (int o = 1; o < 64; o <<= 1) { const float t = __shfl_up(incl, o); if (F.lane >= o) incl += t; }
    float run = incl - tot;
#pragma unroll 8
    for (int i = 0; i < 64; ++i) { run += lf[i]; cb[i] = -run * 11.313708498984761f; }
}
__device__ __forceinline__ void p3_phase(Frame& F) {
    if (F.wave == 0) for (int bh = blockIdx.x; bh < 16; bh += F.G) p3_cumsum(F, bh);
    for (int it = blockIdx.x; it < 512; it += F.G) p3_item(F, it >> 5, it & 31);
}
__device__ __forceinline__ void p3b_scan(Frame& F) {
    const float* KV = (const float*)(F.ws + WS_KV); bf16* SP = (bf16*)(F.ws + WS_SP);
    for (int idx = blockIdx.x * (NWAVES * 64) + F.tid; idx < 16 * 16384; idx += F.G * NWAVES * 64) {
        const int bh = idx >> 14, de = idx & 16383; const float cd = exp2f(ret_lg2(bh & 7) * 128.f);
        float st = 0.f;
        for (int n = 0; n < 32; ++n) { const size_t o = ((size_t)bh * 32 + n) * 16384 + de; SP[o] = (bf16)f2bf(st); st = st * cd + KV[o]; }
    }
}
__device__ __forceinline__ void ret_item(Frame& F, int bh, int n) {
    const int h = bh & 7, b = bh >> 3, tid = F.tid, lane = F.lane, w = F.wave, hi = lane >> 5, c32 = lane & 31;
    const bf16* qkv = (const bf16*)(F.ws + WS_QKV);
    const size_t rbase = ((size_t)bh * SEQ + (size_t)n * 128) * HD;
    const bf16* RQ = qkv + 0 * TSZ + rbase; const bf16* RK = qkv + 1 * TSZ + rbase; const bf16* RV = qkv + 2 * TSZ + rbase; const bf16* RG = qkv + 3 * TSZ + rbase;
    const bf16* SPg = (const bf16*)(F.ws + WS_SP) + ((size_t)bh * 32 + n) * 16384;
    LAS bf16* Qs = (LAS bf16*)F.lds; LAS bf16* Ks = Qs + TILE_EL; LAS bf16* Vs = Ks + TILE_EL; LAS bf16* Ss = Vs + TILE_EL;
    LAS float* st = (LAS float*)(Ss + TILE_EL);
#pragma unroll
    for (int j = 0; j < 4; ++j) { const int c = tid + 512 * j, row = c >> 4, col8 = (c & 15) * 8; const size_t go = (size_t)row * HD + col8; const int lo = row * TLD + col8;
        *(LAS v4u*)(Qs + lo) = *(const v4u*)(RQ + go); *(LAS v4u*)(Ks + lo) = *(const v4u*)(RK + go);
        *(LAS v4u*)(Vs + lo) = *(const v4u*)(RV + go); *(LAS v4u*)(Ss + lo) = *(const v4u*)(SPg + go); }
    v4u gt[4];
#pragma unroll
    for (int j = 0; j < 4; ++j) { const int c = tid + 512 * j; gt[j] = *(const v4u*)(RG + (size_t)(c >> 4) * HD + (c & 15) * 8); }
    LDS_WAIT(); __syncthreads();
    const int qb = w >> 1, cb2 = 2 * (w & 1);
    const float lg2 = ret_lg2(h);
    f32x16 s0 = {}, s1 = {};
#pragma unroll
    for (int kk = 0; kk < 8; ++kk) { const bf16x8 a = frag_row(Qs, 32 * qb, 16 * kk, lane), b0 = frag_row(Ks, 32 * cb2, 16 * kk, lane), b1 = frag_row(Ks, 32 * cb2 + 32, 16 * kk, lane);
        s0 = __builtin_amdgcn_mfma_f32_32x32x16_bf16(a, b0, s0, 0, 0, 0); s1 = __builtin_amdgcn_mfma_f32_32x32x16_bf16(a, b1, s1, 0, 0, 0); }
    const int key0 = 32 * cb2 + c32, key1 = key0 + 32;
    const float f0 = __builtin_amdgcn_exp2f(-lg2 * (float)(key0 + 1)), f1 = __builtin_amdgcn_exp2f(-lg2 * (float)(key1 + 1));
    LDS_WAIT(); __syncthreads();
#pragma unroll
    for (int r = 0; r < 16; ++r) { const int q = 32 * qb + crow16(r, hi);
        Ks[q * TLD + key0] = (bf16)f2bf(key0 <= q ? s0[r] * f0 : 0.f); Ks[q * TLD + key1] = (bf16)f2bf(key1 <= q ? s1[r] * f1 : 0.f); }
    LDS_WAIT(); __syncthreads();
    f32x16 o0 = {}, o1 = {};
#pragma unroll
    for (int kk = 0; kk < 8; ++kk) { const bf16x8 a = frag_row(Ks, 32 * qb, 16 * kk, lane), b0 = frag_tr(Vs, 16 * kk, 32 * cb2, lane), b1 = frag_tr(Vs, 16 * kk, 32 * cb2 + 32, lane);
        o0 = __builtin_amdgcn_mfma_f32_32x32x16_bf16(a, b0, o0, 0, 0, 0); o1 = __builtin_amdgcn_mfma_f32_32x32x16_bf16(a, b1, o1, 0, 0, 0); }
#pragma unroll
    for (int kk = 0; kk < 8; ++kk) { const bf16x8 a = frag_row(Qs, 32 * qb, 16 * kk, lane), b0 = frag_tr(Ss, 16 * kk, 32 * cb2, lane), b1 = frag_tr(Ss, 16 * kk, 32 * cb2 + 32, lane);
        o0 = __builtin_amdgcn_mfma_f32_32x32x16_bf16(a, b0, o0, 0, 0, 0); o1 = __builtin_amdgcn_mfma_f32_32x32x16_bf16(a, b1, o1, 0, 0, 0); }
#pragma unroll
    for (int r = 0; r < 16; ++r) { const int q = 32 * qb + crow16(r, hi); const float xi = __builtin_amdgcn_exp2f(lg2 * (float)(q + 1));
        o0[r] *= xi; o1[r] *= xi;
        float s = o0[r] + o1[r], ss = o0[r] * o0[r] + o1[r] * o1[r];
        s = half32_sum(s); ss = half32_sum(ss);
        if (c32 == 0) { st[q * 4 + (w & 1) * 2] = s; st[q * 4 + (w & 1) * 2 + 1] = ss; } }
    LDS_WAIT(); __syncthreads();
#pragma unroll
    for (int j = 0; j < 4; ++j) { const int c = tid + 512 * j, row = c >> 4, col8 = (c & 15) * 8; *(LAS v4u*)(Qs + row * TLD + col8) = gt[j]; }
    LDS_WAIT(); __syncthreads();
    { const float* gn = F.in[8] + h * 128; const float g0 = gn[key0], g1 = gn[key1];
#pragma unroll
      for (int r = 0; r < 16; ++r) { const int q = 32 * qb + crow16(r, hi);
          const float s = st[q * 4] + st[q * 4 + 2], ss = st[q * 4 + 1] + st[q * 4 + 3];
          const float mu = s * (1.f / 128.f), var = fmaxf(ss * (1.f / 128.f) - mu * mu, 0.f), rstd = rsqrtf(var + EPS);
          const float y0 = (o0[r] - mu) * rstd * g0 * bf2f(Qs[q * TLD + key0]), y1 = (o1[r] - mu) * rstd * g1 * bf2f(Qs[q * TLD + key1]);
          Ks[q * TLD + key0] = (bf16)f2bf(y0); Ks[q * TLD + key1] = (bf16)f2bf(y1); } }
    LDS_WAIT(); __syncthreads();
    { bf16* CAT = (bf16*)(F.ws + WS_CAT) + ((size_t)b * SEQ + (size_t)n * 128) * DM + h * 128;
#pragma unroll
      for (int j = 0; j < 4; ++j) { const int c = tid + 512 * j, row = c >> 4, col8 = (c & 15) * 8; *(v4u*)(CAT + (size_t)row * DM + col8) = *(const LAS v4u*)(Ks + row * TLD + col8); } }
    LDS_WAIT(); __syncthreads();
}
__device__ __forceinline__ void p4_phase(Frame& F) {
    const int bx = blockIdx.x; const int vcu = (F.G % 8 == 0) ? (bx % 8) * (F.G / 8) + bx / 8 : bx;
    const bf16* qkv = (const bf16*)(F.ws + WS_QKV);
    bf16* CAT = (bf16*)(F.ws + WS_CAT);
    for (int fb = vcu; fb < 256; fb += F.G) {
        const int bh = fb >> 4, qb = fb & 15, h = bh & 7, b = bh >> 3;
        fox::BlockRef<bf16, bf16> cur;
        cur.Q = qkv + 4 * TSZ + ((size_t)bh * SEQ + (size_t)qb * 256) * HD; cur.K = qkv + 5 * TSZ + (size_t)bh * SEQ * HD; cur.V = qkv + 6 * TSZ + (size_t)bh * SEQ * HD;
        cur.O = CAT + ((size_t)b * SEQ + (size_t)qb * 256) * DM + 1024 + h * 128; cur.cb = (const float*)(F.ws + WS_CB) + (size_t)bh * SEQ; cur.onw = F.in[11] + h * 128; cur.P0 = qb * 256;
        cur.jlo = 0; cur.jhi = 4 * qb + 4; cur.part = nullptr;
        fox::Seam<bf16> S;
        fox::causal_swa_prime<bf16, bf16>(cur, SEQ, F.ldsg, S);
        fox::causal_swa_block<bf16, bf16>(cur, cur, SEQ, SEQ, F.ldsg, S);
        asm volatile("s_waitcnt vmcnt(0)" ::: "memory");
        __syncthreads();
    }
    for (;;) {
        if (F.tid == 0) F.MISC[0] = atomicAdd((unsigned*)(F.ws + WS_CTL) + CW_RETQ, 1u);
        __syncthreads();
        const unsigned item = (unsigned)__builtin_amdgcn_readfirstlane((int)F.MISC[0]);
        __syncthreads();
        if (item >= 512u) break;
        ret_item(F, (int)(item >> 5), (int)(item & 31));
    }
}
constexpr int PADROWS = 24576;
constexpr int LTAB_OFF = LDSCTL_OFF + 1024;
constexpr int NSUB = 16, SUBCAP = ECAP / NSUB;
#define LTAB_SB(lds_) ((LAS int*)((lds_) + LTAB_OFF) + 32 + 40)
struct EpiPlain {
    static constexpr bool PERM = true, AFTER_DRAIN = false;
    bf16* O; int ldc; int ntn;
    template <class U> __device__ __forceinline__ void operator()(const pg8::f32x4 (&acc)[2][2][4][2], const U& u, int wr, int wc, int fr, int fq) const {
        const int row0 = u.pm * 256 + wr * 64 + fr, col0 = (u.pn % ntn) * 256 + wc * 32 + 8 * fq;
#pragma unroll
        for (int ai = 0; ai < 2; ++ai)
#pragma unroll
            for (int m = 0; m < 4; ++m) { bf16* rowp = O + (size_t)(row0 + ai * 128 + m * 16) * ldc + col0;
#pragma unroll
                for (int bj = 0; bj < 2; ++bj) { const pg8::f32x4 v0 = acc[ai][bj][m][0], v1 = acc[ai][bj][m][1];
                    pg8::u32x4 w; w.x = pg8::cvt_pk_bf16(v0[0], v0[1]); w.y = pg8::cvt_pk_bf16(v0[2], v0[3]); w.z = pg8::cvt_pk_bf16(v1[0], v1[1]); w.w = pg8::cvt_pk_bf16(v1[2], v1[3]);
                    *(pg8::u32x4*)(rowp + bj * 128) = w; } }
    }
};
struct EpiSwiglu {
    static constexpr bool PERM = true, AFTER_DRAIN = false;
    unsigned char* O;
    template <class U> __device__ __forceinline__ void operator()(const pg8::f32x4 (&acc)[2][2][4][2], const U& u, int wr, int wc, int fr, int fq) const {
        const int row0 = u.pm * 256 + wr * 64 + fr, col0 = (u.pn & 3) * 128 + wc * 32 + 8 * fq;
#pragma unroll
        for (int ai = 0; ai < 2; ++ai)
#pragma unroll
            for (int m = 0; m < 4; ++m) { float g[8];
#pragma unroll
                for (int n = 0; n < 2; ++n)
#pragma unroll
                    for (int i = 0; i < 4; ++i) { const float a = acc[ai][0][m][n][i], b = acc[ai][1][m][n][i]; g[4 * n + i] = a * __builtin_amdgcn_rcpf(1.f + __expf(-a)) * b; }
                uint2 w; w.x = fp8x4(g[0], g[1], g[2], g[3]); w.y = fp8x4(g[4], g[5], g[6], g[7]);
                *(uint2*)(O + (size_t)(row0 + ai * 128 + m * 16) * DE + col0) = w; }
    }
};
struct GUnit { int pm, pn, e, lt; };
template <int NJ> struct GroupedOrder {
    typedef GUnit unit_t;
    const LAS int* ts; int G, c, total;
    __device__ __forceinline__ void init(const LAS int* ts_, int G_, int c_) { ts = ts_; G = G_; c = c_; total = ts_[32] * NJ; }
    __device__ __forceinline__ bool next(int i, GUnit& u) const {
        const int L = i * G + c; if (L >= total) return false;
        const int mt = L / NJ, j = L % NJ; int e = 0;
        while (ts[e + 1] <= mt) ++e;
        u.e = e; u.lt = mt - ts[e]; u.pm = mt; u.pn = e * NJ + j; return true;
    }
    __device__ __forceinline__ void a_ready(const GUnit&) const {}
    __device__ __forceinline__ void done(const GUnit&) const {}
};
struct GatherRows { const int* list; const LAS int* cntL; const LAS int* sb;
    __device__ __forceinline__ unsigned row(const GUnit& u, int r) const { const int lr = u.lt * 256 + r; if (lr >= cntL[u.e]) return 0u;
        const LAS int* p = sb + u.e * 17; int su = 0;
#pragma unroll
        for (int st = 8; st > 0; st >>= 1) if (p[su + st] <= lr) su += st;
        return (unsigned)list[(size_t)(u.e * NSUB + su) * SUBCAP + (lr - p[su])]; } };
__device__ __forceinline__ void moe_tables(Frame& F) {
    LAS int* cntL = (LAS int*)(F.lds + LTAB_OFF); LAS int* ts = cntL + 32;
    __syncthreads();
    LAS int* sb = LTAB_SB(F.lds);
    { const int e = F.tid >> 4, su = F.tid & 15; sb[e * 17 + su + 1] = (int)__hip_atomic_load(F.ctl + F.cnt_off + 64 * F.tid, RLX_AGENT); }
    __syncthreads();
    if (F.tid < 32) { LAS int* p = sb + F.tid * 17; int a = 0; p[0] = 0; for (int su = 1; su <= 16; ++su) { a += p[su]; p[su] = a; } cntL[F.tid] = a; }
    __syncthreads();
    if (F.tid == 0) { int a = 0; for (int e = 0; e < 32; ++e) { ts[e] = a; a += (cntL[e] + 255) >> 8; } ts[32] = a; }
    __syncthreads();
}
__device__ __forceinline__ f32x4 bf4(unsigned lo, unsigned hi) { return (f32x4){__uint_as_float(lo << 16), __uint_as_float(lo & 0xffff0000u), __uint_as_float(hi << 16), __uint_as_float(hi & 0xffff0000u)}; }
constexpr int P6_PAR = 0, P6_AH = 40960, P6_AHLD = 1028, P6_RED = P6_AH + 16 * P6_AHLD * 4, P6_LG = P6_RED + 8 * 768 * 4, P6_END = P6_LG + 16 * 48 * 4;
static_assert(P6_END <= LDSCTL_OFF, "p6 LDS map");
typedef float f32x4v __attribute__((ext_vector_type(4)));
__device__ __forceinline__ void split8(const f32x4 a, const f32x4 b, bf16x8& hi, bf16x8& lo) {
    float v[8] = {a.x, a.y, a.z, a.w, b.x, b.y, b.z, b.w}; unsigned h[8], l[8];
#pragma unroll
    for (int i = 0; i < 8; ++i) { h[i] = f2bf(v[i]); l[i] = f2bf(v[i] - __uint_as_float(h[i] << 16)); }
    hi = (bf16x8){(short)h[0], (short)h[1], (short)h[2], (short)h[3], (short)h[4], (short)h[5], (short)h[6], (short)h[7]};
    lo = (bf16x8){(short)l[0], (short)l[1], (short)l[2], (short)l[3], (short)l[4], (short)l[5], (short)l[6], (short)l[7]};
}
template <int VAR>
__device__ __forceinline__ void p6_phase(Frame& F) {
    const float* x = F.in[0]; const float* wpost = F.in[5]; const float* wpre = F.in[13]; const float* rcb = F.in[16]; const float* rfb = F.in[18];
    const float* mod = (const float*)(F.ws + WS_MOD); const bf16* Yb = (const bf16*)(F.ws + WS_YB); bf16* Hb = (bf16*)(F.ws + WS_HB);
    const bf16* RWH = (const bf16*)(F.ws + WS_RWP); const bf16* RWL = RWH + 48 * DM;
    int* list = (int*)(F.ws + WS_LIST); int* SE = (int*)(F.ws + WS_SLOT); int* SPOS = SE + 2 * T; float* SW = (float*)(SPOS + 2 * T);
    LAS f32x4* PAR = (LAS f32x4*)(F.lds + P6_PAR);
    LAS float* AH = (LAS float*)(F.lds + P6_AH); LAS float* RED = (LAS float*)(F.lds + P6_RED); LAS float* LG = (LAS float*)(F.lds + P6_LG);
    const int lane = F.lane, w = F.wave;
    for (int pass = blockIdx.x; pass < T / 16; pass += F.G) {
        const int row0 = pass * 16 + 2 * w, b = (pass * 16) >> 12;
        f32x4 xv[2][8];
        if (VAR >= 2) {
#pragma unroll
            for (int j = 0; j < 8; ++j) { xv[0][j] = (f32x4){1.f, 2.f, 3.f, (float)lane}; xv[1][j] = (f32x4){2.f, 2.f, 3.f, (float)j}; } }
        __syncthreads();
        { const f32x4* mb = (const f32x4*)(mod + (size_t)b * 6 * DM);
          for (int c = F.tid; c < 512; c += NWAVES * 64) { PAR[c] = mb[2 * 512 + c]; PAR[512 + c] = ((const f32x4*)wpost)[c]; PAR[1024 + c] = ((const f32x4*)wpre)[c]; PAR[1536 + c] = mb[4 * 512 + c] + 1.0f; PAR[2048 + c] = mb[3 * 512 + c]; } }
        LDS_WAIT(); __syncthreads();
#pragma unroll
        for (int rr = 0; rr < (VAR >= 2 ? 0 : 2); ++rr) {
            f32x4* outr = (f32x4*)(F.out + (size_t)(row0 + rr) * DM) + lane; unsigned* hr = (unsigned*)((unsigned char*)Hb + (size_t)(row0 + rr) * DM) + lane;
            uint2 yu[8];
            { const f32x4* xr = (const f32x4*)(x + (size_t)(row0 + rr) * DM) + lane; const uint2* yr = (const uint2*)(Yb + (size_t)(row0 + rr) * DM) + lane;
#pragma unroll
              for (int j = 0; j < 8; ++j) { xv[rr][j] = xr[64 * j]; yu[j] = yr[64 * j]; } }
            f32x4 yv[8]; float ss = 0.f;
#pragma unroll
            for (int j = 0; j < 8; ++j) { yv[j] = bf4(yu[j].x, yu[j].y); ss += (yv[j].x * yv[j].x + yv[j].y * yv[j].y) + (yv[j].z * yv[j].z + yv[j].w * yv[j].w); }
            const float rstd_y = rsqrtf(wave_sum(ss) * (1.f / DM) + EPS);
            float s2 = 0.f;
            asm volatile("" ::: "memory");
#pragma unroll
            for (int j = 0; j < 8; ++j) { const f32x4 x1 = xv[rr][j] + PAR[lane + 64 * j] * (yv[j] * rstd_y * PAR[512 + lane + 64 * j]);
                outr[64 * j] = x1; xv[rr][j] = x1; s2 += (x1.x * x1.x + x1.y * x1.y) + (x1.z * x1.z + x1.w * x1.w); }
            const float rstd = rsqrtf(wave_sum(s2) * (1.f / DM) + EPS);
            asm volatile("" ::: "memory");
#pragma unroll
            for (int j = 0; j < 8; ++j) { const f32x4 h = xv[rr][j] * rstd * PAR[1024 + lane + 64 * j] * PAR[1536 + lane + 64 * j] + PAR[2048 + lane + 64 * j];
                xv[rr][j] = h; hr[64 * j] = fp8x4(h.x, h.y, h.z, h.w); }
            asm volatile("" ::: "memory");
        }
        if (VAR == 1) continue;
        pg8::f32x4 acc[3] = {{0.f, 0.f, 0.f, 0.f}, {0.f, 0.f, 0.f, 0.f}, {0.f, 0.f, 0.f, 0.f}};
#pragma unroll 1
        for (int half = 0; half < 2; ++half) {
            bf16x8 bh[4][3], bl[4][3];
#pragma unroll
            for (int ks = 0; ks < 4; ++ks)
#pragma unroll
                for (int nt = 0; nt < 3; ++nt) { const size_t bo = (size_t)(nt * 16 + (lane & 15)) * DM + 1024 * half + 128 * w + 32 * ks + 8 * (lane >> 4);
                    bh[ks][nt] = *(const bf16x8*)(RWH + bo); bl[ks][nt] = *(const bf16x8*)(RWL + bo); }
            __syncthreads();
#pragma unroll
            for (int rr = 0; rr < 2; ++rr)
#pragma unroll
                for (int j = 0; j < 4; ++j) *(LAS f32x4*)(AH + (2 * w + rr) * P6_AHLD + 256 * j + 4 * lane) = half ? xv[rr][4 + j] : xv[rr][j];
            LDS_WAIT(); __syncthreads();
#pragma unroll
            for (int ks = 0; ks < (VAR == 4 ? 0 : 4); ++ks) {
                const int kh = 128 * w + 32 * ks + 8 * (lane >> 4); const LAS float* ap = AH + (lane & 15) * P6_AHLD + kh;
                const f32x4 a0 = *(const LAS f32x4*)ap, a1 = *(const LAS f32x4*)(ap + 4); bf16x8 ahi, alo; split8(a0, a1, ahi, alo);
#pragma unroll
                for (int nt = 0; nt < 3; ++nt) {
                    acc[nt] = __builtin_amdgcn_mfma_f32_16x16x32_bf16(ahi, bh[ks][nt], acc[nt], 0, 0, 0);
                    acc[nt] = __builtin_amdgcn_mfma_f32_16x16x32_bf16(alo, bh[ks][nt], acc[nt], 0, 0, 0);
                    acc[nt] = __builtin_amdgcn_mfma_f32_16x16x32_bf16(ahi, bl[ks][nt], acc[nt], 0, 0, 0); }
            }
        }
#pragma unroll
        for (int nt = 0; nt < 3; ++nt)
#pragma unroll
            for (int r = 0; r < 4; ++r) RED[w * 768 + (nt * 4 + r) * 64 + lane] = acc[nt][r];
        LDS_WAIT(); __syncthreads();
        for (int idx = F.tid; idx < 768; idx += NWAVES * 64) { float s = 0.f;
#pragma unroll
            for (int ww = 0; ww < NWAVES; ++ww) s += RED[ww * 768 + idx];
            const int nt = idx >> 8, r = (idx >> 6) & 3, l = idx & 63; LG[(4 * (l >> 4) + r) * 48 + nt * 16 + (l & 15)] = s; }
        LDS_WAIT(); __syncthreads();
        {
            const int r = 2 * w + (lane & 1); float lg[36];
#pragma unroll
            for (int o = 0; o < 36; ++o) lg[o] = LG[r * 48 + o] + (o < 4 ? rcb[o] : rfb[o - 4]);
            int g = 0; float mx = lg[0];
#pragma unroll
            for (int j = 1; j < 4; ++j) if (lg[j] > mx) { mx = lg[j]; g = j; }
            float den = 0.f;
#pragma unroll
            for (int j = 0; j < 4; ++j) den += expf(lg[j] - mx);
            const float gprob = 1.f / den;
            float f[8];
#pragma unroll
            for (int i = 0; i < 8; ++i) f[i] = g == 0 ? lg[4 + i] : g == 1 ? lg[12 + i] : g == 2 ? lg[20 + i] : lg[28 + i];
            int i0 = 0; float v0 = f[0];
#pragma unroll
            for (int i = 1; i < 8; ++i) if (f[i] > v0) { v0 = f[i]; i0 = i; }
            int i1 = -1; float v1 = -3.0e38f;
#pragma unroll
            for (int i = 0; i < 8; ++i) if (i != i0 && f[i] > v1) { v1 = f[i]; i1 = i; }
            const float e1 = expf(v1 - v0); const float w0 = gprob / (1.f + e1), w1 = gprob * e1 / (1.f + e1);
            if (VAR == 3) { if (lane == 0) SW[2 * (pass * 16 + r)] = w0 + w1 + (float)(g + i0 + i1); } else
            if (lane < 4) { const int slot = lane >> 1, row = pass * 16 + r, e = g * 8 + (slot ? i1 : i0);
                const int es = e * NSUB + (int)(blockIdx.x & (NSUB - 1));
                const int pos = (int)atomicAdd((unsigned*)(F.ws + WS_CTL) + F.cnt_off + 64 * es, 1u);
                list[(size_t)es * SUBCAP + pos] = row; SE[2 * row + slot] = es; SPOS[2 * row + slot] = pos; SW[2 * row + slot] = slot ? w1 : w0; }
        }
    }
}
__device__ __forceinline__ void p9_final(Frame& F) {
    moe_tables(F);
    const LAS int* ts = (const LAS int*)(F.lds + LTAB_OFF) + 32; const LAS int* sb = LTAB_SB(F.lds);
    const float* wpost = F.in[14]; const float* mod = (const float*)(F.ws + WS_MOD); const bf16* Ys = (const bf16*)(F.ws + WS_YS);
    const int* SE = (const int*)(F.ws + WS_SLOT); const int* SPOS = SE + 2 * T; const float* SW = (const float*)(SPOS + 2 * T);
    const int lane = F.lane;
    for (int row = F.gw; row < T; row += F.NGW) {
        const int b = row >> 12;
        const int es0 = SE[2 * row], es1 = SE[2 * row + 1];
        const int r0 = ts[es0 >> 4] * 256 + sb[(es0 >> 4) * 17 + (es0 & 15)] + SPOS[2 * row], r1 = ts[es1 >> 4] * 256 + sb[(es1 >> 4) * 17 + (es1 & 15)] + SPOS[2 * row + 1]; const float w0 = SW[2 * row], w1 = SW[2 * row + 1];
        const uint2* y0 = (const uint2*)(Ys + (size_t)r0 * DM) + lane; const uint2* y1 = (const uint2*)(Ys + (size_t)r1 * DM) + lane;
        f32x4* outr = (f32x4*)(F.out + (size_t)row * DM) + lane; const f32x4* g2 = (const f32x4*)(mod + (size_t)b * 6 * DM + 5 * DM) + lane;
        f32x4 v[8]; float ss = 0.f;
#pragma unroll
        for (int j = 0; j < 8; ++j) { const uint2 a = y0[64 * j], c = y1[64 * j]; v[j] = bf4(a.x, a.y) * w0 + bf4(c.x, c.y) * w1; ss += (v[j].x * v[j].x + v[j].y * v[j].y) + (v[j].z * v[j].z + v[j].w * v[j].w); }
        const float rstd = rsqrtf(wave_sum(ss) * (1.f / DM) + EPS);
#pragma unroll
        for (int j = 0; j < 8; ++j) outr[64 * j] = outr[64 * j] + g2[64 * j] * (v[j] * rstd * ((const f32x4*)wpost)[lane + 64 * j]);
    }
}
__global__ void __launch_bounds__(NWAVES * 64, 2) mega_fwd(Args args) {
    extern __shared__ __attribute__((aligned(16))) unsigned char lds[];
    Frame F;
    F.lds = (LAS unsigned char*)lds; F.ldsg = (char*)lds;
    F.MISC = (volatile LAS unsigned*)(F.lds + MISC_OFF);
    F.tid = threadIdx.x; F.lane = F.tid & 63; F.wave = __builtin_amdgcn_readfirstlane(F.tid >> 6);
    F.G = gridDim.x; F.gw = blockIdx.x * NWAVES + F.wave; F.NGW = F.G * NWAVES;
    F.cnt_off = args.cnt_off;
    F.ws = args.ws; F.out = args.out; F.ctl = (gu32*)(args.ws + WS_CTL);
#pragma unroll
    for (int i = 0; i < 22; ++i) F.in[i] = args.in[i];
    for (int u = F.tid; u < (LDS_BYTES - LDSCTL_OFF) / 4; u += NWAVES * 64) ((LAS unsigned*)(F.lds + LDSCTL_OFF))[u] = 0u;
    __syncthreads();
    XcdBarrier bar = xcd_barrier_post((unsigned*)(F.ctl + CW_BAR), F.MISC + 8);
#ifdef SW_ID
    if (blockIdx.x == 0 && threadIdx.x == 0) sw_acc_ = 0ull;
#endif
    const int lo = args.ph_lo, hi = args.ph_hi;
#define IN(k) (lo <= (k) && (k) < hi)
#define BOTH(k) (IN(k) && IN((k) + 1))
#define GRID_BAR() xcd_barrier(bar)
#define REFRESH() do { int t_ = threadIdx.x; asm volatile("" : "+v"(t_)); F.tid = t_; F.lane = t_ & 63; F.wave = __builtin_amdgcn_readfirstlane(t_ >> 6); F.gw = blockIdx.x * NWAVES + F.wave; } while (0)
#ifdef TS_PHASE
    unsigned long long ts0_ = 0, ts1_ = 0;
#define TS_BEG(k) do { if ((k) == TS_PHASE) ts0_ = __builtin_amdgcn_s_memrealtime(); if ((k) == TS_PHASE + TS_SPAN) ts1_ = __builtin_amdgcn_s_memrealtime(); } while (0)
#else
#define TS_BEG(k) do {} while (0)
#endif
    if (IN(0)) { REFRESH(); TS_BEG(0); p0_prologue<false>(F); if (BOTH(0)) GRID_BAR(); }
    if (IN(1)) { REFRESH(); TS_BEG(1); p1_prenorm(F); if (BOTH(1)) GRID_BAR(); }
    if (IN(2)) { REFRESH(); TS_BEG(2);
        const int NG2 = (F.G == 256) ? 224 : F.G;
        if ((int)blockIdx.x < NG2) {
            pg8::Gemm g{(const bf16*)(F.ws + WS_HB), (const bf16*)(F.ws + WS_WIN), T, INCM, DM}; pg8::StaticOrder S; S.init(T, INCM, NG2, (int)blockIdx.x);
            EpiHeads E{(bf16*)(F.ws + WS_QKV), (const float*)(F.ws + WS_CS), F.in[9], F.in[10], F.lds};
            pg8::gemm_phase<EpiHeads, pg8::StaticOrder, true, true, pg8::IdentRows, 1>(F.lds + RING_OFF, g, S, E);
            if (F.tid == 0) __hip_atomic_fetch_add(F.ctl + CW_DONE + 64 * 2, 1u, RLX_AGENT);
        } else filler(F, 2, 1, (unsigned)NG2, 0u, (unsigned)N_CONV_BI);
        if (BOTH(2)) GRID_BAR();
    }
    if (IN(3)) { REFRESH(); TS_BEG(3); p3_phase(F); if (BOTH(3)) GRID_BAR(); }
    if (IN(4)) { REFRESH(); TS_BEG(4); p3b_scan(F); if (BOTH(4)) GRID_BAR(); }
    if (IN(5)) { REFRESH(); TS_BEG(5); p4_phase(F); filler(F, 5, 0, (unsigned)F.G, (unsigned)(F.G - F.G / 8), (unsigned)N_CONV_BI); if (BOTH(5)) GRID_BAR(); }
    if (IN(6)) { REFRESH(); TS_BEG(6);
        pg8::Gemm g{(const bf16*)(F.ws + WS_CAT), (const bf16*)(F.ws + WS_WOUT), T, DM, DM}; pg8::StaticOrder S; S.init(T, DM, F.G, (int)blockIdx.x);
        EpiPlain E{(bf16*)(F.ws + WS_YB), DM, 8};
        pg8::gemm_phase<EpiPlain, pg8::StaticOrder, true, true>(F.lds + RING_OFF, g, S, E);
        if (BOTH(6)) GRID_BAR();
    }
#ifdef PROBE_VARIANTS
    if (lo == 11) p6_phase<1>(F);
    if (lo == 12) p6_phase<2>(F);
    if (lo == 13) p6_phase<3>(F);
    if (lo == 14) p6_phase<4>(F);
#endif
    if (IN(7)) { REFRESH(); TS_BEG(7); p6_phase<0>(F); filler(F, 7, 2, 0u, 0u, (unsigned)N_CONV_BI); if (BOTH(7)) GRID_BAR(); }
    if (IN(8)) { REFRESH(); TS_BEG(8);
        moe_tables(F);
        pg8::Gemm g{(const bf16*)(F.ws + WS_HB), (const bf16*)(F.ws + WS_W13), PADROWS, NE * 1024, DM};
        GroupedOrder<4> S; S.init((const LAS int*)(F.lds + LTAB_OFF) + 32, F.G, (int)blockIdx.x);
        EpiSwiglu E{(unsigned char*)(F.ws + WS_GB)}; GatherRows R{(const int*)(F.ws + WS_LIST), (const LAS int*)(F.lds + LTAB_OFF), LTAB_SB(F.lds)};
        pg8::gemm_phase<EpiSwiglu, GroupedOrder<4>, true, true, GatherRows, 1>(F.lds + RING_OFF, g, S, E, R);
        if (BOTH(8)) GRID_BAR();
    }
    if (IN(9)) { REFRESH(); TS_BEG(9);
        moe_tables(F);
        pg8::Gemm g{(const bf16*)(F.ws + WS_GB), (const bf16*)(F.ws + WS_W2), PADROWS, NE * 2048, DE};
        GroupedOrder<8> S; S.init((const LAS int*)(F.lds + LTAB_OFF) + 32, F.G, (int)blockIdx.x);
        EpiPlain E{(bf16*)(F.ws + WS_YS), DM, 8};
        pg8::gemm_phase<EpiPlain, GroupedOrder<8>, true, true, pg8::IdentRows, 1>(F.lds + RING_OFF, g, S, E);
        if (BOTH(9)) GRID_BAR();
    }
    if (IN(10)) { REFRESH(); TS_BEG(10); p9_final(F); }
#ifdef SW_ID
    if (blockIdx.x == 0 && threadIdx.x == 0) { const unsigned long long te = __builtin_amdgcn_s_memrealtime(), want = 4ull * sw_acc_;
        while (__builtin_amdgcn_s_memrealtime() - te < want) __builtin_amdgcn_s_sleep(8); }
#endif
#ifdef TS_PHASE
    TS_BEG(11);
    if (blockIdx.x == 0 && threadIdx.x == 0) { const unsigned long long te = __builtin_amdgcn_s_memrealtime(), want = 4ull * (ts1_ - ts0_);
        while (__builtin_amdgcn_s_memrealtime() - te < want) __builtin_amdgcn_s_sleep(8); }
#endif
#undef IN
#undef BOTH
}

__global__ void k_adapt_proj(const bf16* __restrict__ qkv, const float* __restrict__ zb, float* __restrict__ proj) {
    const size_t i = (size_t)blockIdx.x * blockDim.x + threadIdx.x;
    if (i >= (size_t)T * INC) return;
    const int tok = (int)(i / INC), c = (int)(i % INC);
    if (c >= INCM) { proj[i] = zb[(size_t)tok * 8 + (c - INCM)]; return; }
    const int type = c >> 10, hh = (c & 1023) >> 7, d = c & 127, b = tok >> 12, s = tok & 4095;
    const unsigned v = qkv[(size_t)type * TSZ + ((size_t)((b * 8 + hh) * SEQ + s)) * HD + d];
    proj[i] = __uint_as_float(v << 16);
}

__global__ void k_adapt_cat(const bf16* __restrict__ catb, float* __restrict__ cat) {
    const size_t i = (size_t)blockIdx.x * blockDim.x + threadIdx.x;
    if (i < (size_t)T * DM) cat[i] = __uint_as_float((unsigned)catb[i] << 16);
}
extern "C" void kernel_launch(void* const* d_in, const int* in_sizes, int n_in, void* d_out, int out_size, void* d_ws, size_t ws_size, hipStream_t stream) {
    static int grid = 0;
    if (grid == 0) {
        int dev = 0, cus = 0, per_cu = 0;
        (void)hipGetDevice(&dev); (void)hipDeviceGetAttribute(&cus, hipDeviceAttributeMultiprocessorCount, dev);
        (void)hipFuncSetAttribute((const void*)mega_fwd, hipFuncAttributeMaxDynamicSharedMemorySize, LDS_BYTES);
        (void)hipOccupancyMaxActiveBlocksPerMultiprocessor(&per_cu, (const void*)mega_fwd, NWAVES * 64, LDS_BYTES);
        (void)hipGetLastError();
        if (per_cu < 1) { fprintf(stderr, "kernel_launch: occupancy query says %d blocks/CU\n", per_cu); per_cu = 1; }
        grid = cus > 0 ? cus : 256;
        if (ws_size < WS_END) fprintf(stderr, "kernel_launch: workspace too small (%zu < %zu)\n", ws_size, (size_t)WS_END);
    }
    (void)hipMemsetAsync((char*)d_ws + WS_CTL, 0, CTL_ZERO_BYTES, stream);
    Args a{};
    for (int i = 0; i < 22; ++i) a.in[i] = (const float*)d_in[i];
    a.out = (float*)d_out; a.ws = (unsigned char*)d_ws; a.ph_lo = 0; a.ph_hi = 11; a.cnt_off = CW_CNT;
    hipLaunchKernelGGL(mega_fwd, dim3(grid), dim3(NWAVES * 64), LDS_BYTES, stream, a);
}
```

```cpp
#include <hip/hip_runtime.h>
#include <stdint.h>
#include <cstdio>

constexpr int DM = 2048, NB = 2, SEQ = 4096, T = NB * SEQ;
constexpr int HD = 128, NH = 8;
constexpr int INC = 7176, INCM = 7168;
constexpr int NE = 32, DE = 512;
constexpr float EPS = 1e-6f;
#ifdef SW_ID
__device__ unsigned long long sw_acc_ = 0ull, sw_t0_ = 0ull;
#define SW_BEG(id) do { if ((id) == SW_ID && blockIdx.x == 0 && threadIdx.x == 0) sw_t0_ = __builtin_amdgcn_s_memrealtime(); } while (0)
#define SW_END(id) do { if ((id) == SW_ID && blockIdx.x == 0 && threadIdx.x == 0) sw_acc_ += __builtin_amdgcn_s_memrealtime() - sw_t0_; } while (0)
#else
#define SW_BEG(id) do {} while (0)
#define SW_END(id) do {} while (0)
#endif
#define GAS __attribute__((address_space(1)))
#define LAS __attribute__((address_space(3)))
typedef unsigned short bf16;
typedef unsigned v4u __attribute__((ext_vector_type(4)));
typedef float f32x4 __attribute__((ext_vector_type(4)));
typedef short bf16x8 __attribute__((ext_vector_type(8)));
typedef GAS unsigned gu32;
typedef GAS unsigned long long gu64;
#define RLX_AGENT __ATOMIC_RELAXED, __HIP_MEMORY_SCOPE_AGENT
#define LDS_WAIT() asm volatile("s_waitcnt lgkmcnt(0)" ::: "memory")
#define VM_WAIT() asm volatile("s_waitcnt vmcnt(0)" ::: "memory")
__device__ __forceinline__ unsigned long long rt() { return __builtin_amdgcn_s_memrealtime(); }
__device__ __forceinline__ unsigned f2bf(float f) { unsigned u = __builtin_bit_cast(unsigned, f); return (u + 0x7fffu + ((u >> 16) & 1u)) >> 16; }
__device__ __forceinline__ unsigned pk2(float lo, float hi) { return f2bf(lo) | (f2bf(hi) << 16); }

#define XB_TMO      128
#define XB_XCNT(j)  (256  + 64 * (j))
#define XB_XSUB(j)  (1280 + 64 * (j))
#define XB_XGEN(j)  (2304 + 64 * (j))
#define XB_TOP      3328
#define XB_TOPGEN   3392
#define XCD_BAR_WORDS 3456
#define XB_SPIN_CAP (1u << 18)

__device__ __forceinline__ unsigned xb_ld(unsigned* p)              { return __hip_atomic_load(p, __ATOMIC_RELAXED, __HIP_MEMORY_SCOPE_AGENT); }
__device__ __forceinline__ unsigned xb_add(unsigned* p, unsigned v) { return __hip_atomic_fetch_add(p, v, __ATOMIC_RELAXED, __HIP_MEMORY_SCOPE_AGENT); }
__device__ __forceinline__ unsigned xb_xcc_id() { return (unsigned)__builtin_amdgcn_s_getreg((3 << 11) | 20) & 0xFu; }
#define XB_SPIN(cond, bar) do { unsigned _sp = 0; while (cond) { __builtin_amdgcn_s_sleep(1); \
    if ((++_sp & 255u) == 0u) { if (xb_ld(&(bar)[XB_TMO])) break; if (_sp > XB_SPIN_CAP) { atomicAdd(&(bar)[XB_TMO], 1u); break; } } } } while (0)

struct XcdBarrier {
    unsigned* bar; unsigned x;
    volatile LAS unsigned* st;
};

__device__ __forceinline__ XcdBarrier xcd_barrier_post(unsigned* bar, volatile LAS unsigned* st) {
    XcdBarrier b; b.bar = bar; b.x = xb_xcc_id(); b.st = st;
    if (threadIdx.x == 0) (void)xb_add(&bar[XB_XCNT(b.x)], 1u);
    return b;
}
__device__ __forceinline__ void xcd_barrier_complete(unsigned* bar, unsigned x, unsigned& nloc, unsigned& nx) {
    const unsigned G = gridDim.x * gridDim.y * gridDim.z;
    unsigned sum, cnt, mine, sp = 0u;
    for (;;) {
        sum = 0u; cnt = 0u; mine = 0u;
#pragma unroll
        for (unsigned j = 0; j < 16; ++j) { const unsigned c = xb_ld(&bar[XB_XCNT(j)]); sum += c; cnt += (c > 0u) ? 1u : 0u; mine = (j == x) ? c : mine; }
        if (sum == G) break;
        __builtin_amdgcn_s_sleep(1);
        if ((++sp & 255u) == 0u) { if (xb_ld(&bar[XB_TMO])) break; if (sp > XB_SPIN_CAP) { atomicAdd(&bar[XB_TMO], 1u); break; } }
    }
    nloc = mine > 0u ? mine : 1u; nx = cnt > 0u ? cnt : 1u;
}

__device__ __forceinline__ void xcd_barrier(const XcdBarrier& b) {
    asm volatile("s_waitcnt vmcnt(0)" ::: "memory");
    __syncthreads();
    if (threadIdx.x == 0) {
        unsigned* bar = b.bar;
        __builtin_amdgcn_s_waitcnt(0);
        unsigned nloc = b.st[0], nx = b.st[1];
        if (nloc == 0u) { xcd_barrier_complete(bar, b.x, nloc, nx); b.st[0] = nloc; b.st[1] = nx; }
        const unsigned old = xb_add(&bar[XB_XSUB(b.x)], 1u);
        const unsigned gen = old / nloc;
        if (old + 1u == (gen + 1u) * nloc) {
            __builtin_amdgcn_fence(__ATOMIC_RELEASE, "agent");
            asm volatile("s_waitcnt vmcnt(0)" ::: "memory");
            const unsigned og = xb_add(&bar[XB_TOP], 1u);
            const unsigned tg = og / nx;
            if (og + 1u == (tg + 1u) * nx) xb_add(&bar[XB_TOPGEN], 1u);
            else XB_SPIN(xb_ld(&bar[XB_TOPGEN]) == tg, bar);
            __builtin_amdgcn_fence(__ATOMIC_ACQUIRE, "agent");
            xb_add(&bar[XB_XGEN(b.x)], 1u);
            asm volatile("s_waitcnt vmcnt(0)" ::: "memory");
        } else {
            XB_SPIN(xb_ld(&bar[XB_XGEN(b.x)]) == gen, bar);
            __builtin_amdgcn_fence(__ATOMIC_ACQUIRE, "agent");
            asm volatile("s_waitcnt vmcnt(0)" ::: "memory");
        }
    }
    __syncthreads();
}
namespace pg8 {
#define PG8_LAS __attribute__((address_space(3)))
typedef unsigned short bf16_t;
typedef short bf16x8 __attribute__((ext_vector_type(8)));
typedef float f32x4 __attribute__((ext_vector_type(4)));
typedef unsigned u32x4 __attribute__((ext_vector_type(4)));
constexpr int BM = 256, BK = 64, HALF = 128, HTB = HALF * BK * 2  , STAGE_BYTES = 8 * HTB, NXCD = 8, WGM = 8;

__host__ __device__ __forceinline__ int lds_byte(int r, int c) { const int st = (r >> 4) * 2 + (c >> 5), rr = r & 15, cc = c & 31, ob = rr * 64 + cc * 2; return st * 1024 + (ob ^ (((ob >> 9) & 1) << 5)); }
__host__ __device__ __forceinline__ void stage_rc(int b, int& R, int& C) { const int st = b / 1024, sb = b % 1024, swz = sb ^ (((sb >> 9) & 1) << 5); R = (st >> 1) * 16 + swz / 64; C = (st & 1) * 32 + (swz % 64) / 2; }
__host__ __device__ __forceinline__ int perm32(int rho) { const int n = rho >> 4, i = rho & 15; return 8 * (i >> 2) + 4 * n + (i & 3); }

struct Unit { int pm, pn; };
struct Gemm { const bf16_t* A; const bf16_t* Bt; int M, N, K; };

struct StaticOrder {
    typedef Unit unit_t;
    int nM, nN, nwg, G, c;
    __host__ __device__ void init(int M, int N, int G_, int c_) { nM = M / BM; nN = N / BM; nwg = nM * nN; G = G_; c = c_; }
    __host__ __device__ bool next(int i, Unit& u) const {
        const long L = (long)i * G + c; if (L >= nwg) return false;
        int wgid = (int)L; { const int q = nwg / NXCD, r = nwg % NXCD, xcd = wgid % NXCD, off = wgid / NXCD; wgid = (xcd < r ? xcd * (q + 1) : r * (q + 1) + (xcd - r) * q) + off; }
        const int nig = WGM * nN, gid = wgid / nig, fm = gid * WGM, gsz = (nM - fm) < WGM ? (nM - fm) : WGM;
        u.pm = fm + ((wgid % nig) % gsz); u.pn = (wgid % nig) / gsz; return true;
    }
    __device__ __forceinline__ void a_ready(const Unit&) const {}
    __device__ __forceinline__ void done(const Unit&) const {}
};

__device__ __forceinline__ unsigned cvt_pk_bf16(float lo, float hi) { unsigned r; asm volatile("v_cvt_pk_bf16_f32 %0, %1, %2" : "=v"(r) : "v"(lo), "v"(hi)); return r; }
typedef float f32x2 __attribute__((ext_vector_type(2)));
__device__ __forceinline__ f32x2 gelu_pk(f32x2 v) {
    const f32x2 av = __builtin_elementwise_abs(v), d = av * 0.2316418882f + 1.0f;
    f32x2 t; t.x = __builtin_amdgcn_rcpf(d.x); t.y = __builtin_amdgcn_rcpf(d.y);
    f32x2 q = t * 0.5307027145f + (-0.7265760135f); q = q * t + 0.7107068705f; q = q * t + (-0.142248368f); q = q * t + 0.127414796f; q = q * t;
    const f32x2 s = (v * v) * (-0.72134752044f);
    f32x2 e; e.x = __builtin_amdgcn_exp2f(s.x); e.y = __builtin_amdgcn_exp2f(s.y);
    const f32x2 m = v * (q * e), r = v - m;
    f32x2 o; o.x = v.x < 0.f ? m.x : r.x; o.y = v.y < 0.f ? m.y : r.y; return o;
}

template <int ACT  > struct EpiBf16 {
    static constexpr bool PERM = true, AFTER_DRAIN = false; static_assert(ACT == 0 || ACT == 1, "EpiBf16: ACT is 0 (none) or 1 (gelu_pk)");
    bf16_t* O; int ldc; const float* bias; int split_cols; size_t split_stride; float scale0;
    __device__ __forceinline__ void operator()(const f32x4 (&acc)[2][2][4][2], const Unit& u, int wr, int wc, int fr, int fq) const {
        const int row0 = u.pm * BM + wr * 64 + fr; int colt = u.pn * BM; bf16_t* base = O;
        float sc = 1.f; if (split_cols) { const int t = colt / split_cols; base += (size_t)t * split_stride; colt -= t * split_cols; if (t == 0) sc = scale0; }
        const int col0 = colt + wc * 32 + 8 * fq, bcol0 = u.pn * BM + wc * 32 + 8 * fq;
        f32x4 bv[2][2];
#pragma unroll
        for (int bj = 0; bj < 2; ++bj)
#pragma unroll
            for (int n = 0; n < 2; ++n) bv[bj][n] = bias ? *(const f32x4*)(bias + bcol0 + bj * HALF + 4 * n) : (f32x4){0.f, 0.f, 0.f, 0.f};
#pragma unroll
        for (int ai = 0; ai < 2; ++ai)
#pragma unroll
            for (int m = 0; m < 4; ++m) { bf16_t* rowp = base + (size_t)(row0 + ai * HALF + m * 16) * ldc + col0;
#pragma unroll
                for (int bj = 0; bj < 2; ++bj) { f32x4 v0 = acc[ai][bj][m][0] + bv[bj][0], v1 = acc[ai][bj][m][1] + bv[bj][1];
                    if (ACT == 1) { f32x2 a = gelu_pk((f32x2){v0[0], v0[1]}), b = gelu_pk((f32x2){v0[2], v0[3]}), c = gelu_pk((f32x2){v1[0], v1[1]}), d = gelu_pk((f32x2){v1[2], v1[3]});
                        v0 = (f32x4){a.x, a.y, b.x, b.y}; v1 = (f32x4){c.x, c.y, d.x, d.y}; }
                    v0 = v0 * sc; v1 = v1 * sc; u32x4 w; w.x = cvt_pk_bf16(v0[0], v0[1]); w.y = cvt_pk_bf16(v0[2], v0[3]); w.z = cvt_pk_bf16(v1[0], v1[1]); w.w = cvt_pk_bf16(v1[2], v1[3]);
                    *(u32x4*)(rowp + bj * HALF) = w; } }
    }
};
struct IdentRows { template <class U> __device__ __forceinline__ unsigned row(const U& u, int r) const { return (unsigned)(u.pm * BM + r); } };
typedef int v8i32 __attribute__((ext_vector_type(8))); typedef int v4i32 __attribute__((ext_vector_type(4)));
__device__ __forceinline__ v8i32 cat32(bf16x8 lo, bf16x8 hi) { const v4i32 a = __builtin_bit_cast(v4i32, lo), b = __builtin_bit_cast(v4i32, hi); return __builtin_shufflevector(a, b, 0, 1, 2, 3, 4, 5, 6, 7); }
template <class Epi, class Sched, bool ALIGN_EPI = false, bool SP2 = false, class RowMap = IdentRows, int EB = 2>
__device__ __forceinline__ void gemm_phase(PG8_LAS unsigned char* lds, const Gemm g, const Sched& S, const Epi& E, const RowMap RM = RowMap()) {
    typedef typename Sched::unit_t Unit;
    const int tid = threadIdx.x, wid = __builtin_amdgcn_readfirstlane(tid >> 6), lane = tid & 63, wr = wid >> 2, wc = wid & 3, fr = lane & 15, fq = lane >> 4;
    int K = g.K; asm volatile("" : "+s"(K)); const int nt = K * EB / (BK * 2);
    unsigned voffB[2]; int RA[2], CA[2];
#pragma unroll
    for (int i = 0; i < 2; ++i) { int R, C; stage_rc(tid * 16 + i * 8192, R, C); const int Rb = Epi::PERM ? ((R & ~31) + perm32(R & 31)) : R;
        RA[i] = R; CA[i] = C; voffB[i] = (unsigned)(Rb * K * EB + C * 2); }
    unsigned ao[2][2], an[2][2];
#define PG8_AOFF(dst, U) do { _Pragma("unroll") for (int h_ = 0; h_ < 2; ++h_) _Pragma("unroll") for (int i_ = 0; i_ < 2; ++i_) { \
        dst[h_][i_] = RM.row((U), h_ * HALF + RA[i_]) * (unsigned)(K * EB) + (unsigned)(CA[i_] * 2); } } while (0)
    const size_t kstep = (size_t)(BK * 2);
    const size_t hstep = (size_t)HALF * K * EB;
    const size_t tstep = 2 * hstep;
    const unsigned ldsw = (unsigned)wid * 1024u;
    const int aoff = lds_byte(wr * 64 + fr, fq * 8), boff = lds_byte(wc * 32 + fr, fq * 8);
#define PG8_SA(b, h) (((b) * 2 + (h)) * HTB)
#define PG8_SB(b, h) ((4 + (b) * 2 + (h)) * HTB)
#define PG8_STAGE(bufoff, gbase, voff) do { _Pragma("unroll") for (int _i = 0; _i < 2; ++_i) \
        __builtin_amdgcn_global_load_lds((const unsigned*)((const char*)(gbase) + (voff)[_i]), (PG8_LAS unsigned*)(lds + (bufoff) + ldsw + _i * 8192), 16, 0, 0); } while (0)
#define PG8_STAGE_A(bufoff, kbase, off) do { _Pragma("unroll") for (int _i = 0; _i < 2; ++_i) \
        __builtin_amdgcn_global_load_lds((const unsigned*)((const char*)(kbase) + (off)[_i]), (PG8_LAS unsigned*)(lds + (bufoff) + ldsw + _i * 8192), 16, 0, 0); } while (0)
#define PG8_LDA(dst, b, h) do { _Pragma("unroll") for (int m = 0; m < 4; ++m) { if constexpr (EB == 1) dst##8[m] = cat32(*(const PG8_LAS bf16x8*)(lds + PG8_SA(b, h) + aoff + m * 2048), *(const PG8_LAS bf16x8*)(lds + PG8_SA(b, h) + aoff + m * 2048 + 1024)); \
        else { _Pragma("unroll") for (int k = 0; k < 2; ++k) dst[m][k] = *(const PG8_LAS bf16x8*)(lds + PG8_SA(b, h) + aoff + m * 2048 + k * 1024); } } } while (0)
#define PG8_LDB(dst, b, h) do { _Pragma("unroll") for (int n = 0; n < 2; ++n) { if constexpr (EB == 1) dst##8[n] = cat32(*(const PG8_LAS bf16x8*)(lds + PG8_SB(b, h) + boff + n * 2048), *(const PG8_LAS bf16x8*)(lds + PG8_SB(b, h) + boff + n * 2048 + 1024)); \
        else { _Pragma("unroll") for (int k = 0; k < 2; ++k) dst[n][k] = *(const PG8_LAS bf16x8*)(lds + PG8_SB(b, h) + boff + n * 2048 + k * 1024); } } } while (0)
#define PG8_MMA(ai, bj, At, Bt) do { __builtin_amdgcn_s_setprio(1); _Pragma("unroll") for (int m = 0; m < 4; ++m) _Pragma("unroll") for (int n = 0; n < 2; ++n) { \
        if constexpr (EB == 1) asm volatile("v_mfma_scale_f32_16x16x128_f8f6f4 %0, %1, %2, %0, %3, %4 op_sel_hi:[0,0,0]" : "+v"(acc[ai][bj][m][n]) : "v"(Bt##8[n]), "v"(At##8[m]), "v"(scw_), "v"(sca_)); \
        else { _Pragma("unroll") for (int k = 0; k < 2; ++k) acc[ai][bj][m][n] = __builtin_amdgcn_mfma_f32_16x16x32_bf16(Bt[n][k], At[m][k], acc[ai][bj][m][n], 0, 0, 0); } } \
        __builtin_amdgcn_s_setprio(0); } while (0)
#define PG8_WAIT_V(n) asm volatile("s_waitcnt vmcnt(" #n ")" ::: "memory")
#define PG8_WAIT_L(n) asm volatile("s_waitcnt lgkmcnt(" #n ")" ::: "memory")
#define PG8_BAR __builtin_amdgcn_s_barrier()
#define PG8_SCHED __builtin_amdgcn_sched_barrier(0)
    Unit cur, nxt; int ui = 0;
    if (!S.next(0, cur)) return;
    f32x4 acc[2][2][4][2];
#pragma unroll
    for (int a = 0; a < 2; ++a)
#pragma unroll
        for (int b = 0; b < 2; ++b)
#pragma unroll
            for (int m = 0; m < 4; ++m)
#pragma unroll
                for (int n = 0; n < 2; ++n) acc[a][b][m][n] = (f32x4){0.f, 0.f, 0.f, 0.f};
    int scw_ = 0x79797979, sca_ = 0x7F7F7F7F; asm volatile("" : "+v"(scw_), "+v"(sca_));
    bf16x8 At[4][2], B0[2][2], B1[2][2]; v8i32 At8[4], B08[2], B18[2];
    const char* const Ab = (const char*)g.A; const char* cB = (const char*)g.Bt + (size_t)cur.pn * tstep;
    PG8_AOFF(ao, cur);
    S.a_ready(cur);
    if constexpr (SP2) {
        PG8_STAGE(PG8_SB(0, 0), cB, voffB); PG8_STAGE(PG8_SB(0, 1), cB + hstep, voffB); PG8_STAGE_A(PG8_SA(0, 0), Ab, ao[0]); PG8_STAGE_A(PG8_SA(0, 1), Ab, ao[1]);
        if (wr == 1) PG8_BAR;
        PG8_WAIT_V(2); PG8_BAR;
        PG8_STAGE(PG8_SB(1, 0), cB + kstep, voffB); PG8_STAGE_A(PG8_SA(1, 0), Ab + kstep, ao[0]); PG8_STAGE(PG8_SB(1, 1), cB + hstep + kstep, voffB);
        PG8_WAIT_V(6); PG8_BAR;
    } else {
        PG8_STAGE(PG8_SB(0, 0), cB, voffB); PG8_STAGE_A(PG8_SA(0, 0), Ab, ao[0]); PG8_STAGE(PG8_SB(0, 1), cB + hstep, voffB); PG8_STAGE_A(PG8_SA(0, 1), Ab, ao[1]);
        if (wr == 1) PG8_BAR;
        PG8_WAIT_V(4); PG8_BAR;
        PG8_STAGE(PG8_SB(1, 0), cB + kstep, voffB); PG8_STAGE_A(PG8_SA(1, 0), Ab + kstep, ao[0]); PG8_STAGE(PG8_SB(1, 1), cB + hstep + kstep, voffB);
        PG8_WAIT_V(6); PG8_BAR;
    }
    for (;;) {
        const bool has_next = S.next(ui + 1, nxt);
        const char* nB = has_next ? (const char*)g.Bt + (size_t)nxt.pn * tstep : cB;
        if (has_next) { PG8_AOFF(an, nxt); } else { _Pragma("unroll") for (int h_ = 0; h_ < 2; ++h_) _Pragma("unroll") for (int i_ = 0; i_ < 2; ++i_) an[h_][i_] = ao[h_][i_]; }
        for (int t = 0; t < nt; t += 2) {
            const bool last = (t == nt - 2);
            const char* a1 = Ab + (size_t)(t + 1) * kstep;
            const char* a2 = last ? Ab : Ab + (size_t)(t + 2) * kstep; const char* b2 = last ? nB : cB + (size_t)(t + 2) * kstep;
            const char* a3 = a2 + kstep; const char* b3 = b2 + kstep;
            unsigned as[2][2];
#pragma unroll
            for (int h_ = 0; h_ < 2; ++h_)
#pragma unroll
                for (int i_ = 0; i_ < 2; ++i_) as[h_][i_] = last ? an[h_][i_] : ao[h_][i_];
            if (last && has_next) S.a_ready(nxt);
            if constexpr (SP2) {
            PG8_LDB(B0, 0, 0); PG8_LDB(B1, 0, 1); PG8_SCHED; PG8_LDA(At, 0, 0); PG8_STAGE_A(PG8_SA(1, 1), a1, ao[1]);
            PG8_WAIT_V(8); PG8_WAIT_L(0); PG8_BAR; PG8_MMA(0, 0, At, B0); PG8_MMA(0, 1, At, B1); PG8_BAR; PG8_SCHED;
            PG8_LDA(At, 0, 1); PG8_STAGE(PG8_SB(0, 0), b2, voffB); PG8_STAGE(PG8_SB(0, 1), b2 + hstep, voffB); PG8_STAGE_A(PG8_SA(0, 0), a2, as[0]);
            PG8_WAIT_V(8); PG8_WAIT_L(0); PG8_BAR; PG8_MMA(1, 0, At, B0); PG8_MMA(1, 1, At, B1); PG8_BAR; PG8_SCHED;
            PG8_LDB(B0, 1, 0); PG8_LDB(B1, 1, 1); PG8_SCHED; PG8_LDA(At, 1, 0); PG8_STAGE_A(PG8_SA(0, 1), a2, as[1]);
            PG8_WAIT_V(8); PG8_WAIT_L(0); PG8_BAR; PG8_MMA(0, 0, At, B0); PG8_MMA(0, 1, At, B1); PG8_BAR; PG8_SCHED;
            PG8_LDA(At, 1, 1); PG8_STAGE(PG8_SB(1, 0), b3, voffB); PG8_STAGE(PG8_SB(1, 1), b3 + hstep, voffB); PG8_STAGE_A(PG8_SA(1, 0), a3, as[0]);
            PG8_WAIT_V(8); PG8_WAIT_L(0); PG8_BAR; PG8_MMA(1, 0, At, B0); PG8_MMA(1, 1, At, B1); PG8_BAR; PG8_SCHED;
            } else {
            PG8_LDB(B0, 0, 0); PG8_SCHED; PG8_LDA(At, 0, 0); PG8_STAGE_A(PG8_SA(1, 1), a1, ao[1]);
            PG8_WAIT_L(8); PG8_BAR; PG8_WAIT_L(0); PG8_MMA(0, 0, At, B0); PG8_BAR; PG8_SCHED;
            PG8_LDB(B1, 0, 1); PG8_STAGE(PG8_SB(0, 0), b2, voffB);
            PG8_BAR; PG8_WAIT_L(0); PG8_MMA(0, 1, At, B1); PG8_BAR;
            PG8_LDA(At, 0, 1); PG8_STAGE_A(PG8_SA(0, 0), a2, as[0]);
            PG8_BAR; PG8_WAIT_L(0); PG8_MMA(1, 0, At, B0); PG8_BAR; PG8_SCHED;
            PG8_STAGE(PG8_SB(0, 1), b2 + hstep, voffB);
            PG8_WAIT_V(6); PG8_BAR; PG8_MMA(1, 1, At, B1); PG8_BAR;
            PG8_LDB(B0, 1, 0); PG8_SCHED; PG8_LDA(At, 1, 0); PG8_STAGE_A(PG8_SA(0, 1), a2, as[1]);
            PG8_WAIT_L(8); PG8_BAR; PG8_WAIT_L(0); PG8_MMA(0, 0, At, B0); PG8_BAR; PG8_SCHED;
            PG8_LDB(B1, 1, 1); PG8_STAGE(PG8_SB(1, 0), b3, voffB);
            PG8_BAR; PG8_WAIT_L(0); PG8_MMA(0, 1, At, B1); PG8_BAR;
            PG8_LDA(At, 1, 1); PG8_STAGE_A(PG8_SA(1, 0), a3, as[0]);
            PG8_BAR; PG8_WAIT_L(0); PG8_MMA(1, 0, At, B0); PG8_BAR; PG8_SCHED;
            PG8_STAGE(PG8_SB(1, 1), b3 + hstep, voffB);
            PG8_WAIT_V(6); PG8_BAR; PG8_MMA(1, 1, At, B1); PG8_BAR;
            }
        }
        if constexpr (EB == 1) asm volatile("s_nop 15\n\ts_nop 15" ::: "memory");
        if constexpr (ALIGN_EPI) { if (wr == 0) PG8_BAR; }
        if constexpr (!Epi::AFTER_DRAIN) { SW_BEG(11); E(acc, cur, wr, wc, fr, fq); S.done(cur); SW_END(11); }
        if (!has_next) break;
#pragma unroll
        for (int a = 0; a < 2; ++a)
#pragma unroll
            for (int b = 0; b < 2; ++b)
#pragma unroll
                for (int m = 0; m < 4; ++m)
#pragma unroll
                    for (int n = 0; n < 2; ++n) acc[a][b][m][n] = (f32x4){0.f, 0.f, 0.f, 0.f};
        cur = nxt; cB = nB; ++ui;
#pragma unroll
        for (int h_ = 0; h_ < 2; ++h_)
#pragma unroll
            for (int i_ = 0; i_ < 2; ++i_) ao[h_][i_] = an[h_][i_];
        if constexpr (ALIGN_EPI) { if (wr == 1) PG8_BAR; }
    }
    PG8_WAIT_V(0);
    if constexpr (!ALIGN_EPI) { if (wr == 0) PG8_BAR; }
    PG8_BAR;
    if constexpr (Epi::AFTER_DRAIN) { E.fused(acc, cur, wr, wc, fr, fq, lds, wid, lane); S.done(cur); }
#undef PG8_SA
#undef PG8_SB
#undef PG8_STAGE
#undef PG8_STAGE_A
#undef PG8_AOFF
#undef PG8_LDA
#undef PG8_LDB
#undef PG8_MMA
#undef PG8_WAIT_V
#undef PG8_WAIT_L
#undef PG8_BAR
#undef PG8_SCHED
}
}
constexpr int NWAVES = 8;
constexpr int RING_OFF = 0, RING_BYTES = 131072;
constexpr int LDSCTL_OFF = 150 * 1024, MISC_OFF = LDSCTL_OFF + 320;
constexpr int LDS_BYTES = 160 * 1024;
constexpr size_t MiB = 1u << 20;
constexpr size_t WS_CTL = 0, CTL_ZERO_BYTES = 1 * MiB;
constexpr size_t WS_MOD = 1 * MiB;
constexpr size_t WS_RWP = WS_MOD + 128 * 1024;
constexpr size_t WS_CS = 2 * MiB;
constexpr size_t WS_LOGF = 4 * MiB;
constexpr size_t WS_CB = WS_LOGF + 256 * 1024;
constexpr size_t WS_Z = WS_CB + 256 * 1024;
constexpr size_t WS_WIN = 6 * MiB;
constexpr size_t WS_WOUT = 34 * MiB;
constexpr size_t WS_HB = 42 * MiB;
constexpr size_t WS_QKV = 74 * MiB;
constexpr size_t TSZ = (size_t)16 * 4096 * 128;
constexpr size_t WS_FAST_END = 186 * MiB;
constexpr size_t WS_YB = 74 * MiB;
constexpr size_t WS_GB = 74 * MiB;
constexpr size_t WS_YS = 110 * MiB;
constexpr size_t WS_W13 = 266 * MiB;
constexpr size_t WS_W2 = 394 * MiB;
constexpr size_t WS_LIST = 458 * MiB;
constexpr size_t WS_SLOT = 459 * MiB;
constexpr size_t WS_END = 460 * MiB;
constexpr int ECAP = 8192, CW_CNT = 32768;
constexpr int CW_BAR = 4096;

struct Frame {
    LAS unsigned char* lds; char* ldsg;
    volatile LAS unsigned* MISC;
    gu32* ctl;
    int tid, lane, wave, G, gw, NGW, cnt_off;
    const float* in[22]; float* out; unsigned char* ws;
};
struct Args { const float* in[22]; float* out; unsigned char* ws; int ph_lo, ph_hi, cnt_off, pad; };

template <int CTRL> __device__ __forceinline__ float dppa(float v) { const int t = __builtin_amdgcn_update_dpp(0, __float_as_int(v), CTRL, 0xf, 0xf, true); return v + __int_as_float(t); }
__device__ __forceinline__ float row16_sum(float v) { v = dppa<0xB1>(v); v = dppa<0x4E>(v); v = dppa<0x141>(v); v = dppa<0x140>(v); return v; }
__device__ __forceinline__ float half32_sum(float v) { v = row16_sum(v); return v + __shfl_xor(v, 16); }
__device__ __forceinline__ float wave_sum(float v) {
    v = row16_sum(v);
    const float s0 = __int_as_float(__builtin_amdgcn_readlane(__float_as_int(v), 0)), s1 = __int_as_float(__builtin_amdgcn_readlane(__float_as_int(v), 16));
    const float s2 = __int_as_float(__builtin_amdgcn_readlane(__float_as_int(v), 32)), s3 = __int_as_float(__builtin_amdgcn_readlane(__float_as_int(v), 48));
    return (s0 + s1) + (s2 + s3);
}
__device__ __forceinline__ float silu_f(float v) { return v / (1.f + __expf(-v)); }
__device__ __forceinline__ unsigned fp8x4(float a, float b, float c, float d) { unsigned w = 0; w = __builtin_amdgcn_cvt_pk_fp8_f32(a, b, w, false); w = __builtin_amdgcn_cvt_pk_fp8_f32(c, d, w, true); return w; }

__device__ __forceinline__ void p0_mod(Frame& F) {
    const float* c = F.in[1]; const float* ada_w = F.in[2]; const float* ada_b = F.in[3];
    float* mod = (float*)(F.ws + WS_MOD);
    LAS float* ca = (LAS float*)(F.lds);
    LAS f32x4* red = (LAS f32x4*)(ca + 2 * DM);
    for (int i = F.tid; i < 2 * DM; i += NWAVES * 64) ca[i] = silu_f(c[i]);
    __syncthreads();
    const int rs = F.lane / 12, c4 = F.lane % 12;
    for (int cb = blockIdx.x; cb < 256; cb += F.G) {
        const int j0 = cb * 48;
        f32x4 a0 = {0.f, 0.f, 0.f, 0.f}, a1 = {0.f, 0.f, 0.f, 0.f};
        if (F.lane < 60) {
            const float* wp = ada_w + (size_t)(F.wave * 256) * (6 * DM) + j0 + 4 * c4;
#pragma unroll 1
            for (int i0 = 0; i0 < 52; i0 += 13) {
                f32x4 wv[13];
#pragma unroll
                for (int i = 0; i < 13; ++i) { const int kl = 5 * (i0 + i) + rs; wv[i] = kl < 256 ? *(const f32x4*)(wp + (size_t)kl * (6 * DM)) : (f32x4){0.f, 0.f, 0.f, 0.f}; }
#pragma unroll
                for (int i = 0; i < 13; ++i) { const int kl = 5 * (i0 + i) + rs; const int k = F.wave * 256 + (kl < 256 ? kl : 0); a0 += wv[i] * ca[k]; a1 += wv[i] * ca[DM + k]; }
            }
        }
        red[(F.wave * 64 + F.lane) * 2] = a0; red[(F.wave * 64 + F.lane) * 2 + 1] = a1;
        __syncthreads();
        if (F.tid < 96) { const int b = F.tid / 48, jj = F.tid % 48, cc = jj >> 2, el = jj & 3; float s = 0.f;
            for (int w = 0; w < NWAVES; ++w)
#pragma unroll
                for (int r = 0; r < 5; ++r) s += red[(w * 64 + r * 12 + cc) * 2 + b][el];
            mod[b * 6 * DM + j0 + jj] = s + ada_b[j0 + jj]; }
        __syncthreads();
    }
}
template <bool ROPE = false, bool FP8 = false>
__device__ __forceinline__ void tr_tile(const float* __restrict__ src, int ldn, int k0, int n0, bf16* __restrict__ dst, int ldk, int drow0, LAS float* scr, int lane) {
#pragma unroll 4
    for (int i = 0; i < 16; ++i) { const int kk = 4 * i + (lane >> 4);
        const f32x4 v = *(const f32x4*)(src + (size_t)(k0 + kk) * ldn + n0 + 4 * (lane & 15));
        LAS float* p = scr + kk * 65 + 4 * (lane & 15); p[0] = v.x; p[1] = v.y; p[2] = v.z; p[3] = v.w; }
    LDS_WAIT(); asm volatile("" ::: "memory");
    const int c = lane & 7;
#pragma unroll
    for (int jj = 0; jj < 8; ++jj) { const int n = (lane >> 3) + 8 * jj; const LAS float* s = scr + (8 * c) * 65 + n;
        v4u o; o.x = pk2(s[0], s[65]); o.y = pk2(s[130], s[195]); o.z = pk2(s[260], s[325]); o.w = pk2(s[390], s[455]);
        int drow = drow0 + n;
        if (ROPE) { const int d = (n0 & 127) + n; drow = drow0 + 32 * ((d >> 4) & 3) + 8 * ((d >> 2) & 3) + 4 * (d >> 6) + (d & 3); }
        if (FP8) { uint2 q; q.x = fp8x4(s[0] * 64.f, s[65] * 64.f, s[130] * 64.f, s[195] * 64.f); q.y = fp8x4(s[260] * 64.f, s[325] * 64.f, s[390] * 64.f, s[455] * 64.f);
                   *(uint2*)((unsigned char*)dst + (size_t)drow * ldk + k0 + 8 * c) = q; }
        else *(v4u*)(dst + (size_t)drow * ldk + k0 + 8 * c) = o; }
    LDS_WAIT(); asm volatile("" ::: "memory");
}
constexpr int CW_CONVQ = 2112, CW_DONE = 2176;
constexpr int I_E = 256 * NE, CONV_PER_WAVE = 2, N_CONV_BI = 3 * I_E / (NWAVES * CONV_PER_WAVE);
struct ConvTile { const float* src; unsigned char* dst; int ldn, ldk; };
__device__ __forceinline__ ConvTile conv_decode(Frame& F, int r) {
    ConvTile t;
    if (r < 2 * I_E) { const int which = r / I_E, rr = r % I_E, e = rr >> 8, q = rr & 255, kt = q >> 3, nt = q & 7;
        t.src = (which == 0 ? F.in[19] : F.in[20]) + (size_t)e * DM * DE + (size_t)(64 * kt) * DE + 64 * nt; t.ldn = DE;
        t.dst = (unsigned char*)(F.ws + WS_W13) + (size_t)(e * 1024 + (nt >> 1) * 256 + which * 128 + (nt & 1) * 64) * DM + 64 * kt; t.ldk = DM; return t; }
    r -= 2 * I_E;
    { const int e = r >> 8, q = r & 255, kt = q >> 5, nt = q & 31;
      t.src = F.in[21] + (size_t)e * DE * DM + (size_t)(64 * kt) * DM + 64 * nt; t.ldn = DM;
      t.dst = (unsigned char*)(F.ws + WS_W2) + (size_t)(e * 2048 + 64 * nt) * DE + 64 * kt; t.ldk = DE; }
    return t;
}
__device__ __forceinline__ void conv_load(const ConvTile& t, f32x4 (&v)[16], int lane) {
#pragma unroll
    for (int i = 0; i < 16; ++i) v[i] = *(const f32x4*)(t.src + (size_t)(4 * i + (lane >> 4)) * t.ldn + 4 * (lane & 15));
}
__device__ __forceinline__ void conv_store(const ConvTile& t, const f32x4 (&v)[16], LAS float* scr, int lane) {
#pragma unroll
    for (int i = 0; i < 16; ++i) { LAS float* p = scr + (4 * i + (lane >> 4)) * 65 + 4 * (lane & 15); p[0] = v[i].x; p[1] = v[i].y; p[2] = v[i].z; p[3] = v[i].w; }
    LDS_WAIT(); asm volatile("" ::: "memory");
    const int c = lane & 7;
#pragma unroll
    for (int jj = 0; jj < 8; ++jj) { const int n = (lane >> 3) + 8 * jj; const LAS float* s = scr + (8 * c) * 65 + n;
        uint2 o; o.x = fp8x4(s[0] * 64.f, s[65] * 64.f, s[130] * 64.f, s[195] * 64.f); o.y = fp8x4(s[260] * 64.f, s[325] * 64.f, s[390] * 64.f, s[455] * 64.f);
        *(uint2*)(t.dst + (size_t)n * t.ldk + 8 * c) = o; }
    LDS_WAIT(); asm volatile("" ::: "memory");
}
constexpr int N_CONV_13 = 2 * I_E / (NWAVES * CONV_PER_WAVE);
__device__ __forceinline__ unsigned conv_pull(Frame& F, unsigned qlimit) {
    return __hip_atomic_fetch_add(F.ctl + CW_CONVQ, 1u, RLX_AGENT);
}
__device__ __forceinline__ void filler(Frame& F, int ph, int mode, unsigned nfin, unsigned early, unsigned qlimit) {
    __syncthreads();
    LAS float* scr = (LAS float*)(F.lds) + F.wave * (64 * 65);
    unsigned nxt = 0xffffffffu;
    if (F.tid == 0) { bool go = true;
        if (mode == 0) go = __hip_atomic_fetch_add(F.ctl + CW_DONE + 64 * ph, 1u, RLX_AGENT) < early;
        if (mode == 1) go = __hip_atomic_load(F.ctl + CW_DONE + 64 * ph, RLX_AGENT) < nfin;
        if (go) nxt = conv_pull(F, qlimit); }
    for (;;) {
        if (F.tid == 0) F.MISC[1] = nxt;
        __syncthreads();
        const unsigned it = (unsigned)__builtin_amdgcn_readfirstlane((int)F.MISC[1]);
        __syncthreads();
        if (it >= (unsigned)N_CONV_BI) break;
        if (F.tid == 0) { const bool stop = mode != 2 && __hip_atomic_load(F.ctl + CW_DONE + 64 * ph, RLX_AGENT) >= nfin;
            nxt = stop ? 0xffffffffu : conv_pull(F, qlimit); }
        const int r0 = ((int)it * NWAVES + F.wave) * CONV_PER_WAVE;
        const ConvTile t0 = conv_decode(F, r0), t1 = conv_decode(F, r0 + 1);
        f32x4 va[16], vb[16];
        conv_load(t0, va, F.lane); conv_load(t1, vb, F.lane);
        conv_store(t0, va, scr, F.lane); conv_store(t1, vb, scr, F.lane);
    }
}
template <bool EXPERTS>
__device__ __forceinline__ void p0_prologue(Frame& F) {
    SW_BEG(30); p0_mod(F);
    __syncthreads(); SW_END(30); SW_BEG(31);
    LAS float* scr = (LAS float*)(F.lds) + F.wave * (64 * 65);
    bf16* WinT = (bf16*)(F.ws + WS_WIN); bf16* WoutT = (bf16*)(F.ws + WS_WOUT);
    constexpr int I_IN = 32 * 112, I_OUT = 32 * 32;
    constexpr int NIT = I_IN + I_OUT;
    for (int it = F.gw; it < NIT; it += F.NGW) {
        int r = it;
        if (r < I_IN) { const int nt = r % 112;
            if (nt < 32) tr_tile<true, true>(F.in[6], INC, 64 * (r / 112), 64 * nt, WinT, DM, 128 * (nt >> 1), scr, F.lane);
            else tr_tile<false, true>(F.in[6], INC, 64 * (r / 112), 64 * nt, WinT, DM, 64 * nt, scr, F.lane);
            continue; } r -= I_IN;
        if (r < I_OUT) { tr_tile<false>(F.in[12], DM, 64 * (r / 32), 64 * (r % 32), WoutT, DM, 64 * (r % 32), scr, F.lane); continue; } r -= I_OUT;
    }
    SW_END(31); SW_BEG(32);
    { bf16* rh = (bf16*)(F.ws + WS_RWP); bf16* rl = rh + 48 * DM; const float* rcw = F.in[15]; const float* rfw = F.in[17];
      for (int idx = blockIdx.x * (NWAVES * 64) + F.tid; idx < 48 * DM; idx += F.G * NWAVES * 64) {
          const int o = idx >> 11, k = idx & 2047; const float v = o < 4 ? rcw[k * 4 + o] : (o < 36 ? rfw[k * 32 + (o - 4)] : 0.f);
          const unsigned h = f2bf(v); const float hf = __uint_as_float(h << 16);
          rh[idx] = (bf16)h; rl[idx] = (bf16)f2bf(v - hf); } }
    { float* cs = (float*)(F.ws + WS_CS);
      for (int idx = blockIdx.x * (NWAVES * 64) + F.tid; idx < SEQ * 64; idx += F.G * NWAVES * 64) {
          const int i = idx & 63, s = idx >> 6; const float inv_freq = powf(10000.f, -(float)(2 * i) / 128.f); const float ang = (float)s * inv_freq;
          cs[2 * idx] = cosf(ang); cs[2 * idx + 1] = sinf(ang); }     SW_END(32);
}
}

__device__ __forceinline__ void p1_row(Frame& F, int row, const f32x4 (&v)[8], const LAS f32x4* wf, const LAS f32x4* par, bf16* Hb, float* logf, float* zb, const float* fbias) {
    const int b = row >> 12, s = row & 4095;
    float ss = 0.f;
#pragma unroll
    for (int j = 0; j < 8; ++j) ss += (v[j].x * v[j].x + v[j].y * v[j].y) + (v[j].z * v[j].z + v[j].w * v[j].w);
    const float rstd = rsqrtf(wave_sum(ss) * (1.f / DM) + EPS);
    float acc[8];
#pragma unroll
    for (int o = 0; o < 8; ++o) acc[o] = 0.f;
    unsigned* o4 = (unsigned*)((unsigned char*)Hb + (size_t)row * DM) + F.lane;
#pragma unroll
    for (int j = 0; j < 8; ++j) {
        const f32x4 h = v[j] * rstd * par[(b * 2) * 512 + 64 * j + F.lane] + par[(b * 2 + 1) * 512 + 64 * j + F.lane];
        o4[64 * j] = fp8x4(h.x, h.y, h.z, h.w);
#pragma unroll
        for (int i = 0; i < 4; ++i) { const f32x4 wa = wf[((j * 4 + i) * 2 + 0) * 64 + F.lane], wb = wf[((j * 4 + i) * 2 + 1) * 64 + F.lane]; const float hv = h[i];
            acc[0] = fmaf(hv, wa.x, acc[0]); acc[1] = fmaf(hv, wa.y, acc[1]); acc[2] = fmaf(hv, wa.z, acc[2]); acc[3] = fmaf(hv, wa.w, acc[3]);
            acc[4] = fmaf(hv, wb.x, acc[4]); acc[5] = fmaf(hv, wb.y, acc[5]); acc[6] = fmaf(hv, wb.z, acc[6]); acc[7] = fmaf(hv, wb.w, acc[7]); }
        asm volatile("" ::: "memory");
    }
    float z = 0.f;
#pragma unroll
    for (int o = 0; o < 8; ++o) { const float t = wave_sum(acc[o]); z = (F.lane == o) ? t : z; }
    if (F.lane < 8) { const float zz = z + fbias[F.lane];
        logf[((size_t)b * NH + F.lane) * SEQ + s] = fminf(zz, 0.f) - log1pf(expf(-fabsf(zz)));
        zb[(size_t)row * 8 + F.lane] = z; }
}
__device__ __forceinline__ void p1_prenorm(Frame& F) {
    const float* x = F.in[0]; const float* wpre = F.in[4]; const float* w_in = F.in[6]; const float* fbias = F.in[7];
    const float* mod = (const float*)(F.ws + WS_MOD);
    bf16* Hb = (bf16*)(F.ws + WS_HB); float* logf = (float*)(F.ws + WS_LOGF); float* zb = (float*)(F.ws + WS_Z);
    LAS f32x4* wf = (LAS f32x4*)F.lds;
    LAS f32x4* par = wf + 4096;
    for (int idx = F.tid; idx < 4096; idx += NWAVES * 64) { const int l = idx & 63, half = (idx >> 6) & 1, i = (idx >> 7) & 3, j = idx >> 9;
        wf[idx] = *(const f32x4*)(w_in + (size_t)(256 * j + 4 * l + i) * INC + INCM + 4 * half); }
    for (int c = F.tid; c < 1024; c += NWAVES * 64) { const int b = c >> 9, cc = c & 511; const f32x4* mb = (const f32x4*)(mod + (size_t)b * 6 * DM);
        par[(b * 2) * 512 + cc] = ((const f32x4*)wpre)[cc] * (mb[512 + cc] + 1.0f); par[(b * 2 + 1) * 512 + cc] = mb[cc]; }
    LDS_WAIT(); __syncthreads();
    int row = F.gw; if (row >= T) return;
    f32x4 va[8], vb[8];
    { const f32x4* xr = (const f32x4*)(x + (size_t)row * DM) + F.lane;
#pragma unroll
      for (int j = 0; j < 8; ++j) va[j] = xr[64 * j]; }
    for (;;) {
        const int r1 = row + F.NGW;
        if (r1 < T) { const f32x4* xr = (const f32x4*)(x + (size_t)r1 * DM) + F.lane;
#pragma unroll
            for (int j = 0; j < 8; ++j) vb[j] = xr[64 * j]; }
        p1_row(F, row, va, wf, par, Hb, logf, zb, fbias);
        if (r1 >= T) break;
        const int r2 = r1 + F.NGW;
        if (r2 < T) { const f32x4* xr = (const f32x4*)(x + (size_t)r2 * DM) + F.lane;
#pragma unroll
            for (int j = 0; j < 8; ++j) va[j] = xr[64 * j]; }
        p1_row(F, r1, vb, wf, par, Hb, logf, zb, fbias);
        if (r2 >= T) break;
        row = r2;
    }
}

struct SignalOrder : pg8::StaticOrder {
    gu32* word; pg8::Unit last;
    __device__ __forceinline__ void arm(gu32* w) { word = w; int n = 0; pg8::Unit u; while (next(n, u)) { last = u; ++n; } }
    __device__ __forceinline__ void a_ready(const pg8::Unit& u) const { if (threadIdx.x == 0 && u.pm == last.pm && u.pn == last.pn) __hip_atomic_fetch_add(word, 1u, RLX_AGENT); }
};
constexpr int EPI_SCR = RING_BYTES;
struct EpiHeads {
    static constexpr bool PERM = true, AFTER_DRAIN = false;
    bf16* base; const float* cs; const float* qn; const float* kn; LAS unsigned char* lds;
    __device__ __forceinline__ void operator()(const pg8::f32x4 (&acc)[2][2][4][2], const pg8::Unit& u, int wr, int wc, int fr, int fq) const {
        const int type = u.pn >> 2, head0 = (u.pn & 3) * 2; const int row0 = u.pm * 256 + wr * 64 + fr;
        if (type <= 1) {
            const int i0 = 16 * wc + 4 * fq; const float sc = type == 1 ? 0.08838834764831845f : 1.f;
#pragma unroll
            for (int ai = 0; ai < 2; ++ai)
#pragma unroll
                for (int m = 0; m < 4; ++m) { const int r = row0 + ai * 128 + m * 16, b = r >> 12, s = r & 4095;
                    const pg8::f32x4 c0 = *(const pg8::f32x4*)(cs + ((size_t)s * 64 + i0) * 2), c1 = *(const pg8::f32x4*)(cs + ((size_t)s * 64 + i0) * 2 + 4);
                    const float cv[4] = {c0[0], c0[2], c1[0], c1[2]}, sv[4] = {c0[1], c0[3], c1[1], c1[3]};
#pragma unroll
                    for (int bj = 0; bj < 2; ++bj) { const pg8::f32x4 x1 = acc[ai][bj][m][0], x2 = acc[ai][bj][m][1]; float o1[4], o2[4];
#pragma unroll
                        for (int j = 0; j < 4; ++j) { o1[j] = (x1[j] * cv[j] - x2[j] * sv[j]) * sc; o2[j] = (x1[j] * sv[j] + x2[j] * cv[j]) * sc; }
                        bf16* dst = base + (size_t)type * TSZ + ((size_t)((b * 8 + head0 + bj) * SEQ + s)) * HD + i0;
                        uint2 w1, w2; w1.x = pg8::cvt_pk_bf16(o1[0], o1[1]); w1.y = pg8::cvt_pk_bf16(o1[2], o1[3]); w2.x = pg8::cvt_pk_bf16(o2[0], o2[1]); w2.y = pg8::cvt_pk_bf16(o2[2], o2[3]);
                        *(uint2*)dst = w1; *(uint2*)(dst + 64) = w2; } }
            return;
        }
        float rs[2][4][2];
        if (type == 4 || type == 5) {
            LAS float* P = (LAS float*)(lds + EPI_SCR);
#pragma unroll
            for (int ai = 0; ai < 2; ++ai)
#pragma unroll
                for (int m = 0; m < 4; ++m)
#pragma unroll
                    for (int bj = 0; bj < 2; ++bj) { const pg8::f32x4 v0 = acc[ai][bj][m][0], v1 = acc[ai][bj][m][1];
                        float q = ((v0[0] * v0[0] + v0[1] * v0[1]) + (v0[2] * v0[2] + v0[3] * v0[3])) + ((v1[0] * v1[0] + v1[1] * v1[1]) + (v1[2] * v1[2] + v1[3] * v1[3]));
                        q += __shfl_xor(q, 16); q += __shfl_xor(q, 32);
                        if (fq == 0) P[((ai * 128 + wr * 64 + m * 16 + fr) * 2 + bj) * 4 + wc] = q; }
            asm volatile("s_waitcnt lgkmcnt(0)" ::: "memory"); __builtin_amdgcn_s_barrier(); asm volatile("" ::: "memory");
#pragma unroll
            for (int ai = 0; ai < 2; ++ai)
#pragma unroll
                for (int m = 0; m < 4; ++m)
#pragma unroll
                    for (int bj = 0; bj < 2; ++bj) { const pg8::f32x4 p4 = *(const LAS pg8::f32x4*)(P + ((ai * 128 + wr * 64 + m * 16 + fr) * 2 + bj) * 4);
                        rs[ai][m][bj] = rsqrtf(((p4[0] + p4[1]) + (p4[2] + p4[3])) * (1.f / 128.f) + EPS); }
            asm volatile("s_waitcnt lgkmcnt(0)" ::: "memory"); __builtin_amdgcn_s_barrier(); asm volatile("" ::: "memory");
        }
        pg8::f32x4 g0 = {1.f, 1.f, 1.f, 1.f}, g1 = {1.f, 1.f, 1.f, 1.f};
        if (type == 4 || type == 5) { const float* gp = (type == 4 ? qn : kn) + wc * 32 + 8 * fq; g0 = *(const pg8::f32x4*)gp; g1 = *(const pg8::f32x4*)(gp + 4); }
#pragma unroll
        for (int ai = 0; ai < 2; ++ai)
#pragma unroll
            for (int m = 0; m < 4; ++m) { const int r = row0 + ai * 128 + m * 16, b = r >> 12, s = r & 4095;
#pragma unroll
                for (int bj = 0; bj < 2; ++bj) { pg8::f32x4 v0 = acc[ai][bj][m][0], v1 = acc[ai][bj][m][1];
                    if (type == 4 || type == 5) { v0 = v0 * rs[ai][m][bj] * g0; v1 = v1 * rs[ai][m][bj] * g1; }
                    if (type == 3) {
#pragma unroll
                        for (int j = 0; j < 4; ++j) { v0[j] = v0[j] * __builtin_amdgcn_rcpf(1.f + __expf(-v0[j])); v1[j] = v1[j] * __builtin_amdgcn_rcpf(1.f + __expf(-v1[j])); } }
                    pg8::u32x4 w; w.x = pg8::cvt_pk_bf16(v0[0], v0[1]); w.y = pg8::cvt_pk_bf16(v0[2], v0[3]); w.z = pg8::cvt_pk_bf16(v1[0], v1[1]); w.w = pg8::cvt_pk_bf16(v1[2], v1[3]);
                    *(pg8::u32x4*)(base + (size_t)type * TSZ + ((size_t)((b * 8 + head0 + bj) * SEQ + s)) * HD + wc * 32 + 8 * fq) = w; } }
    }
};

namespace fox {
__device__ __forceinline__ int fox_tid() { int t = threadIdx.x; asm volatile("" : "+v"(t)); return t; }
typedef unsigned short bf16;
constexpr int D = 128, OLD = 2048;
constexpr bool WSKIP = false; constexpr float THR = 8.f;
constexpr float SCALE = 0.08838834764831845f;
constexpr int NW = 8, QBLK = 32, KVBLK = 64, QB = NW * QBLK;
constexpr int SHM_V = KVBLK * D * 2, SHM_K = KVBLK * D * 2;
constexpr int LDS_BYTES = 2 * SHM_V + 2 * SHM_K + NW * 64 * 4 + 2 * 64 * 4;
typedef short bf16x8 __attribute__((ext_vector_type(8)));
typedef short s16x4 __attribute__((ext_vector_type(4)));
typedef float f32x16 __attribute__((ext_vector_type(16)));
typedef float f32x4 __attribute__((ext_vector_type(4)));
typedef unsigned u32x4 __attribute__((ext_vector_type(4)));
template <class A, class Bt> struct same_t { static constexpr bool v = false; };
template <class A> struct same_t<A, A> { static constexpr bool v = true; };

#define KSWZ(row, colB) ((row) * 256 + ((colB) ^ (((row) & 7) << 4)))
#define SBAR() __builtin_amdgcn_sched_barrier(0)
__device__ __forceinline__ int v_st(int k, int c) { const int kk = (k & ~0xC) | ((k & 4) << 1) | ((k & 8) >> 1); return ((kk >> 3) * 4 + (c >> 5)) * 512 + ((kk & 7) * 32 + (c & 31)) * 2; }
__device__ __forceinline__ int v_rd_base(int lane) { return ((lane & 3) << 3) | (((lane >> 2) & 3) << 6) | (((lane >> 4) & 1) << 5) | (((lane >> 5) & 1) << 8); }
constexpr int v_rd_off(int d0, int ks, int half) { return d0 * 512 + ks * 4096 + half * 2048; }
__device__ __forceinline__ int crow(int r, int hi) { return (r & 3) + 8 * (r >> 2) + 4 * hi; }
__device__ __forceinline__ unsigned cvtpk(float lo, float hi) {
    unsigned r; asm volatile("v_cvt_pk_bf16_f32 %0, %1, %2" : "=v"(r) : "v"(lo), "v"(hi)); return r;
}
__device__ __forceinline__ bf16x8 pack8(f32x4 a, f32x4 b) {
    u32x4 w = {cvtpk(a[0], a[1]), cvtpk(a[2], a[3]), cvtpk(b[0], b[1]), cvtpk(b[2], b[3])};
    return *reinterpret_cast<bf16x8*>(&w);
}
template <class T> __device__ __forceinline__ bf16x8 load8(const T* p) {
    if constexpr (same_t<T, float>::v) { return pack8(*(const f32x4*)p, *(const f32x4*)(p + 4)); }
    else { return *reinterpret_cast<const bf16x8*>(p); }
}
__device__ __forceinline__ void mask_tile(f32x16& p0, f32x16& p1, int dq, unsigned W) {
    const float NEG = -__builtin_inff();
#pragma unroll
    for (int r = 0; r < 16; ++r) {
        const int c = (r & 3) + 8 * (r >> 2);
        if ((unsigned)(dq - c) >= W) p0[r] = NEG;
        if ((unsigned)(dq - c - 32) >= W) p1[r] = NEG;
    }
}
__device__ __forceinline__ void partialSM(f32x16& p0, f32x16& p1, float& m_reg, float& mn, float& alpha) {
    float pmax = p0[0]; for (int r = 1; r < 16; ++r) pmax = fmaxf(pmax, p0[r]); for (int r = 0; r < 16; ++r) pmax = fmaxf(pmax, p1[r]);
    { auto rr = __builtin_amdgcn_permlane32_swap(__float_as_uint(pmax), __float_as_uint(pmax), false, false);
      pmax = fmaxf(__uint_as_float(rr[0]), __uint_as_float(rr[1])); }
    constexpr float C2 = 1.4426950408889634f * SCALE;
    if (__builtin_expect(__all((pmax - m_reg) * SCALE <= THR), 1)) { mn = m_reg; alpha = 1.f; }
    else { mn = fmaxf(m_reg, pmax); alpha = __builtin_amdgcn_exp2f((m_reg - mn) * C2); m_reg = mn; }
    const float mnL = -mn * C2;
    for (int r = 0; r < 16; ++r) p0[r] = fmaf(p0[r], C2, mnL); for (int r = 0; r < 16; ++r) p1[r] = fmaf(p1[r], C2, mnL);
    for (int r = 0; r < 16; ++r) p0[r] = __builtin_amdgcn_exp2f(p0[r]);
}
__device__ __forceinline__ void finishSM(f32x16& p0, f32x16& p1, float alpha, float& l_reg, bf16x8& pa0, bf16x8& pa1, bf16x8& pa2, bf16x8& pa3) {
    for (int r = 0; r < 16; ++r) p1[r] = __builtin_amdgcn_exp2f(p1[r]);
    float ps = 0; for (int r = 0; r < 16; ++r) ps += p0[r]; for (int r = 0; r < 16; ++r) ps += p1[r];
    { auto rr = __builtin_amdgcn_permlane32_swap(__float_as_uint(ps), __float_as_uint(ps), false, false);
      ps = __uint_as_float(rr[0]) + __uint_as_float(rr[1]); }
    l_reg = l_reg * alpha + ps;
#define PK4(P, B_, OUT) do { unsigned a0 = cvtpk(P[B_+0], P[B_+1]), a1 = cvtpk(P[B_+2], P[B_+3]);                          \
        unsigned b0 = cvtpk(P[B_+4], P[B_+5]), b1 = cvtpk(P[B_+6], P[B_+7]);                                             \
        auto r0 = __builtin_amdgcn_permlane32_swap(a0, b0, false, false); auto r1 = __builtin_amdgcn_permlane32_swap(a1, b1, false, false); \
        u32x4 w = {r0[0], r1[0], r0[1], r1[1]}; OUT = *reinterpret_cast<bf16x8*>(&w); } while (0)
    PK4(p0, 0, pa0); PK4(p0, 8, pa1); PK4(p1, 0, pa2); PK4(p1, 8, pa3);
#undef PK4
}
template <int KB, bool SK>
__device__ __forceinline__ void qkt(f32x16& p0, f32x16& p1, const char* K_lds, int r32, int hi, const bf16x8* qr, bool act) {
    if (SK && !act) { const float NEG = -__builtin_inff();
#pragma unroll
        for (int r = 0; r < 16; ++r) { p0[r] = NEG; p1[r] = NEG; } return; }
    { const float* bl = (const float*)(K_lds + 2 * SHM_K + NW * 64 * 4) + KB * 64 + 4 * hi;
#pragma unroll
      for (int g = 0; g < 4; ++g) { const f32x4 b0 = *(const f32x4*)(bl + 8 * g), b1 = *(const f32x4*)(bl + 32 + 8 * g);
          p0[4 * g] = b0[0]; p0[4 * g + 1] = b0[1]; p0[4 * g + 2] = b0[2]; p0[4 * g + 3] = b0[3]; p1[4 * g] = b1[0]; p1[4 * g + 1] = b1[1]; p1[4 * g + 2] = b1[2]; p1[4 * g + 3] = b1[3]; } }
    const char* kb[4];
#pragma unroll
    for (int dd = 0; dd < 4; ++dd) kb[dd] = K_lds + KB * SHM_K + KSWZ(r32, (dd * 16 + hi * 8) * 2);
#pragma unroll
    for (int d0 = 0; d0 < 8; ++d0) { const char* a = kb[d0 & 3] + (d0 >> 2) * 128;
        bf16x8 b0 = *reinterpret_cast<const bf16x8*>(a);
        bf16x8 b1 = *reinterpret_cast<const bf16x8*>(a + 32 * 256);
        p0 = __builtin_amdgcn_mfma_f32_32x32x16_bf16(b0, qr[d0], p0, 0, 0, 0);
        p1 = __builtin_amdgcn_mfma_f32_32x32x16_bf16(b1, qr[d0], p1, 0, 0, 0); }
}
template <int VB, bool SK>
__device__ __forceinline__ void pv_tile(f32x16* o, int vb0, bf16x8 pa0, bf16x8 pa1, bf16x8 pa2, bf16x8 pa3, bool act) {
    if (SK && !act) return;
#define TRRD(dst, off) asm volatile("ds_read_b64_tr_b16 %0, %1 offset:%2" : "=&v"(dst) : "v"(vb0), "i"(off) : "memory")
#define PV_D0(d0) do { s16x4 l0, l1, l2, l3, h0, h1, h2, h3; constexpr int b_ = VB * SHM_V + v_rd_off(d0, 0, 0);     \
        TRRD(l0, b_); TRRD(h0, b_ + 2048); TRRD(l1, b_ + 4096); TRRD(h1, b_ + 6144); TRRD(l2, b_ + 8192); TRRD(h2, b_ + 10240); TRRD(l3, b_ + 12288); TRRD(h3, b_ + 14336); \
        asm volatile("s_waitcnt lgkmcnt(0)" ::: "memory"); SBAR();                 \
        o[d0] = __builtin_amdgcn_mfma_f32_32x32x16_bf16(pa0, (bf16x8){l0[0], l0[1], l0[2], l0[3], h0[0], h0[1], h0[2], h0[3]}, o[d0], 0, 0, 0);   \
        o[d0] = __builtin_amdgcn_mfma_f32_32x32x16_bf16(pa1, (bf16x8){l1[0], l1[1], l1[2], l1[3], h1[0], h1[1], h1[2], h1[3]}, o[d0], 0, 0, 0);   \
        o[d0] = __builtin_amdgcn_mfma_f32_32x32x16_bf16(pa2, (bf16x8){l2[0], l2[1], l2[2], l2[3], h2[0], h2[1], h2[2], h2[3]}, o[d0], 0, 0, 0);   \
        o[d0] = __builtin_amdgcn_mfma_f32_32x32x16_bf16(pa3, (bf16x8){l3[0], l3[1], l3[2], l3[3], h3[0], h3[1], h3[2], h3[3]}, o[d0], 0, 0, 0); } while (0)
    PV_D0(0); PV_D0(1); PV_D0(2); PV_D0(3);
#undef PV_D0
#undef TRRD
}

template <class TIn, class TOut> struct BlockRef { const TIn* Q; const TIn* K; const TIn* V; TOut* O; const float* cb; const float* onw; int P0; int jlo, jhi; float* part; };
template <class TIn> struct Seam {
    bf16x8 qr[8];
    bf16x8 st_v0, st_v1, st_k0, st_k1; float st_b; f32x4 sf0, sf1, sf2, sf3;
    f32x4 tq[16];
};
__device__ __forceinline__ int swa_jlo(int P0, int W) { const int lowk = P0 - W + 1; return lowk > 0 ? lowk / KVBLK : 0; }
#define ROW(p, k0, rr) ((p) + (size_t)((k0) + (rr)) * D + sc)
#define VMW() asm volatile("s_waitcnt vmcnt(0)" ::: "memory")
#define VMWN(n) asm volatile("s_waitcnt vmcnt(%0)" :: "i"(n) : "memory")
#define SLOAD_H(Kp, Vp, Bp, k0) do { S.st_v0 = load8<TIn>(ROW(Vp, k0, sr)); S.st_v1 = load8<TIn>(ROW(Vp, k0, 32 + sr));              \
                         S.st_k0 = load8<TIn>(ROW(Kp, k0, sr)); S.st_k1 = load8<TIn>(ROW(Kp, k0, 32 + sr)); S.st_b = (Bp)[(k0) + (tid & 63)]; } while (0)
#define SWRITE_HK(bf) do { *(bf16x8*)(K_lds + (bf) * SHM_K + kws) = S.st_k0; *(bf16x8*)(K_lds + (bf) * SHM_K + kws + 32 * 256) = S.st_k1; \
                           if (tid < 64) ((float*)(K_lds + 2 * SHM_K + NW * 64 * 4))[(bf) * 64 + tid] = S.st_b; } while (0)
#define SWRITE_HV(bf) do { *(bf16x8*)(V_lds + (bf) * SHM_V + vst0) = S.st_v0; *(bf16x8*)(V_lds + (bf) * SHM_V + vst1) = S.st_v1; } while (0)
#define SWRITE_H(bf) do { SWRITE_HV(bf); SWRITE_HK(bf); } while (0)
#define SLOAD_F(p, k0) do { S.sf0 = *(const f32x4*)ROW(p, k0, sr); S.sf1 = *(const f32x4*)(ROW(p, k0, sr) + 4);                \
                            S.sf2 = *(const f32x4*)ROW(p, k0, 32 + sr); S.sf3 = *(const f32x4*)(ROW(p, k0, 32 + sr) + 4); } while (0)
#define SWRITE_KF(bf) do { *(bf16x8*)(K_lds + (bf) * SHM_K + kws) = pack8(S.sf0, S.sf1); *(bf16x8*)(K_lds + (bf) * SHM_K + kws + 32 * 256) = pack8(S.sf2, S.sf3); } while (0)
#define SWRITE_VF(bf) do { *(bf16x8*)(V_lds + (bf) * SHM_V + vst0) = pack8(S.sf0, S.sf1); *(bf16x8*)(V_lds + (bf) * SHM_V + vst1) = pack8(S.sf2, S.sf3); } while (0)
template <class TIn, class TOut>
__device__ __forceinline__ void causal_swa_prime(const BlockRef<TIn, TOut>& cur, int W, char* lds, Seam<TIn>& S) {
    constexpr bool F32 = same_t<TIn, float>::v;
    const int tid = fox_tid(), wid = __builtin_amdgcn_readfirstlane(tid >> 6), lane = tid & 63, r32 = lane & 31, hi = lane >> 5;
    const int sr = tid >> 4, sc = (tid & 15) * 8, kws = KSWZ(sr, sc * 2); char* K_lds = lds + 2 * SHM_V;
    const int kb0 = cur.jlo * KVBLK;
    for (int d0 = 0; d0 < 8; ++d0) S.qr[d0] = load8<TIn>(cur.Q + (size_t)(wid * QBLK + r32) * D + d0 * 16 + hi * 8);
    if constexpr (F32) { SLOAD_F((const float*)cur.K, kb0); VMW(); SWRITE_KF(0); SBAR(); SLOAD_F((const float*)cur.V, kb0); }
    else { SLOAD_H(cur.K, cur.V, cur.cb, kb0); VMW(); SWRITE_HK(0); }
    __syncthreads();
}
template <class TIn, class TOut>
__device__ __forceinline__ void causal_swa_block(const BlockRef<TIn, TOut>& cur, const BlockRef<TIn, TOut>& nxt, int skv, int W, char* lds, Seam<TIn>& S) {
    constexpr bool F32 = same_t<TIn, float>::v;
    const int tid = fox_tid(), wid = __builtin_amdgcn_readfirstlane(tid >> 6), lane = tid & 63, r32 = lane & 31, hi = lane >> 5;
    const int j_lo = cur.jlo, j_hi = cur.jhi;
    const int NT = j_hi - j_lo;
    const int kbn = nxt.jlo * KVBLK;
    const int qlo = cur.P0 + wid * QBLK, qm = qlo + r32 - 4 * hi;
    char* V_lds = lds; char* K_lds = lds + 2 * SHM_V;
    float* ws = (float*)(lds + 2 * SHM_V + 2 * SHM_K) + wid * 64; float* li_l = ws, * al_l = ws + 32;
    float m_reg = -1e30f, l_reg = 0; f32x16 o[4] = {};
    const int sr = tid >> 4, sc = (tid & 15) * 8, vst0 = v_st(sr, sc), vst1 = v_st(32 + sr, sc), kws = KSWZ(sr, sc * 2);
    const int vb0 = (int)(uintptr_t)V_lds + v_rd_base(lane);
    const TIn* Kh = cur.K; const TIn* Vh = cur.V;
#define RESC(a) do { if (__any((a) < 1.f)) { if (hi == 0) al_l[r32] = (a); asm volatile("s_waitcnt lgkmcnt(0)" ::: "memory");              \
                     for (int d_ = 0; d_ < 4; ++d_) for (int r = 0; r < 16; ++r) o[d_][r] *= al_l[crow(r, hi)]; } } while (0)
#define KBASE(t) ((j_lo + (t)) * KVBLK)
#define ACT(t) (KBASE(t) <= qlo + QBLK - 1 && KBASE(t) + KVBLK - 1 >= qlo - W + 1)
#define MASKT(P0_, P1_, t) do { const int kb_ = KBASE(t); if ((!SK || ACT(t)) && (kb_ + KVBLK - 1 > qlo || kb_ <= qlo + QBLK - 1 - W)) mask_tile(P0_, P1_, qm - kb_, (unsigned)W); } while (0)
    constexpr int NQL = F32 ? 16 : 8;
    constexpr bool SK = WSKIP && !F32;
#define SEAM_K0() do { VMWN(NQL); if constexpr (F32) { SWRITE_KF(0); SBAR(); SLOAD_F((const float*)nxt.V, kbn); } else { SWRITE_HK(0); } SBAR(); } while (0)
    f32x16 pA0, pA1, pB0, pB1; float mnA, mnB, alA, alB; bf16x8 pa0, pa1, pa2, pa3;
    if constexpr (F32) { VMW(); SWRITE_VF(0); SBAR(); } else { SWRITE_HV(0); SBAR(); }
    if (NT > 1) { if constexpr (F32) SLOAD_F((const float*)Kh, KBASE(1)); else SLOAD_H(Kh, Vh, cur.cb, KBASE(1)); }
    SBAR(); qkt<0, SK>(pA0, pA1, K_lds, r32, hi, S.qr, ACT(0));
    if constexpr (F32) { if (NT > 1) { VMW(); SWRITE_KF(1); SBAR(); SLOAD_F((const float*)Vh, KBASE(1)); } }
    MASKT(pA0, pA1, 0); partialSM(pA0, pA1, m_reg, mnA, alA);
    if (NT > 1) { VMW(); if constexpr (F32) { SWRITE_VF(1); SBAR(); if (NT > 2) SLOAD_F((const float*)Kh, KBASE(2)); } else SWRITE_H(1); }
    __syncthreads();
#define HALF_STEP(PX0, PX1, mnX, alX, PY0, PY1, alY, t, KB, VB, SB) do {                                                      \
        SBAR(); qkt<KB, SK>(PX0, PX1, K_lds, r32, hi, S.qr, ACT(t));                                             \
        finishSM(PY0, PY1, alY, l_reg, pa0, pa1, pa2, pa3); SBAR();                                                           \
        if ((t) + 1 < NT) { if constexpr (F32) { VMW(); SWRITE_KF(SB); SBAR(); SLOAD_F((const float*)Vh, KBASE((t) + 1)); }  \
                            else { SLOAD_H(Kh, Vh, cur.cb, KBASE((t) + 1)); } SBAR(); }                                               \
        pv_tile<VB, SK>(o, vb0, pa0, pa1, pa2, pa3, ACT((t) - 1)); MASKT(PX0, PX1, (t)); partialSM(PX0, PX1, m_reg, mnX, alX);                                        \
        __syncthreads();                                                                                                      \
        if ((t) + 1 < NT) { VMW(); if constexpr (F32) { SWRITE_VF(SB); SBAR(); if ((t) + 2 < NT) SLOAD_F((const float*)Kh, KBASE((t) + 2)); } \
                            else { SWRITE_H(SB); } }                                                                          \
        RESC(alX); __syncthreads(); } while (0)
    for (int t = 1; t + 1 < NT; t += 2) {
        HALF_STEP(pB0, pB1, mnB, alB, pA0, pA1, alA, t, 1, 0, 0);
        HALF_STEP(pA0, pA1, mnA, alA, pB0, pB1, alB, t + 1, 0, 1, 1);
    }
    const bool even = (NT & 1) == 0;
    if (even) { SBAR(); qkt<1, SK>(pB0, pB1, K_lds, r32, hi, S.qr, ACT(NT - 1)); SBAR(); }
#define QROW(e) (nxt.Q + (size_t)(wid * QBLK + r32) * D + ((e) >> 1) * 16 + hi * 8 + ((e) & 1) * 4)
    if constexpr (F32) { SLOAD_F((const float*)nxt.K, kbn); SBAR();
#pragma unroll
        for (int e = 0; e < 8; ++e) S.tq[e] = *(const f32x4*)QROW(e); }
    else { SLOAD_H(nxt.K, nxt.V, nxt.cb, kbn); SBAR();
#pragma unroll
        for (int d0 = 0; d0 < 8; ++d0) S.qr[d0] = load8<TIn>(nxt.Q + (size_t)(wid * QBLK + r32) * D + d0 * 16 + hi * 8); }
    SBAR();
    finishSM(pA0, pA1, alA, l_reg, pa0, pa1, pa2, pa3); SBAR();
    if constexpr (F32) {
#pragma unroll
        for (int e = 8; e < 16; ++e) S.tq[e] = *(const f32x4*)QROW(e); SBAR(); }
#undef QROW
    pv_tile<0, SK>(o, vb0, pa0, pa1, pa2, pa3, ACT(even ? NT - 2 : NT - 1));
    if (even) { MASKT(pB0, pB1, NT - 1); partialSM(pB0, pB1, m_reg, mnB, alB); __syncthreads(); RESC(alB);
        finishSM(pB0, pB1, alB, l_reg, pa0, pa1, pa2, pa3); SBAR(); pv_tile<1, SK>(o, vb0, pa0, pa1, pa2, pa3, ACT(NT - 1)); }
    SBAR(); SEAM_K0();
    if (cur.part) {
        float* po = cur.part + (size_t)(wid * QBLK) * D;
#pragma unroll
        for (int r = 0; r < 16; ++r) { const int orow = crow(r, hi);
#pragma unroll
            for (int d0 = 0; d0 < 4; ++d0) po[(size_t)orow * D + d0 * 32 + r32] = o[d0][r]; }
        if (hi == 0) { float* ml = cur.part + (size_t)QB * D + (size_t)(wid * QBLK + r32) * 2; ml[0] = m_reg; ml[1] = l_reg; }
    } else {
    if (hi == 0) li_l[r32] = l_reg; asm volatile("s_waitcnt lgkmcnt(0)" ::: "memory");
    { float gw[4];
#pragma unroll
      for (int d0 = 0; d0 < 4; ++d0) gw[d0] = cur.onw[d0 * 32 + r32];
      TOut* Ow = cur.O + (size_t)(wid * QBLK) * OLD;
#pragma unroll
      for (int r = 0; r < 16; ++r) { const int orow = crow(r, hi); const float rl = __builtin_amdgcn_rcpf(li_l[orow]);
          float v[4]; float ss = 0.f;
#pragma unroll
          for (int d0 = 0; d0 < 4; ++d0) { v[d0] = o[d0][r] * rl; ss += v[d0] * v[d0]; }
          ss = half32_sum(ss);
          const float rs = rsqrtf(ss * (1.f / 128.f) + 1e-6f);
#pragma unroll
          for (int d0 = 0; d0 < 4; ++d0) { const float y = v[d0] * rs * gw[d0]; const float yn = __shfl_xor(y, 1);
              if ((r32 & 1) == 0) *(unsigned*)(Ow + (size_t)orow * OLD + d0 * 32 + r32) = cvtpk(y, yn); } } }
    }
    if constexpr (F32) {
#pragma unroll
        for (int d0 = 0; d0 < 8; ++d0) S.qr[d0] = pack8(S.tq[2 * d0], S.tq[2 * d0 + 1]); }
    __syncthreads();
#undef RESC
#undef KBASE
#undef ACT
#undef MASKT
#undef SEAM_K0
#undef HALF_STEP
}
#undef ROW
#undef VMW
#undef VMWN
#undef SLOAD_H
#undef SWRITE_HK
#undef SWRITE_HV
#undef SWRITE_H
#undef SLOAD_F
#undef SWRITE_KF
#undef SWRITE_VF


#undef KSWZ
#undef SBAR
}
constexpr size_t WS_KV = 186 * MiB;
constexpr size_t WS_SP = 218 * MiB;
constexpr size_t WS_CAT = 234 * MiB;
constexpr size_t WS_P34_END = 266 * MiB;
constexpr int CW_RETQ = 2048;
typedef short v4i16_t __attribute__((ext_vector_type(4)));
typedef float f32x16 __attribute__((ext_vector_type(16)));
constexpr int TLD = 136;
constexpr int TILE_EL = 128 * TLD;

__device__ __forceinline__ bf16x8 frag_row(const LAS bf16* X, int r0, int k0, int lane) {
    return *(const LAS bf16x8*)(X + (r0 + (lane & 31)) * TLD + k0 + 8 * (lane >> 5));
}
__device__ __forceinline__ bf16x8 frag_tr(const LAS bf16* X, int k0, int c0, int lane) {
    const int g = lane >> 4, i = lane & 15, q = i >> 2, p = i & 3, h = g >> 1;
    const LAS bf16* a = X + (k0 + 8 * h + q) * TLD + c0 + 16 * (g & 1) + 4 * p;
    const v4i16_t lo = __builtin_amdgcn_ds_read_tr16_b64_v4i16((LAS v4i16_t*)a);
    const v4i16_t hi = __builtin_amdgcn_ds_read_tr16_b64_v4i16((LAS v4i16_t*)(a + 4 * TLD));
    return (bf16x8){lo[0], lo[1], lo[2], lo[3], hi[0], hi[1], hi[2], hi[3]};
}
__device__ __forceinline__ int crow16(int r, int hi) { return (r & 3) + 8 * (r >> 2) + 4 * hi; }
__device__ __forceinline__ float bf2f(unsigned short v) { return __uint_as_float((unsigned)v << 16); }
__device__ __forceinline__ float ret_lg2(int h) { return log1pf(-exp2f(-5.f - (float)h)) * 1.4426950408889634f; }

__device__ __forceinline__ void p3_item(Frame& F, int bh, int n) {
    const int h = bh & 7, tid = F.tid, lane = F.lane, w = F.wave;
    const bf16* qkv = (const bf16*)(F.ws + WS_QKV);
    const size_t rbase = ((size_t)bh * SEQ + (size_t)n * 128) * HD;
    const bf16* RK = qkv + 1 * TSZ + rbase; const bf16* RV = qkv + 2 * TSZ + rbase;
    LAS bf16* Kz = (LAS bf16*)F.lds; LAS bf16* Vt = Kz + TILE_EL;
    const float lg2 = ret_lg2(h);
#pragma unroll
    for (int j = 0; j < 4; ++j) { const int c = tid + 512 * j, row = c >> 4, col8 = (c & 15) * 8;
        *(LAS v4u*)(Vt + row * TLD + col8) = *(const v4u*)(RV + (size_t)row * HD + col8);
        const bf16x8 k = *(const bf16x8*)(RK + (size_t)row * HD + col8); const float zeta = exp2f(lg2 * (float)(127 - row)); float kv[8];
#pragma unroll
        for (int i = 0; i < 8; ++i) kv[i] = bf2f((unsigned short)k[i]) * zeta;
        v4u o; o.x = pk2(kv[0], kv[1]); o.y = pk2(kv[2], kv[3]); o.z = pk2(kv[4], kv[5]); o.w = pk2(kv[6], kv[7]);
        *(LAS v4u*)(Kz + row * TLD + col8) = o; }
    LDS_WAIT(); __syncthreads();
    { const int db = w >> 1, eb = 2 * (w & 1), hi = lane >> 5;
      f32x16 a0 = {}, a1 = {};
#pragma unroll
      for (int kk = 0; kk < 8; ++kk) { const bf16x8 a = frag_tr(Kz, 16 * kk, 32 * db, lane), b0 = frag_tr(Vt, 16 * kk, 32 * eb, lane), b1 = frag_tr(Vt, 16 * kk, 32 * eb + 32, lane);
          a0 = __builtin_amdgcn_mfma_f32_32x32x16_bf16(a, b0, a0, 0, 0, 0); a1 = __builtin_amdgcn_mfma_f32_32x32x16_bf16(a, b1, a1, 0, 0, 0); }
      float* KV = (float*)(F.ws + WS_KV) + ((size_t)bh * 32 + n) * 16384;
#pragma unroll
      for (int r = 0; r < 16; ++r) { const int d = 32 * db + crow16(r, hi); KV[d * 128 + 32 * eb + (lane & 31)] = a0[r]; KV[d * 128 + 32 * eb + 32 + (lane & 31)] = a1[r]; } }
    LDS_WAIT(); __syncthreads();
}
__device__ __forceinline__ void p3_cumsum(Frame& F, int bh) {
    const float* lf = (const float*)(F.ws + WS_LOGF) + (size_t)bh * SEQ + 64 * F.lane; float* cb = (float*)(F.ws + WS_CB) + (size_t)bh * SEQ + 64 * F.lane;
    float tot = 0.f;
#pragma unroll 8
    for (int i = 0; i < 64; ++i) tot += lf[i];
    float incl = tot;
#pragma unroll
    for (int o = 1; o < 64; o <<= 1) { const float t = __shfl_up(incl, o); if (F.lane >= o) incl += t; }
    float run = incl - tot;
#pragma unroll 8
    for (int i = 0; i < 64; ++i) { run += lf[i]; cb[i] = -run * 11.313708498984761f; }
}
__device__ __forceinline__ void p3_phase(Frame& F) {
    if (F.wave == 0) for (int bh = blockIdx.x; bh < 16; bh += F.G) p3_cumsum(F, bh);
    for (int it = blockIdx.x; it < 512; it += F.G) p3_item(F, it >> 5, it & 31);
}
__device__ __forceinline__ void p3b_scan(Frame& F) {
    const float* KV = (const float*)(F.ws + WS_KV); bf16* SP = (bf16*)(F.ws + WS_SP);
    for (int idx = blockIdx.x * (NWAVES * 64) + F.tid; idx < 16 * 16384; idx += F.G * NWAVES * 64) {
        const int bh = idx >> 14, de = idx & 16383; const float cd = exp2f(ret_lg2(bh & 7) * 128.f);
        float st = 0.f;
        for (int n = 0; n < 32; ++n) { const size_t o = ((size_t)bh * 32 + n) * 16384 + de; SP[o] = (bf16)f2bf(st); st = st * cd + KV[o]; }
    }
}
__device__ __forceinline__ void ret_item(Frame& F, int bh, int n) {
    const int h = bh & 7, b = bh >> 3, tid = F.tid, lane = F.lane, w = F.wave, hi = lane >> 5, c32 = lane & 31;
    const bf16* qkv = (const bf16*)(F.ws + WS_QKV);
    const size_t rbase = ((size_t)bh * SEQ + (size_t)n * 128) * HD;
    const bf16* RQ = qkv + 0 * TSZ + rbase; const bf16* RK = qkv + 1 * TSZ + rbase; const bf16* RV = qkv + 2 * TSZ + rbase; const bf16* RG = qkv + 3 * TSZ + rbase;
    const bf16* SPg = (const bf16*)(F.ws + WS_SP) + ((size_t)bh * 32 + n) * 16384;
    LAS bf16* Qs = (LAS bf16*)F.lds; LAS bf16* Ks = Qs + TILE_EL; LAS bf16* Vs = Ks + TILE_EL; LAS bf16* Ss = Vs + TILE_EL;
    LAS float* st = (LAS float*)(Ss + TILE_EL);
#pragma unroll
    for (int j = 0; j < 4; ++j) { const int c = tid + 512 * j, row = c >> 4, col8 = (c & 15) * 8; const size_t go = (size_t)row * HD + col8; const int lo = row * TLD + col8;
        *(LAS v4u*)(Qs + lo) = *(const v4u*)(RQ + go); *(LAS v4u*)(Ks + lo) = *(const v4u*)(RK + go);
        *(LAS v4u*)(Vs + lo) = *(const v4u*)(RV + go); *(LAS v4u*)(Ss + lo) = *(const v4u*)(SPg + go); }
    v4u gt[4];
#pragma unroll
    for (int j = 0; j < 4; ++j) { const int c = tid + 512 * j; gt[j] = *(const v4u*)(RG + (size_t)(c >> 4) * HD + (c & 15) * 8); }
    LDS_WAIT(); __syncthreads();
    const int qb = w >> 1, cb2 = 2 * (w & 1);
    const float lg2 = ret_lg2(h);
    f32x16 s0 = {}, s1 = {};
#pragma unroll
    for (int kk = 0; kk < 8; ++kk) { const bf16x8 a = frag_row(Qs, 32 * qb, 16 * kk, lane), b0 = frag_row(Ks, 32 * cb2, 16 * kk, lane), b1 = frag_row(Ks, 32 * cb2 + 32, 16 * kk, lane);
        s0 = __builtin_amdgcn_mfma_f32_32x32x16_bf16(a, b0, s0, 0, 0, 0); s1 = __builtin_amdgcn_mfma_f32_32x32x16_bf16(a, b1, s1, 0, 0, 0); }
    const int key0 = 32 * cb2 + c32, key1 = key0 + 32;
    const float f0 = __builtin_amdgcn_exp2f(-lg2 * (float)(key0 + 1)), f1 = __builtin_amdgcn_exp2f(-lg2 * (float)(key1 + 1));
    LDS_WAIT(); __syncthreads();
#pragma unroll
    for (int r = 0; r < 16; ++r) { const int q = 32 * qb + crow16(r, hi);
        Ks[q * TLD + key0] = (bf16)f2bf(key0 <= q ? s0[r] * f0 : 0.f); Ks[q * TLD + key1] = (bf16)f2bf(key1 <= q ? s1[r] * f1 : 0.f); }
    LDS_WAIT(); __syncthreads();
    f32x16 o0 = {}, o1 = {};
#pragma unroll
    for (int kk = 0; kk < 8; ++kk) { const bf16x8 a = frag_row(Ks, 32 * qb, 16 * kk, lane), b0 = frag_tr(Vs, 16 * kk, 32 * cb2, lane), b1 = frag_tr(Vs, 16 * kk, 32 * cb2 + 32, lane);
        o0 = __builtin_amdgcn_mfma_f32_32x32x16_bf16(a, b0, o0, 0, 0, 0); o1 = __builtin_amdgcn_mfma_f32_32x32x16_bf16(a, b1, o1, 0, 0, 0); }
#pragma unroll
    for (int kk = 0; kk < 8; ++kk) { const bf16x8 a = frag_row(Qs, 32 * qb, 16 * kk, lane), b0 = frag_tr(Ss, 16 * kk, 32 * cb2, lane), b1 = frag_tr(Ss, 16 * kk, 32 * cb2 + 32, lane);
        o0 = __builtin_amdgcn_mfma_f32_32x32x16_bf16(a, b0, o0, 0, 0, 0); o1 = __builtin_amdgcn_mfma_f32_32x32x16_bf16(a, b1, o1, 0, 0, 0); }
#pragma unroll
    for (int r = 0; r < 16; ++r) { const int q = 32 * qb + crow16(r, hi); const float xi = __builtin_amdgcn_exp2f(lg2 * (float)(q + 1));
        o0[r] *= xi; o1[r] *= xi;
        float s = o0[r] + o1[r], ss = o0[r] * o0[r] + o1[r] * o1[r];
        s = half32_sum(s); ss = half32_sum(ss);
        if (c32 == 0) { st[q * 4 + (w & 1) * 2] = s; st[q * 4 + (w & 1) * 2 + 1] = ss; } }
    LDS_WAIT(); __syncthreads();
#pragma unroll
    for (int j = 0; j < 4; ++j) { const int c = tid + 512 * j, row = c >> 4, col8 = (c & 15) * 8; *(LAS v4u*)(Qs + row * TLD + col8) = gt[j]; }
    LDS_WAIT(); __syncthreads();
    { const float* gn = F.in[8] + h * 128; const float g0 = gn[key0], g1 = gn[key1];
#pragma unroll
      for (int r = 0; r < 16; ++r) { const int q = 32 * qb + crow16(r, hi);
          const float s = st[q * 4] + st[q * 4 + 2], ss = st[q * 4 + 1] + st[q * 4 + 3];
          const float mu = s * (1.f / 128.f), var = fmaxf(ss * (1.f / 128.f) - mu * mu, 0.f), rstd = rsqrtf(var + EPS);
          const float y0 = (o0[r] - mu) * rstd * g0 * bf2f(Qs[q * TLD + key0]), y1 = (o1[r] - mu) * rstd * g1 * bf2f(Qs[q * TLD + key1]);
          Ks[q * TLD + key0] = (bf16)f2bf(y0); Ks[q * TLD + key1] = (bf16)f2bf(y1); } }
    LDS_WAIT(); __syncthreads();
    { bf16* CAT = (bf16*)(F.ws + WS_CAT) + ((size_t)b * SEQ + (size_t)n * 128) * DM + h * 128;
#pragma unroll
      for (int j = 0; j < 4; ++j) { const int c = tid + 512 * j, row = c >> 4, col8 = (c & 15) * 8; *(v4u*)(CAT + (size_t)row * DM + col8) = *(const LAS v4u*)(Ks + row * TLD + col8); } }
    LDS_WAIT(); __syncthreads();
}
__device__ __forceinline__ void p4_phase(Frame& F) {
    const int bx = blockIdx.x; const int vcu = (F.G % 8 == 0) ? (bx % 8) * (F.G / 8) + bx / 8 : bx;
    const bf16* qkv = (const bf16*)(F.ws + WS_QKV);
    bf16* CAT = (bf16*)(F.ws + WS_CAT);
    for (int fb = vcu; fb < 256; fb += F.G) {
        const int bh = fb >> 4, qb = fb & 15, h = bh & 7, b = bh >> 3;
        fox::BlockRef<bf16, bf16> cur;
        cur.Q = qkv + 4 * TSZ + ((size_t)bh * SEQ + (size_t)qb * 256) * HD; cur.K = qkv + 5 * TSZ + (size_t)bh * SEQ * HD; cur.V = qkv + 6 * TSZ + (size_t)bh * SEQ * HD;
        cur.O = CAT + ((size_t)b * SEQ + (size_t)qb * 256) * DM + 1024 + h * 128; cur.cb = (const float*)(F.ws + WS_CB) + (size_t)bh * SEQ; cur.onw = F.in[11] + h * 128; cur.P0 = qb * 256;
        cur.jlo = 0; cur.jhi = 4 * qb + 4; cur.part = nullptr;
        fox::Seam<bf16> S;
        fox::causal_swa_prime<bf16, bf16>(cur, SEQ, F.ldsg, S);
        fox::causal_swa_block<bf16, bf16>(cur, cur, SEQ, SEQ, F.ldsg, S);
        asm volatile("s_waitcnt vmcnt(0)" ::: "memory");
        __syncthreads();
    }
    for (;;) {
        if (F.tid == 0) F.MISC[0] = atomicAdd((unsigned*)(F.ws + WS_CTL) + CW_RETQ, 1u);
        __syncthreads();
        const unsigned item = (unsigned)__builtin_amdgcn_readfirstlane((int)F.MISC[0]);
        __syncthreads();
        if (item >= 512u) break;
        ret_item(F, (int)(item >> 5), (int)(item & 31));
    }
}
constexpr int PADROWS = 24576;
constexpr int LTAB_OFF = LDSCTL_OFF + 1024;
constexpr int NSUB = 16, SUBCAP = ECAP / NSUB;
#define LTAB_SB(lds_) ((LAS int*)((lds_) + LTAB_OFF) + 32 + 40)
struct EpiPlain {
    static constexpr bool PERM = true, AFTER_DRAIN = false;
    bf16* O; int ldc; int ntn;
    template <class U> __device__ __forceinline__ void operator()(const pg8::f32x4 (&acc)[2][2][4][2], const U& u, int wr, int wc, int fr, int fq) const {
        const int row0 = u.pm * 256 + wr * 64 + fr, col0 = (u.pn % ntn) * 256 + wc * 32 + 8 * fq;
#pragma unroll
        for (int ai = 0; ai < 2; ++ai)
#pragma unroll
            for (int m = 0; m < 4; ++m) { bf16* rowp = O + (size_t)(row0 + ai * 128 + m * 16) * ldc + col0;
#pragma unroll
                for (int bj = 0; bj < 2; ++bj) { const pg8::f32x4 v0 = acc[ai][bj][m][0], v1 = acc[ai][bj][m][1];
                    pg8::u32x4 w; w.x = pg8::cvt_pk_bf16(v0[0], v0[1]); w.y = pg8::cvt_pk_bf16(v0[2], v0[3]); w.z = pg8::cvt_pk_bf16(v1[0], v1[1]); w.w = pg8::cvt_pk_bf16(v1[2], v1[3]);
                    *(pg8::u32x4*)(rowp + bj * 128) = w; } }
    }
};
struct EpiSwiglu {
    static constexpr bool PERM = true, AFTER_DRAIN = false;
    unsigned char* O;
    template <class U> __device__ __forceinline__ void operator()(const pg8::f32x4 (&acc)[2][2][4][2], const U& u, int wr, int wc, int fr, int fq) const {
        const int row0 = u.pm * 256 + wr * 64 + fr, col0 = (u.pn & 3) * 128 + wc * 32 + 8 * fq;
#pragma unroll
        for (int ai = 0; ai < 2; ++ai)
#pragma unroll
            for (int m = 0; m < 4; ++m) { float g[8];
#pragma unroll
                for (int n = 0; n < 2; ++n)
#pragma unroll
                    for (int i = 0; i < 4; ++i) { const float a = acc[ai][0][m][n][i], b = acc[ai][1][m][n][i]; g[4 * n + i] = a * __builtin_amdgcn_rcpf(1.f + __expf(-a)) * b; }
                uint2 w; w.x = fp8x4(g[0], g[1], g[2], g[3]); w.y = fp8x4(g[4], g[5], g[6], g[7]);
                *(uint2*)(O + (size_t)(row0 + ai * 128 + m * 16) * DE + col0) = w; }
    }
};
struct GUnit { int pm, pn, e, lt; };
template <int NJ> struct GroupedOrder {
    typedef GUnit unit_t;
    const LAS int* ts; int G, c, total;
    __device__ __forceinline__ void init(const LAS int* ts_, int G_, int c_) { ts = ts_; G = G_; c = c_; total = ts_[32] * NJ; }
    __device__ __forceinline__ bool next(int i, GUnit& u) const {
        const int L = i * G + c; if (L >= total) return false;
        const int mt = L / NJ, j = L % NJ; int e = 0;
        while (ts[e + 1] <= mt) ++e;
        u.e = e; u.lt = mt - ts[e]; u.pm = mt; u.pn = e * NJ + j; return true;
    }
    __device__ __forceinline__ void a_ready(const GUnit&) const {}
    __device__ __forceinline__ void done(const GUnit&) const {}
};
struct GatherRows { const int* list; const LAS int* cntL; const LAS int* sb;
    __device__ __forceinline__ unsigned row(const GUnit& u, int r) const { const int lr = u.lt * 256 + r; if (lr >= cntL[u.e]) return 0u;
        const LAS int* p = sb + u.e * 17; int su = 0;
#pragma unroll
        for (int st = 8; st > 0; st >>= 1) if (p[su + st] <= lr) su += st;
        return (unsigned)list[(size_t)(u.e * NSUB + su) * SUBCAP + (lr - p[su])]; } };
__device__ __forceinline__ void moe_tables(Frame& F) {
    LAS int* cntL = (LAS int*)(F.lds + LTAB_OFF); LAS int* ts = cntL + 32;
    __syncthreads();
    LAS int* sb = LTAB_SB(F.lds);
    { const int e = F.tid >> 4, su = F.tid & 15; sb[e * 17 + su + 1] = (int)__hip_atomic_load(F.ctl + F.cnt_off + 64 * F.tid, RLX_AGENT); }
    __syncthreads();
    if (F.tid < 32) { LAS int* p = sb + F.tid * 17; int a = 0; p[0] = 0; for (int su = 1; su <= 16; ++su) { a += p[su]; p[su] = a; } cntL[F.tid] = a; }
    __syncthreads();
    if (F.tid == 0) { int a = 0; for (int e = 0; e < 32; ++e) { ts[e] = a; a += (cntL[e] + 255) >> 8; } ts[32] = a; }
    __syncthreads();
}
__device__ __forceinline__ f32x4 bf4(unsigned lo, unsigned hi) { return (f32x4){__uint_as_float(lo << 16), __uint_as_float(lo & 0xffff0000u), __uint_as_float(hi << 16), __uint_as_float(hi & 0xffff0000u)}; }
constexpr int P6_PAR = 0, P6_AH = 40960, P6_AHLD = 1028, P6_RED = P6_AH + 16 * P6_AHLD * 4, P6_LG = P6_RED + 8 * 768 * 4, P6_END = P6_LG + 16 * 48 * 4;
static_assert(P6_END <= LDSCTL_OFF, "p6 LDS map");
typedef float f32x4v __attribute__((ext_vector_type(4)));
__device__ __forceinline__ void split8(const f32x4 a, const f32x4 b, bf16x8& hi, bf16x8& lo) {
    float v[8] = {a.x, a.y, a.z, a.w, b.x, b.y, b.z, b.w}; unsigned h[8], l[8];
#pragma unroll
    for (int i = 0; i < 8; ++i) { h[i] = f2bf(v[i]); l[i] = f2bf(v[i] - __uint_as_float(h[i] << 16)); }
    hi = (bf16x8){(short)h[0], (short)h[1], (short)h[2], (short)h[3], (short)h[4], (short)h[5], (short)h[6], (short)h[7]};
    lo = (bf16x8){(short)l[0], (short)l[1], (short)l[2], (short)l[3], (short)l[4], (short)l[5], (short)l[6], (short)l[7]};
}
template <int VAR>
__device__ __forceinline__ void p6_phase(Frame& F) {
    const float* x = F.in[0]; const float* wpost = F.in[5]; const float* wpre = F.in[13]; const float* rcb = F.in[16]; const float* rfb = F.in[18];
    const float* mod = (const float*)(F.ws + WS_MOD); const bf16* Yb = (const bf16*)(F.ws + WS_YB); bf16* Hb = (bf16*)(F.ws + WS_HB);
    const bf16* RWH = (const bf16*)(F.ws + WS_RWP); const bf16* RWL = RWH + 48 * DM;
    int* list = (int*)(F.ws + WS_LIST); int* SE = (int*)(F.ws + WS_SLOT); int* SPOS = SE + 2 * T; float* SW = (float*)(SPOS + 2 * T);
    LAS f32x4* PAR = (LAS f32x4*)(F.lds + P6_PAR);
    LAS float* AH = (LAS float*)(F.lds + P6_AH); LAS float* RED = (LAS float*)(F.lds + P6_RED); LAS float* LG = (LAS float*)(F.lds + P6_LG);
    const int lane = F.lane, w = F.wave;
    for (int pass = blockIdx.x; pass < T / 16; pass += F.G) {
        const int row0 = pass * 16 + 2 * w, b = (pass * 16) >> 12;
        SW_BEG(40);
        f32x4 xv[2][8];
        if (VAR >= 2) {
#pragma unroll
            for (int j = 0; j < 8; ++j) { xv[0][j] = (f32x4){1.f, 2.f, 3.f, (float)lane}; xv[1][j] = (f32x4){2.f, 2.f, 3.f, (float)j}; } }
        __syncthreads();
        { const f32x4* mb = (const f32x4*)(mod + (size_t)b * 6 * DM);
          for (int c = F.tid; c < 512; c += NWAVES * 64) { PAR[c] = mb[2 * 512 + c]; PAR[512 + c] = ((const f32x4*)wpost)[c]; PAR[1024 + c] = ((const f32x4*)wpre)[c]; PAR[1536 + c] = mb[4 * 512 + c] + 1.0f; PAR[2048 + c] = mb[3 * 512 + c]; } }
        LDS_WAIT(); __syncthreads();
#pragma unroll
        for (int rr = 0; rr < (VAR >= 2 ? 0 : 2); ++rr) {
            f32x4* outr = (f32x4*)(F.out + (size_t)(row0 + rr) * DM) + lane; unsigned* hr = (unsigned*)((unsigned char*)Hb + (size_t)(row0 + rr) * DM) + lane;
            uint2 yu[8];
            { const f32x4* xr = (const f32x4*)(x + (size_t)(row0 + rr) * DM) + lane; const uint2* yr = (const uint2*)(Yb + (size_t)(row0 + rr) * DM) + lane;
#pragma unroll
              for (int j = 0; j < 8; ++j) { xv[rr][j] = xr[64 * j]; yu[j] = yr[64 * j]; } }
            f32x4 yv[8]; float ss = 0.f;
#pragma unroll
            for (int j = 0; j < 8; ++j) { yv[j] = bf4(yu[j].x, yu[j].y); ss += (yv[j].x * yv[j].x + yv[j].y * yv[j].y) + (yv[j].z * yv[j].z + yv[j].w * yv[j].w); }
            const float rstd_y = rsqrtf(wave_sum(ss) * (1.f / DM) + EPS);
            float s2 = 0.f;
            asm volatile("" ::: "memory");
#pragma unroll
            for (int j = 0; j < 8; ++j) { const f32x4 x1 = xv[rr][j] + PAR[lane + 64 * j] * (yv[j] * rstd_y * PAR[512 + lane + 64 * j]);
                outr[64 * j] = x1; xv[rr][j] = x1; s2 += (x1.x * x1.x + x1.y * x1.y) + (x1.z * x1.z + x1.w * x1.w); }
            const float rstd = rsqrtf(wave_sum(s2) * (1.f / DM) + EPS);
            asm volatile("" ::: "memory");
#pragma unroll
            for (int j = 0; j < 8; ++j) { const f32x4 h = xv[rr][j] * rstd * PAR[1024 + lane + 64 * j] * PAR[1536 + lane + 64 * j] + PAR[2048 + lane + 64 * j];
                xv[rr][j] = h; hr[64 * j] = fp8x4(h.x, h.y, h.z, h.w); }
            asm volatile("" ::: "memory");
        }
        if (VAR == 1) continue;
        SW_END(40); SW_BEG(41);
        pg8::f32x4 acc[3] = {{0.f, 0.f, 0.f, 0.f}, {0.f, 0.f, 0.f, 0.f}, {0.f, 0.f, 0.f, 0.f}};
#pragma unroll 1
        for (int half = 0; half < 2; ++half) {
            bf16x8 bh[4][3], bl[4][3];
#pragma unroll
            for (int ks = 0; ks < 4; ++ks)
#pragma unroll
                for (int nt = 0; nt < 3; ++nt) { const size_t bo = (size_t)(nt * 16 + (lane & 15)) * DM + 1024 * half + 128 * w + 32 * ks + 8 * (lane >> 4);
                    bh[ks][nt] = *(const bf16x8*)(RWH + bo); bl[ks][nt] = *(const bf16x8*)(RWL + bo); }
            __syncthreads();
#pragma unroll
            for (int rr = 0; rr < 2; ++rr)
#pragma unroll
                for (int j = 0; j < 4; ++j) *(LAS f32x4*)(AH + (2 * w + rr) * P6_AHLD + 256 * j + 4 * lane) = half ? xv[rr][4 + j] : xv[rr][j];
            LDS_WAIT(); __syncthreads();
#pragma unroll
            for (int ks = 0; ks < (VAR == 4 ? 0 : 4); ++ks) {
                const int kh = 128 * w + 32 * ks + 8 * (lane >> 4); const LAS float* ap = AH + (lane & 15) * P6_AHLD + kh;
                const f32x4 a0 = *(const LAS f32x4*)ap, a1 = *(const LAS f32x4*)(ap + 4); bf16x8 ahi, alo; split8(a0, a1, ahi, alo);
#pragma unroll
                for (int nt = 0; nt < 3; ++nt) {
                    acc[nt] = __builtin_amdgcn_mfma_f32_16x16x32_bf16(ahi, bh[ks][nt], acc[nt], 0, 0, 0);
                    acc[nt] = __builtin_amdgcn_mfma_f32_16x16x32_bf16(alo, bh[ks][nt], acc[nt], 0, 0, 0);
                    acc[nt] = __builtin_amdgcn_mfma_f32_16x16x32_bf16(ahi, bl[ks][nt], acc[nt], 0, 0, 0); }
            }
        }
#pragma unroll
        for (int nt = 0; nt < 3; ++nt)
#pragma unroll
            for (int r = 0; r < 4; ++r) RED[w * 768 + (nt * 4 + r) * 64 + lane] = acc[nt][r];
        LDS_WAIT(); __syncthreads();
        for (int idx = F.tid; idx < 768; idx += NWAVES * 64) { float s = 0.f;
#pragma unroll
            for (int ww = 0; ww < NWAVES; ++ww) s += RED[ww * 768 + idx];
            const int nt = idx >> 8, r = (idx >> 6) & 3, l = idx & 63; LG[(4 * (l >> 4) + r) * 48 + nt * 16 + (l & 15)] = s; }
        LDS_WAIT(); __syncthreads();
        SW_END(41); SW_BEG(42);
        {
            const int r = 2 * w + (lane & 1); float lg[36];
#pragma unroll
            for (int o = 0; o < 36; ++o) lg[o] = LG[r * 48 + o] + (o < 4 ? rcb[o] : rfb[o - 4]);
            int g = 0; float mx = lg[0];
#pragma unroll
            for (int j = 1; j < 4; ++j) if (lg[j] > mx) { mx = lg[j]; g = j; }
            float den = 0.f;
#pragma unroll
            for (int j = 0; j < 4; ++j) den += expf(lg[j] - mx);
            const float gprob = 1.f / den;
            float f[8];
#pragma unroll
            for (int i = 0; i < 8; ++i) f[i] = g == 0 ? lg[4 + i] : g == 1 ? lg[12 + i] : g == 2 ? lg[20 + i] : lg[28 + i];
            int i0 = 0; float v0 = f[0];
#pragma unroll
            for (int i = 1; i < 8; ++i) if (f[i] > v0) { v0 = f[i]; i0 = i; }
            int i1 = -1; float v1 = -3.0e38f;
#pragma unroll
            for (int i = 0; i < 8; ++i) if (i != i0 && f[i] > v1) { v1 = f[i]; i1 = i; }
            const float e1 = expf(v1 - v0); const float w0 = gprob / (1.f + e1), w1 = gprob * e1 / (1.f + e1);
            if (VAR == 3) { if (lane == 0) SW[2 * (pass * 16 + r)] = w0 + w1 + (float)(g + i0 + i1); } else
            if (lane < 4) { const int slot = lane >> 1, row = pass * 16 + r, e = g * 8 + (slot ? i1 : i0);
                const int es = e * NSUB + (int)(blockIdx.x & (NSUB - 1));
                const int pos = (int)atomicAdd((unsigned*)(F.ws + WS_CTL) + F.cnt_off + 64 * es, 1u);
                list[(size_t)es * SUBCAP + pos] = row; SE[2 * row + slot] = es; SPOS[2 * row + slot] = pos; SW[2 * row + slot] = slot ? w1 : w0; }
        }
        SW_END(42);
    }
}
__device__ __forceinline__ void p9_final(Frame& F) {
    moe_tables(F);
    const LAS int* ts = (const LAS int*)(F.lds + LTAB_OFF) + 32; const LAS int* sb = LTAB_SB(F.lds);
    const float* wpost = F.in[14]; const float* mod = (const float*)(F.ws + WS_MOD); const bf16* Ys = (const bf16*)(F.ws + WS_YS);
    const int* SE = (const int*)(F.ws + WS_SLOT); const int* SPOS = SE + 2 * T; const float* SW = (const float*)(SPOS + 2 * T);
    const int lane = F.lane;
    for (int row = F.gw; row < T; row += F.NGW) {
        const int b = row >> 12;
        const int es0 = SE[2 * row], es1 = SE[2 * row + 1];
        const int r0 = ts[es0 >> 4] * 256 + sb[(es0 >> 4) * 17 + (es0 & 15)] + SPOS[2 * row], r1 = ts[es1 >> 4] * 256 + sb[(es1 >> 4) * 17 + (es1 & 15)] + SPOS[2 * row + 1]; const float w0 = SW[2 * row], w1 = SW[2 * row + 1];
        const uint2* y0 = (const uint2*)(Ys + (size_t)r0 * DM) + lane; const uint2* y1 = (const uint2*)(Ys + (size_t)r1 * DM) + lane;
        f32x4* outr = (f32x4*)(F.out + (size_t)row * DM) + lane; const f32x4* g2 = (const f32x4*)(mod + (size_t)b * 6 * DM + 5 * DM) + lane;
        f32x4 v[8]; float ss = 0.f;
#pragma unroll
        for (int j = 0; j < 8; ++j) { const uint2 a = y0[64 * j], c = y1[64 * j]; v[j] = bf4(a.x, a.y) * w0 + bf4(c.x, c.y) * w1; ss += (v[j].x * v[j].x + v[j].y * v[j].y) + (v[j].z * v[j].z + v[j].w * v[j].w); }
        const float rstd = rsqrtf(wave_sum(ss) * (1.f / DM) + EPS);
#pragma unroll
        for (int j = 0; j < 8; ++j) outr[64 * j] = outr[64 * j] + g2[64 * j] * (v[j] * rstd * ((const f32x4*)wpost)[lane + 64 * j]);
    }
}
__global__ void __launch_bounds__(NWAVES * 64, 2) mega_fwd(Args args) {
    extern __shared__ __attribute__((aligned(16))) unsigned char lds[];
    Frame F;
    F.lds = (LAS unsigned char*)lds; F.ldsg = (char*)lds;
    F.MISC = (volatile LAS unsigned*)(F.lds + MISC_OFF);
    F.tid = threadIdx.x; F.lane = F.tid & 63; F.wave = __builtin_amdgcn_readfirstlane(F.tid >> 6);
    F.G = gridDim.x; F.gw = blockIdx.x * NWAVES + F.wave; F.NGW = F.G * NWAVES;
    F.cnt_off = args.cnt_off;
    F.ws = args.ws; F.out = args.out; F.ctl = (gu32*)(args.ws + WS_CTL);
#pragma unroll
    for (int i = 0; i < 22; ++i) F.in[i] = args.in[i];
    for (int u = F.tid; u < (LDS_BYTES - LDSCTL_OFF) / 4; u += NWAVES * 64) ((LAS unsigned*)(F.lds + LDSCTL_OFF))[u] = 0u;
    __syncthreads();
    XcdBarrier bar = xcd_barrier_post((unsigned*)(F.ctl + CW_BAR), F.MISC + 8);
#ifdef SW_ID
    if (blockIdx.x == 0 && threadIdx.x == 0) sw_acc_ = 0ull;
#endif
    const int lo = args.ph_lo, hi = args.ph_hi;
#define IN(k) (lo <= (k) && (k) < hi)
#define BOTH(k) (IN(k) && IN((k) + 1))
#define GRID_BAR() xcd_barrier(bar)
#define REFRESH() do { int t_ = threadIdx.x; asm volatile("" : "+v"(t_)); F.tid = t_; F.lane = t_ & 63; F.wave = __builtin_amdgcn_readfirstlane(t_ >> 6); F.gw = blockIdx.x * NWAVES + F.wave; } while (0)
#ifdef TS_PHASE
    unsigned long long ts0_ = 0, ts1_ = 0;
#define TS_BEG(k) do { if ((k) == TS_PHASE) ts0_ = __builtin_amdgcn_s_memrealtime(); if ((k) == TS_PHASE + TS_SPAN) ts1_ = __builtin_amdgcn_s_memrealtime(); } while (0)
#else
#define TS_BEG(k) do {} while (0)
#endif
    if (IN(0)) { REFRESH(); TS_BEG(0); p0_prologue<false>(F); if (BOTH(0)) GRID_BAR(); }
    if (IN(1)) { REFRESH(); TS_BEG(1); p1_prenorm(F); if (BOTH(1)) GRID_BAR(); }
    if (IN(2)) { REFRESH(); TS_BEG(2);
        const int NG2 = (F.G == 256) ? 224 : F.G;
        if ((int)blockIdx.x < NG2) {
            pg8::Gemm g{(const bf16*)(F.ws + WS_HB), (const bf16*)(F.ws + WS_WIN), T, INCM, DM}; SignalOrder S; S.init(T, INCM, NG2, (int)blockIdx.x); S.arm(F.ctl + CW_DONE + 64 * 2);
            EpiHeads E{(bf16*)(F.ws + WS_QKV), (const float*)(F.ws + WS_CS), F.in[9], F.in[10], F.lds};
            SW_BEG(20); pg8::gemm_phase<EpiHeads, SignalOrder, true, true, pg8::IdentRows, 1>(F.lds + RING_OFF, g, S, E); SW_END(20);
        } else filler(F, 2, 1, 1u, 0u, (unsigned)N_CONV_BI);
        if (BOTH(2)) GRID_BAR();
    }
    if (IN(3)) { REFRESH(); TS_BEG(3); p3_phase(F); if (BOTH(3)) GRID_BAR(); }
    if (IN(4)) { REFRESH(); TS_BEG(4); p3b_scan(F); if (BOTH(4)) GRID_BAR(); }
    if (IN(5)) { REFRESH(); TS_BEG(5); p4_phase(F); filler(F, 5, 0, (unsigned)F.G, (unsigned)(F.G - F.G / 8), (unsigned)N_CONV_BI); if (BOTH(5)) GRID_BAR(); }
    if (IN(6)) { REFRESH(); TS_BEG(6);
        pg8::Gemm g{(const bf16*)(F.ws + WS_CAT), (const bf16*)(F.ws + WS_WOUT), T, DM, DM}; pg8::StaticOrder S; S.init(T, DM, F.G, (int)blockIdx.x);
        EpiPlain E{(bf16*)(F.ws + WS_YB), DM, 8};
        SW_BEG(21); pg8::gemm_phase<EpiPlain, pg8::StaticOrder, true, true>(F.lds + RING_OFF, g, S, E); SW_END(21);
        if (BOTH(6)) GRID_BAR();
    }
#ifdef PROBE_VARIANTS
    if (lo == 11) p6_phase<1>(F);
    if (lo == 12) p6_phase<2>(F);
    if (lo == 13) p6_phase<3>(F);
    if (lo == 14) p6_phase<4>(F);
#endif
    if (IN(7)) { REFRESH(); TS_BEG(7); p6_phase<0>(F); SW_BEG(43); filler(F, 7, 2, 0u, 0u, (unsigned)N_CONV_BI); SW_END(43); if (BOTH(7)) GRID_BAR(); }
    if (IN(8)) { REFRESH(); TS_BEG(8);
        moe_tables(F);
        pg8::Gemm g{(const bf16*)(F.ws + WS_HB), (const bf16*)(F.ws + WS_W13), PADROWS, NE * 1024, DM};
        GroupedOrder<4> S; S.init((const LAS int*)(F.lds + LTAB_OFF) + 32, F.G, (int)blockIdx.x);
        EpiSwiglu E{(unsigned char*)(F.ws + WS_GB)}; GatherRows R{(const int*)(F.ws + WS_LIST), (const LAS int*)(F.lds + LTAB_OFF), LTAB_SB(F.lds)};
        SW_BEG(22); pg8::gemm_phase<EpiSwiglu, GroupedOrder<4>, true, true, GatherRows, 1>(F.lds + RING_OFF, g, S, E, R); SW_END(22);
        if (BOTH(8)) GRID_BAR();
    }
    if (IN(9)) { REFRESH(); TS_BEG(9);
        moe_tables(F);
        pg8::Gemm g{(const bf16*)(F.ws + WS_GB), (const bf16*)(F.ws + WS_W2), PADROWS, NE * 2048, DE};
        GroupedOrder<8> S; S.init((const LAS int*)(F.lds + LTAB_OFF) + 32, F.G, (int)blockIdx.x);
        EpiPlain E{(bf16*)(F.ws + WS_YS), DM, 8};
        SW_BEG(23); pg8::gemm_phase<EpiPlain, GroupedOrder<8>, true, true, pg8::IdentRows, 1>(F.lds + RING_OFF, g, S, E); SW_END(23);
        if (BOTH(9)) GRID_BAR();
    }
    if (IN(10)) { REFRESH(); TS_BEG(10); p9_final(F); }
#ifdef SW_ID
    if (blockIdx.x == 0 && threadIdx.x == 0) { const unsigned long long te = __builtin_amdgcn_s_memrealtime(), want = 4ull * sw_acc_;
        while (__builtin_amdgcn_s_memrealtime() - te < want) __builtin_amdgcn_s_sleep(8); }
#endif
#ifdef TS_PHASE
    TS_BEG(11);
    if (blockIdx.x == 0 && threadIdx.x == 0) { const unsigned long long te = __builtin_amdgcn_s_memrealtime(), want = 4ull * (ts1_ - ts0_);
        while (__builtin_amdgcn_s_memrealtime() - te < want) __builtin_amdgcn_s_sleep(8); }
#endif
#undef IN
#undef BOTH
}

__global__ void k_adapt_proj(const bf16* __restrict__ qkv, const float* __restrict__ zb, float* __restrict__ proj) {
    const size_t i = (size_t)blockIdx.x * blockDim.x + threadIdx.x;
    if (i >= (size_t)T * INC) return;
    const int tok = (int)(i / INC), c = (int)(i % INC);
    if (c >= INCM) { proj[i] = zb[(size_t)tok * 8 + (c - INCM)]; return; }
    const int type = c >> 10, hh = (c & 1023) >> 7, d = c & 127, b = tok >> 12, s = tok & 4095;
    const unsigned v = qkv[(size_t)type * TSZ + ((size_t)((b * 8 + hh) * SEQ + s)) * HD + d];
    proj[i] = __uint_as_float(v << 16);
}

__global__ void k_adapt_cat(const bf16* __restrict__ catb, float* __restrict__ cat) {
    const size_t i = (size_t)blockIdx.x * blockDim.x + threadIdx.x;
    if (i < (size_t)T * DM) cat[i] = __uint_as_float((unsigned)catb[i] << 16);
}
extern "C" void kernel_launch(void* const* d_in, const int* in_sizes, int n_in, void* d_out, int out_size, void* d_ws, size_t ws_size, hipStream_t stream) {
    static int grid = 0;
    if (grid == 0) {
        int dev = 0, cus = 0, per_cu = 0;
        (void)hipGetDevice(&dev); (void)hipDeviceGetAttribute(&cus, hipDeviceAttributeMultiprocessorCount, dev);
        (void)hipFuncSetAttribute((const void*)mega_fwd, hipFuncAttributeMaxDynamicSharedMemorySize, LDS_BYTES);
        (void)hipOccupancyMaxActiveBlocksPerMultiprocessor(&per_cu, (const void*)mega_fwd, NWAVES * 64, LDS_BYTES);
        (void)hipGetLastError();
        if (per_cu < 1) { fprintf(stderr, "kernel_launch: occupancy query says %d blocks/CU\n", per_cu); per_cu = 1; }
        grid = cus > 0 ? cus : 256;
        if (ws_size < WS_END) fprintf(stderr, "kernel_launch: workspace too small (%zu < %zu)\n", ws_size, (size_t)WS_END);
    }
    (void)hipMemsetAsync((char*)d_ws + WS_CTL, 0, CTL_ZERO_BYTES, stream);
    Args a{};
    for (int i = 0; i < 22; ++i) a.in[i] = (const float*)d_in[i];
    a.out = (float*)d_out; a.ws = (unsigned char*)d_ws; a.ph_lo = 0; a.ph_hi = 11; a.cnt_off = CW_CNT;
    hipLaunchKernelGGL(mega_fwd, dim3(grid), dim3(NWAVES * 64), LDS_BYTES, stream, a);
}
```
